# Optimizing an MI355X kernel written in HIP

```python
import math
import jax
import jax.numpy as jnp
from jax import lax
import numpy as np

D_MODEL = 1024
BATCH = 4
SEQ = 8192
DEPTH = 1

CTX_LEN = 256
GRID_W = 64

HY_WIDTH = 512
HY_BANDS = 16
HY_EMB = 2 * HY_BANDS + 1
HY_FILTER_ORDER = 64
HY_DECAY_TARGET = 1e-2
HY_DECAY_SHORT = 0.3
HY_DECAY_LONG = 1.5

RW_HEADS = 8
RW_HEAD = 64
RW_WIDTH = RW_HEADS * RW_HEAD
LORA_W = 64
LORA_A = 64
LORA_G = 128
RW_LN_EPS = 64e-5
SCAN_DIRECTIONS = (False, True)

HY_COLS = 3 * HY_WIDTH
RW_COLS = 3 * RW_WIDTH + LORA_W + LORA_A + LORA_G
GATE_COLS = 2 * D_MODEL
IN_COLS = HY_COLS + RW_COLS + GATE_COLS
RW_SPLITS = (RW_WIDTH, 2 * RW_WIDTH, 3 * RW_WIDTH, 3 * RW_WIDTH + LORA_W, 3 * RW_WIDTH + LORA_W + LORA_A)
STATE_LO = RW_WIDTH
STATE_HI = 3 * RW_WIDTH + LORA_W + LORA_A

N_EXPERTS = 16
D_EXPERT = 2048
EC_CAPACITY = 2
NORM_EPS = 1e-6

kernel_name = 'hyena_rwkv7_ec_moe_diffusion_block'


def rmsnorm(x, g):
    x32 = x.astype(jnp.float32)
    y = x32 * lax.rsqrt(jnp.mean(x32 * x32, axis=-1, keepdims=True) + NORM_EPS)
    return y.astype(x.dtype) * g


def modulation(cvec, p):
    return jnp.split(jax.nn.silu(cvec) @ p['mod_w'] + p['mod_b'], 6, axis=-1)


def shift_prev(z):
    return jnp.pad(z, ((0, 0), (1, 0), (0, 0)))[:, :-1]


def shift_next(z):
    return jnp.pad(z, ((0, 0), (0, 1), (0, 0)))[:, 1:]


def centred_mix(z, mu):
    return z + mu[0] * (shift_prev(z) - z) + mu[1] * (shift_next(z) - z)


def heads(z):
    return z.reshape(z.shape[:-1] + (RW_HEADS, RW_HEAD))


def hyena_filter_spectrum(L, p):
    f32 = jnp.float32
    t = jnp.linspace(0.0, 1.0, L, dtype=f32)[:, None]
    ang = (2.0 * math.pi / L) * jnp.arange(L, dtype=f32)[:, None]
    bands = jnp.linspace(1e-4, HY_BANDS - 1, HY_BANDS, dtype=f32)
    feat = jnp.concatenate([t, jnp.cos(bands * ang), -jnp.sin(bands * ang)], axis=-1)
    freq = p['hy_freq'].astype(f32)
    hid = jnp.sin(freq * (feat @ p['hy_ffn_w1'].astype(f32) + p['hy_ffn_b1'].astype(f32)))
    hid = jnp.sin(freq * (hid @ p['hy_ffn_w2'].astype(f32) + p['hy_ffn_b2'].astype(f32)))
    filt = (hid @ p['hy_ffn_w3'].astype(f32)).reshape(L, 2, HY_WIDTH)
    deltas = jnp.abs(jnp.linspace(math.log(HY_DECAY_TARGET) / HY_DECAY_LONG,
                                  math.log(HY_DECAY_TARGET) / HY_DECAY_SHORT, HY_WIDTH, dtype=f32))
    filt = filt * jnp.exp(-t[:, :, None] * deltas)
    circ = jnp.concatenate([filt[:, 0], jnp.zeros((1, HY_WIDTH), f32), filt[:0:-1, 1]], axis=0)
    circ = circ / jnp.sum(jnp.abs(circ), axis=0, keepdims=True)
    return jnp.fft.rfft(circ, axis=0)


def long_conv(z, spec):
    L = z.shape[1]
    zf = jnp.fft.rfft(z.astype(jnp.float32), n=2 * L, axis=1)
    return jnp.fft.irfft(zf * spec, n=2 * L, axis=1)[:, :L].astype(z.dtype)


def hyena_branch(cols, p):
    w = p['hy_conv_w']
    u = w[0] * shift_prev(cols) + w[1] * cols + w[2] * shift_next(cols) + p['hy_conv_b']
    x0, x1, v = jnp.split(u, 3, axis=-1)
    z = v * x1
    z = long_conv(z, hyena_filter_spectrum(cols.shape[1], p)) + p['hy_bias'] * z
    return z * x0


def rwkv_direction(k, lw, la, p, d):
    w = -jax.nn.softplus(-(p['rw_w0'][d] + jnp.tanh(lw) @ p['rw_w_up'][d])) - 0.5
    decay = jnp.exp(-jnp.exp(w.astype(jnp.float32)))
    a = jax.nn.sigmoid(p['rw_a0'][d] + la @ p['rw_a_up'][d])
    kk = heads(k * p['rw_k_k']).astype(jnp.float32)
    kk = kk * lax.rsqrt(jnp.maximum(jnp.sum(kk * kk, axis=-1, keepdims=True), 1e-24))
    k_mod = heads(k * (1.0 + (a - 1.0) * p['rw_k_a']))
    return heads(decay), k_mod, -kk, kk * heads(a).astype(jnp.float32)


def rwkv_scan(decay, k, v, a_vec, b_vec, r, state0, reverse):
    emit = r is not None
    xs = (decay, k, v, a_vec, b_vec) + ((r,) if emit else ())
    xs = tuple(jnp.moveaxis(t.astype(jnp.float32), 1, 0) for t in xs)

    def step(S, inp):
        w_t, k_t, v_t, a_t, b_t = inp[:5]
        sa = jnp.einsum('bhij,bhj->bhi', S, a_t)
        S = S * w_t[:, :, None, :] + sa[..., None] * b_t[:, :, None, :] + v_t[..., None] * k_t[:, :, None, :]
        y = jnp.einsum('bhij,bhj->bhi', S, inp[5]) if emit else None
        return S, y

    S, ys = lax.scan(step, state0, xs, reverse=reverse)
    return S, (jnp.moveaxis(ys, 0, 1) if emit else None)


def head_groupnorm(y, g, b):
    y32 = y.astype(jnp.float32)
    mu = jnp.mean(y32, axis=-1, keepdims=True)
    var = jnp.mean(jnp.square(y32 - mu), axis=-1, keepdims=True)
    yn = (y32 - mu) * lax.rsqrt(var + RW_LN_EPS)
    return yn.reshape(y.shape[:-2] + (RW_WIDTH,)).astype(g.dtype) * g + b


def rwkv_branch(cols, p, states0):
    z = centred_mix(cols, p['rw_mu'])
    r, k, v, lw, la, lg = jnp.split(z, RW_SPLITS, axis=-1)
    r_h, v_h = heads(r), heads(v)
    outs, bonuses, finals = [], [], []
    for d, reverse in enumerate(SCAN_DIRECTIONS):
        decay, k_mod, a_vec, b_vec = rwkv_direction(k, lw, la, p, d)
        S, y_d = rwkv_scan(decay, k_mod, v_h, a_vec, b_vec, r_h, states0[d], reverse)
        outs.append(y_d)
        finals.append(S)
        bonuses.append(jnp.sum(r_h * k_mod * p['rw_r_k'], axis=-1, keepdims=True) * v_h)
    y = head_groupnorm(outs[0] + outs[1], p['rw_ln_g'], p['rw_ln_b'])
    y = y + (bonuses[0] + bonuses[1]).reshape(cols.shape[:-1] + (RW_WIDTH,))
    g = jax.nn.sigmoid(lg) @ p['rw_g_up']
    return y * g, finals


def rwkv_context_states(cols, p, state0):
    z = centred_mix(cols, p['rw_mu'][:, STATE_LO:STATE_HI])
    k, v, lw, la = jnp.split(z, (RW_WIDTH, 2 * RW_WIDTH, 2 * RW_WIDTH + LORA_W), axis=-1)
    v_h = heads(v)
    finals = []
    for d, reverse in enumerate(SCAN_DIRECTIONS):
        decay, k_mod, a_vec, b_vec = rwkv_direction(k, lw, la, p, d)
        S, _ = rwkv_scan(decay, k_mod, v_h, a_vec, b_vec, None, state0, reverse)
        finals.append(S)
    return finals


def token_mixer(h, p, states0):
    cols = h @ p['w_in']
    hy_cols, rw_cols, gate_cols = jnp.split(cols, (HY_COLS, HY_COLS + RW_COLS), axis=-1)
    y_hy = hyena_branch(hy_cols, p) @ p['hy_proj']
    y_rw, finals = rwkv_branch(rw_cols, p, states0)
    g_hy, g_rw = jnp.split(jax.nn.sigmoid(gate_cols), 2, axis=-1)
    mixed = (g_hy * y_hy + g_rw * (y_rw @ p['rw_proj'])) @ p['w_out']
    return mixed, finals


def expert_choice_moe(h, p):
    B, T, D = h.shape
    cap = EC_CAPACITY * T // N_EXPERTS
    affinity = jax.nn.softmax((h @ p['router_w']).astype(jnp.float32), axis=-1)
    gates, idx = lax.top_k(jnp.swapaxes(affinity, 1, 2), cap)
    xe = jax.vmap(lambda hb, ib: hb[ib])(h, idx)
    hid = jax.nn.silu(jnp.einsum('becd,edf->becf', xe, p['exp_w1'])) * jnp.einsum('becd,edf->becf', xe, p['exp_w3'])
    ye = jnp.einsum('becf,efd->becd', hid, p['exp_w2']) * gates[..., None].astype(h.dtype)
    return jax.vmap(lambda ib, yb: jnp.zeros((T, D), yb.dtype).at[ib.reshape(-1)].add(yb.reshape(-1, D)))(idx, ye)


def layer(x, ctx, c, c_ctx, p, ctx_out):
    m_lat = modulation(c[:, None, :], p)
    m_ctx = modulation(c_ctx, p)
    zero_state = jnp.zeros((ctx.shape[0], RW_HEADS, RW_HEAD, RW_HEAD), jnp.float32)
    h_ctx = rmsnorm(ctx, p['norm1_pre']) * (1.0 + m_ctx[1]) + m_ctx[0]
    if ctx_out:
        mixed_ctx, ctx_states = token_mixer(h_ctx, p, (zero_state, zero_state))
        ctx = ctx + m_ctx[2] * rmsnorm(mixed_ctx, p['norm1_post'])
        h2_ctx = rmsnorm(ctx, p['norm2_pre']) * (1.0 + m_ctx[4]) + m_ctx[3]
        ctx = ctx + m_ctx[5] * rmsnorm(expert_choice_moe(h2_ctx, p), p['norm2_post'])
    else:
        cols = h_ctx @ p['w_in'][:, HY_COLS + STATE_LO:HY_COLS + STATE_HI]
        ctx_states = rwkv_context_states(cols, p, zero_state)
    h = rmsnorm(x, p['norm1_pre']) * (1.0 + m_lat[1]) + m_lat[0]
    mixed, _ = token_mixer(h, p, ctx_states)
    x = x + m_lat[2] * rmsnorm(mixed, p['norm1_post'])
    h2 = rmsnorm(x, p['norm2_pre']) * (1.0 + m_lat[4]) + m_lat[3]
    x = x + m_lat[5] * rmsnorm(expert_choice_moe(h2, p), p['norm2_post'])
    return x, ctx


def setup_inputs(seed: int = 0) -> dict:
    key = jax.random.key(seed)
    ks = iter(jax.random.split(key, 64))
    f32 = jnp.float32

    def nrm(shape, scale=1.0):
        return scale * jax.random.normal(next(ks), shape, f32)

    def unif(shape, lo, hi):
        return jax.random.uniform(next(ks), shape, f32, lo, hi)

    L, D, E = DEPTH, D_MODEL, N_EXPERTS
    return {
        'x': nrm((BATCH, SEQ, D)),
        'c': nrm((BATCH, D)),
        'ctx': nrm((BATCH, CTX_LEN, D)),
        'c_ctx': nrm((D,)),
        'mod_w': nrm((L, D, 6 * D), 0.5 * D ** -0.5),
        'mod_b': nrm((L, 6 * D), 0.02),
        'norm1_pre': 1.0 + nrm((L, D), 0.1),
        'norm1_post': 1.0 + nrm((L, D), 0.1),
        'norm2_pre': 1.0 + nrm((L, D), 0.1),
        'norm2_post': 1.0 + nrm((L, D), 0.1),
        'w_in': nrm((L, D, IN_COLS), D ** -0.5),
        'hy_conv_w': nrm((L, 3, HY_COLS), 0.5),
        'hy_conv_b': nrm((L, HY_COLS), 0.02),
        'hy_ffn_w1': nrm((L, HY_EMB, HY_FILTER_ORDER), HY_EMB ** -0.5),
        'hy_ffn_b1': nrm((L, HY_FILTER_ORDER), 0.1),
        'hy_ffn_w2': nrm((L, HY_FILTER_ORDER, HY_FILTER_ORDER), HY_FILTER_ORDER ** -0.5),
        'hy_ffn_b2': nrm((L, HY_FILTER_ORDER), 0.1),
        'hy_ffn_w3': nrm((L, HY_FILTER_ORDER, 2 * HY_WIDTH), HY_FILTER_ORDER ** -0.5),
        'hy_freq': 1.0 + nrm((L, HY_FILTER_ORDER), 0.1),
        'hy_bias': nrm((L, HY_WIDTH), 0.5),
        'hy_proj': nrm((L, HY_WIDTH, D), HY_WIDTH ** -0.5),
        'rw_mu': unif((L, 2, RW_COLS), 0.0, 0.5),
        'rw_w0': unif((L, 2, RW_WIDTH), -6.0, 0.0),
        'rw_w_up': nrm((L, 2, LORA_W, RW_WIDTH), 0.1),
        'rw_a0': nrm((L, 2, RW_WIDTH), 0.3),
        'rw_a_up': nrm((L, 2, LORA_A, RW_WIDTH), 0.1),
        'rw_g_up': nrm((L, LORA_G, RW_WIDTH), LORA_G ** -0.5),
        'rw_k_k': 0.85 + nrm((L, RW_WIDTH), 0.1),
        'rw_k_a': 1.0 + nrm((L, RW_WIDTH), 0.1),
        'rw_r_k': nrm((L, RW_HEADS, RW_HEAD), 0.1),
        'rw_ln_g': 1.0 + nrm((L, RW_WIDTH), 0.1),
        'rw_ln_b': nrm((L, RW_WIDTH), 0.02),
        'rw_proj': nrm((L, RW_WIDTH, D), RW_WIDTH ** -0.5),
        'w_out': nrm((L, D, D), D ** -0.5),
        'router_w': nrm((L, D, E), D ** -0.5),
        'exp_w1': nrm((L, E, D, D_EXPERT), D ** -0.5),
        'exp_w3': nrm((L, E, D, D_EXPERT), D ** -0.5),
        'exp_w2': nrm((L, E, D_EXPERT, D), D_EXPERT ** -0.5),
    }


def reference(x, c, ctx, c_ctx, mod_w, mod_b, norm1_pre, norm1_post, norm2_pre, norm2_post, w_in,
              hy_conv_w, hy_conv_b, hy_ffn_w1, hy_ffn_b1, hy_ffn_w2, hy_ffn_b2, hy_ffn_w3, hy_freq,
              hy_bias, hy_proj, rw_mu, rw_w0, rw_w_up, rw_a0, rw_a_up, rw_g_up, rw_k_k, rw_k_a,
              rw_r_k, rw_ln_g, rw_ln_b, rw_proj, w_out, router_w, exp_w1, exp_w3, exp_w2):
    for l in range(DEPTH):
        p = {
            'mod_w': mod_w[l], 'mod_b': mod_b[l],
            'norm1_pre': norm1_pre[l], 'norm1_post': norm1_post[l],
            'norm2_pre': norm2_pre[l], 'norm2_post': norm2_post[l],
            'w_in': w_in[l],
            'hy_conv_w': hy_conv_w[l], 'hy_conv_b': hy_conv_b[l],
            'hy_ffn_w1': hy_ffn_w1[l], 'hy_ffn_b1': hy_ffn_b1[l],
            'hy_ffn_w2': hy_ffn_w2[l], 'hy_ffn_b2': hy_ffn_b2[l],
            'hy_ffn_w3': hy_ffn_w3[l], 'hy_freq': hy_freq[l],
            'hy_bias': hy_bias[l], 'hy_proj': hy_proj[l],
            'rw_mu': rw_mu[l], 'rw_w0': rw_w0[l], 'rw_w_up': rw_w_up[l],
            'rw_a0': rw_a0[l], 'rw_a_up': rw_a_up[l], 'rw_g_up': rw_g_up[l],
            'rw_k_k': rw_k_k[l], 'rw_k_a': rw_k_a[l], 'rw_r_k': rw_r_k[l],
            'rw_ln_g': rw_ln_g[l], 'rw_ln_b': rw_ln_b[l], 'rw_proj': rw_proj[l],
            'w_out': w_out[l], 'router_w': router_w[l],
            'exp_w1': exp_w1[l], 'exp_w3': exp_w3[l], 'exp_w2': exp_w2[l],
        }
        x, ctx = layer(x, ctx, c, c_ctx, p, l < DEPTH - 1)
    return x
```

```cpp
#include <hip/hip_runtime.h>
#include <hip/hip_cooperative_groups.h>
#include <cstdio>
#include <cstdint>
namespace cg = cooperative_groups;

#define DEV __device__ __forceinline__
typedef float f32x16 __attribute__((ext_vector_type(16)));

constexpr int kD = 1024, kB = 4, kT = 8192, kCTX = 256, kROWS = kB * kT;
constexpr int kHYW = 512, kHYC = 1536, kRWW = 512, kRWC = 1792, kINC = 5376;
constexpr int kH = 8, kE = 16, kF = 2048, kCAP = 1024;
constexpr int kCC = 1152;
constexpr int NTHR = 512;
constexpr size_t LDS_BYTES = 132 * 1024;

constexpr size_t OFF_MOD   = 0;
constexpr size_t OFF_RSTDX = OFF_MOD + 131072;
constexpr size_t OFF_RSTDC = OFF_RSTDX + 131072;
constexpr size_t OFF_RSTD2 = OFF_RSTDC + 4096;
constexpr size_t OFF_NORM  = OFF_RSTD2 + 131072;
constexpr size_t OFF_CNT   = OFF_NORM + 2048;
constexpr size_t OFF_SCTX  = OFF_CNT + 256;
constexpr size_t OFF_BS    = OFF_SCTX + 1048576;
constexpr size_t OFF_AFF   = OFF_BS + 2097152;
constexpr size_t OFF_IDX   = OFF_AFF + 2097152;
constexpr size_t OFF_GATE  = OFF_IDX + 262144;
constexpr size_t OFF_CC    = OFF_GATE + 262144;
constexpr size_t OFF_KFU   = OFF_CC + 4718592;
constexpr size_t OFF_RA    = OFF_KFU + 33554432;
constexpr size_t OFF_RB    = OFF_RA + 234881024;
constexpr size_t WS_TOTAL  = OFF_RB + 201326592;

struct Params {
  const float* in[38];
  float* out;
  char* ws;
};

enum { I_X = 0, I_C, I_CTX, I_CCTX, I_MODW, I_MODB, I_N1PRE, I_N1POST, I_N2PRE, I_N2POST, I_WIN,
       I_HCW, I_HCB, I_HW1, I_HB1, I_HW2, I_HB2, I_HW3, I_HFREQ, I_HBIAS, I_HPROJ,
       I_MU, I_W0, I_WUP, I_A0, I_AUP, I_GUP, I_KK, I_KA, I_RK, I_LNG, I_LNB, I_RWPROJ, I_WOUT, I_ROUTER,
       I_EW1, I_EW3, I_EW2 };

DEV float wave_sum(float v) {
#pragma unroll
  for (int o = 32; o > 0; o >>= 1) v += __shfl_xor(v, o);
  return v;
}
DEV float sigmoidf_(float x) { return 1.0f / (1.0f + expf(-x)); }
DEV float siluf_(float x) { return x / (1.0f + expf(-x)); }
DEV float softplusf_(float x) { return x > 20.f ? x : log1pf(expf(x)); }
DEV void sincos_cw(float x, float& sn, float& cs) {
  const float kf = rintf(x * 0.6366197723675814f);
  const int k = (int)kf;
  float r = fmaf(kf, -1.5703125f, x);
  r = fmaf(kf, -4.837512969970703125e-4f, r);
  r = fmaf(kf, -7.54978995489188216e-8f, r);
  const float r2 = r * r;
  const float sp = r + r * r2 * (-1.6666654611e-1f + r2 * (8.3321608736e-3f + r2 * (-1.9515295891e-4f)));
  const float cp = 1.0f - 0.5f * r2 + r2 * r2 * (4.166664568298827e-2f + r2 * (-1.388731625493765e-3f + r2 * 2.443315711809948e-5f));
  const float s0 = (k & 1) ? cp : sp, c0 = (k & 1) ? sp : cp;
  sn = (k & 2) ? -s0 : s0;
  cs = ((k + 1) & 2) ? -c0 : c0;
}
DEV float sin_cw(float x) { float a, b; sincos_cw(x, a, b); return a; }
DEV float4 ld4(const float* p) { return *reinterpret_cast<const float4*>(p); }

constexpr int GA_S = 132;
template <class AL, class BL, class EP>
__device__ void gemm_f32(float* lds, int M, int N, int K, const AL& al, const BL& bl, const EP& ep, int bid, int nb) {
  float* As = lds;
  float* Bs = lds + 16 * GA_S;
  const int tid = threadIdx.x, lane = tid & 63, wid = tid >> 6, wm = wid >> 1, wn = wid & 1;
  const int arow = tid >> 2, akq = (tid & 3) * 4;
  const int bk = tid >> 5, bnq = (tid & 31) * 4;
  const int tilesN = N / 128, ntiles = (M / 128) * tilesN;
  for (int tile = bid; tile < ntiles; tile += nb) {
    const int m0 = (tile / tilesN) * 128, n0 = (tile % tilesN) * 128;
    f32x16 acc0, acc1;
#pragma unroll
    for (int i = 0; i < 16; ++i) { acc0[i] = 0.f; acc1[i] = 0.f; }
    float4 ra = al(m0 + arow, akq), rb = bl(m0, bk, n0 + bnq);
    for (int k0 = 0; k0 < K; k0 += 16) {
      __syncthreads();
      As[(akq + 0) * GA_S + arow] = ra.x; As[(akq + 1) * GA_S + arow] = ra.y;
      As[(akq + 2) * GA_S + arow] = ra.z; As[(akq + 3) * GA_S + arow] = ra.w;
      *reinterpret_cast<float4*>(&Bs[bk * 128 + bnq]) = rb;
      __syncthreads();
      if (k0 + 16 < K) { ra = al(m0 + arow, k0 + 16 + akq); rb = bl(m0, k0 + 16 + bk, n0 + bnq); }
#pragma unroll
      for (int kk = 0; kk < 8; ++kk) {
        const int kr = 2 * kk + (lane >> 5);
        const float a = As[kr * GA_S + wm * 32 + (lane & 31)];
        const float b0 = Bs[kr * 128 + wn * 64 + (lane & 31)];
        const float b1 = Bs[kr * 128 + wn * 64 + 32 + (lane & 31)];
        acc0 = __builtin_amdgcn_mfma_f32_32x32x2f32(a, b0, acc0, 0, 0, 0);
        acc1 = __builtin_amdgcn_mfma_f32_32x32x2f32(a, b1, acc1, 0, 0, 0);
      }
    }
#pragma unroll
    for (int r = 0; r < 16; ++r) {
      const int row = m0 + wm * 32 + (r & 3) + 8 * (r >> 2) + 4 * (lane >> 5);
      const int col = n0 + wn * 64 + (lane & 31);
      ep(row, col, acc0[r]);
      ep(row, col + 32, acc1[r]);
    }
  }
}

struct ALoadNorm {
  const float* x; const float* rstd; const float* g; const float* mod; int rows_per_b; int fixed_mrow; int sc_off, sh_off;
  DEV float4 operator()(int row, int k) const {
    const int mr = fixed_mrow >= 0 ? fixed_mrow : row / rows_per_b;
    const float4 xv = ld4(x + (size_t)row * kD + k), gv = ld4(g + k);
    const float4 sc = ld4(mod + mr * 6144 + sc_off + k), sh = ld4(mod + mr * 6144 + sh_off + k);
    const float r = rstd[row];
    return make_float4(xv.x * r * gv.x * (1.f + sc.x) + sh.x, xv.y * r * gv.y * (1.f + sc.y) + sh.y,
                       xv.z * r * gv.z * (1.f + sc.z) + sh.z, xv.w * r * gv.w * (1.f + sc.w) + sh.w);
  }
};
struct ALoadPlain { const float* a; int lda; DEV float4 operator()(int row, int k) const { return ld4(a + (size_t)row * lda + k); } };
struct ALoadSum2 { const float* a; const float* b; int lda;
  DEV float4 operator()(int row, int k) const { const float4 u = ld4(a + (size_t)row * lda + k), v = ld4(b + (size_t)row * lda + k);
    return make_float4(u.x + v.x, u.y + v.y, u.z + v.z, u.w + v.w); } };
struct BLoadPlain { const float* b; int ldb; int coff; DEV float4 operator()(int, int k, int n) const { return ld4(b + (size_t)k * ldb + coff + n); } };
struct BLoadExpert { const float* w; int ldb; size_t estride; int e0;
  DEV float4 operator()(int m0, int k, int n) const { return ld4(w + (size_t)(e0 + m0 / 4096) * estride + (size_t)k * ldb + n); } };
struct ALoadGatherNorm {
  const float* x1; const float* rstd2; const float* g; const float* mod; const int* idx; int e0;
  DEV float4 operator()(int s, int k) const {
    const int e = e0 + s / 4096, b = (s % 4096) / 1024, c = s % 1024;
    const int row = b * kT + idx[(b * kE + e) * kCAP + c];
    const float4 xv = ld4(x1 + (size_t)row * kD + k), gv = ld4(g + k);
    const float4 sc = ld4(mod + b * 6144 + 4096 + k), sh = ld4(mod + b * 6144 + 3072 + k);
    const float r = rstd2[row];
    return make_float4(xv.x * r * gv.x * (1.f + sc.x) + sh.x, xv.y * r * gv.y * (1.f + sc.y) + sh.y,
                       xv.z * r * gv.z * (1.f + sc.z) + sh.z, xv.w * r * gv.w * (1.f + sc.w) + sh.w);
  }
};
struct EpiStore { float* c; int ldc; DEV void operator()(int r, int col, float v) const { c[(size_t)r * ldc + col] = v; } };
struct EpiSplitHyRw { float* hy; float* rw;
  DEV void operator()(int r, int col, float v) const { if (col < kHYC) hy[(size_t)r * kHYC + col] = v; else rw[(size_t)r * kRWC + col - kHYC] = v; } };
struct EpiGates { float* pre; float* tmp;
  DEV void operator()(int r, int col, float v) const { const float s = sigmoidf_(v);
    if (col < kD) pre[(size_t)r * kD + col] *= s; else tmp[(size_t)r * kD + col - kD] *= s; } };
struct EpiSilu { float* c; int ldc; DEV void operator()(int r, int col, float v) const { c[(size_t)r * ldc + col] = siluf_(v); } };
struct EpiMul { float* c; int ldc; DEV void operator()(int r, int col, float v) const { c[(size_t)r * ldc + col] *= v; } };
struct EpiScatter { float* moe; const int* idx; const float* gate; int e0;
  DEV void operator()(int s, int col, float v) const {
    const int e = e0 + s / 4096, b = (s % 4096) / 1024, c = s % 1024;
    const int o = (b * kE + e) * kCAP + c;
    atomicAdd(moe + (size_t)(b * kT + idx[o]) * kD + col, v * gate[o]);
  }
};

__device__ void phase_rstd(const float* x, const float* ctx, float* rstdx, float* rstdc, int bid, int nb) {
  const int lane = threadIdx.x & 63, wid = threadIdx.x >> 6;
  for (int row = bid * 8 + wid; row < kROWS + kB * kCTX; row += nb * 8) {
    const float* p = row < kROWS ? x + (size_t)row * kD : ctx + (size_t)(row - kROWS) * kD;
    float s = 0.f;
#pragma unroll
    for (int i = 0; i < 4; ++i) { const float4 v = ld4(p + i * 256 + lane * 4); s += v.x * v.x + v.y * v.y + v.z * v.z + v.w * v.w; }
    s = wave_sum(s);
    const float r = rsqrtf(s * (1.0f / kD) + 1e-6f);
    if (lane == 0) { if (row < kROWS) rstdx[row] = r; else rstdc[row - kROWS] = r; }
  }
}

__device__ void phase_mod(float* lds, const float* c, const float* cctx, const float* modw, const float* modb, float* mod, int bid, int nb) {
  float* sc = lds;
  float* red = lds + 5120;
  const int tid = threadIdx.x, kk = tid >> 6, nl = tid & 63;
  bool loaded = false;
  for (int item = bid; item < 96; item += nb) {
    if (!loaded) {
      for (int i = tid; i < 5120; i += NTHR) { const int v = i >> 10, k = i & 1023; const float cv = v < 4 ? c[v * kD + k] : cctx[k]; sc[i] = siluf_(cv); }
      loaded = true;
    }
    __syncthreads();
    const int n = item * 64 + nl;
    float acc[5] = {0.f, 0.f, 0.f, 0.f, 0.f};
#pragma unroll 8
    for (int k = kk * 128; k < kk * 128 + 128; ++k) {
      const float w = modw[(size_t)k * 6144 + n];
#pragma unroll
      for (int v = 0; v < 5; ++v) acc[v] += sc[v * 1024 + k] * w;
    }
#pragma unroll
    for (int v = 0; v < 5; ++v) red[(kk * 5 + v) * 64 + nl] = acc[v];
    __syncthreads();
    if (tid < 320) {
      const int v = tid >> 6;
      float s = 0.f;
#pragma unroll
      for (int q = 0; q < 8; ++q) s += red[(q * 5 + v) * 64 + nl];
      mod[v * 6144 + n] = s + modb[n];
    }
    __syncthreads();
  }
}

__device__ void phase_filter(float* lds, const Params& p, float* kfu, float* nrm, int bid, int nb) {
  float* feat = lds;
  float* h1 = lds + 32 * 33;
  float* h2 = h1 + 32 * 64;
  const float* w1 = p.in[I_HW1]; const float* b1 = p.in[I_HB1]; const float* w2 = p.in[I_HW2]; const float* b2 = p.in[I_HB2];
  const float* w3 = p.in[I_HW3]; const float* fr = p.in[I_HFREQ];
  const int tid = threadIdx.x;
  for (int item = bid; item < kT / 32; item += nb) {
    const int l0 = item * 32;
    __syncthreads();
    for (int i = tid; i < 32 * 33; i += NTHR) {
      const int pz = i / 33, f = i % 33, l = l0 + pz;
      float v;
      if (f == 0) v = (float)l / (float)(kT - 1);
      else {
        const int j = (f - 1) & 15;
        const float band = 1e-4f + (float)j * ((15.0f - 1e-4f) / 15.0f);
        const float ang = (6.283185307179586f / (float)kT) * (float)l;
        float sn, cs; sincos_cw(band * ang, sn, cs); v = f <= 16 ? cs : -sn;
      }
      feat[i] = v;
    }
    __syncthreads();
    for (int i = tid; i < 32 * 64; i += NTHR) {
      const int pz = i >> 6, o = i & 63;
      float s = b1[o];
#pragma unroll 3
      for (int f = 0; f < 33; ++f) s += feat[pz * 33 + f] * w1[f * 64 + o];
      h1[i] = sin_cw(fr[o] * s);
    }
    __syncthreads();
    for (int i = tid; i < 32 * 64; i += NTHR) {
      const int pz = i >> 6, o = i & 63;
      float s = b2[o];
#pragma unroll 4
      for (int f = 0; f < 64; ++f) s += h1[pz * 64 + f] * w2[f * 64 + o];
      h2[i] = sin_cw(fr[o] * s);
    }
    __syncthreads();
#pragma unroll 1
    for (int half = 0; half < 2; ++half) {
      const int n = tid + half * 512;
      const int c = tid;
      float wr[64];
#pragma unroll
      for (int o = 0; o < 64; ++o) wr[o] = w3[o * 1024 + n];
      const float dlo = -4.605170185988091f / 1.5f, dhi = -4.605170185988091f / 0.3f;
      const float delta = fabsf(dlo + (float)c * ((dhi - dlo) / 511.0f));
      float asum = 0.f;
#pragma unroll 1
      for (int q = 0; q < 32; ++q) {
        float a = 0.f;
#pragma unroll
        for (int o = 0; o < 64; ++o) a += h2[q * 64 + o] * wr[o];
        const int l = l0 + q;
        const float tt = (float)l / (float)(kT - 1);
        const float v = a * expf(-tt * delta);
        if (half == 0) { kfu[(size_t)(8191 + l) * 512 + c] = v; asum += fabsf(v); }
        else if (l >= 1) { kfu[(size_t)(8191 - l) * 512 + c] = v; asum += fabsf(v); }
      }
      atomicAdd(nrm + c, asum);
    }
  }
}

__device__ void rwkv_scan_block(float* lds, const Params& p, const float* cols, int ldc, int Tlen, int cR, int cK, int cV, int cLW, int cLA, int muoff,
                                int b, int h, int dir, const float* S0, float* Sout, float* Y, float* BSo) {
  float* aR = lds;            float* aK = lds + 4096;      float* aV = lds + 8192;     float* aLW = lds + 12288;
  float* aLA = lds + 16384;   float* aDEC = lds + 20480;   float* aAV = lds + 24576;   float* aBV = lds + 28672;
  const float* mu = p.in[I_MU];
  const float* w0 = p.in[I_W0] + dir * 512 + h * 64;  const float* wup = p.in[I_WUP] + (size_t)dir * 64 * 512 + h * 64;
  const float* a0 = p.in[I_A0] + dir * 512 + h * 64;  const float* aup = p.in[I_AUP] + (size_t)dir * 64 * 512 + h * 64;
  const float* kkw = p.in[I_KK] + h * 64; const float* kaw = p.in[I_KA] + h * 64; const float* rkw = p.in[I_RK] + h * 64;
  const int tid = threadIdx.x, lane = tid & 63, wid = tid >> 6;
  const int si = tid >> 3, sj = (tid & 7) * 8;
  const bool emit = cR >= 0;
  float s[8];
#pragma unroll
  for (int j = 0; j < 8; ++j) s[j] = S0 ? S0[si * 64 + sj + j] : 0.f;
  const float* base = cols + (size_t)b * Tlen * ldc;
  for (int ci = 0; ci < Tlen / 64; ++ci) {
    __syncthreads();
    for (int i = tid; i < 5 * 4096; i += NTHR) {
      const int arr = i >> 12, q = (i >> 6) & 63, j = i & 63;
      if (arr == 0 && !emit) continue;
      const int t = dir ? (Tlen - 1 - (ci * 64 + q)) : (ci * 64 + q);
      const int col = (arr == 0 ? cR + h * 64 : arr == 1 ? cK + h * 64 : arr == 2 ? cV + h * 64 : arr == 3 ? cLW : cLA) + j;
      const float cur = base[(size_t)t * ldc + col];
      const float prv = t > 0 ? base[(size_t)(t - 1) * ldc + col] : 0.f;
      const float nxt = t < Tlen - 1 ? base[(size_t)(t + 1) * ldc + col] : 0.f;
      float z = cur + mu[col + muoff] * (prv - cur) + mu[kRWC + col + muoff] * (nxt - cur);
      if (arr == 3) z = tanhf(z);
      lds[arr * 4096 + q * 64 + j] = z;
    }
    __syncthreads();
    for (int i = tid; i < 4096; i += NTHR) {
      const int q = i >> 6, j = i & 63;
      float sw = w0[j], sa = a0[j];
      for (int k = 0; k < 64; ++k) { sw += aLW[q * 64 + k] * wup[k * 512 + j]; sa += aLA[q * 64 + k] * aup[k * 512 + j]; }
      const float w = -softplusf_(-sw) - 0.5f;
      aDEC[i] = expf(-expf(w));
      aBV[i] = sigmoidf_(sa);
    }
    __syncthreads();
    for (int q = wid; q < 64; q += 8) {
      const float kraw = aK[q * 64 + lane], a = aBV[q * 64 + lane];
      const float kkv = kraw * kkw[lane];
      const float ss = wave_sum(kkv * kkv);
      const float kkn = kkv * rsqrtf(fmaxf(ss, 1e-24f));
      const float km = kraw * (1.f + (a - 1.f) * kaw[lane]);
      aAV[q * 64 + lane] = -kkn; aBV[q * 64 + lane] = kkn * a; aK[q * 64 + lane] = km;
      if (emit) {
        const float bsum = wave_sum(aR[q * 64 + lane] * km * rkw[lane]);
        const int t = dir ? (Tlen - 1 - (ci * 64 + q)) : (ci * 64 + q);
        if (lane == 0) BSo[((size_t)dir * kROWS + (size_t)b * Tlen + t) * 8 + h] = bsum;
      }
    }
    __syncthreads();
    for (int q = 0; q < 64; ++q) {
      const float4 a0v = *reinterpret_cast<const float4*>(&aAV[q * 64 + sj]), a1v = *reinterpret_cast<const float4*>(&aAV[q * 64 + sj + 4]);
      const float av[8] = {a0v.x, a0v.y, a0v.z, a0v.w, a1v.x, a1v.y, a1v.z, a1v.w};
      float sa = 0.f;
#pragma unroll
      for (int j = 0; j < 8; ++j) sa += s[j] * av[j];
      sa += __shfl_xor(sa, 1); sa += __shfl_xor(sa, 2); sa += __shfl_xor(sa, 4);
      const float vi = aV[q * 64 + si];
      float y = 0.f;
#pragma unroll
      for (int j = 0; j < 8; ++j) {
        s[j] = s[j] * aDEC[q * 64 + sj + j] + sa * aBV[q * 64 + sj + j] + vi * aK[q * 64 + sj + j];
        if (emit) y += s[j] * aR[q * 64 + sj + j];
      }
      if (emit) {
        y += __shfl_xor(y, 1); y += __shfl_xor(y, 2); y += __shfl_xor(y, 4);
        const int t = dir ? (Tlen - 1 - (ci * 64 + q)) : (ci * 64 + q);
        if ((tid & 7) == 0) Y[(size_t)dir * kROWS * 512 + ((size_t)b * Tlen + t) * 512 + h * 64 + si] = y;
      }
    }
  }
  if (Sout) {
#pragma unroll
    for (int j = 0; j < 8; ++j) Sout[si * 64 + sj + j] = s[j];
  }
}

__device__ void phase_hyprep(const Params& p, const float* hyc, float* Z, float* X0, int bid, int nb) {
  const float* cw = p.in[I_HCW]; const float* cb = p.in[I_HCB];
  for (size_t i = (size_t)bid * NTHR + threadIdx.x; i < (size_t)kROWS * 512; i += (size_t)nb * NTHR) {
    const int row = (int)(i >> 9), c = (int)(i & 511), t = row & (kT - 1);
    float u[3];
#pragma unroll
    for (int g = 0; g < 3; ++g) {
      const int col = g * 512 + c;
      const float cur = hyc[(size_t)row * kHYC + col];
      const float prv = t > 0 ? hyc[(size_t)(row - 1) * kHYC + col] : 0.f;
      const float nxt = t < kT - 1 ? hyc[(size_t)(row + 1) * kHYC + col] : 0.f;
      u[g] = cw[col] * prv + cw[kHYC + col] * cur + cw[2 * kHYC + col] * nxt + cb[col];
    }
    X0[i] = u[0];
    Z[i] = u[2] * u[1];
  }
}

__device__ void conv_item(const Params& p, int item, const float* Z, const float* X0, const float* kfu, const float* nrm, float* hyo) {
  const int lane = threadIdx.x & 63, wid = threadIdx.x >> 6;
  const int b = item >> 9, ct = (item >> 6) & 7, tt = item & 63;
  const int c = ct * 64 + lane, t0 = tt * 128 + wid * 16;
  const float* zb = Z + (size_t)b * kT * 512 + c;
  const float* kb = kfu + c;
  float acc[16], kw[31];
#pragma unroll
  for (int r = 0; r < 16; ++r) acc[r] = 0.f;
#pragma unroll
  for (int d = 0; d < 31; ++d) kw[d] = 0.f;
#pragma unroll
  for (int d = 0; d < 15; ++d) { const int lag = t0 + 1 + d; kw[d] = lag <= 8191 ? kb[(size_t)(8191 + lag) * 512] : 0.f; }
  for (int s0 = 0; s0 < kT; s0 += 16) {
#pragma unroll
    for (int d = 30; d >= 16; --d) kw[d] = kw[d - 16];
#pragma unroll
    for (int d = 0; d < 16; ++d) kw[d] = kb[(size_t)(8191 + t0 - s0 - 15 + d) * 512];
    float zv[16];
#pragma unroll
    for (int q = 0; q < 16; ++q) zv[q] = zb[(size_t)(s0 + q) * 512];
#pragma unroll
    for (int q = 0; q < 16; ++q)
#pragma unroll
      for (int r = 0; r < 16; ++r) acc[r] += kw[r - q + 15] * zv[q];
  }
  const float inv = 1.0f / nrm[c], hb = p.in[I_HBIAS][c];
#pragma unroll
  for (int r = 0; r < 16; ++r) {
    const size_t o = ((size_t)b * kT + t0 + r) * 512 + c;
    hyo[o] = (acc[r] * inv + hb * Z[o]) * X0[o];
  }
}

__device__ void phase_rwout(float* lds, const Params& p, const float* rwc, float* Y0, const float* Y1, const float* BS, int bid, int nb) {
  const int lane = threadIdx.x & 63, wid = threadIdx.x >> 6;
  float* lg = lds + wid * 128;
  const float* mu = p.in[I_MU]; const float* gup = p.in[I_GUP]; const float* lng = p.in[I_LNG]; const float* lnb = p.in[I_LNB];
  for (int row = bid * 8 + wid; row < kROWS; row += nb * 8) {
    const int t = row & (kT - 1);
    const float* cur = rwc + (size_t)row * kRWC;
    for (int i = lane; i < 128; i += 64) {
      const int col = 1664 + i;
      const float cv = cur[col], pv = t > 0 ? cur[col - kRWC] : 0.f, nv = t < kT - 1 ? cur[col + kRWC] : 0.f;
      lg[i] = sigmoidf_(cv + mu[col] * (pv - cv) + mu[kRWC + col] * (nv - cv));
    }
    __syncthreads();
    const int c0 = lane * 8, h = lane >> 3;
    float y[8], g[8];
    float sum = 0.f;
#pragma unroll
    for (int j = 0; j < 8; ++j) { y[j] = Y0[(size_t)row * 512 + c0 + j] + Y1[(size_t)row * 512 + c0 + j]; sum += y[j]; g[j] = 0.f; }
    sum += __shfl_xor(sum, 1); sum += __shfl_xor(sum, 2); sum += __shfl_xor(sum, 4);
    const float mean = sum * (1.0f / 64.0f);
    float var = 0.f;
#pragma unroll
    for (int j = 0; j < 8; ++j) { const float d = y[j] - mean; var += d * d; }
    var += __shfl_xor(var, 1); var += __shfl_xor(var, 2); var += __shfl_xor(var, 4);
    const float rs = rsqrtf(var * (1.0f / 64.0f) + 64e-5f);
    for (int i = 0; i < 128; ++i) {
      const float sg = lg[i];
      const float4 u0 = ld4(gup + i * 512 + c0), u1 = ld4(gup + i * 512 + c0 + 4);
      g[0] += sg * u0.x; g[1] += sg * u0.y; g[2] += sg * u0.z; g[3] += sg * u0.w;
      g[4] += sg * u1.x; g[5] += sg * u1.y; g[6] += sg * u1.z; g[7] += sg * u1.w;
    }
    const float bsum = BS[(size_t)row * 8 + h] + BS[((size_t)kROWS + row) * 8 + h];
#pragma unroll
    for (int j = 0; j < 8; ++j) {
      const int col = 1024 + c0 + j;
      const float cv = cur[col], pv = t > 0 ? cur[col - kRWC] : 0.f, nv = t < kT - 1 ? cur[col + kRWC] : 0.f;
      const float vm = cv + mu[col] * (pv - cv) + mu[kRWC + col] * (nv - cv);
      const float yn = (y[j] - mean) * rs * lng[c0 + j] + lnb[c0 + j];
      Y0[(size_t)row * 512 + c0 + j] = (yn + bsum * vm) * g[j];
    }
    __syncthreads();
  }
}

__device__ void phase_post(const Params& p, const float* mixed, float* x1o, float* rstd2, float* aff, const float* mod, int bid, int nb) {
  const int lane = threadIdx.x & 63, wid = threadIdx.x >> 6;
  const float* x = p.in[I_X]; const float* n1post = p.in[I_N1POST]; const float* n2pre = p.in[I_N2PRE]; const float* rw = p.in[I_ROUTER];
  for (int row = bid * 8 + wid; row < kROWS; row += nb * 8) {
    const int b = row / kT;
    float m[16], xv[16];
    float ss = 0.f;
#pragma unroll
    for (int i = 0; i < 4; ++i) { const float4 v = ld4(mixed + (size_t)row * kD + i * 256 + lane * 4);
      m[i * 4] = v.x; m[i * 4 + 1] = v.y; m[i * 4 + 2] = v.z; m[i * 4 + 3] = v.w; ss += v.x * v.x + v.y * v.y + v.z * v.z + v.w * v.w; }
    ss = wave_sum(ss);
    const float r1 = rsqrtf(ss * (1.0f / kD) + 1e-6f);
    float s2 = 0.f;
#pragma unroll
    for (int i = 0; i < 4; ++i) {
      const int k = i * 256 + lane * 4;
      const float4 xx = ld4(x + (size_t)row * kD + k), gp = ld4(n1post + k), gt = ld4(mod + b * 6144 + 2048 + k);
      xv[i * 4] = xx.x + gt.x * m[i * 4] * r1 * gp.x; xv[i * 4 + 1] = xx.y + gt.y * m[i * 4 + 1] * r1 * gp.y;
      xv[i * 4 + 2] = xx.z + gt.z * m[i * 4 + 2] * r1 * gp.z; xv[i * 4 + 3] = xx.w + gt.w * m[i * 4 + 3] * r1 * gp.w;
      *reinterpret_cast<float4*>(x1o + (size_t)row * kD + k) = make_float4(xv[i * 4], xv[i * 4 + 1], xv[i * 4 + 2], xv[i * 4 + 3]);
#pragma unroll
      for (int j = 0; j < 4; ++j) s2 += xv[i * 4 + j] * xv[i * 4 + j];
    }
    s2 = wave_sum(s2);
    const float r2 = rsqrtf(s2 * (1.0f / kD) + 1e-6f);
    if (lane == 0) rstd2[row] = r2;
    float lgt[16];
#pragma unroll
    for (int e = 0; e < 16; ++e) lgt[e] = 0.f;
#pragma unroll
    for (int i = 0; i < 4; ++i)
#pragma unroll
      for (int j = 0; j < 4; ++j) {
        const int k = i * 256 + lane * 4 + j;
        const float h2 = xv[i * 4 + j] * r2 * n2pre[k] * (1.f + mod[b * 6144 + 4096 + k]) + mod[b * 6144 + 3072 + k];
        const float4 w0 = ld4(rw + k * 16), w1 = ld4(rw + k * 16 + 4), w2 = ld4(rw + k * 16 + 8), w3 = ld4(rw + k * 16 + 12);
        lgt[0] += h2 * w0.x; lgt[1] += h2 * w0.y; lgt[2] += h2 * w0.z; lgt[3] += h2 * w0.w;
        lgt[4] += h2 * w1.x; lgt[5] += h2 * w1.y; lgt[6] += h2 * w1.z; lgt[7] += h2 * w1.w;
        lgt[8] += h2 * w2.x; lgt[9] += h2 * w2.y; lgt[10] += h2 * w2.z; lgt[11] += h2 * w2.w;
        lgt[12] += h2 * w3.x; lgt[13] += h2 * w3.y; lgt[14] += h2 * w3.z; lgt[15] += h2 * w3.w;
      }
    float mx = -1e30f;
#pragma unroll
    for (int e = 0; e < 16; ++e) { lgt[e] = wave_sum(lgt[e]); mx = fmaxf(mx, lgt[e]); }
    float den = 0.f;
#pragma unroll
    for (int e = 0; e < 16; ++e) { lgt[e] = expf(lgt[e] - mx); den += lgt[e]; }
    const float inv = 1.0f / den;
    float mine = 0.f;
#pragma unroll
    for (int e = 0; e < 16; ++e) if (lane == e) mine = lgt[e] * inv;
    if (lane < 16) aff[(size_t)row * 16 + lane] = mine;
  }
}

__device__ void phase_topk(float* lds, const float* aff, int* idx, float* gate, int bid, int nb) {
  unsigned long long* keys = reinterpret_cast<unsigned long long*>(lds);
  const int tid = threadIdx.x;
  for (int item = bid; item < kB * kE; item += nb) {
    const int b = item / kE, e = item % kE;
    __syncthreads();
    for (int t = tid; t < kT; t += NTHR) {
      const float a = aff[((size_t)b * kT + t) * 16 + e];
      keys[t] = ((unsigned long long)__float_as_uint(a) << 32) | (unsigned)(0xFFFFFFFFu - (unsigned)t);
    }
    __syncthreads();
    for (int k = 2; k <= kT; k <<= 1) {
      for (int j = k >> 1; j > 0; j >>= 1) {
        for (int i = tid; i < kT; i += NTHR) {
          const int ixj = i ^ j;
          if (ixj > i) {
            const unsigned long long a = keys[i], c = keys[ixj];
            const bool desc = (i & k) == 0;
            if (desc ? (a < c) : (a > c)) { keys[i] = c; keys[ixj] = a; }
          }
        }
        __syncthreads();
      }
    }
    for (int c = tid; c < kCAP; c += NTHR) {
      const unsigned long long kv = keys[c];
      idx[item * kCAP + c] = (int)(0xFFFFFFFFu - (unsigned)(kv & 0xFFFFFFFFull));
      gate[item * kCAP + c] = __uint_as_float((unsigned)(kv >> 32));
    }
  }
}

__device__ void phase_final(const Params& p, const float* moe, float* out, const float* mod, int bid, int nb) {
  const int lane = threadIdx.x & 63, wid = threadIdx.x >> 6;
  const float* n2post = p.in[I_N2POST];
  for (int row = bid * 8 + wid; row < kROWS; row += nb * 8) {
    const int b = row / kT;
    float4 m[4];
    float ss = 0.f;
#pragma unroll
    for (int i = 0; i < 4; ++i) { m[i] = ld4(moe + (size_t)row * kD + i * 256 + lane * 4); ss += m[i].x * m[i].x + m[i].y * m[i].y + m[i].z * m[i].z + m[i].w * m[i].w; }
    ss = wave_sum(ss);
    const float r = rsqrtf(ss * (1.0f / kD) + 1e-6f);
#pragma unroll
    for (int i = 0; i < 4; ++i) {
      const int k = i * 256 + lane * 4;
      float4 o = ld4(out + (size_t)row * kD + k);
      const float4 gp = ld4(n2post + k), gt = ld4(mod + b * 6144 + 5120 + k);
      o.x += gt.x * m[i].x * r * gp.x; o.y += gt.y * m[i].y * r * gp.y; o.z += gt.z * m[i].z * r * gp.z; o.w += gt.w * m[i].w * r * gp.w;
      *reinterpret_cast<float4*>(out + (size_t)row * kD + k) = o;
    }
  }
}

__global__ void __launch_bounds__(NTHR, 2) fwd_megakernel(Params p) {
  extern __shared__ __attribute__((aligned(16))) float lds[];
  cg::grid_group grid = cg::this_grid();
  const int bid = blockIdx.x, nb = gridDim.x;
  char* ws = p.ws;
  float* mod = (float*)(ws + OFF_MOD);   float* rstdx = (float*)(ws + OFF_RSTDX); float* rstdc = (float*)(ws + OFF_RSTDC);
  float* rstd2 = (float*)(ws + OFF_RSTD2); float* nrm = (float*)(ws + OFF_NORM);  unsigned* cnt = (unsigned*)(ws + OFF_CNT);
  float* sctx = (float*)(ws + OFF_SCTX); float* BS = (float*)(ws + OFF_BS);       float* aff = (float*)(ws + OFF_AFF);
  int* idx = (int*)(ws + OFF_IDX);       float* gate = (float*)(ws + OFF_GATE);   float* CC = (float*)(ws + OFF_CC);
  float* kfu = (float*)(ws + OFF_KFU);
  float* RA = (float*)(ws + OFF_RA);     float* RB = (float*)(ws + OFF_RB);
  float* RWCb = RA;
  float* HYCb = RB;
  float* HYO = RB;
  float* Y0 = RB + (size_t)kROWS * 512;
  float* Y1 = Y0 + (size_t)kROWS * 512;
  float* Zb = p.out;
  float* X0b = p.out + (size_t)kROWS * 512;
  float* PRE = RA;
  float* TMP = p.out;
  float* MIXED = RB;
  float* MOE = RB;
  float* HID = RA;

  phase_mod(lds, p.in[I_C], p.in[I_CCTX], p.in[I_MODW], p.in[I_MODB], mod, bid, nb);
  phase_filter(lds, p, kfu, nrm, bid, nb);
  phase_rstd(p.in[I_X], p.in[I_CTX], rstdx, rstdc, bid, nb);
  grid.sync();
  {
    ALoadNorm al{p.in[I_CTX], rstdc, p.in[I_N1PRE], mod, 1, 4, 1024, 0};
    BLoadPlain bl{p.in[I_WIN], kINC, 2048};
    EpiStore ep{CC, kCC};
    gemm_f32(lds, kB * kCTX, kCC, kD, al, bl, ep, bid, nb);
  }
  grid.sync();
  if (bid < 64) {
    const int dir = bid >> 5, b = (bid >> 3) & 3, h = bid & 7;
    rwkv_scan_block(lds, p, CC, kCC, kCTX, -1, 0, 512, 1024, 1088, 512, b, h, dir, nullptr, sctx + (size_t)bid * 4096, nullptr, nullptr);
    __syncthreads();
  }
  {
    ALoadNorm al{p.in[I_X], rstdx, p.in[I_N1PRE], mod, kT, -1, 1024, 0};
    BLoadPlain bl{p.in[I_WIN], kINC, 0};
    EpiSplitHyRw ep{HYCb, RWCb};
    gemm_f32(lds, kROWS, kHYC + kRWC, kD, al, bl, ep, bid, nb);
  }
  grid.sync();
  phase_hyprep(p, HYCb, Zb, X0b, bid, nb);
  grid.sync();
  if (bid < 64) {
    const int dir = bid >> 5, b = (bid >> 3) & 3, h = bid & 7;
    rwkv_scan_block(lds, p, RWCb, kRWC, kT, 0, 512, 1024, 1536, 1600, 0, b, h, dir, sctx + (size_t)bid * 4096, nullptr, Y0, BS);
    __syncthreads();
  }
  {
    int* sitem = reinterpret_cast<int*>(lds);
    for (;;) {
      __syncthreads();
      if (threadIdx.x == 0) *sitem = (int)atomicAdd(cnt, 1u);
      __syncthreads();
      const int item = *sitem;
      if (item >= 2048) break;
      conv_item(p, item, Zb, X0b, kfu, nrm, HYO);
    }
  }
  grid.sync();
  phase_rwout(lds, p, RWCb, Y0, Y1, BS, bid, nb);
  grid.sync();
  {
    ALoadPlain al{HYO, 512}; BLoadPlain bl{p.in[I_HPROJ], kD, 0}; EpiStore ep{PRE, kD};
    gemm_f32(lds, kROWS, kD, 512, al, bl, ep, bid, nb);
    ALoadPlain al2{Y0, 512}; BLoadPlain bl2{p.in[I_RWPROJ], kD, 0}; EpiStore ep2{TMP, kD};
    gemm_f32(lds, kROWS, kD, 512, al2, bl2, ep2, bid, nb);
  }
  grid.sync();
  {
    ALoadNorm al{p.in[I_X], rstdx, p.in[I_N1PRE], mod, kT, -1, 1024, 0};
    BLoadPlain bl{p.in[I_WIN], kINC, kHYC + kRWC};
    EpiGates ep{PRE, TMP};
    gemm_f32(lds, kROWS, 2 * kD, kD, al, bl, ep, bid, nb);
  }
  grid.sync();
  {
    ALoadSum2 al{PRE, TMP, kD}; BLoadPlain bl{p.in[I_WOUT], kD, 0}; EpiStore ep{MIXED, kD};
    gemm_f32(lds, kROWS, kD, kD, al, bl, ep, bid, nb);
  }
  grid.sync();
  phase_post(p, MIXED, p.out, rstd2, aff, mod, bid, nb);
  grid.sync();
  phase_topk(lds, aff, idx, gate, bid, nb);
  for (size_t i = (size_t)bid * NTHR + threadIdx.x; i < (size_t)kROWS * kD / 4; i += (size_t)nb * NTHR)
    reinterpret_cast<float4*>(MOE)[i] = make_float4(0.f, 0.f, 0.f, 0.f);
  grid.sync();
  for (int eg = 0; eg < 4; ++eg) {
    ALoadGatherNorm al{p.out, rstd2, p.in[I_N2PRE], mod, idx, eg * 4};
    {
      BLoadExpert bl{p.in[I_EW1], kF, (size_t)kD * kF, eg * 4}; EpiSilu ep{HID, kF};
      gemm_f32(lds, 16384, kF, kD, al, bl, ep, bid, nb);
    }
    grid.sync();
    {
      BLoadExpert bl{p.in[I_EW3], kF, (size_t)kD * kF, eg * 4}; EpiMul ep{HID, kF};
      gemm_f32(lds, 16384, kF, kD, al, bl, ep, bid, nb);
    }
    grid.sync();
    {
      ALoadPlain al2{HID, kF}; BLoadExpert bl{p.in[I_EW2], kD, (size_t)kF * kD, eg * 4}; EpiScatter ep{MOE, idx, gate, eg * 4};
      gemm_f32(lds, 16384, kD, kF, al2, bl, ep, bid, nb);
    }
    grid.sync();
  }
  phase_final(p, MOE, p.out, mod, bid, nb);
}

extern "C" void kernel_launch(void* const* d_in, const int* in_sizes, int n_in, void* d_out, int out_size, void* d_ws, size_t ws_size,
                              hipStream_t stream) {
  static int grid_blocks = 0;
  if (!grid_blocks) {
    int dev = 0, cus = 0, per_cu = 0;
    hipGetDevice(&dev);
    hipDeviceGetAttribute(&cus, hipDeviceAttributeMultiprocessorCount, dev);
    hipFuncSetAttribute((const void*)fwd_megakernel, hipFuncAttributeMaxDynamicSharedMemorySize, (int)LDS_BYTES);
    hipOccupancyMaxActiveBlocksPerMultiprocessor(&per_cu, fwd_megakernel, NTHR, LDS_BYTES);
    if (per_cu < 1) per_cu = 1;
    if (per_cu > 1) per_cu = 1;
    grid_blocks = cus * per_cu;
  }
  Params p{};
  for (int i = 0; i < 38; ++i) p.in[i] = (const float*)d_in[i];
  p.out = (float*)d_out;
  p.ws = (char*)d_ws;
  hipMemsetAsync((char*)d_ws + OFF_NORM, 0, 2048 + 256, stream);
  void* args[] = {&p};
  hipError_t e = hipLaunchCooperativeKernel((void*)fwd_megakernel, dim3(grid_blocks), dim3(NTHR), args, LDS_BYTES, stream);
  if (e != hipSuccess) fprintf(stderr, "cooperative launch failed: %s (grid %d)\n", hipGetErrorString(e), grid_blocks);
}
```

```cpp
#include <hip/hip_runtime.h>
#include <hip/hip_cooperative_groups.h>
#include <cstdio>
#include <cstdint>
namespace cg = cooperative_groups;

#define DEV __device__ __forceinline__
typedef float f32x16 __attribute__((ext_vector_type(16)));

constexpr int kD = 1024, kB = 4, kT = 8192, kCTX = 256, kROWS = kB * kT;
constexpr int kHYW = 512, kHYC = 1536, kRWW = 512, kRWC = 1792, kINC = 5376;
constexpr int kH = 8, kE = 16, kF = 2048, kCAP = 1024;
constexpr int kCC = 1152;
constexpr int NTHR = 512;
constexpr size_t LDS_BYTES = 132 * 1024;

constexpr size_t OFF_MOD   = 0;
constexpr size_t OFF_RSTDX = OFF_MOD + 131072;
constexpr size_t OFF_RSTDC = OFF_RSTDX + 131072;
constexpr size_t OFF_RSTD2 = OFF_RSTDC + 4096;
constexpr size_t OFF_NORM  = OFF_RSTD2 + 131072;
constexpr size_t OFF_CNT   = OFF_NORM + 2048;
constexpr size_t OFF_SCTX  = OFF_CNT + 256;
constexpr size_t OFF_BS    = OFF_SCTX + 1048576;
constexpr size_t OFF_AFF   = OFF_BS + 2097152;
constexpr size_t OFF_IDX   = OFF_AFF + 2097152;
constexpr size_t OFF_GATE  = OFF_IDX + 262144;
constexpr size_t OFF_CC    = OFF_GATE + 262144;
constexpr size_t OFF_KFU   = OFF_CC + 4718592;
constexpr size_t OFF_RA    = OFF_KFU + 33554432;
constexpr size_t OFF_RB    = OFF_RA + 234881024;
constexpr size_t OFF_WINT  = OFF_RB + 201326592;
constexpr size_t OFF_HB    = OFF_WINT + 11010048;
constexpr size_t WS_TOTAL  = OFF_HB + 67108864;

struct Params {
  const float* in[38];
  float* out;
  char* ws;
};

enum { I_X = 0, I_C, I_CTX, I_CCTX, I_MODW, I_MODB, I_N1PRE, I_N1POST, I_N2PRE, I_N2POST, I_WIN,
       I_HCW, I_HCB, I_HW1, I_HB1, I_HW2, I_HB2, I_HW3, I_HFREQ, I_HBIAS, I_HPROJ,
       I_MU, I_W0, I_WUP, I_A0, I_AUP, I_GUP, I_KK, I_KA, I_RK, I_LNG, I_LNB, I_RWPROJ, I_WOUT, I_ROUTER,
       I_EW1, I_EW3, I_EW2 };

DEV float wave_sum(float v) {
#pragma unroll
  for (int o = 32; o > 0; o >>= 1) v += __shfl_xor(v, o);
  return v;
}
DEV float sigmoidf_(float x) { return 1.0f / (1.0f + expf(-x)); }
DEV float siluf_(float x) { return x / (1.0f + expf(-x)); }
DEV float softplusf_(float x) { return x > 20.f ? x : log1pf(expf(x)); }
DEV void sincos_cw(float x, float& sn, float& cs) {
  const float kf = rintf(x * 0.6366197723675814f);
  const int k = (int)kf;
  float r = fmaf(kf, -1.5703125f, x);
  r = fmaf(kf, -4.837512969970703125e-4f, r);
  r = fmaf(kf, -7.54978995489188216e-8f, r);
  const float r2 = r * r;
  const float sp = r + r * r2 * (-1.6666654611e-1f + r2 * (8.3321608736e-3f + r2 * (-1.9515295891e-4f)));
  const float cp = 1.0f - 0.5f * r2 + r2 * r2 * (4.166664568298827e-2f + r2 * (-1.388731625493765e-3f + r2 * 2.443315711809948e-5f));
  const float s0 = (k & 1) ? cp : sp, c0 = (k & 1) ? sp : cp;
  sn = (k & 2) ? -s0 : s0;
  cs = ((k + 1) & 2) ? -c0 : c0;
}
DEV float sin_cw(float x) { float a, b; sincos_cw(x, a, b); return a; }
DEV float4 ld4(const float* p) { return *reinterpret_cast<const float4*>(p); }

constexpr int GA_S = 132;
template <class AL, class BL, class EP>
__device__ void gemm_f32(float* lds, int M, int N, int K, const AL& al, const BL& bl, const EP& ep, int bid, int nb) {
  float* As = lds;
  float* Bs = lds + 16 * GA_S;
  const int tid = threadIdx.x, lane = tid & 63, wid = tid >> 6, wm = wid >> 1, wn = wid & 1;
  const int arow = tid >> 2, akq = (tid & 3) * 4;
  const int bk = tid >> 5, bnq = (tid & 31) * 4;
  const int tilesN = N / 128, ntiles = (M / 128) * tilesN;
  for (int tile = bid; tile < ntiles; tile += nb) {
    const int m0 = (tile / tilesN) * 128, n0 = (tile % tilesN) * 128;
    f32x16 acc0, acc1;
#pragma unroll
    for (int i = 0; i < 16; ++i) { acc0[i] = 0.f; acc1[i] = 0.f; }
    float4 ra = al(m0 + arow, akq), rb = bl(m0, bk, n0 + bnq);
    for (int k0 = 0; k0 < K; k0 += 16) {
      __syncthreads();
      As[(akq + 0) * GA_S + arow] = ra.x; As[(akq + 1) * GA_S + arow] = ra.y;
      As[(akq + 2) * GA_S + arow] = ra.z; As[(akq + 3) * GA_S + arow] = ra.w;
      *reinterpret_cast<float4*>(&Bs[bk * 128 + bnq]) = rb;
      __syncthreads();
      if (k0 + 16 < K) { ra = al(m0 + arow, k0 + 16 + akq); rb = bl(m0, k0 + 16 + bk, n0 + bnq); }
#pragma unroll
      for (int kk = 0; kk < 8; ++kk) {
        const int kr = 2 * kk + (lane >> 5);
        const float a = As[kr * GA_S + wm * 32 + (lane & 31)];
        const float b0 = Bs[kr * 128 + wn * 64 + (lane & 31)];
        const float b1 = Bs[kr * 128 + wn * 64 + 32 + (lane & 31)];
        acc0 = __builtin_amdgcn_mfma_f32_32x32x2f32(a, b0, acc0, 0, 0, 0);
        acc1 = __builtin_amdgcn_mfma_f32_32x32x2f32(a, b1, acc1, 0, 0, 0);
      }
    }
#pragma unroll
    for (int r = 0; r < 16; ++r) {
      const int row = m0 + wm * 32 + (r & 3) + 8 * (r >> 2) + 4 * (lane >> 5);
      const int col = n0 + wn * 64 + (lane & 31);
      ep(row, col, acc0[r]);
      ep(row, col + 32, acc1[r]);
    }
  }
}


namespace pg8 {
#define PG8_LAS __attribute__((address_space(3)))
typedef unsigned short bf16_t;
typedef short bf16x8 __attribute__((ext_vector_type(8)));
typedef float f32x4 __attribute__((ext_vector_type(4)));
typedef unsigned u32x4 __attribute__((ext_vector_type(4)));
typedef unsigned u32x2 __attribute__((ext_vector_type(2)));
constexpr int BM = 256, BK = 64, HALF = 128, HTB = HALF * BK * 2, STAGE_BYTES = 8 * HTB, NXCD = 8, WGM = 8;
__host__ __device__ __forceinline__ int lds_byte(int r, int c) { const int st = (r >> 4) * 2 + (c >> 5), rr = r & 15, cc = c & 31, ob = rr * 64 + cc * 2; return st * 1024 + (ob ^ (((ob >> 9) & 1) << 5)); }
__host__ __device__ __forceinline__ void stage_rc(int b, int& R, int& C) { const int st = b / 1024, sb = b % 1024, swz = sb ^ (((sb >> 9) & 1) << 5); R = (st >> 1) * 16 + swz / 64; C = (st & 1) * 32 + (swz % 64) / 2; }
__host__ __device__ __forceinline__ int perm32(int rho) { const int n = rho >> 4, i = rho & 15; return 8 * (i >> 2) + 4 * n + (i & 3); }
__device__ __forceinline__ unsigned cvt_pk_bf16(float lo, float hi) { unsigned r; asm volatile("v_cvt_pk_bf16_f32 %0, %1, %2" : "=v"(r) : "v"(lo), "v"(hi)); return r; }

struct Unit { int pm, pn; const char* a; const char* b; };

struct TileOrder {
  int nM, nN, nwg, G, c;
  __device__ void init(int nM_, int nN_, int G_, int c_) { nM = nM_; nN = nN_; nwg = nM * nN; G = G_; c = c_; }
  __device__ bool tile(int i, int& pm, int& pn) const {
    const long L = (long)i * G + c; if (L >= nwg) return false;
    int wgid = (int)L; { const int q = nwg / NXCD, r = nwg % NXCD, xcd = wgid % NXCD, off = wgid / NXCD; wgid = (xcd < r ? xcd * (q + 1) : r * (q + 1) + (xcd - r) * q) + off; }
    const int nig = WGM * nN, gid = wgid / nig, fm = gid * WGM, gsz = (nM - fm) < WGM ? (nM - fm) : WGM;
    pm = fm + ((wgid % nig) % gsz); pn = (wgid % nig) / gsz; return true;
  }
};

template <class Epi, class Sched, bool GATHER>
__device__ __forceinline__ void gemm_phase(PG8_LAS unsigned char* lds, const int K, const Sched& S, const Epi& E) {
  const int tid = threadIdx.x, wid = __builtin_amdgcn_readfirstlane(tid >> 6), lane = tid & 63, wr = wid >> 2, wc = wid & 3, fr = lane & 15, fq = lane >> 4;
  const int nt = K / BK;
  unsigned voffA[2], voffB[2]; int rA[2], cA2[2];
#pragma unroll
  for (int i = 0; i < 2; ++i) { int R, C; stage_rc(tid * 16 + i * 8192, R, C); const int Rb = Epi::PERM ? ((R & ~31) + perm32(R & 31)) : R;
    voffA[i] = (unsigned)(R * K + C) * 2u; voffB[i] = (unsigned)(Rb * K + C) * 2u; rA[i] = R; cA2[i] = C * 2; }
  const size_t kstep = (size_t)(BK * 2);
  const size_t hstep = (size_t)HALF * K * 2;
  const unsigned ldsw = (unsigned)wid * 1024u;
  const int aoff = lds_byte(wr * 64 + fr, fq * 8), boff = lds_byte(wc * 32 + fr, fq * 8);
#define PG8_SA(b, h) (((b) * 2 + (h)) * HTB)
#define PG8_SB(b, h) ((4 + (b) * 2 + (h)) * HTB)
#define PG8_STAGE(bufoff, gbase, voff) do { _Pragma("unroll") for (int _i = 0; _i < 2; ++_i) \
    __builtin_amdgcn_global_load_lds((const unsigned*)((const char*)(gbase) + (voff)[_i]), (PG8_LAS unsigned*)(lds + (bufoff) + ldsw + _i * 8192), 16, 0, 0); } while (0)
#define PG8_STAGE_A(bufoff, gbase, h, usenext) do { if constexpr (GATHER) { unsigned _v[2]; _v[0] = (usenext) ? vAn[h][0] : vAc[h][0]; _v[1] = (usenext) ? vAn[h][1] : vAc[h][1]; PG8_STAGE(bufoff, gbase, _v); } \
    else { PG8_STAGE(bufoff, (gbase) + (h) * hstep, voffA); } } while (0)
#define PG8_LDA(dst, b, h) do { _Pragma("unroll") for (int m = 0; m < 4; ++m) _Pragma("unroll") for (int k = 0; k < 2; ++k) dst[m][k] = *(const PG8_LAS bf16x8*)(lds + PG8_SA(b, h) + aoff + m * 2048 + k * 1024); } while (0)
#define PG8_LDB(dst, b, h) do { _Pragma("unroll") for (int n = 0; n < 2; ++n) _Pragma("unroll") for (int k = 0; k < 2; ++k) dst[n][k] = *(const PG8_LAS bf16x8*)(lds + PG8_SB(b, h) + boff + n * 2048 + k * 1024); } while (0)
#define PG8_MMA(ai, bj, At, Bt) do { __builtin_amdgcn_s_setprio(1); _Pragma("unroll") for (int m = 0; m < 4; ++m) _Pragma("unroll") for (int n = 0; n < 2; ++n) _Pragma("unroll") for (int k = 0; k < 2; ++k) \
    acc[ai][bj][m][n] = __builtin_amdgcn_mfma_f32_16x16x32_bf16(Bt[n][k], At[m][k], acc[ai][bj][m][n], 0, 0, 0); __builtin_amdgcn_s_setprio(0); } while (0)
#define PG8_WAIT_V(n) asm volatile("s_waitcnt vmcnt(" #n ")" ::: "memory")
#define PG8_WAIT_L(n) asm volatile("s_waitcnt lgkmcnt(" #n ")" ::: "memory")
#define PG8_BAR __builtin_amdgcn_s_barrier()
#define PG8_SCHED __builtin_amdgcn_sched_barrier(0)
  Unit cur, nxt; int ui = 0;
  if (!S.next(0, cur)) return;
  unsigned vAc[2][2], vAn[2][2];
  if constexpr (GATHER) {
#pragma unroll
    for (int h = 0; h < 2; ++h)
#pragma unroll
      for (int i = 0; i < 2; ++i) { vAc[h][i] = (unsigned)S.row(cur, h * HALF + rA[i]) * (unsigned)(K * 2) + (unsigned)cA2[i]; vAn[h][i] = vAc[h][i]; }
  } else {
#pragma unroll
    for (int h = 0; h < 2; ++h)
#pragma unroll
      for (int i = 0; i < 2; ++i) { vAc[h][i] = 0u; vAn[h][i] = 0u; }
  }
  f32x4 acc[2][2][4][2];
#pragma unroll
  for (int a = 0; a < 2; ++a)
#pragma unroll
    for (int b = 0; b < 2; ++b)
#pragma unroll
      for (int m = 0; m < 4; ++m)
#pragma unroll
        for (int n = 0; n < 2; ++n) acc[a][b][m][n] = (f32x4){0.f, 0.f, 0.f, 0.f};
  bf16x8 At[4][2], B0[2][2], B1[2][2];
  const char* cA = cur.a; const char* cB = cur.b;
  PG8_STAGE(PG8_SB(0, 0), cB, voffB); PG8_STAGE_A(PG8_SA(0, 0), cA, 0, false); PG8_STAGE(PG8_SB(0, 1), cB + hstep, voffB); PG8_STAGE_A(PG8_SA(0, 1), cA, 1, false);
  if (wr == 1) PG8_BAR;
  PG8_WAIT_V(4); PG8_BAR;
  PG8_STAGE(PG8_SB(1, 0), cB + kstep, voffB); PG8_STAGE_A(PG8_SA(1, 0), cA + kstep, 0, false); PG8_STAGE(PG8_SB(1, 1), cB + hstep + kstep, voffB);
  PG8_WAIT_V(6); PG8_BAR;
  for (;;) {
    const bool has_next = S.next(ui + 1, nxt);
    const char* nA = has_next ? nxt.a : cA; const char* nB = has_next ? nxt.b : cB;
    for (int t = 0; t < nt; t += 2) {
      const bool last = (t == nt - 2);
      const char* a1 = cA + (size_t)(t + 1) * kstep;
      const char* a2 = last ? nA : cA + (size_t)(t + 2) * kstep; const char* b2 = last ? nB : cB + (size_t)(t + 2) * kstep;
      const char* a3 = a2 + kstep; const char* b3 = b2 + kstep;
      if constexpr (GATHER) {
        if (last && has_next) {
#pragma unroll
          for (int h = 0; h < 2; ++h)
#pragma unroll
            for (int i = 0; i < 2; ++i) vAn[h][i] = (unsigned)S.row(nxt, h * HALF + rA[i]) * (unsigned)(K * 2) + (unsigned)cA2[i];
        }
      }
      PG8_LDB(B0, 0, 0); PG8_SCHED; PG8_LDA(At, 0, 0); PG8_STAGE_A(PG8_SA(1, 1), a1, 1, false);
      PG8_WAIT_L(8); PG8_BAR; PG8_WAIT_L(0); PG8_MMA(0, 0, At, B0); PG8_BAR; PG8_SCHED;
      PG8_LDB(B1, 0, 1); PG8_STAGE(PG8_SB(0, 0), b2, voffB);
      PG8_BAR; PG8_WAIT_L(0); PG8_MMA(0, 1, At, B1); PG8_BAR;
      PG8_LDA(At, 0, 1); PG8_STAGE_A(PG8_SA(0, 0), a2, 0, last);
      PG8_BAR; PG8_WAIT_L(0); PG8_MMA(1, 0, At, B0); PG8_BAR; PG8_SCHED;
      PG8_STAGE(PG8_SB(0, 1), b2 + hstep, voffB);
      PG8_WAIT_V(6); PG8_BAR; PG8_MMA(1, 1, At, B1); PG8_BAR;
      PG8_LDB(B0, 1, 0); PG8_SCHED; PG8_LDA(At, 1, 0); PG8_STAGE_A(PG8_SA(0, 1), a2, 1, last);
      PG8_WAIT_L(8); PG8_BAR; PG8_WAIT_L(0); PG8_MMA(0, 0, At, B0); PG8_BAR; PG8_SCHED;
      PG8_LDB(B1, 1, 1); PG8_STAGE(PG8_SB(1, 0), b3, voffB);
      PG8_BAR; PG8_WAIT_L(0); PG8_MMA(0, 1, At, B1); PG8_BAR;
      PG8_LDA(At, 1, 1); PG8_STAGE_A(PG8_SA(1, 0), a3, 0, last);
      PG8_BAR; PG8_WAIT_L(0); PG8_MMA(1, 0, At, B0); PG8_BAR; PG8_SCHED;
      PG8_STAGE(PG8_SB(1, 1), b3 + hstep, voffB);
      PG8_WAIT_V(6); PG8_BAR; PG8_MMA(1, 1, At, B1); PG8_BAR;
    }
    E(acc, cur, wr, wc, fr, fq);
    if (!has_next) break;
#pragma unroll
    for (int a = 0; a < 2; ++a)
#pragma unroll
      for (int b = 0; b < 2; ++b)
#pragma unroll
        for (int m = 0; m < 4; ++m)
#pragma unroll
          for (int n = 0; n < 2; ++n) acc[a][b][m][n] = (f32x4){0.f, 0.f, 0.f, 0.f};
    cur = nxt; cA = nA; cB = nB; ++ui;
    if constexpr (GATHER) {
#pragma unroll
      for (int h = 0; h < 2; ++h)
#pragma unroll
        for (int i = 0; i < 2; ++i) vAc[h][i] = vAn[h][i];
    }
  }
  PG8_WAIT_V(0);
  if (wr == 0) PG8_BAR;
  PG8_BAR;
#undef PG8_SA
#undef PG8_SB
#undef PG8_STAGE
#undef PG8_STAGE_A
#undef PG8_LDA
#undef PG8_LDB
#undef PG8_MMA
#undef PG8_WAIT_V
#undef PG8_WAIT_L
#undef PG8_BAR
#undef PG8_SCHED
}
}

__device__ void transpose_tile(float* tl, const float* src, int ld, int scol0, unsigned short* dst, int K, int n0, int k0) {
  const int tid = threadIdx.x;
  __syncthreads();
#pragma unroll
  for (int ps = 0; ps < 4; ++ps) {
    const int kr = ps * 32 + (tid >> 4), c4 = (tid & 15) * 4;
    const float4 v = ld4(src + (size_t)(k0 + kr) * ld + scol0 + c4);
    tl[kr * 65 + c4] = v.x; tl[kr * 65 + c4 + 1] = v.y; tl[kr * 65 + c4 + 2] = v.z; tl[kr * 65 + c4 + 3] = v.w;
  }
  __syncthreads();
  const int n = tid >> 3, kq = (tid & 7) * 16;
  unsigned w[8];
#pragma unroll
  for (int i = 0; i < 8; ++i) w[i] = pg8::cvt_pk_bf16(tl[(kq + 2 * i) * 65 + n], tl[(kq + 2 * i + 1) * 65 + n]);
  uint4* o = reinterpret_cast<uint4*>(dst + (size_t)(n0 + n) * K + k0 + kq);
  o[0] = make_uint4(w[0], w[1], w[2], w[3]); o[1] = make_uint4(w[4], w[5], w[6], w[7]);
}

__device__ void phase_wprep(float* lds, const Params& p, unsigned short* winT, int bid, int nb) {
  for (int item = bid; item < 84 * 8; item += nb) {
    const int nt = item >> 3, kt = item & 7, n0 = nt * 64;
    int scol;
    if (n0 < 3328) scol = n0;
    else { const int r = n0 - 3328, j = r >> 8, q = r & 255; scol = 3328 + (q < 128 ? 0 : 1024) + j * 128 + (q & 127); }
    transpose_tile(lds, p.in[I_WIN], kINC, scol, winT, kD, n0, kt * 128);
  }
}

__device__ void phase_hb(const Params& p, const float* mod, unsigned short* hb, int bid, int nb) {
  const int lane = threadIdx.x & 63, wid = threadIdx.x >> 6;
  const float* x = p.in[I_X]; const float* g = p.in[I_N1PRE];
  for (int row = bid * 8 + wid; row < kROWS; row += nb * 8) {
    const int b = row / kT;
    float4 v[4]; float ss = 0.f;
#pragma unroll
    for (int i = 0; i < 4; ++i) { v[i] = ld4(x + (size_t)row * kD + i * 256 + lane * 4); ss += v[i].x * v[i].x + v[i].y * v[i].y + v[i].z * v[i].z + v[i].w * v[i].w; }
    ss = wave_sum(ss);
    const float r = rsqrtf(ss * (1.0f / kD) + 1e-6f);
#pragma unroll
    for (int i = 0; i < 4; ++i) {
      const int k = i * 256 + lane * 4;
      const float4 gv = ld4(g + k), sc = ld4(mod + b * 6144 + 1024 + k), sh = ld4(mod + b * 6144 + k);
      const float h0 = v[i].x * r * gv.x * (1.f + sc.x) + sh.x, h1 = v[i].y * r * gv.y * (1.f + sc.y) + sh.y;
      const float h2 = v[i].z * r * gv.z * (1.f + sc.z) + sh.z, h3 = v[i].w * r * gv.w * (1.f + sc.w) + sh.w;
      *reinterpret_cast<uint2*>(hb + (size_t)row * kD + k) = make_uint2(pg8::cvt_pk_bf16(h0, h1), pg8::cvt_pk_bf16(h2, h3));
    }
  }
}

struct SchedG1 {
  pg8::TileOrder o; const char* A; const char* B;
  __device__ bool next(int i, pg8::Unit& u) const { if (!o.tile(i, u.pm, u.pn)) return false; u.a = A + (size_t)u.pm * 256 * kD * 2; u.b = B + (size_t)u.pn * 256 * kD * 2; return true; }
};
struct EpiG1F32 {
  static constexpr bool PERM = false;
  float* hy; float* rw;
  __device__ __forceinline__ void operator()(const pg8::f32x4 (&acc)[2][2][4][2], const pg8::Unit& u, int wr, int wc, int fr, int fq) const {
    float* C; int ldc, colt;
    if (u.pn < 6) { C = hy; ldc = kHYC; colt = u.pn * 256; } else { C = rw; ldc = kRWC; colt = (u.pn - 6) * 256; }
    const int row0 = u.pm * 256 + wr * 64 + fr, col0 = colt + wc * 32 + 4 * fq;
#pragma unroll
    for (int ai = 0; ai < 2; ++ai)
#pragma unroll
      for (int m = 0; m < 4; ++m) { float* rowp = C + (size_t)(row0 + ai * 128 + m * 16) * ldc + col0;
#pragma unroll
        for (int bj = 0; bj < 2; ++bj)
#pragma unroll
          for (int n = 0; n < 2; ++n) *(pg8::f32x4*)(rowp + bj * 128 + n * 16) = acc[ai][bj][m][n]; }
  }
};

struct ALoadNorm {
  const float* x; const float* rstd; const float* g; const float* mod; int rows_per_b; int fixed_mrow; int sc_off, sh_off;
  DEV float4 operator()(int row, int k) const {
    const int mr = fixed_mrow >= 0 ? fixed_mrow : row / rows_per_b;
    const float4 xv = ld4(x + (size_t)row * kD + k), gv = ld4(g + k);
    const float4 sc = ld4(mod + mr * 6144 + sc_off + k), sh = ld4(mod + mr * 6144 + sh_off + k);
    const float r = rstd[row];
    return make_float4(xv.x * r * gv.x * (1.f + sc.x) + sh.x, xv.y * r * gv.y * (1.f + sc.y) + sh.y,
                       xv.z * r * gv.z * (1.f + sc.z) + sh.z, xv.w * r * gv.w * (1.f + sc.w) + sh.w);
  }
};
struct ALoadPlain { const float* a; int lda; DEV float4 operator()(int row, int k) const { return ld4(a + (size_t)row * lda + k); } };
struct ALoadSum2 { const float* a; const float* b; int lda;
  DEV float4 operator()(int row, int k) const { const float4 u = ld4(a + (size_t)row * lda + k), v = ld4(b + (size_t)row * lda + k);
    return make_float4(u.x + v.x, u.y + v.y, u.z + v.z, u.w + v.w); } };
struct BLoadPlain { const float* b; int ldb; int coff; DEV float4 operator()(int, int k, int n) const { return ld4(b + (size_t)k * ldb + coff + n); } };
struct BLoadExpert { const float* w; int ldb; size_t estride; int e0;
  DEV float4 operator()(int m0, int k, int n) const { return ld4(w + (size_t)(e0 + m0 / 4096) * estride + (size_t)k * ldb + n); } };
struct ALoadGatherNorm {
  const float* x1; const float* rstd2; const float* g; const float* mod; const int* idx; int e0;
  DEV float4 operator()(int s, int k) const {
    const int e = e0 + s / 4096, b = (s % 4096) / 1024, c = s % 1024;
    const int row = b * kT + idx[(b * kE + e) * kCAP + c];
    const float4 xv = ld4(x1 + (size_t)row * kD + k), gv = ld4(g + k);
    const float4 sc = ld4(mod + b * 6144 + 4096 + k), sh = ld4(mod + b * 6144 + 3072 + k);
    const float r = rstd2[row];
    return make_float4(xv.x * r * gv.x * (1.f + sc.x) + sh.x, xv.y * r * gv.y * (1.f + sc.y) + sh.y,
                       xv.z * r * gv.z * (1.f + sc.z) + sh.z, xv.w * r * gv.w * (1.f + sc.w) + sh.w);
  }
};
struct EpiStore { float* c; int ldc; DEV void operator()(int r, int col, float v) const { c[(size_t)r * ldc + col] = v; } };
struct EpiSplitHyRw { float* hy; float* rw;
  DEV void operator()(int r, int col, float v) const { if (col < kHYC) hy[(size_t)r * kHYC + col] = v; else rw[(size_t)r * kRWC + col - kHYC] = v; } };
struct EpiGates { float* pre; float* tmp;
  DEV void operator()(int r, int col, float v) const { const float s = sigmoidf_(v);
    if (col < kD) pre[(size_t)r * kD + col] *= s; else tmp[(size_t)r * kD + col - kD] *= s; } };
struct EpiSilu { float* c; int ldc; DEV void operator()(int r, int col, float v) const { c[(size_t)r * ldc + col] = siluf_(v); } };
struct EpiMul { float* c; int ldc; DEV void operator()(int r, int col, float v) const { c[(size_t)r * ldc + col] *= v; } };
struct EpiScatter { float* moe; const int* idx; const float* gate; int e0;
  DEV void operator()(int s, int col, float v) const {
    const int e = e0 + s / 4096, b = (s % 4096) / 1024, c = s % 1024;
    const int o = (b * kE + e) * kCAP + c;
    atomicAdd(moe + (size_t)(b * kT + idx[o]) * kD + col, v * gate[o]);
  }
};

__device__ void phase_rstd(const float* x, const float* ctx, float* rstdx, float* rstdc, int bid, int nb) {
  const int lane = threadIdx.x & 63, wid = threadIdx.x >> 6;
  for (int row = bid * 8 + wid; row < kROWS + kB * kCTX; row += nb * 8) {
    const float* p = row < kROWS ? x + (size_t)row * kD : ctx + (size_t)(row - kROWS) * kD;
    float s = 0.f;
#pragma unroll
    for (int i = 0; i < 4; ++i) { const float4 v = ld4(p + i * 256 + lane * 4); s += v.x * v.x + v.y * v.y + v.z * v.z + v.w * v.w; }
    s = wave_sum(s);
    const float r = rsqrtf(s * (1.0f / kD) + 1e-6f);
    if (lane == 0) { if (row < kROWS) rstdx[row] = r; else rstdc[row - kROWS] = r; }
  }
}

__device__ void phase_mod(float* lds, const float* c, const float* cctx, const float* modw, const float* modb, float* mod, int bid, int nb) {
  float* sc = lds;
  float* red = lds + 5120;
  const int tid = threadIdx.x, kk = tid >> 6, nl = tid & 63;
  bool loaded = false;
  for (int item = bid; item < 96; item += nb) {
    if (!loaded) {
      for (int i = tid; i < 5120; i += NTHR) { const int v = i >> 10, k = i & 1023; const float cv = v < 4 ? c[v * kD + k] : cctx[k]; sc[i] = siluf_(cv); }
      loaded = true;
    }
    __syncthreads();
    const int n = item * 64 + nl;
    float acc[5] = {0.f, 0.f, 0.f, 0.f, 0.f};
#pragma unroll 8
    for (int k = kk * 128; k < kk * 128 + 128; ++k) {
      const float w = modw[(size_t)k * 6144 + n];
#pragma unroll
      for (int v = 0; v < 5; ++v) acc[v] += sc[v * 1024 + k] * w;
    }
#pragma unroll
    for (int v = 0; v < 5; ++v) red[(kk * 5 + v) * 64 + nl] = acc[v];
    __syncthreads();
    if (tid < 320) {
      const int v = tid >> 6;
      float s = 0.f;
#pragma unroll
      for (int q = 0; q < 8; ++q) s += red[(q * 5 + v) * 64 + nl];
      mod[v * 6144 + n] = s + modb[n];
    }
    __syncthreads();
  }
}

__device__ void phase_filter(float* lds, const Params& p, float* kfu, float* nrm, int bid, int nb) {
  float* feat = lds;
  float* h1 = lds + 32 * 33;
  float* h2 = h1 + 32 * 64;
  const float* w1 = p.in[I_HW1]; const float* b1 = p.in[I_HB1]; const float* w2 = p.in[I_HW2]; const float* b2 = p.in[I_HB2];
  const float* w3 = p.in[I_HW3]; const float* fr = p.in[I_HFREQ];
  const int tid = threadIdx.x;
  for (int item = bid; item < kT / 32; item += nb) {
    const int l0 = item * 32;
    __syncthreads();
    for (int i = tid; i < 32 * 33; i += NTHR) {
      const int pz = i / 33, f = i % 33, l = l0 + pz;
      float v;
      if (f == 0) v = (float)l / (float)(kT - 1);
      else {
        const int j = (f - 1) & 15;
        const float band = 1e-4f + (float)j * ((15.0f - 1e-4f) / 15.0f);
        const float ang = (6.283185307179586f / (float)kT) * (float)l;
        float sn, cs; sincos_cw(band * ang, sn, cs); v = f <= 16 ? cs : -sn;
      }
      feat[i] = v;
    }
    __syncthreads();
    for (int i = tid; i < 32 * 64; i += NTHR) {
      const int pz = i >> 6, o = i & 63;
      float s = b1[o];
#pragma unroll 3
      for (int f = 0; f < 33; ++f) s += feat[pz * 33 + f] * w1[f * 64 + o];
      h1[i] = sin_cw(fr[o] * s);
    }
    __syncthreads();
    for (int i = tid; i < 32 * 64; i += NTHR) {
      const int pz = i >> 6, o = i & 63;
      float s = b2[o];
#pragma unroll 4
      for (int f = 0; f < 64; ++f) s += h1[pz * 64 + f] * w2[f * 64 + o];
      h2[i] = sin_cw(fr[o] * s);
    }
    __syncthreads();
#pragma unroll 1
    for (int half = 0; half < 2; ++half) {
      const int n = tid + half * 512;
      const int c = tid;
      float wr[64];
#pragma unroll
      for (int o = 0; o < 64; ++o) wr[o] = w3[o * 1024 + n];
      const float dlo = -4.605170185988091f / 1.5f, dhi = -4.605170185988091f / 0.3f;
      const float delta = fabsf(dlo + (float)c * ((dhi - dlo) / 511.0f));
      float asum = 0.f;
#pragma unroll 1
      for (int q = 0; q < 32; ++q) {
        float a = 0.f;
#pragma unroll
        for (int o = 0; o < 64; ++o) a += h2[q * 64 + o] * wr[o];
        const int l = l0 + q;
        const float tt = (float)l / (float)(kT - 1);
        const float v = a * expf(-tt * delta);
        if (half == 0) { kfu[(size_t)(8191 + l) * 512 + c] = v; asum += fabsf(v); }
        else if (l >= 1) { kfu[(size_t)(8191 - l) * 512 + c] = v; asum += fabsf(v); }
      }
      atomicAdd(nrm + c, asum);
    }
  }
}

__device__ void rwkv_scan_block(float* lds, const Params& p, const float* cols, int ldc, int Tlen, int cR, int cK, int cV, int cLW, int cLA, int muoff,
                                int b, int h, int dir, const float* S0, float* Sout, float* Y, float* BSo) {
  float* aR = lds;            float* aK = lds + 4096;      float* aV = lds + 8192;     float* aLW = lds + 12288;
  float* aLA = lds + 16384;   float* aDEC = lds + 20480;   float* aAV = lds + 24576;   float* aBV = lds + 28672;
  const float* mu = p.in[I_MU];
  const float* w0 = p.in[I_W0] + dir * 512 + h * 64;  const float* wup = p.in[I_WUP] + (size_t)dir * 64 * 512 + h * 64;
  const float* a0 = p.in[I_A0] + dir * 512 + h * 64;  const float* aup = p.in[I_AUP] + (size_t)dir * 64 * 512 + h * 64;
  const float* kkw = p.in[I_KK] + h * 64; const float* kaw = p.in[I_KA] + h * 64; const float* rkw = p.in[I_RK] + h * 64;
  const int tid = threadIdx.x, lane = tid & 63, wid = tid >> 6;
  const int si = tid >> 3, sj = (tid & 7) * 8;
  const bool emit = cR >= 0;
  float s[8];
#pragma unroll
  for (int j = 0; j < 8; ++j) s[j] = S0 ? S0[si * 64 + sj + j] : 0.f;
  const float* base = cols + (size_t)b * Tlen * ldc;
  for (int ci = 0; ci < Tlen / 64; ++ci) {
    __syncthreads();
    for (int i = tid; i < 5 * 4096; i += NTHR) {
      const int arr = i >> 12, q = (i >> 6) & 63, j = i & 63;
      if (arr == 0 && !emit) continue;
      const int t = dir ? (Tlen - 1 - (ci * 64 + q)) : (ci * 64 + q);
      const int col = (arr == 0 ? cR + h * 64 : arr == 1 ? cK + h * 64 : arr == 2 ? cV + h * 64 : arr == 3 ? cLW : cLA) + j;
      const float cur = base[(size_t)t * ldc + col];
      const float prv = t > 0 ? base[(size_t)(t - 1) * ldc + col] : 0.f;
      const float nxt = t < Tlen - 1 ? base[(size_t)(t + 1) * ldc + col] : 0.f;
      float z = cur + mu[col + muoff] * (prv - cur) + mu[kRWC + col + muoff] * (nxt - cur);
      if (arr == 3) z = tanhf(z);
      lds[arr * 4096 + q * 64 + j] = z;
    }
    __syncthreads();
    for (int i = tid; i < 4096; i += NTHR) {
      const int q = i >> 6, j = i & 63;
      float sw = w0[j], sa = a0[j];
      for (int k = 0; k < 64; ++k) { sw += aLW[q * 64 + k] * wup[k * 512 + j]; sa += aLA[q * 64 + k] * aup[k * 512 + j]; }
      const float w = -softplusf_(-sw) - 0.5f;
      aDEC[i] = expf(-expf(w));
      aBV[i] = sigmoidf_(sa);
    }
    __syncthreads();
    for (int q = wid; q < 64; q += 8) {
      const float kraw = aK[q * 64 + lane], a = aBV[q * 64 + lane];
      const float kkv = kraw * kkw[lane];
      const float ss = wave_sum(kkv * kkv);
      const float kkn = kkv * rsqrtf(fmaxf(ss, 1e-24f));
      const float km = kraw * (1.f + (a - 1.f) * kaw[lane]);
      aAV[q * 64 + lane] = -kkn; aBV[q * 64 + lane] = kkn * a; aK[q * 64 + lane] = km;
      if (emit) {
        const float bsum = wave_sum(aR[q * 64 + lane] * km * rkw[lane]);
        const int t = dir ? (Tlen - 1 - (ci * 64 + q)) : (ci * 64 + q);
        if (lane == 0) BSo[((size_t)dir * kROWS + (size_t)b * Tlen + t) * 8 + h] = bsum;
      }
    }
    __syncthreads();
    for (int q = 0; q < 64; ++q) {
      const float4 a0v = *reinterpret_cast<const float4*>(&aAV[q * 64 + sj]), a1v = *reinterpret_cast<const float4*>(&aAV[q * 64 + sj + 4]);
      const float av[8] = {a0v.x, a0v.y, a0v.z, a0v.w, a1v.x, a1v.y, a1v.z, a1v.w};
      float sa = 0.f;
#pragma unroll
      for (int j = 0; j < 8; ++j) sa += s[j] * av[j];
      sa += __shfl_xor(sa, 1); sa += __shfl_xor(sa, 2); sa += __shfl_xor(sa, 4);
      const float vi = aV[q * 64 + si];
      float y = 0.f;
#pragma unroll
      for (int j = 0; j < 8; ++j) {
        s[j] = s[j] * aDEC[q * 64 + sj + j] + sa * aBV[q * 64 + sj + j] + vi * aK[q * 64 + sj + j];
        if (emit) y += s[j] * aR[q * 64 + sj + j];
      }
      if (emit) {
        y += __shfl_xor(y, 1); y += __shfl_xor(y, 2); y += __shfl_xor(y, 4);
        const int t = dir ? (Tlen - 1 - (ci * 64 + q)) : (ci * 64 + q);
        if ((tid & 7) == 0) Y[(size_t)dir * kROWS * 512 + ((size_t)b * Tlen + t) * 512 + h * 64 + si] = y;
      }
    }
  }
  if (Sout) {
#pragma unroll
    for (int j = 0; j < 8; ++j) Sout[si * 64 + sj + j] = s[j];
  }
}

__device__ void phase_hyprep(const Params& p, const float* hyc, float* Z, float* X0, int bid, int nb) {
  const float* cw = p.in[I_HCW]; const float* cb = p.in[I_HCB];
  for (size_t i = (size_t)bid * NTHR + threadIdx.x; i < (size_t)kROWS * 512; i += (size_t)nb * NTHR) {
    const int row = (int)(i >> 9), c = (int)(i & 511), t = row & (kT - 1);
    float u[3];
#pragma unroll
    for (int g = 0; g < 3; ++g) {
      const int col = g * 512 + c;
      const float cur = hyc[(size_t)row * kHYC + col];
      const float prv = t > 0 ? hyc[(size_t)(row - 1) * kHYC + col] : 0.f;
      const float nxt = t < kT - 1 ? hyc[(size_t)(row + 1) * kHYC + col] : 0.f;
      u[g] = cw[col] * prv + cw[kHYC + col] * cur + cw[2 * kHYC + col] * nxt + cb[col];
    }
    X0[i] = u[0];
    Z[i] = u[2] * u[1];
  }
}

__device__ void conv_item(const Params& p, int item, const float* Z, const float* X0, const float* kfu, const float* nrm, float* hyo) {
  const int lane = threadIdx.x & 63, wid = threadIdx.x >> 6;
  const int b = item >> 9, ct = (item >> 6) & 7, tt = item & 63;
  const int c = ct * 64 + lane, t0 = tt * 128 + wid * 16;
  const float* zb = Z + (size_t)b * kT * 512 + c;
  const float* kb = kfu + c;
  float acc[16], kw[31];
#pragma unroll
  for (int r = 0; r < 16; ++r) acc[r] = 0.f;
#pragma unroll
  for (int d = 0; d < 31; ++d) kw[d] = 0.f;
#pragma unroll
  for (int d = 0; d < 15; ++d) { const int lag = t0 + 1 + d; kw[d] = lag <= 8191 ? kb[(size_t)(8191 + lag) * 512] : 0.f; }
  for (int s0 = 0; s0 < kT; s0 += 16) {
#pragma unroll
    for (int d = 30; d >= 16; --d) kw[d] = kw[d - 16];
#pragma unroll
    for (int d = 0; d < 16; ++d) kw[d] = kb[(size_t)(8191 + t0 - s0 - 15 + d) * 512];
    float zv[16];
#pragma unroll
    for (int q = 0; q < 16; ++q) zv[q] = zb[(size_t)(s0 + q) * 512];
#pragma unroll
    for (int q = 0; q < 16; ++q)
#pragma unroll
      for (int r = 0; r < 16; ++r) acc[r] += kw[r - q + 15] * zv[q];
  }
  const float inv = 1.0f / nrm[c], hb = p.in[I_HBIAS][c];
#pragma unroll
  for (int r = 0; r < 16; ++r) {
    const size_t o = ((size_t)b * kT + t0 + r) * 512 + c;
    hyo[o] = (acc[r] * inv + hb * Z[o]) * X0[o];
  }
}

__device__ void phase_rwout(float* lds, const Params& p, const float* rwc, float* Y0, const float* Y1, const float* BS, int bid, int nb) {
  const int lane = threadIdx.x & 63, wid = threadIdx.x >> 6;
  float* lg = lds + wid * 128;
  const float* mu = p.in[I_MU]; const float* gup = p.in[I_GUP]; const float* lng = p.in[I_LNG]; const float* lnb = p.in[I_LNB];
  for (int row = bid * 8 + wid; row < kROWS; row += nb * 8) {
    const int t = row & (kT - 1);
    const float* cur = rwc + (size_t)row * kRWC;
    for (int i = lane; i < 128; i += 64) {
      const int col = 1664 + i;
      const float cv = cur[col], pv = t > 0 ? cur[col - kRWC] : 0.f, nv = t < kT - 1 ? cur[col + kRWC] : 0.f;
      lg[i] = sigmoidf_(cv + mu[col] * (pv - cv) + mu[kRWC + col] * (nv - cv));
    }
    __syncthreads();
    const int c0 = lane * 8, h = lane >> 3;
    float y[8], g[8];
    float sum = 0.f;
#pragma unroll
    for (int j = 0; j < 8; ++j) { y[j] = Y0[(size_t)row * 512 + c0 + j] + Y1[(size_t)row * 512 + c0 + j]; sum += y[j]; g[j] = 0.f; }
    sum += __shfl_xor(sum, 1); sum += __shfl_xor(sum, 2); sum += __shfl_xor(sum, 4);
    const float mean = sum * (1.0f / 64.0f);
    float var = 0.f;
#pragma unroll
    for (int j = 0; j < 8; ++j) { const float d = y[j] - mean; var += d * d; }
    var += __shfl_xor(var, 1); var += __shfl_xor(var, 2); var += __shfl_xor(var, 4);
    const float rs = rsqrtf(var * (1.0f / 64.0f) + 64e-5f);
    for (int i = 0; i < 128; ++i) {
      const float sg = lg[i];
      const float4 u0 = ld4(gup + i * 512 + c0), u1 = ld4(gup + i * 512 + c0 + 4);
      g[0] += sg * u0.x; g[1] += sg * u0.y; g[2] += sg * u0.z; g[3] += sg * u0.w;
      g[4] += sg * u1.x; g[5] += sg * u1.y; g[6] += sg * u1.z; g[7] += sg * u1.w;
    }
    const float bsum = BS[(size_t)row * 8 + h] + BS[((size_t)kROWS + row) * 8 + h];
#pragma unroll
    for (int j = 0; j < 8; ++j) {
      const int col = 1024 + c0 + j;
      const float cv = cur[col], pv = t > 0 ? cur[col - kRWC] : 0.f, nv = t < kT - 1 ? cur[col + kRWC] : 0.f;
      const float vm = cv + mu[col] * (pv - cv) + mu[kRWC + col] * (nv - cv);
      const float yn = (y[j] - mean) * rs * lng[c0 + j] + lnb[c0 + j];
      Y0[(size_t)row * 512 + c0 + j] = (yn + bsum * vm) * g[j];
    }
    __syncthreads();
  }
}

__device__ void phase_post(const Params& p, const float* mixed, float* x1o, float* rstd2, float* aff, const float* mod, int bid, int nb) {
  const int lane = threadIdx.x & 63, wid = threadIdx.x >> 6;
  const float* x = p.in[I_X]; const float* n1post = p.in[I_N1POST]; const float* n2pre = p.in[I_N2PRE]; const float* rw = p.in[I_ROUTER];
  for (int row = bid * 8 + wid; row < kROWS; row += nb * 8) {
    const int b = row / kT;
    float m[16], xv[16];
    float ss = 0.f;
#pragma unroll
    for (int i = 0; i < 4; ++i) { const float4 v = ld4(mixed + (size_t)row * kD + i * 256 + lane * 4);
      m[i * 4] = v.x; m[i * 4 + 1] = v.y; m[i * 4 + 2] = v.z; m[i * 4 + 3] = v.w; ss += v.x * v.x + v.y * v.y + v.z * v.z + v.w * v.w; }
    ss = wave_sum(ss);
    const float r1 = rsqrtf(ss * (1.0f / kD) + 1e-6f);
    float s2 = 0.f;
#pragma unroll
    for (int i = 0; i < 4; ++i) {
      const int k = i * 256 + lane * 4;
      const float4 xx = ld4(x + (size_t)row * kD + k), gp = ld4(n1post + k), gt = ld4(mod + b * 6144 + 2048 + k);
      xv[i * 4] = xx.x + gt.x * m[i * 4] * r1 * gp.x; xv[i * 4 + 1] = xx.y + gt.y * m[i * 4 + 1] * r1 * gp.y;
      xv[i * 4 + 2] = xx.z + gt.z * m[i * 4 + 2] * r1 * gp.z; xv[i * 4 + 3] = xx.w + gt.w * m[i * 4 + 3] * r1 * gp.w;
      *reinterpret_cast<float4*>(x1o + (size_t)row * kD + k) = make_float4(xv[i * 4], xv[i * 4 + 1], xv[i * 4 + 2], xv[i * 4 + 3]);
#pragma unroll
      for (int j = 0; j < 4; ++j) s2 += xv[i * 4 + j] * xv[i * 4 + j];
    }
    s2 = wave_sum(s2);
    const float r2 = rsqrtf(s2 * (1.0f / kD) + 1e-6f);
    if (lane == 0) rstd2[row] = r2;
    float lgt[16];
#pragma unroll
    for (int e = 0; e < 16; ++e) lgt[e] = 0.f;
#pragma unroll
    for (int i = 0; i < 4; ++i)
#pragma unroll
      for (int j = 0; j < 4; ++j) {
        const int k = i * 256 + lane * 4 + j;
        const float h2 = xv[i * 4 + j] * r2 * n2pre[k] * (1.f + mod[b * 6144 + 4096 + k]) + mod[b * 6144 + 3072 + k];
        const float4 w0 = ld4(rw + k * 16), w1 = ld4(rw + k * 16 + 4), w2 = ld4(rw + k * 16 + 8), w3 = ld4(rw + k * 16 + 12);
        lgt[0] += h2 * w0.x; lgt[1] += h2 * w0.y; lgt[2] += h2 * w0.z; lgt[3] += h2 * w0.w;
        lgt[4] += h2 * w1.x; lgt[5] += h2 * w1.y; lgt[6] += h2 * w1.z; lgt[7] += h2 * w1.w;
        lgt[8] += h2 * w2.x; lgt[9] += h2 * w2.y; lgt[10] += h2 * w2.z; lgt[11] += h2 * w2.w;
        lgt[12] += h2 * w3.x; lgt[13] += h2 * w3.y; lgt[14] += h2 * w3.z; lgt[15] += h2 * w3.w;
      }
    float mx = -1e30f;
#pragma unroll
    for (int e = 0; e < 16; ++e) { lgt[e] = wave_sum(lgt[e]); mx = fmaxf(mx, lgt[e]); }
    float den = 0.f;
#pragma unroll
    for (int e = 0; e < 16; ++e) { lgt[e] = expf(lgt[e] - mx); den += lgt[e]; }
    const float inv = 1.0f / den;
    float mine = 0.f;
#pragma unroll
    for (int e = 0; e < 16; ++e) if (lane == e) mine = lgt[e] * inv;
    if (lane < 16) aff[(size_t)row * 16 + lane] = mine;
  }
}

__device__ void phase_topk(float* lds, const float* aff, int* idx, float* gate, int bid, int nb) {
  unsigned long long* keys = reinterpret_cast<unsigned long long*>(lds);
  const int tid = threadIdx.x;
  for (int item = bid; item < kB * kE; item += nb) {
    const int b = item / kE, e = item % kE;
    __syncthreads();
    for (int t = tid; t < kT; t += NTHR) {
      const float a = aff[((size_t)b * kT + t) * 16 + e];
      keys[t] = ((unsigned long long)__float_as_uint(a) << 32) | (unsigned)(0xFFFFFFFFu - (unsigned)t);
    }
    __syncthreads();
    for (int k = 2; k <= kT; k <<= 1) {
      for (int j = k >> 1; j > 0; j >>= 1) {
        for (int i = tid; i < kT; i += NTHR) {
          const int ixj = i ^ j;
          if (ixj > i) {
            const unsigned long long a = keys[i], c = keys[ixj];
            const bool desc = (i & k) == 0;
            if (desc ? (a < c) : (a > c)) { keys[i] = c; keys[ixj] = a; }
          }
        }
        __syncthreads();
      }
    }
    for (int c = tid; c < kCAP; c += NTHR) {
      const unsigned long long kv = keys[c];
      idx[item * kCAP + c] = (int)(0xFFFFFFFFu - (unsigned)(kv & 0xFFFFFFFFull));
      gate[item * kCAP + c] = __uint_as_float((unsigned)(kv >> 32));
    }
  }
}

__device__ void phase_final(const Params& p, const float* moe, float* out, const float* mod, int bid, int nb) {
  const int lane = threadIdx.x & 63, wid = threadIdx.x >> 6;
  const float* n2post = p.in[I_N2POST];
  for (int row = bid * 8 + wid; row < kROWS; row += nb * 8) {
    const int b = row / kT;
    float4 m[4];
    float ss = 0.f;
#pragma unroll
    for (int i = 0; i < 4; ++i) { m[i] = ld4(moe + (size_t)row * kD + i * 256 + lane * 4); ss += m[i].x * m[i].x + m[i].y * m[i].y + m[i].z * m[i].z + m[i].w * m[i].w; }
    ss = wave_sum(ss);
    const float r = rsqrtf(ss * (1.0f / kD) + 1e-6f);
#pragma unroll
    for (int i = 0; i < 4; ++i) {
      const int k = i * 256 + lane * 4;
      float4 o = ld4(out + (size_t)row * kD + k);
      const float4 gp = ld4(n2post + k), gt = ld4(mod + b * 6144 + 5120 + k);
      o.x += gt.x * m[i].x * r * gp.x; o.y += gt.y * m[i].y * r * gp.y; o.z += gt.z * m[i].z * r * gp.z; o.w += gt.w * m[i].w * r * gp.w;
      *reinterpret_cast<float4*>(out + (size_t)row * kD + k) = o;
    }
  }
}

__global__ void __launch_bounds__(NTHR, 2) fwd_megakernel(Params p) {
  extern __shared__ __attribute__((aligned(16))) float lds[];
  cg::grid_group grid = cg::this_grid();
  const int bid = blockIdx.x, nb = gridDim.x;
  char* ws = p.ws;
  float* mod = (float*)(ws + OFF_MOD);   float* rstdx = (float*)(ws + OFF_RSTDX); float* rstdc = (float*)(ws + OFF_RSTDC);
  float* rstd2 = (float*)(ws + OFF_RSTD2); float* nrm = (float*)(ws + OFF_NORM);  unsigned* cnt = (unsigned*)(ws + OFF_CNT);
  float* sctx = (float*)(ws + OFF_SCTX); float* BS = (float*)(ws + OFF_BS);       float* aff = (float*)(ws + OFF_AFF);
  int* idx = (int*)(ws + OFF_IDX);       float* gate = (float*)(ws + OFF_GATE);   float* CC = (float*)(ws + OFF_CC);
  float* kfu = (float*)(ws + OFF_KFU);
  unsigned short* winT = (unsigned short*)(ws + OFF_WINT); unsigned short* hb = (unsigned short*)(ws + OFF_HB);
  float* RA = (float*)(ws + OFF_RA);     float* RB = (float*)(ws + OFF_RB);
  float* RWCb = RA;
  float* HYCb = RB;
  float* HYO = RB;
  float* Y0 = RB + (size_t)kROWS * 512;
  float* Y1 = Y0 + (size_t)kROWS * 512;
  float* Zb = p.out;
  float* X0b = p.out + (size_t)kROWS * 512;
  float* PRE = RA;
  float* TMP = p.out;
  float* MIXED = RB;
  float* MOE = RB;
  float* HID = RA;

  phase_mod(lds, p.in[I_C], p.in[I_CCTX], p.in[I_MODW], p.in[I_MODB], mod, bid, nb);
  phase_filter(lds, p, kfu, nrm, bid, nb);
  phase_rstd(p.in[I_X], p.in[I_CTX], rstdx, rstdc, bid, nb);
  phase_wprep(lds, p, winT, bid, nb);
  grid.sync();
  phase_hb(p, mod, hb, bid, nb);
  {
    ALoadNorm al{p.in[I_CTX], rstdc, p.in[I_N1PRE], mod, 1, 4, 1024, 0};
    BLoadPlain bl{p.in[I_WIN], kINC, 2048};
    EpiStore ep{CC, kCC};
    gemm_f32(lds, kB * kCTX, kCC, kD, al, bl, ep, bid, nb);
  }
  grid.sync();
  if (bid < 64) {
    const int dir = bid >> 5, b = (bid >> 3) & 3, h = bid & 7;
    rwkv_scan_block(lds, p, CC, kCC, kCTX, -1, 0, 512, 1024, 1088, 512, b, h, dir, nullptr, sctx + (size_t)bid * 4096, nullptr, nullptr);
    __syncthreads();
  }
  {
    __syncthreads();
    SchedG1 S; S.o.init(kROWS / 256, 13, nb, bid); S.A = (const char*)hb; S.B = (const char*)winT;
    EpiG1F32 E{HYCb, RWCb};
    pg8::gemm_phase<EpiG1F32, SchedG1, false>((PG8_LAS unsigned char*)lds, kD, S, E);
    __syncthreads();
  }
  grid.sync();
  phase_hyprep(p, HYCb, Zb, X0b, bid, nb);
  grid.sync();
  if (bid < 64) {
    const int dir = bid >> 5, b = (bid >> 3) & 3, h = bid & 7;
    rwkv_scan_block(lds, p, RWCb, kRWC, kT, 0, 512, 1024, 1536, 1600, 0, b, h, dir, sctx + (size_t)bid * 4096, nullptr, Y0, BS);
    __syncthreads();
  }
  {
    int* sitem = reinterpret_cast<int*>(lds);
    for (;;) {
      __syncthreads();
      if (threadIdx.x == 0) *sitem = (int)atomicAdd(cnt, 1u);
      __syncthreads();
      const int item = *sitem;
      if (item >= 2048) break;
      conv_item(p, item, Zb, X0b, kfu, nrm, HYO);
    }
  }
  grid.sync();
  phase_rwout(lds, p, RWCb, Y0, Y1, BS, bid, nb);
  grid.sync();
  {
    ALoadPlain al{HYO, 512}; BLoadPlain bl{p.in[I_HPROJ], kD, 0}; EpiStore ep{PRE, kD};
    gemm_f32(lds, kROWS, kD, 512, al, bl, ep, bid, nb);
    ALoadPlain al2{Y0, 512}; BLoadPlain bl2{p.in[I_RWPROJ], kD, 0}; EpiStore ep2{TMP, kD};
    gemm_f32(lds, kROWS, kD, 512, al2, bl2, ep2, bid, nb);
  }
  grid.sync();
  {
    ALoadNorm al{p.in[I_X], rstdx, p.in[I_N1PRE], mod, kT, -1, 1024, 0};
    BLoadPlain bl{p.in[I_WIN], kINC, kHYC + kRWC};
    EpiGates ep{PRE, TMP};
    gemm_f32(lds, kROWS, 2 * kD, kD, al, bl, ep, bid, nb);
  }
  grid.sync();
  {
    ALoadSum2 al{PRE, TMP, kD}; BLoadPlain bl{p.in[I_WOUT], kD, 0}; EpiStore ep{MIXED, kD};
    gemm_f32(lds, kROWS, kD, kD, al, bl, ep, bid, nb);
  }
  grid.sync();
  phase_post(p, MIXED, p.out, rstd2, aff, mod, bid, nb);
  grid.sync();
  phase_topk(lds, aff, idx, gate, bid, nb);
  for (size_t i = (size_t)bid * NTHR + threadIdx.x; i < (size_t)kROWS * kD / 4; i += (size_t)nb * NTHR)
    reinterpret_cast<float4*>(MOE)[i] = make_float4(0.f, 0.f, 0.f, 0.f);
  grid.sync();
  for (int eg = 0; eg < 4; ++eg) {
    ALoadGatherNorm al{p.out, rstd2, p.in[I_N2PRE], mod, idx, eg * 4};
    {
      BLoadExpert bl{p.in[I_EW1], kF, (size_t)kD * kF, eg * 4}; EpiSilu ep{HID, kF};
      gemm_f32(lds, 16384, kF, kD, al, bl, ep, bid, nb);
    }
    grid.sync();
    {
      BLoadExpert bl{p.in[I_EW3], kF, (size_t)kD * kF, eg * 4}; EpiMul ep{HID, kF};
      gemm_f32(lds, 16384, kF, kD, al, bl, ep, bid, nb);
    }
    grid.sync();
    {
      ALoadPlain al2{HID, kF}; BLoadExpert bl{p.in[I_EW2], kD, (size_t)kF * kD, eg * 4}; EpiScatter ep{MOE, idx, gate, eg * 4};
      gemm_f32(lds, 16384, kD, kF, al2, bl, ep, bid, nb);
    }
    grid.sync();
  }
  phase_final(p, MOE, p.out, mod, bid, nb);
}

extern "C" void kernel_launch(void* const* d_in, const int* in_sizes, int n_in, void* d_out, int out_size, void* d_ws, size_t ws_size,
                              hipStream_t stream) {
  static int grid_blocks = 0;
  if (!grid_blocks) {
    int dev = 0, cus = 0, per_cu = 0;
    hipGetDevice(&dev);
    hipDeviceGetAttribute(&cus, hipDeviceAttributeMultiprocessorCount, dev);
    hipFuncSetAttribute((const void*)fwd_megakernel, hipFuncAttributeMaxDynamicSharedMemorySize, (int)LDS_BYTES);
    hipOccupancyMaxActiveBlocksPerMultiprocessor(&per_cu, fwd_megakernel, NTHR, LDS_BYTES);
    if (per_cu < 1) per_cu = 1;
    if (per_cu > 1) per_cu = 1;
    grid_blocks = cus * per_cu;
  }
  Params p{};
  for (int i = 0; i < 38; ++i) p.in[i] = (const float*)d_in[i];
  p.out = (float*)d_out;
  p.ws = (char*)d_ws;
  hipMemsetAsync((char*)d_ws + OFF_NORM, 0, 2048 + 256, stream);
  void* args[] = {&p};
  hipError_t e = hipLaunchCooperativeKernel((void*)fwd_megakernel, dim3(grid_blocks), dim3(NTHR), args, LDS_BYTES, stream);
  if (e != hipSuccess) fprintf(stderr, "cooperative launch failed: %s (grid %d)\n", hipGetErrorString(e), grid_blocks);
}
```

```cpp
#include <hip/hip_runtime.h>
#include <hip/hip_cooperative_groups.h>
#include <hip/hip_fp16.h>
#include <cstdio>
#include <cstdint>
namespace cg = cooperative_groups;

#define DEV __device__ __forceinline__
typedef float f32x16 __attribute__((ext_vector_type(16)));

constexpr int kD = 1024, kB = 4, kT = 8192, kCTX = 256, kROWS = kB * kT;
constexpr int kHYW = 512, kHYC = 1536, kRWW = 512, kRWC = 1792, kINC = 5376;
constexpr int kH = 8, kE = 16, kF = 2048, kCAP = 1024;
constexpr int kCC = 1152;
constexpr int NTHR = 512;
constexpr size_t LDS_BYTES = 140 * 1024;

constexpr size_t OFF_MOD   = 0;
constexpr size_t OFF_RSTDC = OFF_MOD + 131072;
constexpr size_t OFF_NORM  = OFF_RSTDC + 4096;
constexpr size_t OFF_CNT   = OFF_NORM + 2048;
constexpr size_t OFF_SCTX  = OFF_CNT + 256;
constexpr size_t OFF_BS    = OFF_SCTX + 1048576;
constexpr size_t OFF_AFF   = OFF_BS + 2097152;
constexpr size_t OFF_IDX   = OFF_AFF + 2097152;
constexpr size_t OFF_GATE  = OFF_IDX + 262144;
constexpr size_t OFF_KFU   = OFF_GATE + 262144;
constexpr size_t OFF_SEL   = OFF_KFU + 33554432;
constexpr size_t OFF_WINT  = OFF_SEL + 2097152;
constexpr size_t OFF_HPT   = OFF_WINT + 11010048;
constexpr size_t OFF_RPT   = OFF_HPT + 1048576;
constexpr size_t OFF_WOT   = OFF_RPT + 1048576;
constexpr size_t OFF_W13T  = OFF_WOT + 2097152;
constexpr size_t OFF_W2T   = OFF_W13T + 134217728;
constexpr size_t OFF_A0    = OFF_W2T + 67108864;
constexpr size_t OFF_A1    = OFF_A0 + 67108864;
constexpr size_t A1_BYTES  = 268435456;
constexpr size_t WS_TOTAL  = OFF_A1 + A1_BYTES;
static_assert(WS_TOTAL <= 597000000, "workspace budget");

struct Params {
  const float* in[38];
  float* out;
  char* ws;
};

enum { I_X = 0, I_C, I_CTX, I_CCTX, I_MODW, I_MODB, I_N1PRE, I_N1POST, I_N2PRE, I_N2POST, I_WIN,
       I_HCW, I_HCB, I_HW1, I_HB1, I_HW2, I_HB2, I_HW3, I_HFREQ, I_HBIAS, I_HPROJ,
       I_MU, I_W0, I_WUP, I_A0, I_AUP, I_GUP, I_KK, I_KA, I_RK, I_LNG, I_LNB, I_RWPROJ, I_WOUT, I_ROUTER,
       I_EW1, I_EW3, I_EW2 };

DEV int tidx() { int t = threadIdx.x; asm volatile("" : "+v"(t)); return t; }
DEV float wave_sum(float v) {
#pragma unroll
  for (int o = 32; o > 0; o >>= 1) v += __shfl_xor(v, o);
  return v;
}
DEV float sigmoidf_(float x) { return 1.0f / (1.0f + expf(-x)); }
DEV float siluf_(float x) { return x / (1.0f + expf(-x)); }
DEV float softplusf_(float x) { return x > 20.f ? x : log1pf(expf(x)); }
DEV void sincos_cw(float x, float& sn, float& cs) {
  const float kf = rintf(x * 0.6366197723675814f);
  const int k = (int)kf;
  float r = fmaf(kf, -1.5703125f, x);
  r = fmaf(kf, -4.837512969970703125e-4f, r);
  r = fmaf(kf, -7.54978995489188216e-8f, r);
  const float r2 = r * r;
  const float sp = r + r * r2 * (-1.6666654611e-1f + r2 * (8.3321608736e-3f + r2 * (-1.9515295891e-4f)));
  const float cp = 1.0f - 0.5f * r2 + r2 * r2 * (4.166664568298827e-2f + r2 * (-1.388731625493765e-3f + r2 * 2.443315711809948e-5f));
  const float s0 = (k & 1) ? cp : sp, c0 = (k & 1) ? sp : cp;
  sn = (k & 2) ? -s0 : s0;
  cs = ((k + 1) & 2) ? -c0 : c0;
}
DEV float sin_cw(float x) { float a, b; sincos_cw(x, a, b); return a; }
DEV float4 ld4(const float* p) { return *reinterpret_cast<const float4*>(p); }

constexpr int GA_S = 132;
template <class AL, class BL, class EP>
__device__ void gemm_f32(float* lds, int M, int N, int K, const AL& al, const BL& bl, const EP& ep, int bid, int nb) {
  float* As = lds;
  float* Bs = lds + 16 * GA_S;
  const int tid = tidx(), lane = tid & 63, wid = tid >> 6, wm = wid >> 1, wn = wid & 1;
  const int arow = tid >> 2, akq = (tid & 3) * 4;
  const int bk = tid >> 5, bnq = (tid & 31) * 4;
  const int tilesN = N / 128, ntiles = (M / 128) * tilesN;
  for (int tile = bid; tile < ntiles; tile += nb) {
    const int m0 = (tile / tilesN) * 128, n0 = (tile % tilesN) * 128;
    f32x16 acc0, acc1;
#pragma unroll
    for (int i = 0; i < 16; ++i) { acc0[i] = 0.f; acc1[i] = 0.f; }
    float4 ra = al(m0 + arow, akq), rb = bl(m0, bk, n0 + bnq);
    for (int k0 = 0; k0 < K; k0 += 16) {
      __syncthreads();
      As[(akq + 0) * GA_S + arow] = ra.x; As[(akq + 1) * GA_S + arow] = ra.y;
      As[(akq + 2) * GA_S + arow] = ra.z; As[(akq + 3) * GA_S + arow] = ra.w;
      *reinterpret_cast<float4*>(&Bs[bk * 128 + bnq]) = rb;
      __syncthreads();
      if (k0 + 16 < K) { ra = al(m0 + arow, k0 + 16 + akq); rb = bl(m0, k0 + 16 + bk, n0 + bnq); }
#pragma unroll
      for (int kk = 0; kk < 8; ++kk) {
        const int kr = 2 * kk + (lane >> 5);
        const float a = As[kr * GA_S + wm * 32 + (lane & 31)];
        const float b0 = Bs[kr * 128 + wn * 64 + (lane & 31)];
        const float b1 = Bs[kr * 128 + wn * 64 + 32 + (lane & 31)];
        acc0 = __builtin_amdgcn_mfma_f32_32x32x2f32(a, b0, acc0, 0, 0, 0);
        acc1 = __builtin_amdgcn_mfma_f32_32x32x2f32(a, b1, acc1, 0, 0, 0);
      }
    }
#pragma unroll
    for (int r = 0; r < 16; ++r) {
      const int row = m0 + wm * 32 + (r & 3) + 8 * (r >> 2) + 4 * (lane >> 5);
      const int col = n0 + wn * 64 + (lane & 31);
      ep(row, col, acc0[r]);
      ep(row, col + 32, acc1[r]);
    }
  }
}


namespace pg8 {
#define PG8_LAS __attribute__((address_space(3)))
typedef unsigned short bf16_t;
typedef short bf16x8 __attribute__((ext_vector_type(8)));
typedef float f32x4 __attribute__((ext_vector_type(4)));
typedef unsigned u32x4 __attribute__((ext_vector_type(4)));
typedef unsigned u32x2 __attribute__((ext_vector_type(2)));
constexpr int BM = 256, BK = 64, HALF = 128, HTB = HALF * BK * 2, STAGE_BYTES = 8 * HTB, NXCD = 8, WGM = 8;
__host__ __device__ __forceinline__ int lds_byte(int r, int c) { const int st = (r >> 4) * 2 + (c >> 5), rr = r & 15, cc = c & 31, ob = rr * 64 + cc * 2; return st * 1024 + (ob ^ (((ob >> 9) & 1) << 5)); }
__host__ __device__ __forceinline__ void stage_rc(int b, int& R, int& C) { const int st = b / 1024, sb = b % 1024, swz = sb ^ (((sb >> 9) & 1) << 5); R = (st >> 1) * 16 + swz / 64; C = (st & 1) * 32 + (swz % 64) / 2; }
__host__ __device__ __forceinline__ int perm32(int rho) { const int n = rho >> 4, i = rho & 15; return 8 * (i >> 2) + 4 * n + (i & 3); }
__device__ __forceinline__ unsigned cvt_pk_bf16(float lo, float hi) { unsigned r; asm volatile("v_cvt_pk_bf16_f32 %0, %1, %2" : "=v"(r) : "v"(lo), "v"(hi)); return r; }

struct Unit { int pm, pn; const char* a; const char* b; };

struct TileOrder {
  int nM, nN, nwg, G, c;
  __device__ void init(int nM_, int nN_, int G_, int c_) { nM = nM_; nN = nN_; nwg = nM * nN; G = G_; c = c_; }
  __device__ bool tile(int i, int& pm, int& pn) const {
    const long L = (long)i * G + c; if (L >= nwg) return false;
    int wgid = (int)L; { const int q = nwg / NXCD, r = nwg % NXCD, xcd = wgid % NXCD, off = wgid / NXCD; wgid = (xcd < r ? xcd * (q + 1) : r * (q + 1) + (xcd - r) * q) + off; }
    const int nig = WGM * nN, gid = wgid / nig, fm = gid * WGM, gsz = (nM - fm) < WGM ? (nM - fm) : WGM;
    pm = fm + ((wgid % nig) % gsz); pn = (wgid % nig) / gsz; return true;
  }
};

template <class Epi, class Sched, bool GATHER>
__device__ __forceinline__ void gemm_phase(PG8_LAS unsigned char* lds, const int K, const Sched& S, const Epi& E) {
  int tid_ = tidx(); asm volatile("" : "+v"(tid_));
  const int tid = tid_, wid = __builtin_amdgcn_readfirstlane(tid >> 6), lane = tid & 63, wr = wid >> 2, wc = wid & 3, fr = lane & 15, fq = lane >> 4;
  const int nt = K / BK;
  unsigned voffA[2], voffB[2];
#pragma unroll
  for (int i = 0; i < 2; ++i) { int R, C; stage_rc(tid * 16 + i * 8192, R, C); const int Rb = Epi::PERM ? ((R & ~31) + perm32(R & 31)) : R;
    voffA[i] = (unsigned)(R * K + C) * 2u; voffB[i] = (unsigned)(Rb * K + C) * 2u; }
  const size_t kstep = (size_t)(BK * 2);
  const size_t hstep = (size_t)HALF * K * 2;
  const unsigned ldsw = (unsigned)wid * 1024u;
  const int aoff = lds_byte(wr * 64 + fr, fq * 8), boff = lds_byte(wc * 32 + fr, fq * 8);
#define PG8_SA(b, h) (((b) * 2 + (h)) * HTB)
#define PG8_SB(b, h) ((4 + (b) * 2 + (h)) * HTB)
#define PG8_STAGE(bufoff, gbase, voff) do { _Pragma("unroll") for (int _i = 0; _i < 2; ++_i) \
    __builtin_amdgcn_global_load_lds((const unsigned*)((const char*)(gbase) + (voff)[_i]), (PG8_LAS unsigned*)(lds + (bufoff) + ldsw + _i * 8192), 16, 0, 0); } while (0)
#define PG8_STAGE_A(bufoff, gbase, h) do { if constexpr (GATHER) { PG8_STAGE(bufoff, gbase, vAc[h]); } else { PG8_STAGE(bufoff, (gbase) + (h) * hstep, voffA); } } while (0)
#define PG8_GATHER_OFFS(dst, u) do { _Pragma("unroll") for (int _h = 0; _h < 2; ++_h) _Pragma("unroll") for (int _i = 0; _i < 2; ++_i) { int _R, _C; stage_rc(tid * 16 + _i * 8192, _R, _C); \
    dst[_h][_i] = (unsigned)S.row(u, _h * HALF + _R) * (unsigned)(K * 2) + (unsigned)(_C * 2); } } while (0)
#define PG8_LDA(dst, b, h) do { _Pragma("unroll") for (int m = 0; m < 4; ++m) _Pragma("unroll") for (int k = 0; k < 2; ++k) dst[m][k] = *(const PG8_LAS bf16x8*)(lds + PG8_SA(b, h) + aoff + m * 2048 + k * 1024); } while (0)
#define PG8_LDB(dst, b, h) do { _Pragma("unroll") for (int n = 0; n < 2; ++n) _Pragma("unroll") for (int k = 0; k < 2; ++k) dst[n][k] = *(const PG8_LAS bf16x8*)(lds + PG8_SB(b, h) + boff + n * 2048 + k * 1024); } while (0)
#define PG8_MMA(ai, bj, At, Bt) do { __builtin_amdgcn_s_setprio(1); _Pragma("unroll") for (int m = 0; m < 4; ++m) _Pragma("unroll") for (int n = 0; n < 2; ++n) _Pragma("unroll") for (int k = 0; k < 2; ++k) \
    acc[ai][bj][m][n] = __builtin_amdgcn_mfma_f32_16x16x32_bf16(Bt[n][k], At[m][k], acc[ai][bj][m][n], 0, 0, 0); __builtin_amdgcn_s_setprio(0); } while (0)
#define PG8_WAIT_V(n) asm volatile("s_waitcnt vmcnt(" #n ")" ::: "memory")
#define PG8_WAIT_L(n) asm volatile("s_waitcnt lgkmcnt(" #n ")" ::: "memory")
#define PG8_BAR __builtin_amdgcn_s_barrier()
#define PG8_SCHED __builtin_amdgcn_sched_barrier(0)
  Unit cur, nxt; int ui = 0;
  if (!S.next(0, cur)) return;
  unsigned vAc[2][2];
  if constexpr (GATHER) { PG8_GATHER_OFFS(vAc, cur); }
  else { vAc[0][0] = vAc[0][1] = vAc[1][0] = vAc[1][1] = 0u; }
  f32x4 acc[2][2][4][2];
#pragma unroll
  for (int a = 0; a < 2; ++a)
#pragma unroll
    for (int b = 0; b < 2; ++b)
#pragma unroll
      for (int m = 0; m < 4; ++m)
#pragma unroll
        for (int n = 0; n < 2; ++n) acc[a][b][m][n] = (f32x4){0.f, 0.f, 0.f, 0.f};
  bf16x8 At[4][2], B0[2][2], B1[2][2];
  const char* cA = cur.a; const char* cB = cur.b;
  PG8_STAGE(PG8_SB(0, 0), cB, voffB); PG8_STAGE_A(PG8_SA(0, 0), cA, 0); PG8_STAGE(PG8_SB(0, 1), cB + hstep, voffB); PG8_STAGE_A(PG8_SA(0, 1), cA, 1);
  if (wr == 1) PG8_BAR;
  PG8_WAIT_V(4); PG8_BAR;
  PG8_STAGE(PG8_SB(1, 0), cB + kstep, voffB); PG8_STAGE_A(PG8_SA(1, 0), cA + kstep, 0); PG8_STAGE(PG8_SB(1, 1), cB + hstep + kstep, voffB);
  PG8_WAIT_V(6); PG8_BAR;
  for (;;) {
    const bool has_next = S.next(ui + 1, nxt);
    const char* nA = has_next ? nxt.a : cA; const char* nB = has_next ? nxt.b : cB;
    for (int t = 0; t < nt; t += 2) {
      const bool last = (t == nt - 2);
      const char* a1 = cA + (size_t)(t + 1) * kstep;
      const char* a2 = last ? nA : cA + (size_t)(t + 2) * kstep; const char* b2 = last ? nB : cB + (size_t)(t + 2) * kstep;
      const char* a3 = a2 + kstep; const char* b3 = b2 + kstep;
      unsigned vAn[2][2];
      if constexpr (GATHER) { PG8_SCHED; if (last && has_next) { PG8_GATHER_OFFS(vAn, nxt); } PG8_SCHED; }
      PG8_LDB(B0, 0, 0); PG8_SCHED; PG8_LDA(At, 0, 0); PG8_STAGE_A(PG8_SA(1, 1), a1, 1);
      PG8_WAIT_L(8); PG8_BAR; PG8_WAIT_L(0); PG8_MMA(0, 0, At, B0); PG8_BAR; PG8_SCHED;
      if constexpr (GATHER) { if (last && has_next) { vAc[0][0] = vAn[0][0]; vAc[0][1] = vAn[0][1]; vAc[1][0] = vAn[1][0]; vAc[1][1] = vAn[1][1]; } }
      PG8_LDB(B1, 0, 1); PG8_STAGE(PG8_SB(0, 0), b2, voffB);
      PG8_BAR; PG8_WAIT_L(0); PG8_MMA(0, 1, At, B1); PG8_BAR;
      PG8_LDA(At, 0, 1); PG8_STAGE_A(PG8_SA(0, 0), a2, 0);
      PG8_BAR; PG8_WAIT_L(0); PG8_MMA(1, 0, At, B0); PG8_BAR; PG8_SCHED;
      PG8_STAGE(PG8_SB(0, 1), b2 + hstep, voffB);
      PG8_WAIT_V(6); PG8_BAR; PG8_MMA(1, 1, At, B1); PG8_BAR;
      PG8_LDB(B0, 1, 0); PG8_SCHED; PG8_LDA(At, 1, 0); PG8_STAGE_A(PG8_SA(0, 1), a2, 1);
      PG8_WAIT_L(8); PG8_BAR; PG8_WAIT_L(0); PG8_MMA(0, 0, At, B0); PG8_BAR; PG8_SCHED;
      PG8_LDB(B1, 1, 1); PG8_STAGE(PG8_SB(1, 0), b3, voffB);
      PG8_BAR; PG8_WAIT_L(0); PG8_MMA(0, 1, At, B1); PG8_BAR;
      PG8_LDA(At, 1, 1); PG8_STAGE_A(PG8_SA(1, 0), a3, 0);
      PG8_BAR; PG8_WAIT_L(0); PG8_MMA(1, 0, At, B0); PG8_BAR; PG8_SCHED;
      PG8_STAGE(PG8_SB(1, 1), b3 + hstep, voffB);
      PG8_WAIT_V(6); PG8_BAR; PG8_MMA(1, 1, At, B1); PG8_BAR;
    }
    E(acc, cur, wr, wc, fr, fq);
    if (!has_next) break;
#pragma unroll
    for (int a = 0; a < 2; ++a)
#pragma unroll
      for (int b = 0; b < 2; ++b)
#pragma unroll
        for (int m = 0; m < 4; ++m)
#pragma unroll
          for (int n = 0; n < 2; ++n) acc[a][b][m][n] = (f32x4){0.f, 0.f, 0.f, 0.f};
    cur = nxt; cA = nA; cB = nB; ++ui;
  }
  PG8_WAIT_V(0);
  if (wr == 0) PG8_BAR;
  PG8_BAR;
#undef PG8_SA
#undef PG8_SB
#undef PG8_STAGE
#undef PG8_STAGE_A
#undef PG8_GATHER_OFFS
#undef PG8_LDA
#undef PG8_LDB
#undef PG8_MMA
#undef PG8_WAIT_V
#undef PG8_WAIT_L
#undef PG8_BAR
#undef PG8_SCHED
}
}

__device__ void transpose_tile(float* tl, const float* src, int ld, int scol0, unsigned short* dst, int K, int n0, int k0) {
  const int tid = tidx();
  __syncthreads();
#pragma unroll
  for (int ps = 0; ps < 4; ++ps) {
    const int kr = ps * 32 + (tid >> 4), c4 = (tid & 15) * 4;
    const float4 v = ld4(src + (size_t)(k0 + kr) * ld + scol0 + c4);
    tl[kr * 65 + c4] = v.x; tl[kr * 65 + c4 + 1] = v.y; tl[kr * 65 + c4 + 2] = v.z; tl[kr * 65 + c4 + 3] = v.w;
  }
  __syncthreads();
  const int n = tid >> 3, kq = (tid & 7) * 16;
  unsigned w[8];
#pragma unroll
  for (int i = 0; i < 8; ++i) w[i] = pg8::cvt_pk_bf16(tl[(kq + 2 * i) * 65 + n], tl[(kq + 2 * i + 1) * 65 + n]);
  uint4* o = reinterpret_cast<uint4*>(dst + (size_t)(n0 + n) * K + k0 + kq);
  o[0] = make_uint4(w[0], w[1], w[2], w[3]); o[1] = make_uint4(w[4], w[5], w[6], w[7]);
}

typedef unsigned short bf16_t;
DEV float bf2f(bf16_t v) { return __uint_as_float((unsigned)v << 16); }
DEV float bflo(unsigned w) { return __uint_as_float(w << 16); }
DEV float bfhi(unsigned w) { return __uint_as_float(w & 0xffff0000u); }
DEV bf16_t f2bf(float f) { return (bf16_t)(pg8::cvt_pk_bf16(f, 0.f) & 0xffffu); }
DEV float fsigmoid(float x) { return 1.0f / (1.0f + __expf(-x)); }

__device__ void phase_wprep(float* lds, const Params& p, char* ws, int bid, int nb) {
  bf16_t* winT = (bf16_t*)(ws + OFF_WINT); bf16_t* hpT = (bf16_t*)(ws + OFF_HPT); bf16_t* rpT = (bf16_t*)(ws + OFF_RPT);
  bf16_t* woT = (bf16_t*)(ws + OFF_WOT); bf16_t* w13T = (bf16_t*)(ws + OFF_W13T); bf16_t* w2T = (bf16_t*)(ws + OFF_W2T);
  constexpr int N0 = 672, N1 = N0 + 64, N2 = N1 + 64, N3 = N2 + 128, N4 = N3 + 8192, N5 = N4 + 4096;
  for (int item = bid; item < N5; item += nb) {
    if (item < N0) {
      const int nt = item >> 3, kt = item & 7, n0 = nt * 64;
      int scol;
      if (n0 < 3328) scol = n0;
      else { const int r = n0 - 3328, j = r >> 8, q = r & 255; scol = 3328 + (q < 128 ? 0 : 1024) + j * 128 + (q & 127); }
      transpose_tile(lds, p.in[I_WIN], kINC, scol, winT, kD, n0, kt * 128);
    } else if (item < N1) { const int it = item - N0; transpose_tile(lds, p.in[I_HPROJ], kD, (it >> 2) * 64, hpT, 512, (it >> 2) * 64, (it & 3) * 128);
    } else if (item < N2) { const int it = item - N1; transpose_tile(lds, p.in[I_RWPROJ], kD, (it >> 2) * 64, rpT, 512, (it >> 2) * 64, (it & 3) * 128);
    } else if (item < N3) { const int it = item - N2; transpose_tile(lds, p.in[I_WOUT], kD, (it >> 3) * 64, woT, kD, (it >> 3) * 64, (it & 7) * 128);
    } else if (item < N4) {
      const int it = item - N3, e = it >> 9, nt = (it >> 3) & 63, kt = it & 7, n0 = nt * 64, j = n0 >> 8, q = n0 & 255;
      const float* src = (q < 128 ? p.in[I_EW1] : p.in[I_EW3]) + (size_t)e * kD * kF;
      transpose_tile(lds, src, kF, j * 128 + (q & 127), w13T + (size_t)e * 4096 * kD, kD, n0, kt * 128);
    } else {
      const int it = item - N4, e = it >> 8, nt = (it >> 4) & 15, kt = it & 15;
      transpose_tile(lds, p.in[I_EW2] + (size_t)e * kF * kD, kD, nt * 64, w2T + (size_t)e * kD * kF, kF, nt * 64, kt * 128);
    }
  }
}

__device__ void phase_hb(const Params& p, const float* mod, bf16_t* hb, int bid, int nb) {
  const int lane = tidx() & 63, wid = tidx() >> 6;
  const float* x = p.in[I_X]; const float* g = p.in[I_N1PRE];
  for (int row = bid * 8 + wid; row < kROWS; row += nb * 8) {
    const int b = row / kT;
    float4 v[4]; float ss = 0.f;
#pragma unroll
    for (int i = 0; i < 4; ++i) { v[i] = ld4(x + (size_t)row * kD + i * 256 + lane * 4); ss += v[i].x * v[i].x + v[i].y * v[i].y + v[i].z * v[i].z + v[i].w * v[i].w; }
    ss = wave_sum(ss);
    const float r = rsqrtf(ss * (1.0f / kD) + 1e-6f);
#pragma unroll
    for (int i = 0; i < 4; ++i) {
      const int k = i * 256 + lane * 4;
      const float4 gv = ld4(g + k), sc = ld4(mod + b * 6144 + 1024 + k), sh = ld4(mod + b * 6144 + k);
      const float h0 = v[i].x * r * gv.x * (1.f + sc.x) + sh.x, h1 = v[i].y * r * gv.y * (1.f + sc.y) + sh.y;
      const float h2 = v[i].z * r * gv.z * (1.f + sc.z) + sh.z, h3 = v[i].w * r * gv.w * (1.f + sc.w) + sh.w;
      *reinterpret_cast<uint2*>(hb + (size_t)row * kD + k) = make_uint2(pg8::cvt_pk_bf16(h0, h1), pg8::cvt_pk_bf16(h2, h3));
    }
  }
}

struct SchedPlain {
  pg8::TileOrder o; const char* A; const char* B; size_t tstep;
  __device__ bool next(int i, pg8::Unit& u) const { if (!o.tile(i, u.pm, u.pn)) return false; u.a = A + (size_t)u.pm * tstep; u.b = B + (size_t)u.pn * tstep; return true; }
  __device__ int row(const pg8::Unit&, int) const { return 0; }
};
struct SchedExp1 {
  pg8::TileOrder o; const char* H2; const char* W13T; const int* idx; int e0;
  __device__ bool next(int i, pg8::Unit& u) const { if (!o.tile(i, u.pm, u.pn)) return false;
    const int e = e0 + (u.pm >> 4); u.a = H2; u.b = W13T + ((size_t)e * 4096 + (size_t)u.pn * 256) * kD * 2; return true; }
  __device__ int row(const pg8::Unit& u, int r) const { return idx[(unsigned)(u.pm * 256 + r)]; }
};
struct SchedExp2 {
  pg8::TileOrder o; const char* HID; const char* W2T; int e0;
  __device__ bool next(int i, pg8::Unit& u) const { if (!o.tile(i, u.pm, u.pn)) return false;
    const int e = e0 + (u.pm >> 4); u.a = HID + (size_t)u.pm * 256 * kF * 2; u.b = W2T + ((size_t)e * kD + (size_t)u.pn * 256) * kF * 2; return true; }
  __device__ int row(const pg8::Unit&, int) const { return 0; }
};

struct EpiBf16Split {
  static constexpr bool PERM = true;
  bf16_t* o0; int ld0; int nt0; bf16_t* o1; int ld1;
  __device__ __forceinline__ void operator()(const pg8::f32x4 (&acc)[2][2][4][2], const pg8::Unit& u, int wr, int wc, int fr, int fq) const {
    bf16_t* base; int ldc, colt;
    if (u.pn < nt0) { base = o0; ldc = ld0; colt = u.pn * 256; } else { base = o1; ldc = ld1; colt = (u.pn - nt0) * 256; }
    const int row0 = u.pm * 256 + wr * 64 + fr, col0 = colt + wc * 32 + 8 * fq;
#pragma unroll
    for (int ai = 0; ai < 2; ++ai)
#pragma unroll
      for (int m = 0; m < 4; ++m) { bf16_t* rowp = base + (size_t)(row0 + ai * 128 + m * 16) * ldc + col0;
#pragma unroll
        for (int bj = 0; bj < 2; ++bj) { const pg8::f32x4 v0 = acc[ai][bj][m][0], v1 = acc[ai][bj][m][1];
          pg8::u32x4 w; w.x = pg8::cvt_pk_bf16(v0[0], v0[1]); w.y = pg8::cvt_pk_bf16(v0[2], v0[3]); w.z = pg8::cvt_pk_bf16(v1[0], v1[1]); w.w = pg8::cvt_pk_bf16(v1[2], v1[3]);
          *(pg8::u32x4*)(rowp + bj * 128) = w; } }
  }
};
struct EpiF32Store {
  static constexpr bool PERM = false;
  float* C; int ldc;
  __device__ __forceinline__ void operator()(const pg8::f32x4 (&acc)[2][2][4][2], const pg8::Unit& u, int wr, int wc, int fr, int fq) const {
    const int row0 = u.pm * 256 + wr * 64 + fr, col0 = u.pn * 256 + wc * 32 + 4 * fq;
#pragma unroll
    for (int ai = 0; ai < 2; ++ai)
#pragma unroll
      for (int m = 0; m < 4; ++m) { float* rowp = C + (size_t)(row0 + ai * 128 + m * 16) * ldc + col0;
#pragma unroll
        for (int bj = 0; bj < 2; ++bj)
#pragma unroll
          for (int n = 0; n < 2; ++n) *(pg8::f32x4*)(rowp + bj * 128 + n * 16) = acc[ai][bj][m][n]; }
  }
};
struct EpiGatesMerge {
  static constexpr bool PERM = true;
  const bf16_t* yh; const bf16_t* yr; bf16_t* pre;
  __device__ __forceinline__ void operator()(const pg8::f32x4 (&acc)[2][2][4][2], const pg8::Unit& u, int wr, int wc, int fr, int fq) const {
    const int row0 = u.pm * 256 + wr * 64 + fr, col0 = u.pn * 128 + wc * 32 + 8 * fq;
#pragma unroll
    for (int ai = 0; ai < 2; ++ai)
#pragma unroll
      for (int m = 0; m < 4; ++m) { const size_t off = (size_t)(row0 + ai * 128 + m * 16) * kD + col0;
        const pg8::u32x4 a = *(const pg8::u32x4*)(yh + off), b = *(const pg8::u32x4*)(yr + off);
        const pg8::f32x4 g0 = acc[ai][0][m][0], g1 = acc[ai][0][m][1], r0 = acc[ai][1][m][0], r1 = acc[ai][1][m][1];
        float o[8];
        o[0] = fsigmoid(g0[0]) * bflo(a.x) + fsigmoid(r0[0]) * bflo(b.x); o[1] = fsigmoid(g0[1]) * bfhi(a.x) + fsigmoid(r0[1]) * bfhi(b.x);
        o[2] = fsigmoid(g0[2]) * bflo(a.y) + fsigmoid(r0[2]) * bflo(b.y); o[3] = fsigmoid(g0[3]) * bfhi(a.y) + fsigmoid(r0[3]) * bfhi(b.y);
        o[4] = fsigmoid(g1[0]) * bflo(a.z) + fsigmoid(r1[0]) * bflo(b.z); o[5] = fsigmoid(g1[1]) * bfhi(a.z) + fsigmoid(r1[1]) * bfhi(b.z);
        o[6] = fsigmoid(g1[2]) * bflo(a.w) + fsigmoid(r1[2]) * bflo(b.w); o[7] = fsigmoid(g1[3]) * bfhi(a.w) + fsigmoid(r1[3]) * bfhi(b.w);
        pg8::u32x4 w; w.x = pg8::cvt_pk_bf16(o[0], o[1]); w.y = pg8::cvt_pk_bf16(o[2], o[3]); w.z = pg8::cvt_pk_bf16(o[4], o[5]); w.w = pg8::cvt_pk_bf16(o[6], o[7]);
        *(pg8::u32x4*)(pre + off) = w; }
  }
};
struct EpiSwiGLU {
  static constexpr bool PERM = true;
  bf16_t* hid;
  __device__ __forceinline__ void operator()(const pg8::f32x4 (&acc)[2][2][4][2], const pg8::Unit& u, int wr, int wc, int fr, int fq) const {
    const int row0 = u.pm * 256 + wr * 64 + fr, col0 = u.pn * 128 + wc * 32 + 8 * fq;
#pragma unroll
    for (int ai = 0; ai < 2; ++ai)
#pragma unroll
      for (int m = 0; m < 4; ++m) { const size_t off = (size_t)(row0 + ai * 128 + m * 16) * kF + col0;
        float o[8];
#pragma unroll
        for (int n = 0; n < 2; ++n)
#pragma unroll
          for (int j = 0; j < 4; ++j) { const float a = acc[ai][0][m][n][j]; o[n * 4 + j] = a * fsigmoid(a) * acc[ai][1][m][n][j]; }
        pg8::u32x4 w; w.x = pg8::cvt_pk_bf16(o[0], o[1]); w.y = pg8::cvt_pk_bf16(o[2], o[3]); w.z = pg8::cvt_pk_bf16(o[4], o[5]); w.w = pg8::cvt_pk_bf16(o[6], o[7]);
        *(pg8::u32x4*)(hid + off) = w; }
  }
};
struct EpiYE {
  static constexpr bool PERM = true;
  bf16_t* ye; const float* gate; int e0;
  __device__ __forceinline__ void operator()(const pg8::f32x4 (&acc)[2][2][4][2], const pg8::Unit& u, int wr, int wc, int fr, int fq) const {
    const int e = e0 + (u.pm >> 4), s0 = (u.pm & 15) * 256 + wr * 64 + fr, col0 = u.pn * 256 + wc * 32 + 8 * fq;
#pragma unroll
    for (int ai = 0; ai < 2; ++ai)
#pragma unroll
      for (int m = 0; m < 4; ++m) { const int s = s0 + ai * 128 + m * 16, b = s >> 10, c = s & 1023, slot = (b * kE + e) * kCAP + c;
        const float g = gate[slot]; bf16_t* rowp = ye + (size_t)slot * kD + col0;
#pragma unroll
        for (int bj = 0; bj < 2; ++bj) { const pg8::f32x4 v0 = acc[ai][bj][m][0] * g, v1 = acc[ai][bj][m][1] * g;
          pg8::u32x4 w; w.x = pg8::cvt_pk_bf16(v0[0], v0[1]); w.y = pg8::cvt_pk_bf16(v0[2], v0[3]); w.z = pg8::cvt_pk_bf16(v1[0], v1[1]); w.w = pg8::cvt_pk_bf16(v1[2], v1[3]);
          *(pg8::u32x4*)(rowp + bj * 128) = w; } }
  }
};

struct ALoadNorm {
  const float* x; const float* rstd; const float* g; const float* mod; int rows_per_b; int fixed_mrow; int sc_off, sh_off;
  DEV float4 operator()(int row, int k) const {
    const int mr = fixed_mrow >= 0 ? fixed_mrow : row / rows_per_b;
    const float4 xv = ld4(x + (size_t)row * kD + k), gv = ld4(g + k);
    const float4 sc = ld4(mod + mr * 6144 + sc_off + k), sh = ld4(mod + mr * 6144 + sh_off + k);
    const float r = rstd[row];
    return make_float4(xv.x * r * gv.x * (1.f + sc.x) + sh.x, xv.y * r * gv.y * (1.f + sc.y) + sh.y,
                       xv.z * r * gv.z * (1.f + sc.z) + sh.z, xv.w * r * gv.w * (1.f + sc.w) + sh.w);
  }
};
struct BLoadPlain { const float* b; int ldb; int coff; DEV float4 operator()(int, int k, int n) const { return ld4(b + (size_t)k * ldb + coff + n); } };
struct EpiStore { float* c; int ldc; DEV void operator()(int r, int col, float v) const { c[(size_t)r * ldc + col] = v; } };

__device__ void phase_rstd(const float* ctx, float* rstdc, int bid, int nb) {
  const int lane = tidx() & 63, wid = tidx() >> 6;
  for (int row = bid * 8 + wid; row < kB * kCTX; row += nb * 8) {
    const float* p = ctx + (size_t)row * kD;
    float s = 0.f;
#pragma unroll
    for (int i = 0; i < 4; ++i) { const float4 v = ld4(p + i * 256 + lane * 4); s += v.x * v.x + v.y * v.y + v.z * v.z + v.w * v.w; }
    s = wave_sum(s);
    if (lane == 0) rstdc[row] = rsqrtf(s * (1.0f / kD) + 1e-6f);
  }
}
__device__ void phase_mod(float* lds, const float* c, const float* cctx, const float* modw, const float* modb, float* mod, int bid, int nb) {
  float* sc = lds;
  float* red = lds + 5120;
  const int tid = tidx(), kk = tid >> 6, nl = tid & 63;
  bool loaded = false;
  for (int item = bid; item < 96; item += nb) {
    if (!loaded) {
      for (int i = tid; i < 5120; i += NTHR) { const int v = i >> 10, k = i & 1023; const float cv = v < 4 ? c[v * kD + k] : cctx[k]; sc[i] = siluf_(cv); }
      loaded = true;
    }
    __syncthreads();
    const int n = item * 64 + nl;
    float acc[5] = {0.f, 0.f, 0.f, 0.f, 0.f};
#pragma unroll 8
    for (int k = kk * 128; k < kk * 128 + 128; ++k) {
      const float w = modw[(size_t)k * 6144 + n];
#pragma unroll
      for (int v = 0; v < 5; ++v) acc[v] += sc[v * 1024 + k] * w;
    }
#pragma unroll
    for (int v = 0; v < 5; ++v) red[(kk * 5 + v) * 64 + nl] = acc[v];
    __syncthreads();
    if (tid < 320) {
      const int v = tid >> 6;
      float s = 0.f;
#pragma unroll
      for (int q = 0; q < 8; ++q) s += red[(q * 5 + v) * 64 + nl];
      mod[v * 6144 + n] = s + modb[n];
    }
    __syncthreads();
  }
}

__device__ void phase_filter(float* lds, const Params& p, float* circT, int bid, int nb) {
  float* feat = lds;
  float* h1 = lds + 32 * 33;
  float* h2 = h1 + 32 * 64;
  const float* w1 = p.in[I_HW1]; const float* b1 = p.in[I_HB1]; const float* w2 = p.in[I_HW2]; const float* b2 = p.in[I_HB2];
  const float* w3 = p.in[I_HW3]; const float* fr = p.in[I_HFREQ];
  const int tid = tidx();
  for (int item = bid; item < kT / 32; item += nb) {
    const int l0 = item * 32;
    __syncthreads();
    for (int i = tid; i < 32 * 33; i += NTHR) {
      const int pz = i / 33, f = i % 33, l = l0 + pz;
      float v;
      if (f == 0) v = (float)l / (float)(kT - 1);
      else {
        const int j = (f - 1) & 15;
        const float band = 1e-4f + (float)j * ((15.0f - 1e-4f) / 15.0f);
        const float ang = (6.283185307179586f / (float)kT) * (float)l;
        float sn, cs; sincos_cw(band * ang, sn, cs); v = f <= 16 ? cs : -sn;
      }
      feat[i] = v;
    }
    __syncthreads();
    for (int i = tid; i < 32 * 64; i += NTHR) {
      const int pz = i >> 6, o = i & 63;
      float s = b1[o];
#pragma unroll 3
      for (int f = 0; f < 33; ++f) s += feat[pz * 33 + f] * w1[f * 64 + o];
      h1[i] = sin_cw(fr[o] * s);
    }
    __syncthreads();
    for (int i = tid; i < 32 * 64; i += NTHR) {
      const int pz = i >> 6, o = i & 63;
      float s = b2[o];
#pragma unroll 4
      for (int f = 0; f < 64; ++f) s += h1[pz * 64 + f] * w2[f * 64 + o];
      h2[i] = sin_cw(fr[o] * s);
    }
    __syncthreads();
#pragma unroll 1
    for (int half = 0; half < 2; ++half) {
      const int n = tid + half * 512;
      const int c = tid;
      float wr[64];
#pragma unroll
      for (int o = 0; o < 64; ++o) wr[o] = w3[o * 1024 + n];
      const float dlo = -4.605170185988091f / 1.5f, dhi = -4.605170185988091f / 0.3f;
      const float delta = fabsf(dlo + (float)c * ((dhi - dlo) / 511.0f));
      float asum = 0.f;
#pragma unroll 1
      for (int q = 0; q < 32; ++q) {
        float a = 0.f;
#pragma unroll
        for (int o = 0; o < 64; ++o) a += h2[q * 64 + o] * wr[o];
        const int l = l0 + q;
        const float tt = (float)l / (float)(kT - 1);
        const float v = a * expf(-tt * delta);
        if (half == 0) circT[(size_t)c * 16384 + l] = v;
        else circT[(size_t)c * 16384 + 16384 - l - (l == 0 ? 8192 : 0)] = (l == 0 ? 0.f : v);
      }
      (void)asum;
    }
  }
}

DEV float ldcol(const float* p, size_t i) { return p[i]; }
DEV float ldcol(const bf16_t* p, size_t i) { return bf2f(p[i]); }
template <class CT>
__device__ void rwkv_scan_block(float* lds, const Params& p, const CT* cols, int ldc, int Tlen, int cR, int cK, int cV, int cLW, int cLA, int muoff,
                                int b, int h, int dir, const float* S0, float* Sout, bf16_t* Y, float* BSo) {
  float* aR = lds;            float* aK = lds + 4096;      float* aV = lds + 8192;     float* aLW = lds + 12288;
  float* aLA = lds + 16384;   float* aDEC = lds + 20480;   float* aAV = lds + 24576;   float* aBV = lds + 28672;
  const float* mu = p.in[I_MU];
  const float* w0 = p.in[I_W0] + dir * 512 + h * 64;  const float* wup = p.in[I_WUP] + (size_t)dir * 64 * 512 + h * 64;
  const float* a0 = p.in[I_A0] + dir * 512 + h * 64;  const float* aup = p.in[I_AUP] + (size_t)dir * 64 * 512 + h * 64;
  const float* kkw = p.in[I_KK] + h * 64; const float* kaw = p.in[I_KA] + h * 64; const float* rkw = p.in[I_RK] + h * 64;
  const int tid = tidx(), lane = tid & 63, wid = tid >> 6;
  const int si = tid >> 3, sj = (tid & 7) * 8;
  const bool emit = cR >= 0;
  float s[8];
#pragma unroll
  for (int j = 0; j < 8; ++j) s[j] = S0 ? S0[si * 64 + sj + j] : 0.f;
  const CT* base = cols + (size_t)b * Tlen * ldc;
  for (int ci = 0; ci < Tlen / 64; ++ci) {
    __syncthreads();
    for (int i = tid; i < 5 * 4096; i += NTHR) {
      const int arr = i >> 12, q = (i >> 6) & 63, j = i & 63;
      if (arr == 0 && !emit) continue;
      const int t = dir ? (Tlen - 1 - (ci * 64 + q)) : (ci * 64 + q);
      const int col = (arr == 0 ? cR + h * 64 : arr == 1 ? cK + h * 64 : arr == 2 ? cV + h * 64 : arr == 3 ? cLW : cLA) + j;
      const float cur = ldcol(base, (size_t)t * ldc + col);
      const float prv = t > 0 ? ldcol(base, (size_t)(t - 1) * ldc + col) : 0.f;
      const float nxt = t < Tlen - 1 ? ldcol(base, (size_t)(t + 1) * ldc + col) : 0.f;
      float z = cur + mu[col + muoff] * (prv - cur) + mu[kRWC + col + muoff] * (nxt - cur);
      if (arr == 3) z = tanhf(z);
      lds[arr * 4096 + q * 64 + j] = z;
    }
    __syncthreads();
    for (int i = tid; i < 4096; i += NTHR) {
      const int q = i >> 6, j = i & 63;
      float sw = w0[j], sa = a0[j];
      for (int k = 0; k < 64; ++k) { sw += aLW[q * 64 + k] * wup[k * 512 + j]; sa += aLA[q * 64 + k] * aup[k * 512 + j]; }
      const float w = -softplusf_(-sw) - 0.5f;
      aDEC[i] = expf(-expf(w));
      aBV[i] = sigmoidf_(sa);
    }
    __syncthreads();
    for (int q = wid; q < 64; q += 8) {
      const float kraw = aK[q * 64 + lane], a = aBV[q * 64 + lane];
      const float kkv = kraw * kkw[lane];
      const float ss = wave_sum(kkv * kkv);
      const float kkn = kkv * rsqrtf(fmaxf(ss, 1e-24f));
      const float km = kraw * (1.f + (a - 1.f) * kaw[lane]);
      aAV[q * 64 + lane] = -kkn; aBV[q * 64 + lane] = kkn * a; aK[q * 64 + lane] = km;
      if (emit) {
        const float bsum = wave_sum(aR[q * 64 + lane] * km * rkw[lane]);
        const int t = dir ? (Tlen - 1 - (ci * 64 + q)) : (ci * 64 + q);
        if (lane == 0) BSo[((size_t)dir * kROWS + (size_t)b * Tlen + t) * 8 + h] = bsum;
      }
    }
    __syncthreads();
    for (int q = 0; q < 64; ++q) {
      const float4 a0v = *reinterpret_cast<const float4*>(&aAV[q * 64 + sj]), a1v = *reinterpret_cast<const float4*>(&aAV[q * 64 + sj + 4]);
      const float av[8] = {a0v.x, a0v.y, a0v.z, a0v.w, a1v.x, a1v.y, a1v.z, a1v.w};
      float sa = 0.f;
#pragma unroll
      for (int j = 0; j < 8; ++j) sa += s[j] * av[j];
      sa += __shfl_xor(sa, 1); sa += __shfl_xor(sa, 2); sa += __shfl_xor(sa, 4);
      const float vi = aV[q * 64 + si];
      float y = 0.f;
#pragma unroll
      for (int j = 0; j < 8; ++j) {
        s[j] = s[j] * aDEC[q * 64 + sj + j] + sa * aBV[q * 64 + sj + j] + vi * aK[q * 64 + sj + j];
        if (emit) y += s[j] * aR[q * 64 + sj + j];
      }
      if (emit) {
        y += __shfl_xor(y, 1); y += __shfl_xor(y, 2); y += __shfl_xor(y, 4);
        const int t = dir ? (Tlen - 1 - (ci * 64 + q)) : (ci * 64 + q);
        if ((tid & 7) == 0) Y[(size_t)dir * kROWS * 512 + ((size_t)b * Tlen + t) * 512 + h * 64 + si] = f2bf(y);
      }
    }
  }
  if (Sout) {
#pragma unroll
    for (int j = 0; j < 8; ++j) Sout[si * 64 + sj + j] = s[j];
  }
}

typedef float2 cf;
DEV cf cmul(cf a, cf b) { return make_float2(a.x * b.x - a.y * b.y, a.x * b.y + a.y * b.x); }
DEV cf cadd(cf a, cf b) { return make_float2(a.x + b.x, a.y + b.y); }
DEV cf csub(cf a, cf b) { return make_float2(a.x - b.x, a.y - b.y); }
DEV int PADI(int i) { return i + (i >> 4); }
constexpr int FFT_N = 16384, FFT_PAD = FFT_N + FFT_N / 16;
DEV void dft4(cf& x0, cf& x1, cf& x2, cf& x3) {
  const cf a0 = cadd(x0, x2), a1 = csub(x0, x2), a2 = cadd(x1, x3), d = csub(x1, x3);
  const cf a3 = make_float2(d.y, -d.x);
  x0 = cadd(a0, a2); x1 = cadd(a1, a3); x2 = csub(a0, a2); x3 = csub(a1, a3);
}
DEV void dft16(cf (&v)[16]) {
#pragma unroll
  for (int a = 0; a < 4; ++a) dft4(v[a], v[a + 4], v[a + 8], v[a + 12]);
  const cf w1 = make_float2(0.9238795325112867f, -0.3826834323650898f), w2 = make_float2(0.7071067811865476f, -0.7071067811865476f);
  const cf w3 = make_float2(0.3826834323650898f, -0.9238795325112867f), w6 = make_float2(-0.7071067811865476f, -0.7071067811865476f);
  const cf w9 = make_float2(-0.9238795325112867f, 0.3826834323650898f);
  v[1 + 4] = cmul(v[1 + 4], w1); v[1 + 8] = cmul(v[1 + 8], w2); v[1 + 12] = cmul(v[1 + 12], w3);
  v[2 + 4] = cmul(v[2 + 4], w2); v[2 + 8] = make_float2(v[2 + 8].y, -v[2 + 8].x); v[2 + 12] = cmul(v[2 + 12], w6);
  v[3 + 4] = cmul(v[3 + 4], w3); v[3 + 8] = cmul(v[3 + 8], w6); v[3 + 12] = cmul(v[3 + 12], w9);
#pragma unroll
  for (int c = 0; c < 4; ++c) dft4(v[4 * c], v[4 * c + 1], v[4 * c + 2], v[4 * c + 3]);
}
template <int PASS>
DEV void fft_pass16(cf* buf, int tid) {
  constexpr int lg = 4 * PASS, Ns = 1 << lg;
  cf v0[16], v1[16];
  const cf* rd = buf + PADI(tid);
#pragma unroll
  for (int r = 0; r < 16; ++r) { v0[r] = rd[1088 * r]; v1[r] = rd[1088 * r + 544]; }
  __syncthreads();
#pragma unroll
  for (int h = 0; h < 2; ++h) {
    cf (&v)[16] = h ? v1 : v0;
    int tl = tid; asm volatile("" : "+v"(tl) :: "memory");
    const int j = tl + 512 * h, k = j & (Ns - 1);
    if (PASS > 0) {
      float sn, cs; sincos_cw(-6.283185307179586f * (float)k / (float)(Ns * 16), sn, cs);
      const cf w = make_float2(cs, sn); cf pw = w;
#pragma unroll
      for (int r = 1; r < 16; ++r) { v[r] = cmul(v[r], pw); if (r < 15) pw = cmul(pw, w); }
    }
    dft16(v);
    const int j0 = ((j >> lg) << (lg + 4)) + k;
    cf* wr = buf + PADI(j0);
    constexpr int step = PASS == 0 ? 1 : Ns + Ns / 16;
#pragma unroll
    for (int r = 0; r < 16; ++r) wr[step * r] = v[4 * (r & 3) + (r >> 2)];
  }
  __syncthreads();
}
__device__ void fft16384(cf* buf) {
  int tid = tidx(); asm volatile("" : "+v"(tid));
  fft_pass16<0>(buf, tid);
  fft_pass16<1>(buf, tid);
  fft_pass16<2>(buf, tid);
#pragma unroll 2
  for (int q = 0; q < 8; ++q) {
    const int j = tid + 512 * q;
    cf* pp = buf + PADI(j);
    cf x0 = pp[0], x1 = pp[4352], x2 = pp[8704], x3 = pp[13056];
    float sn, cs; sincos_cw(-6.283185307179586f * (float)j / 16384.0f, sn, cs);
    const cf w1 = make_float2(cs, sn), w2 = cmul(w1, w1), w3 = cmul(w2, w1);
    x1 = cmul(x1, w1); x2 = cmul(x2, w2); x3 = cmul(x3, w3);
    dft4(x0, x1, x2, x3);
    pp[0] = x0; pp[4352] = x1; pp[8704] = x2; pp[13056] = x3;
  }
  __syncthreads();
}
DEV float hy_conv3t(const Params& p, const bf16_t* hyt, int col, int b, int t) {
  const bf16_t* q = hyt + (size_t)col * kROWS + b * kT;
  const float* cw = p.in[I_HCW];
  const float cur = bf2f(q[t]), prv = t > 0 ? bf2f(q[t - 1]) : 0.f, nxt = t < kT - 1 ? bf2f(q[t + 1]) : 0.f;
  return cw[col] * prv + cw[kHYC + col] * cur + cw[2 * kHYC + col] * nxt + p.in[I_HCB][col];
}
__device__ void fftconv_channel(float* ldsf, const Params& p, int c, const float* circT, const bf16_t* hyt, bf16_t* hyot) {
  cf* buf = reinterpret_cast<cf*>(ldsf);
  float* red = ldsf + 2 * FFT_PAD;
  const int tid = tidx(), lane = tid & 63, wid = tid >> 6;
  const float* cc = circT + (size_t)c * FFT_N;
  const float hbias = p.in[I_HBIAS][c];
  unsigned H[32];
#pragma unroll
  for (int m = 0; m < 32; ++m) H[m] = 0u;
  float inrm = 0.f;
  __syncthreads();
#pragma unroll 1
  for (int ph = 0; ph < 5; ++ph) {
    const int pair = (ph - 1) >> 1, b0 = 2 * pair, b1 = b0 + 1;
    if (ph == 0) {
      float asum = 0.f;
#pragma unroll 4
      for (int m = 0; m < 32; ++m) { const float f = cc[tid + 512 * m]; asum += fabsf(f); buf[PADI(tid) + 544 * m] = make_float2(f, 0.f); }
      asum = wave_sum(asum);
      if (lane == 0) red[wid] = asum;
    } else if (ph & 1) {
#pragma unroll 1
      for (int m = 0; m < 16; ++m) {
        const int t = tid + 512 * m;
        const float z0 = hy_conv3t(p, hyt, 1024 + c, b0, t) * hy_conv3t(p, hyt, 512 + c, b0, t);
        const float z1 = hy_conv3t(p, hyt, 1024 + c, b1, t) * hy_conv3t(p, hyt, 512 + c, b1, t);
        buf[PADI(t)] = make_float2(z0, z1);
        buf[PADI(t + 8192)] = make_float2(0.f, 0.f);
      }
    }
    __syncthreads();
    if (ph == 0) { float nrm = 0.f;
#pragma unroll
      for (int w = 0; w < 8; ++w) nrm += red[w];
      inrm = 1.0f / nrm; }
    fft16384(buf);
    if (ph == 0) {
#pragma unroll
      for (int m = 0; m < 32; ++m) { const cf hv = buf[PADI(tid) + 544 * m]; const __half2 hh = __floats2half2_rn(hv.x * inrm, hv.y * inrm); H[m] = *reinterpret_cast<const unsigned*>(&hh); }
    } else if (ph & 1) {
#pragma unroll
      for (int m = 0; m < 32; ++m) { const int i = PADI(tid) + 544 * m; const unsigned hu = H[m]; const float2 hf = __half22float2(*reinterpret_cast<const __half2*>(&hu)); const cf w = cmul(buf[i], hf); buf[i] = make_float2(w.y, w.x); }
    } else {
      const float scale = 1.0f / (float)FFT_N;
#pragma unroll 1
      for (int m = 0; m < 16; ++m) {
        const int t = tid + 512 * m;
        const cf val = buf[PADI(t)];
        const float y0 = val.y * scale, y1 = val.x * scale;
        const float z0 = hy_conv3t(p, hyt, 1024 + c, b0, t) * hy_conv3t(p, hyt, 512 + c, b0, t);
        const float z1 = hy_conv3t(p, hyt, 1024 + c, b1, t) * hy_conv3t(p, hyt, 512 + c, b1, t);
        hyot[(size_t)c * kROWS + b0 * kT + t] = f2bf((y0 + hbias * z0) * hy_conv3t(p, hyt, c, b0, t));
        hyot[(size_t)c * kROWS + b1 * kT + t] = f2bf((y1 + hbias * z1) * hy_conv3t(p, hyt, c, b1, t));
      }
    }
    __syncthreads();
  }
}
__device__ void phase_hyo_transpose(float* ldsf, const bf16_t* hyot, bf16_t* hyo, int bid, int nb) {
  bf16_t* tl = reinterpret_cast<bf16_t*>(ldsf);
  const int tid = tidx();
  for (int item = bid; item < 8 * 512; item += nb) {
    const int c0 = (item & 7) * 64, t0 = (item >> 3) * 64;
    __syncthreads();
    { const int cl = tid >> 3, t8 = (tid & 7) * 8;
      const uint4 u = *reinterpret_cast<const uint4*>(hyot + (size_t)(c0 + cl) * kROWS + t0 + t8);
      *reinterpret_cast<uint4*>(tl + cl * 72 + t8) = u; }
    __syncthreads();
    { const int tl_ = tid >> 3, c8 = (tid & 7) * 8;
      unsigned w[4];
#pragma unroll
      for (int i = 0; i < 4; ++i) w[i] = (unsigned)tl[(c8 + 2 * i) * 72 + tl_] | ((unsigned)tl[(c8 + 2 * i + 1) * 72 + tl_] << 16);
      *reinterpret_cast<uint4*>(hyo + (size_t)(t0 + tl_) * 512 + c0 + c8) = make_uint4(w[0], w[1], w[2], w[3]); }
  }
}

__device__ void phase_rwout(float* lds, const Params& p, const bf16_t* rwc, const bf16_t* Y0, const bf16_t* Y1, const float* BS, bf16_t* rwo, int bid, int nb) {
  const int lane = tidx() & 63, wid = tidx() >> 6;
  float* lg = lds + wid * 128;
  const float* mu = p.in[I_MU]; const float* gup = p.in[I_GUP]; const float* lng = p.in[I_LNG]; const float* lnb = p.in[I_LNB];
  for (int row = bid * 8 + wid; row < kROWS; row += nb * 8) {
    const int t = row & (kT - 1);
    const bf16_t* cur = rwc + (size_t)row * kRWC;
    for (int i = lane; i < 128; i += 64) {
      const int col = 1664 + i;
      const float cv = bf2f(cur[col]), pv = t > 0 ? bf2f(cur[col - kRWC]) : 0.f, nv = t < kT - 1 ? bf2f(cur[col + kRWC]) : 0.f;
      lg[i] = sigmoidf_(cv + mu[col] * (pv - cv) + mu[kRWC + col] * (nv - cv));
    }
    __syncthreads();
    const int c0 = lane * 8, h = lane >> 3;
    float y[8], g[8];
    float sum = 0.f;
    {
      const uint4 u0 = *reinterpret_cast<const uint4*>(Y0 + (size_t)row * 512 + c0), u1 = *reinterpret_cast<const uint4*>(Y1 + (size_t)row * 512 + c0);
      y[0] = bflo(u0.x) + bflo(u1.x); y[1] = bfhi(u0.x) + bfhi(u1.x); y[2] = bflo(u0.y) + bflo(u1.y); y[3] = bfhi(u0.y) + bfhi(u1.y);
      y[4] = bflo(u0.z) + bflo(u1.z); y[5] = bfhi(u0.z) + bfhi(u1.z); y[6] = bflo(u0.w) + bflo(u1.w); y[7] = bfhi(u0.w) + bfhi(u1.w);
    }
#pragma unroll
    for (int j = 0; j < 8; ++j) { sum += y[j]; g[j] = 0.f; }
    sum += __shfl_xor(sum, 1); sum += __shfl_xor(sum, 2); sum += __shfl_xor(sum, 4);
    const float mean = sum * (1.0f / 64.0f);
    float var = 0.f;
#pragma unroll
    for (int j = 0; j < 8; ++j) { const float d = y[j] - mean; var += d * d; }
    var += __shfl_xor(var, 1); var += __shfl_xor(var, 2); var += __shfl_xor(var, 4);
    const float rs = rsqrtf(var * (1.0f / 64.0f) + 64e-5f);
#pragma unroll 4
    for (int i = 0; i < 128; ++i) {
      const float sg = lg[i];
      const float4 u0 = ld4(gup + i * 512 + c0), u1 = ld4(gup + i * 512 + c0 + 4);
      g[0] += sg * u0.x; g[1] += sg * u0.y; g[2] += sg * u0.z; g[3] += sg * u0.w;
      g[4] += sg * u1.x; g[5] += sg * u1.y; g[6] += sg * u1.z; g[7] += sg * u1.w;
    }
    const float bsum = BS[(size_t)row * 8 + h] + BS[((size_t)kROWS + row) * 8 + h];
    float o[8];
#pragma unroll
    for (int j = 0; j < 8; ++j) {
      const int col = 1024 + c0 + j;
      const float cv = bf2f(cur[col]), pv = t > 0 ? bf2f(cur[col - kRWC]) : 0.f, nv = t < kT - 1 ? bf2f(cur[col + kRWC]) : 0.f;
      const float vm = cv + mu[col] * (pv - cv) + mu[kRWC + col] * (nv - cv);
      const float yn = (y[j] - mean) * rs * lng[c0 + j] + lnb[c0 + j];
      o[j] = (yn + bsum * vm) * g[j];
    }
    *reinterpret_cast<uint4*>(rwo + (size_t)row * 512 + c0) = make_uint4(pg8::cvt_pk_bf16(o[0], o[1]), pg8::cvt_pk_bf16(o[2], o[3]), pg8::cvt_pk_bf16(o[4], o[5]), pg8::cvt_pk_bf16(o[6], o[7]));
    __syncthreads();
  }
}

__device__ void phase_post(const Params& p, float* mx, bf16_t* h2o, float* aff, const float* mod, int bid, int nb) {
  const int lane = tidx() & 63, wid = tidx() >> 6;
  const float* x = p.in[I_X]; const float* n1post = p.in[I_N1POST]; const float* n2pre = p.in[I_N2PRE]; const float* rw = p.in[I_ROUTER];
  for (int row = bid * 8 + wid; row < kROWS; row += nb * 8) {
    const int b = row / kT;
    float m[16], xv[16];
    float ss = 0.f;
#pragma unroll
    for (int i = 0; i < 4; ++i) { const float4 v = ld4(mx + (size_t)row * kD + i * 256 + lane * 4);
      m[i * 4] = v.x; m[i * 4 + 1] = v.y; m[i * 4 + 2] = v.z; m[i * 4 + 3] = v.w; ss += v.x * v.x + v.y * v.y + v.z * v.z + v.w * v.w; }
    ss = wave_sum(ss);
    const float r1 = rsqrtf(ss * (1.0f / kD) + 1e-6f);
    float s2 = 0.f;
#pragma unroll
    for (int i = 0; i < 4; ++i) {
      const int k = i * 256 + lane * 4;
      const float4 xx = ld4(x + (size_t)row * kD + k), gp = ld4(n1post + k), gt = ld4(mod + b * 6144 + 2048 + k);
      xv[i * 4] = xx.x + gt.x * m[i * 4] * r1 * gp.x; xv[i * 4 + 1] = xx.y + gt.y * m[i * 4 + 1] * r1 * gp.y;
      xv[i * 4 + 2] = xx.z + gt.z * m[i * 4 + 2] * r1 * gp.z; xv[i * 4 + 3] = xx.w + gt.w * m[i * 4 + 3] * r1 * gp.w;
      *reinterpret_cast<float4*>(mx + (size_t)row * kD + k) = make_float4(xv[i * 4], xv[i * 4 + 1], xv[i * 4 + 2], xv[i * 4 + 3]);
#pragma unroll
      for (int j = 0; j < 4; ++j) s2 += xv[i * 4 + j] * xv[i * 4 + j];
    }
    s2 = wave_sum(s2);
    const float r2 = rsqrtf(s2 * (1.0f / kD) + 1e-6f);
    float lgt[16];
#pragma unroll
    for (int e = 0; e < 16; ++e) lgt[e] = 0.f;
#pragma unroll
    for (int i = 0; i < 4; ++i) {
      const int k0 = i * 256 + lane * 4;
      const float4 gn = ld4(n2pre + k0), sc = ld4(mod + b * 6144 + 4096 + k0), sh = ld4(mod + b * 6144 + 3072 + k0);
      float hh[4];
      hh[0] = xv[i * 4] * r2 * gn.x * (1.f + sc.x) + sh.x; hh[1] = xv[i * 4 + 1] * r2 * gn.y * (1.f + sc.y) + sh.y;
      hh[2] = xv[i * 4 + 2] * r2 * gn.z * (1.f + sc.z) + sh.z; hh[3] = xv[i * 4 + 3] * r2 * gn.w * (1.f + sc.w) + sh.w;
      *reinterpret_cast<uint2*>(h2o + (size_t)row * kD + k0) = make_uint2(pg8::cvt_pk_bf16(hh[0], hh[1]), pg8::cvt_pk_bf16(hh[2], hh[3]));
#pragma unroll
      for (int j = 0; j < 4; ++j) {
        const int k = k0 + j; const float h2 = hh[j];
        const float4 w0 = ld4(rw + k * 16), w1 = ld4(rw + k * 16 + 4), w2 = ld4(rw + k * 16 + 8), w3 = ld4(rw + k * 16 + 12);
        lgt[0] += h2 * w0.x; lgt[1] += h2 * w0.y; lgt[2] += h2 * w0.z; lgt[3] += h2 * w0.w;
        lgt[4] += h2 * w1.x; lgt[5] += h2 * w1.y; lgt[6] += h2 * w1.z; lgt[7] += h2 * w1.w;
        lgt[8] += h2 * w2.x; lgt[9] += h2 * w2.y; lgt[10] += h2 * w2.z; lgt[11] += h2 * w2.w;
        lgt[12] += h2 * w3.x; lgt[13] += h2 * w3.y; lgt[14] += h2 * w3.z; lgt[15] += h2 * w3.w;
      }
    }
    float mxv = -1e30f;
#pragma unroll
    for (int e = 0; e < 16; ++e) { lgt[e] = wave_sum(lgt[e]); mxv = fmaxf(mxv, lgt[e]); }
    float den = 0.f;
#pragma unroll
    for (int e = 0; e < 16; ++e) { lgt[e] = expf(lgt[e] - mxv); den += lgt[e]; }
    const float inv = 1.0f / den;
    float mine = 0.f;
#pragma unroll
    for (int e = 0; e < 16; ++e) if (lane == e) mine = lgt[e] * inv;
    if (lane < 16) aff[(size_t)row * 16 + lane] = mine;
  }
}

__device__ void phase_topk(float* lds, const float* aff, int* idx, float* gate, int* sel, int bid, int nb) {
  unsigned long long* keys = reinterpret_cast<unsigned long long*>(lds);
  const int tid = tidx();
  for (int item = bid; item < kB * kE; item += nb) {
    const int b = item / kE, e = item % kE;
    __syncthreads();
    for (int t = tid; t < kT; t += NTHR) {
      const float a = aff[((size_t)b * kT + t) * 16 + e];
      keys[t] = ((unsigned long long)__float_as_uint(a) << 32) | (unsigned)(0xFFFFFFFFu - (unsigned)t);
    }
    __syncthreads();
    for (int k = 2; k <= kT; k <<= 1) {
      for (int j = k >> 1; j > 0; j >>= 1) {
        for (int i = tid; i < kT; i += NTHR) {
          const int ixj = i ^ j;
          if (ixj > i) {
            const unsigned long long a = keys[i], c = keys[ixj];
            const bool desc = (i & k) == 0;
            if (desc ? (a < c) : (a > c)) { keys[i] = c; keys[ixj] = a; }
          }
        }
        __syncthreads();
      }
    }
    for (int c = tid; c < kT; c += NTHR) {
      const unsigned long long kv = keys[c];
      const int t = (int)(0xFFFFFFFFu - (unsigned)(kv & 0xFFFFFFFFull));
      sel[((size_t)b * kT + t) * 16 + e] = c < kCAP ? c : -1;
      if (c < kCAP) { idx[(e * kB + b) * kCAP + c] = b * kT + t; gate[item * kCAP + c] = __uint_as_float((unsigned)(kv >> 32)); }
    }
  }
}

__device__ void phase_final(const Params& p, const bf16_t* ye, const int* sel, float* out, const float* mod, int bid, int nb) {
  const int lane = tidx() & 63, wid = tidx() >> 6;
  const float* n2post = p.in[I_N2POST];
  for (int row = bid * 8 + wid; row < kROWS; row += nb * 8) {
    const int b = row / kT;
    float m[16];
#pragma unroll
    for (int i = 0; i < 16; ++i) m[i] = 0.f;
    const int myc = lane < 16 ? sel[(size_t)row * 16 + lane] : -1;
#pragma unroll 1
    for (int e = 0; e < 16; ++e) {
      const int c = __shfl(myc, e);
      if (c >= 0) {
        const bf16_t* src = ye + ((size_t)(b * kE + e) * kCAP + c) * kD;
#pragma unroll
        for (int i = 0; i < 4; ++i) { const uint2 u = *reinterpret_cast<const uint2*>(src + i * 256 + lane * 4);
          m[i * 4] += bflo(u.x); m[i * 4 + 1] += bfhi(u.x); m[i * 4 + 2] += bflo(u.y); m[i * 4 + 3] += bfhi(u.y); }
      }
    }
    float ss = 0.f;
#pragma unroll
    for (int i = 0; i < 16; ++i) ss += m[i] * m[i];
    ss = wave_sum(ss);
    const float r = rsqrtf(ss * (1.0f / kD) + 1e-6f);
#pragma unroll
    for (int i = 0; i < 4; ++i) {
      const int k = i * 256 + lane * 4;
      float4 o = ld4(out + (size_t)row * kD + k);
      const float4 gp = ld4(n2post + k), gt = ld4(mod + b * 6144 + 5120 + k);
      o.x += gt.x * m[i * 4] * r * gp.x; o.y += gt.y * m[i * 4 + 1] * r * gp.y; o.z += gt.z * m[i * 4 + 2] * r * gp.z; o.w += gt.w * m[i * 4 + 3] * r * gp.w;
      *reinterpret_cast<float4*>(out + (size_t)row * kD + k) = o;
    }
  }
}

template <class Epi, class Sched, bool G>
DEV void run_gemm(float* lds, int K, const Sched& S, const Epi& E) {
  __syncthreads();
  pg8::gemm_phase<Epi, Sched, G>((PG8_LAS unsigned char*)lds, K, S, E);
  __syncthreads();
}

__global__ void __launch_bounds__(NTHR, 2) fwd_megakernel(Params p) {
  extern __shared__ __attribute__((aligned(16))) float lds[];
  cg::grid_group grid = cg::this_grid();
  const int bid = blockIdx.x, nb = gridDim.x;
  char* const ws = p.ws;
  constexpr size_t MB = 1048576;
#define b_mod   ((float*)(ws + OFF_MOD))
#define b_rstdc ((float*)(ws + OFF_RSTDC))
#define b_sctx  ((float*)(ws + OFF_SCTX))
#define b_BS    ((float*)(ws + OFF_BS))
#define b_aff   ((float*)(ws + OFF_AFF))
#define b_idx   ((int*)(ws + OFF_IDX))
#define b_gate  ((float*)(ws + OFF_GATE))
#define b_CC    (p.out)
#define b_kfu   ((float*)(ws + OFF_KFU))
#define b_sel   ((int*)(ws + OFF_SEL))
#define b_winT  ((const char*)(ws + OFF_WINT))
#define b_hpT   ((const char*)(ws + OFF_HPT))
#define b_rpT   ((const char*)(ws + OFF_RPT))
#define b_woT   ((const char*)(ws + OFF_WOT))
#define b_w13T  ((const char*)(ws + OFF_W13T))
#define b_w2T   ((const char*)(ws + OFF_W2T))
#define b_hb    ((bf16_t*)(ws + OFF_A0))
#define b_A1    (ws + OFF_A1)
#define b_HYT   ((bf16_t*)(b_A1))
#define b_RWC   ((bf16_t*)(b_A1 + 96 * MB))
#define b_HYOT  ((bf16_t*)(b_A1 + 208 * MB))
#define b_HYO   ((bf16_t*)(b_A1))
#define b_RWO   ((bf16_t*)(b_A1 + 32 * MB))
#define b_YH    ((bf16_t*)(b_A1 + 96 * MB))
#define b_YR    ((bf16_t*)(b_A1 + 160 * MB))
#define b_PRE   ((bf16_t*)(b_A1))
#define b_HID0  ((bf16_t*)(b_A1))
#define b_YE    ((bf16_t*)(b_A1 + 128 * MB))
#define b_Y0    ((bf16_t*)(p.out + (size_t)kROWS * 512))
#define b_Y1    (b_Y0 + (size_t)kROWS * 512)

  phase_mod(lds, p.in[I_C], p.in[I_CCTX], p.in[I_MODW], p.in[I_MODB], b_mod, bid, nb);
  phase_filter(lds, p, b_kfu, bid, nb);
  phase_rstd(p.in[I_CTX], b_rstdc, bid, nb);
  phase_wprep(lds, p, ws, bid, nb);
  grid.sync();
  phase_hb(p, b_mod, b_hb, bid, nb);
  {
    ALoadNorm al{p.in[I_CTX], b_rstdc, p.in[I_N1PRE], b_mod, 1, 4, 1024, 0};
    BLoadPlain bl{p.in[I_WIN], kINC, 2048};
    EpiStore ep{b_CC, kCC};
    gemm_f32(lds, kB * kCTX, kCC, kD, al, bl, ep, bid, nb);
  }
  grid.sync();
  if (bid < 64) {
    const int dir = bid >> 5, b = (bid >> 3) & 3, h = bid & 7;
    rwkv_scan_block<float>(lds, p, b_CC, kCC, kCTX, -1, 0, 512, 1024, 1088, 512, b, h, dir, nullptr, b_sctx + (size_t)bid * 4096, nullptr, nullptr);
  }
  {
    SchedPlain S; S.o.init(kROWS / 256, 7, nb, bid); S.A = (const char*)b_hb; S.B = b_winT + (size_t)1536 * kD * 2; S.tstep = (size_t)256 * kD * 2;
    EpiBf16Split E{b_RWC, kRWC, 7, b_RWC, kRWC};
    run_gemm<EpiBf16Split, SchedPlain, false>(lds, kD, S, E);
    SchedPlain S2; S2.o.init(6, kROWS / 256, nb, bid); S2.A = b_winT; S2.B = (const char*)b_hb; S2.tstep = (size_t)256 * kD * 2;
    EpiBf16Split E2{b_HYT, kROWS, kROWS / 256, b_HYT, kROWS};
    run_gemm<EpiBf16Split, SchedPlain, false>(lds, kD, S2, E2);
  }
  grid.sync();
  if (bid < 64) {
    const int dir = bid >> 5, b = (bid >> 3) & 3, h = bid & 7;
    rwkv_scan_block<bf16_t>(lds, p, b_RWC, kRWC, kT, 0, 512, 1024, 1536, 1600, 0, b, h, dir, b_sctx + (size_t)bid * 4096, nullptr, b_Y0, b_BS);
  } else {
    for (int c = bid - 64; c < 512; c += nb - 64) fftconv_channel(lds, p, c, b_kfu, b_HYT, b_HYOT);
  }
  grid.sync();
  phase_rwout(lds, p, b_RWC, b_Y0, b_Y1, b_BS, b_RWO, bid, nb);
  phase_hyo_transpose(lds, b_HYOT, b_HYO, bid, nb);
  grid.sync();
  {
    SchedPlain S; S.o.init(kROWS / 256, 4, nb, bid); S.A = (const char*)b_HYO; S.B = b_hpT; S.tstep = (size_t)256 * 512 * 2;
    EpiBf16Split E{b_YH, kD, 4, b_YH, kD};
    run_gemm<EpiBf16Split, SchedPlain, false>(lds, 512, S, E);
    SchedPlain S2; S2.o.init(kROWS / 256, 4, nb, bid); S2.A = (const char*)b_RWO; S2.B = b_rpT; S2.tstep = (size_t)256 * 512 * 2;
    EpiBf16Split E2{b_YR, kD, 4, b_YR, kD};
    run_gemm<EpiBf16Split, SchedPlain, false>(lds, 512, S2, E2);
  }
  grid.sync();
  {
    SchedPlain S; S.o.init(kROWS / 256, 8, nb, bid); S.A = (const char*)b_hb; S.B = b_winT + (size_t)3328 * kD * 2; S.tstep = (size_t)256 * kD * 2;
    EpiGatesMerge E{b_YH, b_YR, b_PRE};
    run_gemm<EpiGatesMerge, SchedPlain, false>(lds, kD, S, E);
  }
  grid.sync();
  {
    SchedPlain S; S.o.init(kROWS / 256, 4, nb, bid); S.A = (const char*)b_PRE; S.B = b_woT; S.tstep = (size_t)256 * kD * 2;
    EpiF32Store E{p.out, kD};
    run_gemm<EpiF32Store, SchedPlain, false>(lds, kD, S, E);
  }
  grid.sync();
  phase_post(p, p.out, b_hb, b_aff, b_mod, bid, nb);
  grid.sync();
  phase_topk(lds, b_aff, b_idx, b_gate, b_sel, bid, nb);
  grid.sync();
  for (int g = 0; g <= 4; ++g) {
    if (g < 4) {
      SchedExp1 S; S.o.init(64, 16, nb, bid); S.H2 = (const char*)b_hb; S.W13T = b_w13T; S.idx = b_idx + g * 4 * 4096; S.e0 = g * 4;
      EpiSwiGLU E{b_HID0 + (size_t)(g & 1) * 16384 * kF};
      run_gemm<EpiSwiGLU, SchedExp1, true>(lds, kD, S, E);
    }
    if (g > 0) {
      SchedExp2 S; S.o.init(64, 4, nb, bid); S.HID = (const char*)(b_HID0 + (size_t)((g - 1) & 1) * 16384 * kF); S.W2T = b_w2T; S.e0 = (g - 1) * 4;
      EpiYE E{b_YE, b_gate, (g - 1) * 4};
      run_gemm<EpiYE, SchedExp2, false>(lds, kF, S, E);
    }
    grid.sync();
  }
  phase_final(p, b_YE, b_sel, p.out, b_mod, bid, nb);
}

#undef b_mod
#undef b_rstdc
#undef b_sctx
#undef b_BS
#undef b_aff
#undef b_idx
#undef b_gate
#undef b_CC
#undef b_kfu
#undef b_sel
#undef b_winT
#undef b_hpT
#undef b_rpT
#undef b_woT
#undef b_w13T
#undef b_w2T
#undef b_hb
#undef b_A1
#undef b_HYT
#undef b_RWC
#undef b_HYOT
#undef b_HYO
#undef b_RWO
#undef b_YH
#undef b_YR
#undef b_PRE
#undef b_HID0
#undef b_YE
#undef b_Y0
#undef b_Y1
extern "C" void kernel_launch(void* const* d_in, const int* in_sizes, int n_in, void* d_out, int out_size, void* d_ws, size_t ws_size,
                              hipStream_t stream) {
  static int grid_blocks = 0;
  if (!grid_blocks) {
    int dev = 0, cus = 0, per_cu = 0;
    (void)hipGetDevice(&dev);
    (void)hipDeviceGetAttribute(&cus, hipDeviceAttributeMultiprocessorCount, dev);
    (void)hipFuncSetAttribute((const void*)fwd_megakernel, hipFuncAttributeMaxDynamicSharedMemorySize, (int)LDS_BYTES);
    (void)hipOccupancyMaxActiveBlocksPerMultiprocessor(&per_cu, fwd_megakernel, NTHR, LDS_BYTES);
    if (per_cu < 1) per_cu = 1;
    if (per_cu > 1) per_cu = 1;
    grid_blocks = cus * per_cu;
    if (ws_size < WS_TOTAL) fprintf(stderr, "kernel_launch: workspace too small: %zu < %zu\n", ws_size, (size_t)WS_TOTAL);
  }
  if (ws_size < WS_TOTAL) return;
  Params p{};
  for (int i = 0; i < 38; ++i) p.in[i] = (const float*)d_in[i];
  p.out = (float*)d_out;
  p.ws = (char*)d_ws;
    void* args[] = {&p};
  hipError_t e = hipLaunchCooperativeKernel((void*)fwd_megakernel, dim3(grid_blocks), dim3(NTHR), args, LDS_BYTES, stream);
  if (e != hipSuccess) fprintf(stderr, "cooperative launch failed: %s (grid %d)\n", hipGetErrorString(e), grid_blocks);
}
```

```cpp
#include <hip/hip_runtime.h>
#include <hip/hip_cooperative_groups.h>
#include <hip/hip_fp16.h>
#include <cstdio>
#include <cstdint>
namespace cg = cooperative_groups;

#define DEV __device__ __forceinline__
typedef float f32x16 __attribute__((ext_vector_type(16)));

constexpr int kD = 1024, kB = 4, kT = 8192, kCTX = 256, kROWS = kB * kT;
constexpr int kHYW = 512, kHYC = 1536, kRWW = 512, kRWC = 1792, kINC = 5376;
constexpr int kH = 8, kE = 16, kF = 2048, kCAP = 1024;
constexpr int kCC = 1152;
constexpr int NTHR = 512;
constexpr size_t LDS_BYTES = 160 * 1024;

constexpr size_t OFF_MOD   = 0;
constexpr size_t OFF_RSTDC = OFF_MOD + 131072;
constexpr size_t OFF_NORM  = OFF_RSTDC + 4096;
constexpr size_t OFF_CNT   = OFF_NORM + 2048;
constexpr size_t OFF_SCTX  = OFF_CNT + 256;
constexpr size_t OFF_BS    = OFF_SCTX + 1048576;
constexpr size_t OFF_AFF   = OFF_BS + 2097152;
constexpr size_t OFF_IDX   = OFF_AFF + 2097152;
constexpr size_t OFF_GATE  = OFF_IDX + 262144;
constexpr size_t OFF_KFU   = OFF_GATE + 262144;
constexpr size_t OFF_SEL   = OFF_KFU + 33554432;
constexpr size_t OFF_WINT  = OFF_SEL + 2097152;
constexpr size_t OFF_HPT   = OFF_WINT + 11010048;
constexpr size_t OFF_RPT   = OFF_HPT + 1048576;
constexpr size_t OFF_WOT   = OFF_RPT + 1048576;
constexpr size_t OFF_W13T  = OFF_WOT + 2097152;
constexpr size_t OFF_W2T   = OFF_W13T + 134217728;
constexpr size_t OFF_A0    = OFF_W2T + 67108864;
constexpr size_t OFF_A1    = OFF_A0 + 67108864;
constexpr size_t A1_BYTES  = 268435456;
constexpr size_t WS_TOTAL  = OFF_A1 + A1_BYTES;
static_assert(WS_TOTAL <= 597000000, "workspace budget");

struct Params {
  const float* in[38];
  float* out;
  char* ws;
};

enum { I_X = 0, I_C, I_CTX, I_CCTX, I_MODW, I_MODB, I_N1PRE, I_N1POST, I_N2PRE, I_N2POST, I_WIN,
       I_HCW, I_HCB, I_HW1, I_HB1, I_HW2, I_HB2, I_HW3, I_HFREQ, I_HBIAS, I_HPROJ,
       I_MU, I_W0, I_WUP, I_A0, I_AUP, I_GUP, I_KK, I_KA, I_RK, I_LNG, I_LNB, I_RWPROJ, I_WOUT, I_ROUTER,
       I_EW1, I_EW3, I_EW2 };

DEV int tidx() { int t = threadIdx.x; asm volatile("" : "+v"(t)); return t; }
DEV float wave_sum(float v) {
#pragma unroll
  for (int o = 32; o > 0; o >>= 1) v += __shfl_xor(v, o);
  return v;
}
DEV float sigmoidf_(float x) { return 1.0f / (1.0f + expf(-x)); }
DEV float siluf_(float x) { return x / (1.0f + expf(-x)); }
DEV float softplusf_(float x) { return x > 20.f ? x : log1pf(expf(x)); }
DEV void sincos_cw(float x, float& sn, float& cs) {
  const float kf = rintf(x * 0.6366197723675814f);
  const int k = (int)kf;
  float r = fmaf(kf, -1.5703125f, x);
  r = fmaf(kf, -4.837512969970703125e-4f, r);
  r = fmaf(kf, -7.54978995489188216e-8f, r);
  const float r2 = r * r;
  const float sp = r + r * r2 * (-1.6666654611e-1f + r2 * (8.3321608736e-3f + r2 * (-1.9515295891e-4f)));
  const float cp = 1.0f - 0.5f * r2 + r2 * r2 * (4.166664568298827e-2f + r2 * (-1.388731625493765e-3f + r2 * 2.443315711809948e-5f));
  const float s0 = (k & 1) ? cp : sp, c0 = (k & 1) ? sp : cp;
  sn = (k & 2) ? -s0 : s0;
  cs = ((k + 1) & 2) ? -c0 : c0;
}
DEV float sin_cw(float x) { float a, b; sincos_cw(x, a, b); return a; }
DEV float4 ld4(const float* p) { return *reinterpret_cast<const float4*>(p); }

constexpr int GA_S = 132;
template <class AL, class BL, class EP>
__device__ void gemm_f32(float* lds, int M, int N, int K, const AL& al, const BL& bl, const EP& ep, int bid, int nb) {
  float* As = lds;
  float* Bs = lds + 16 * GA_S;
  const int tid = tidx(), lane = tid & 63, wid = tid >> 6, wm = wid >> 1, wn = wid & 1;
  const int arow = tid >> 2, akq = (tid & 3) * 4;
  const int bk = tid >> 5, bnq = (tid & 31) * 4;
  const int tilesN = N / 128, ntiles = (M / 128) * tilesN;
  for (int tile = bid; tile < ntiles; tile += nb) {
    const int m0 = (tile / tilesN) * 128, n0 = (tile % tilesN) * 128;
    f32x16 acc0, acc1;
#pragma unroll
    for (int i = 0; i < 16; ++i) { acc0[i] = 0.f; acc1[i] = 0.f; }
    float4 ra = al(m0 + arow, akq), rb = bl(m0, bk, n0 + bnq);
    for (int k0 = 0; k0 < K; k0 += 16) {
      __syncthreads();
      As[(akq + 0) * GA_S + arow] = ra.x; As[(akq + 1) * GA_S + arow] = ra.y;
      As[(akq + 2) * GA_S + arow] = ra.z; As[(akq + 3) * GA_S + arow] = ra.w;
      *reinterpret_cast<float4*>(&Bs[bk * 128 + bnq]) = rb;
      __syncthreads();
      if (k0 + 16 < K) { ra = al(m0 + arow, k0 + 16 + akq); rb = bl(m0, k0 + 16 + bk, n0 + bnq); }
#pragma unroll
      for (int kk = 0; kk < 8; ++kk) {
        const int kr = 2 * kk + (lane >> 5);
        const float a = As[kr * GA_S + wm * 32 + (lane & 31)];
        const float b0 = Bs[kr * 128 + wn * 64 + (lane & 31)];
        const float b1 = Bs[kr * 128 + wn * 64 + 32 + (lane & 31)];
        acc0 = __builtin_amdgcn_mfma_f32_32x32x2f32(a, b0, acc0, 0, 0, 0);
        acc1 = __builtin_amdgcn_mfma_f32_32x32x2f32(a, b1, acc1, 0, 0, 0);
      }
    }
#pragma unroll
    for (int r = 0; r < 16; ++r) {
      const int row = m0 + wm * 32 + (r & 3) + 8 * (r >> 2) + 4 * (lane >> 5);
      const int col = n0 + wn * 64 + (lane & 31);
      ep(row, col, acc0[r]);
      ep(row, col + 32, acc1[r]);
    }
  }
}


namespace pg8 {
#define PG8_LAS __attribute__((address_space(3)))
typedef unsigned short bf16_t;
typedef short bf16x8 __attribute__((ext_vector_type(8)));
typedef float f32x4 __attribute__((ext_vector_type(4)));
typedef unsigned u32x4 __attribute__((ext_vector_type(4)));
typedef unsigned u32x2 __attribute__((ext_vector_type(2)));
constexpr int BM = 256, BK = 64, HALF = 128, HTB = HALF * BK * 2, STAGE_BYTES = 8 * HTB, NXCD = 8, WGM = 8;
__host__ __device__ __forceinline__ int lds_byte(int r, int c) { const int st = (r >> 4) * 2 + (c >> 5), rr = r & 15, cc = c & 31, ob = rr * 64 + cc * 2; return st * 1024 + (ob ^ (((ob >> 9) & 1) << 5)); }
__host__ __device__ __forceinline__ void stage_rc(int b, int& R, int& C) { const int st = b / 1024, sb = b % 1024, swz = sb ^ (((sb >> 9) & 1) << 5); R = (st >> 1) * 16 + swz / 64; C = (st & 1) * 32 + (swz % 64) / 2; }
__host__ __device__ __forceinline__ int perm32(int rho) { const int n = rho >> 4, i = rho & 15; return 8 * (i >> 2) + 4 * n + (i & 3); }
typedef __bf16 bf16v2 __attribute__((ext_vector_type(2)));
typedef float f32v2 __attribute__((ext_vector_type(2)));
__device__ __forceinline__ unsigned cvt_pk_bf16(float lo, float hi) { const f32v2 v = {lo, hi}; const bf16v2 r = __builtin_convertvector(v, bf16v2); return __builtin_bit_cast(unsigned, r); }

struct Unit { int pm, pn; const char* a; const char* b; };

struct TileOrder {
  int nM, nN, nwg, G, c;
  __device__ void init(int nM_, int nN_, int G_, int c_) { nM = nM_; nN = nN_; nwg = nM * nN; G = G_; c = c_; }
  __device__ bool tile(int i, int& pm, int& pn) const {
    const long L = (long)i * G + c; if (L >= nwg) return false;
    int wgid = (int)L; { const int q = nwg / NXCD, r = nwg % NXCD, xcd = wgid % NXCD, off = wgid / NXCD; wgid = (xcd < r ? xcd * (q + 1) : r * (q + 1) + (xcd - r) * q) + off; }
    const int nig = WGM * nN, gid = wgid / nig, fm = gid * WGM, gsz = (nM - fm) < WGM ? (nM - fm) : WGM;
    pm = fm + ((wgid % nig) % gsz); pn = (wgid % nig) / gsz; return true;
  }
};

template <class Epi, class Sched, bool GATHER>
__device__ __forceinline__ void gemm_phase(PG8_LAS unsigned char* lds, const int K, const Sched& S, const Epi& E) {
  int tid_ = tidx(); asm volatile("" : "+v"(tid_));
  const int tid = tid_, wid = __builtin_amdgcn_readfirstlane(tid >> 6), lane = tid & 63, wr = wid >> 2, wc = wid & 3, fr = lane & 15, fq = lane >> 4;
  const int nt = K / BK;
  unsigned voffA[2], voffB[2];
#pragma unroll
  for (int i = 0; i < 2; ++i) { int R, C; stage_rc(tid * 16 + i * 8192, R, C); const int Rb = Epi::PERM ? ((R & ~31) + perm32(R & 31)) : R;
    voffA[i] = (unsigned)(R * K + C) * 2u; voffB[i] = (unsigned)(Rb * K + C) * 2u; }
  const size_t kstep = (size_t)(BK * 2);
  const size_t hstep = (size_t)HALF * K * 2;
  const unsigned ldsw = (unsigned)wid * 1024u;
  const int aoff = lds_byte(wr * 64 + fr, fq * 8), boff = lds_byte(wc * 32 + fr, fq * 8);
#define PG8_SA(b, h) (((b) * 2 + (h)) * HTB)
#define PG8_SB(b, h) ((4 + (b) * 2 + (h)) * HTB)
#define PG8_STAGE(bufoff, gbase, voff) do { _Pragma("unroll") for (int _i = 0; _i < 2; ++_i) \
    __builtin_amdgcn_global_load_lds((const unsigned*)((const char*)(gbase) + (voff)[_i]), (PG8_LAS unsigned*)(lds + (bufoff) + ldsw + _i * 8192), 16, 0, 0); } while (0)
#define PG8_STAGE_A(bufoff, gbase, h) do { if constexpr (GATHER) { PG8_STAGE(bufoff, gbase, vAc[h]); } else { PG8_STAGE(bufoff, (gbase) + (h) * hstep, voffA); } } while (0)
#define PG8_GATHER_OFFS(dst, u) do { _Pragma("unroll") for (int _h = 0; _h < 2; ++_h) _Pragma("unroll") for (int _i = 0; _i < 2; ++_i) { int _R, _C; stage_rc(tid * 16 + _i * 8192, _R, _C); \
    dst[_h][_i] = (unsigned)S.row(u, _h * HALF + _R) * (unsigned)(K * 2) + (unsigned)(_C * 2); } } while (0)
#define PG8_LDA(dst, b, h) do { _Pragma("unroll") for (int m = 0; m < 4; ++m) _Pragma("unroll") for (int k = 0; k < 2; ++k) dst[m][k] = *(const PG8_LAS bf16x8*)(lds + PG8_SA(b, h) + aoff + m * 2048 + k * 1024); } while (0)
#define PG8_LDB(dst, b, h) do { _Pragma("unroll") for (int n = 0; n < 2; ++n) _Pragma("unroll") for (int k = 0; k < 2; ++k) dst[n][k] = *(const PG8_LAS bf16x8*)(lds + PG8_SB(b, h) + boff + n * 2048 + k * 1024); } while (0)
#define PG8_MMA(ai, bj, At, Bt) do { __builtin_amdgcn_s_setprio(1); _Pragma("unroll") for (int m = 0; m < 4; ++m) _Pragma("unroll") for (int n = 0; n < 2; ++n) _Pragma("unroll") for (int k = 0; k < 2; ++k) \
    acc[ai][bj][m][n] = __builtin_amdgcn_mfma_f32_16x16x32_bf16(Bt[n][k], At[m][k], acc[ai][bj][m][n], 0, 0, 0); __builtin_amdgcn_s_setprio(0); } while (0)
#define PG8_WAIT_V(n) asm volatile("s_waitcnt vmcnt(" #n ")" ::: "memory")
#define PG8_WAIT_L(n) asm volatile("s_waitcnt lgkmcnt(" #n ")" ::: "memory")
#define PG8_BAR __builtin_amdgcn_s_barrier()
#define PG8_SCHED __builtin_amdgcn_sched_barrier(0)
  Unit cur, nxt; int ui = 0;
  if (!S.next(0, cur)) return;
  unsigned vAc[2][2];
  if constexpr (GATHER) { PG8_GATHER_OFFS(vAc, cur); }
  else { vAc[0][0] = vAc[0][1] = vAc[1][0] = vAc[1][1] = 0u; }
  f32x4 acc[2][2][4][2];
#pragma unroll
  for (int a = 0; a < 2; ++a)
#pragma unroll
    for (int b = 0; b < 2; ++b)
#pragma unroll
      for (int m = 0; m < 4; ++m)
#pragma unroll
        for (int n = 0; n < 2; ++n) acc[a][b][m][n] = (f32x4){0.f, 0.f, 0.f, 0.f};
  bf16x8 At[4][2], B0[2][2], B1[2][2];
  const char* cA = cur.a; const char* cB = cur.b;
  PG8_STAGE(PG8_SB(0, 0), cB, voffB); PG8_STAGE_A(PG8_SA(0, 0), cA, 0); PG8_STAGE(PG8_SB(0, 1), cB + hstep, voffB); PG8_STAGE_A(PG8_SA(0, 1), cA, 1);
  if (wr == 1) PG8_BAR;
  PG8_WAIT_V(4); PG8_BAR;
  PG8_STAGE(PG8_SB(1, 0), cB + kstep, voffB); PG8_STAGE_A(PG8_SA(1, 0), cA + kstep, 0); PG8_STAGE(PG8_SB(1, 1), cB + hstep + kstep, voffB);
  PG8_WAIT_V(6); PG8_BAR;
  for (;;) {
    const bool has_next = S.next(ui + 1, nxt);
    const char* nA = has_next ? nxt.a : cA; const char* nB = has_next ? nxt.b : cB;
    for (int t = 0; t < nt; t += 2) {
      const bool last = (t == nt - 2);
      const char* a1 = cA + (size_t)(t + 1) * kstep;
      const char* a2 = last ? nA : cA + (size_t)(t + 2) * kstep; const char* b2 = last ? nB : cB + (size_t)(t + 2) * kstep;
      const char* a3 = a2 + kstep; const char* b3 = b2 + kstep;
      unsigned vAn[2][2];
      if constexpr (GATHER) { PG8_SCHED; if (last && has_next) { PG8_GATHER_OFFS(vAn, nxt); } PG8_SCHED; }
      PG8_LDB(B0, 0, 0); PG8_SCHED; PG8_LDA(At, 0, 0); PG8_STAGE_A(PG8_SA(1, 1), a1, 1);
      PG8_WAIT_L(8); PG8_BAR; PG8_WAIT_L(0); PG8_MMA(0, 0, At, B0); PG8_BAR; PG8_SCHED;
      if constexpr (GATHER) { if (last && has_next) { vAc[0][0] = vAn[0][0]; vAc[0][1] = vAn[0][1]; vAc[1][0] = vAn[1][0]; vAc[1][1] = vAn[1][1]; } }
      PG8_LDB(B1, 0, 1); PG8_STAGE(PG8_SB(0, 0), b2, voffB);
      PG8_BAR; PG8_WAIT_L(0); PG8_MMA(0, 1, At, B1); PG8_BAR;
      PG8_LDA(At, 0, 1); PG8_STAGE_A(PG8_SA(0, 0), a2, 0);
      PG8_BAR; PG8_WAIT_L(0); PG8_MMA(1, 0, At, B0); PG8_BAR; PG8_SCHED;
      PG8_STAGE(PG8_SB(0, 1), b2 + hstep, voffB);
      PG8_WAIT_V(6); PG8_BAR; PG8_MMA(1, 1, At, B1); PG8_BAR;
      PG8_LDB(B0, 1, 0); PG8_SCHED; PG8_LDA(At, 1, 0); PG8_STAGE_A(PG8_SA(0, 1), a2, 1);
      PG8_WAIT_L(8); PG8_BAR; PG8_WAIT_L(0); PG8_MMA(0, 0, At, B0); PG8_BAR; PG8_SCHED;
      PG8_LDB(B1, 1, 1); PG8_STAGE(PG8_SB(1, 0), b3, voffB);
      PG8_BAR; PG8_WAIT_L(0); PG8_MMA(0, 1, At, B1); PG8_BAR;
      PG8_LDA(At, 1, 1); PG8_STAGE_A(PG8_SA(1, 0), a3, 0);
      PG8_BAR; PG8_WAIT_L(0); PG8_MMA(1, 0, At, B0); PG8_BAR; PG8_SCHED;
      PG8_STAGE(PG8_SB(1, 1), b3 + hstep, voffB);
      PG8_WAIT_V(6); PG8_BAR; PG8_MMA(1, 1, At, B1); PG8_BAR;
    }
    E(acc, cur, wr, wc, fr, fq);
    if (!has_next) break;
#pragma unroll
    for (int a = 0; a < 2; ++a)
#pragma unroll
      for (int b = 0; b < 2; ++b)
#pragma unroll
        for (int m = 0; m < 4; ++m)
#pragma unroll
          for (int n = 0; n < 2; ++n) acc[a][b][m][n] = (f32x4){0.f, 0.f, 0.f, 0.f};
    cur = nxt; cA = nA; cB = nB; ++ui;
  }
  PG8_WAIT_V(0);
  if (wr == 0) PG8_BAR;
  PG8_BAR;
#undef PG8_SA
#undef PG8_SB
#undef PG8_STAGE
#undef PG8_STAGE_A
#undef PG8_GATHER_OFFS
#undef PG8_LDA
#undef PG8_LDB
#undef PG8_MMA
#undef PG8_WAIT_V
#undef PG8_WAIT_L
#undef PG8_BAR
#undef PG8_SCHED
}
}

__device__ void transpose_tile(float* tl, const float* src, int ld, int scol0, unsigned short* dst, int K, int n0, int k0) {
  const int tid = tidx();
  __syncthreads();
#pragma unroll
  for (int ps = 0; ps < 4; ++ps) {
    const int kr = ps * 32 + (tid >> 4), c4 = (tid & 15) * 4;
    const float4 v = ld4(src + (size_t)(k0 + kr) * ld + scol0 + c4);
    tl[kr * 65 + c4] = v.x; tl[kr * 65 + c4 + 1] = v.y; tl[kr * 65 + c4 + 2] = v.z; tl[kr * 65 + c4 + 3] = v.w;
  }
  __syncthreads();
  const int n = tid >> 3, kq = (tid & 7) * 16;
  unsigned w[8];
#pragma unroll
  for (int i = 0; i < 8; ++i) w[i] = pg8::cvt_pk_bf16(tl[(kq + 2 * i) * 65 + n], tl[(kq + 2 * i + 1) * 65 + n]);
  uint4* o = reinterpret_cast<uint4*>(dst + (size_t)(n0 + n) * K + k0 + kq);
  o[0] = make_uint4(w[0], w[1], w[2], w[3]); o[1] = make_uint4(w[4], w[5], w[6], w[7]);
}

typedef unsigned short bf16_t;
DEV float bf2f(bf16_t v) { return __uint_as_float((unsigned)v << 16); }
DEV float bflo(unsigned w) { return __uint_as_float(w << 16); }
DEV float bfhi(unsigned w) { return __uint_as_float(w & 0xffff0000u); }
DEV bf16_t f2bf(float f) { return (bf16_t)(pg8::cvt_pk_bf16(f, 0.f) & 0xffffu); }
DEV float fsigmoid(float x) { return 1.0f / (1.0f + __expf(-x)); }

__device__ void phase_wprep(float* lds, const Params& p, char* ws, int bid, int nb) {
  bf16_t* winT = (bf16_t*)(ws + OFF_WINT); bf16_t* hpT = (bf16_t*)(ws + OFF_HPT); bf16_t* rpT = (bf16_t*)(ws + OFF_RPT);
  bf16_t* woT = (bf16_t*)(ws + OFF_WOT); bf16_t* w13T = (bf16_t*)(ws + OFF_W13T); bf16_t* w2T = (bf16_t*)(ws + OFF_W2T);
  constexpr int N0 = 672, N1 = N0 + 64, N2 = N1 + 64, N3 = N2 + 128, N4 = N3 + 8192, N5 = N4 + 4096;
  for (int item = bid; item < N5; item += nb) {
    if (item < N0) {
      const int nt = item >> 3, kt = item & 7, n0 = nt * 64;
      int scol;
      if (n0 < 3328) scol = n0;
      else { const int r = n0 - 3328, j = r >> 8, q = r & 255; scol = 3328 + (q < 128 ? 0 : 1024) + j * 128 + (q & 127); }
      transpose_tile(lds, p.in[I_WIN], kINC, scol, winT, kD, n0, kt * 128);
    } else if (item < N1) { const int it = item - N0; transpose_tile(lds, p.in[I_HPROJ], kD, (it >> 2) * 64, hpT, 512, (it >> 2) * 64, (it & 3) * 128);
    } else if (item < N2) { const int it = item - N1; transpose_tile(lds, p.in[I_RWPROJ], kD, (it >> 2) * 64, rpT, 512, (it >> 2) * 64, (it & 3) * 128);
    } else if (item < N3) { const int it = item - N2; transpose_tile(lds, p.in[I_WOUT], kD, (it >> 3) * 64, woT, kD, (it >> 3) * 64, (it & 7) * 128);
    } else if (item < N4) {
      const int it = item - N3, e = it >> 9, nt = (it >> 3) & 63, kt = it & 7, n0 = nt * 64, j = n0 >> 8, q = n0 & 255;
      const float* src = (q < 128 ? p.in[I_EW1] : p.in[I_EW3]) + (size_t)e * kD * kF;
      transpose_tile(lds, src, kF, j * 128 + (q & 127), w13T + (size_t)e * 4096 * kD, kD, n0, kt * 128);
    } else {
      const int it = item - N4, e = it >> 8, nt = (it >> 4) & 15, kt = it & 15;
      transpose_tile(lds, p.in[I_EW2] + (size_t)e * kF * kD, kD, nt * 64, w2T + (size_t)e * kD * kF, kF, nt * 64, kt * 128);
    }
  }
}

__device__ void phase_hb(const Params& p, const float* mod, bf16_t* hb, int bid, int nb) {
  const int lane = tidx() & 63, wid = tidx() >> 6;
  const float* x = p.in[I_X]; const float* g = p.in[I_N1PRE];
  for (int row = bid * 8 + wid; row < kROWS; row += nb * 8) {
    const int b = row / kT;
    float4 v[4]; float ss = 0.f;
#pragma unroll
    for (int i = 0; i < 4; ++i) { v[i] = ld4(x + (size_t)row * kD + i * 256 + lane * 4); ss += v[i].x * v[i].x + v[i].y * v[i].y + v[i].z * v[i].z + v[i].w * v[i].w; }
    ss = wave_sum(ss);
    const float r = rsqrtf(ss * (1.0f / kD) + 1e-6f);
#pragma unroll
    for (int i = 0; i < 4; ++i) {
      const int k = i * 256 + lane * 4;
      const float4 gv = ld4(g + k), sc = ld4(mod + b * 6144 + 1024 + k), sh = ld4(mod + b * 6144 + k);
      const float h0 = v[i].x * r * gv.x * (1.f + sc.x) + sh.x, h1 = v[i].y * r * gv.y * (1.f + sc.y) + sh.y;
      const float h2 = v[i].z * r * gv.z * (1.f + sc.z) + sh.z, h3 = v[i].w * r * gv.w * (1.f + sc.w) + sh.w;
      *reinterpret_cast<uint2*>(hb + (size_t)row * kD + k) = make_uint2(pg8::cvt_pk_bf16(h0, h1), pg8::cvt_pk_bf16(h2, h3));
    }
  }
}

struct SchedPlain {
  pg8::TileOrder o; const char* A; const char* B; size_t tstep;
  __device__ bool next(int i, pg8::Unit& u) const { if (!o.tile(i, u.pm, u.pn)) return false; u.a = A + (size_t)u.pm * tstep; u.b = B + (size_t)u.pn * tstep; return true; }
  __device__ int row(const pg8::Unit&, int) const { return 0; }
};
struct SchedExp1 {
  pg8::TileOrder o; const char* H2; const char* W13T; const int* idx; int e0;
  __device__ bool next(int i, pg8::Unit& u) const { if (!o.tile(i, u.pm, u.pn)) return false;
    const int e = e0 + (u.pm >> 4); u.a = H2; u.b = W13T + ((size_t)e * 4096 + (size_t)u.pn * 256) * kD * 2; return true; }
  __device__ int row(const pg8::Unit& u, int r) const { return idx[(unsigned)(u.pm * 256 + r)]; }
};
struct SchedExp2 {
  pg8::TileOrder o; const char* HID; const char* W2T; int e0;
  __device__ bool next(int i, pg8::Unit& u) const { if (!o.tile(i, u.pm, u.pn)) return false;
    const int e = e0 + (u.pm >> 4); u.a = HID + (size_t)u.pm * 256 * kF * 2; u.b = W2T + ((size_t)e * kD + (size_t)u.pn * 256) * kF * 2; return true; }
  __device__ int row(const pg8::Unit&, int) const { return 0; }
};

struct EpiBf16Split {
  static constexpr bool PERM = true;
  bf16_t* o0; int ld0; int nt0; bf16_t* o1; int ld1;
  __device__ __forceinline__ void operator()(const pg8::f32x4 (&acc)[2][2][4][2], const pg8::Unit& u, int wr, int wc, int fr, int fq) const {
    bf16_t* base; int ldc, colt;
    if (u.pn < nt0) { base = o0; ldc = ld0; colt = u.pn * 256; } else { base = o1; ldc = ld1; colt = (u.pn - nt0) * 256; }
    const int row0 = u.pm * 256 + wr * 64 + fr, col0 = colt + wc * 32 + 8 * fq;
#pragma unroll
    for (int ai = 0; ai < 2; ++ai)
#pragma unroll
      for (int m = 0; m < 4; ++m) { bf16_t* rowp = base + (size_t)(row0 + ai * 128 + m * 16) * ldc + col0;
#pragma unroll
        for (int bj = 0; bj < 2; ++bj) { const pg8::f32x4 v0 = acc[ai][bj][m][0], v1 = acc[ai][bj][m][1];
          pg8::u32x4 w; w.x = pg8::cvt_pk_bf16(v0[0], v0[1]); w.y = pg8::cvt_pk_bf16(v0[2], v0[3]); w.z = pg8::cvt_pk_bf16(v1[0], v1[1]); w.w = pg8::cvt_pk_bf16(v1[2], v1[3]);
          *(pg8::u32x4*)(rowp + bj * 128) = w; } }
  }
};
struct EpiF32Store {
  static constexpr bool PERM = false;
  float* C; int ldc;
  __device__ __forceinline__ void operator()(const pg8::f32x4 (&acc)[2][2][4][2], const pg8::Unit& u, int wr, int wc, int fr, int fq) const {
    const int row0 = u.pm * 256 + wr * 64 + fr, col0 = u.pn * 256 + wc * 32 + 4 * fq;
#pragma unroll
    for (int ai = 0; ai < 2; ++ai)
#pragma unroll
      for (int m = 0; m < 4; ++m) { float* rowp = C + (size_t)(row0 + ai * 128 + m * 16) * ldc + col0;
#pragma unroll
        for (int bj = 0; bj < 2; ++bj)
#pragma unroll
          for (int n = 0; n < 2; ++n) *(pg8::f32x4*)(rowp + bj * 128 + n * 16) = acc[ai][bj][m][n]; }
  }
};
struct EpiGatesMerge {
  static constexpr bool PERM = true;
  const bf16_t* yh; const bf16_t* yr; bf16_t* pre;
  __device__ __forceinline__ void operator()(const pg8::f32x4 (&acc)[2][2][4][2], const pg8::Unit& u, int wr, int wc, int fr, int fq) const {
    const int row0 = u.pm * 256 + wr * 64 + fr, col0 = u.pn * 128 + wc * 32 + 8 * fq;
#pragma unroll
    for (int ai = 0; ai < 2; ++ai)
#pragma unroll
      for (int m = 0; m < 4; ++m) { const size_t off = (size_t)(row0 + ai * 128 + m * 16) * kD + col0;
        const pg8::u32x4 a = *(const pg8::u32x4*)(yh + off), b = *(const pg8::u32x4*)(yr + off);
        const pg8::f32x4 g0 = acc[ai][0][m][0], g1 = acc[ai][0][m][1], r0 = acc[ai][1][m][0], r1 = acc[ai][1][m][1];
        float o[8];
        o[0] = fsigmoid(g0[0]) * bflo(a.x) + fsigmoid(r0[0]) * bflo(b.x); o[1] = fsigmoid(g0[1]) * bfhi(a.x) + fsigmoid(r0[1]) * bfhi(b.x);
        o[2] = fsigmoid(g0[2]) * bflo(a.y) + fsigmoid(r0[2]) * bflo(b.y); o[3] = fsigmoid(g0[3]) * bfhi(a.y) + fsigmoid(r0[3]) * bfhi(b.y);
        o[4] = fsigmoid(g1[0]) * bflo(a.z) + fsigmoid(r1[0]) * bflo(b.z); o[5] = fsigmoid(g1[1]) * bfhi(a.z) + fsigmoid(r1[1]) * bfhi(b.z);
        o[6] = fsigmoid(g1[2]) * bflo(a.w) + fsigmoid(r1[2]) * bflo(b.w); o[7] = fsigmoid(g1[3]) * bfhi(a.w) + fsigmoid(r1[3]) * bfhi(b.w);
        pg8::u32x4 w; w.x = pg8::cvt_pk_bf16(o[0], o[1]); w.y = pg8::cvt_pk_bf16(o[2], o[3]); w.z = pg8::cvt_pk_bf16(o[4], o[5]); w.w = pg8::cvt_pk_bf16(o[6], o[7]);
        *(pg8::u32x4*)(pre + off) = w; }
  }
};
struct EpiSwiGLU {
  static constexpr bool PERM = true;
  bf16_t* hid;
  __device__ __forceinline__ void operator()(const pg8::f32x4 (&acc)[2][2][4][2], const pg8::Unit& u, int wr, int wc, int fr, int fq) const {
    const int row0 = u.pm * 256 + wr * 64 + fr, col0 = u.pn * 128 + wc * 32 + 8 * fq;
#pragma unroll
    for (int ai = 0; ai < 2; ++ai)
#pragma unroll
      for (int m = 0; m < 4; ++m) { const size_t off = (size_t)(row0 + ai * 128 + m * 16) * kF + col0;
        float o[8];
#pragma unroll
        for (int n = 0; n < 2; ++n)
#pragma unroll
          for (int j = 0; j < 4; ++j) { const float a = acc[ai][0][m][n][j]; o[n * 4 + j] = a * fsigmoid(a) * acc[ai][1][m][n][j]; }
        pg8::u32x4 w; w.x = pg8::cvt_pk_bf16(o[0], o[1]); w.y = pg8::cvt_pk_bf16(o[2], o[3]); w.z = pg8::cvt_pk_bf16(o[4], o[5]); w.w = pg8::cvt_pk_bf16(o[6], o[7]);
        *(pg8::u32x4*)(hid + off) = w; }
  }
};
struct EpiYE {
  static constexpr bool PERM = true;
  bf16_t* ye; const float* gate; int e0;
  __device__ __forceinline__ void operator()(const pg8::f32x4 (&acc)[2][2][4][2], const pg8::Unit& u, int wr, int wc, int fr, int fq) const {
    const int e = e0 + (u.pm >> 4), s0 = (u.pm & 15) * 256 + wr * 64 + fr, col0 = u.pn * 256 + wc * 32 + 8 * fq;
#pragma unroll
    for (int ai = 0; ai < 2; ++ai)
#pragma unroll
      for (int m = 0; m < 4; ++m) { const int s = s0 + ai * 128 + m * 16, b = s >> 10, c = s & 1023, slot = (b * kE + e) * kCAP + c;
        const float g = gate[slot]; bf16_t* rowp = ye + (size_t)slot * kD + col0;
#pragma unroll
        for (int bj = 0; bj < 2; ++bj) { const pg8::f32x4 v0 = acc[ai][bj][m][0] * g, v1 = acc[ai][bj][m][1] * g;
          pg8::u32x4 w; w.x = pg8::cvt_pk_bf16(v0[0], v0[1]); w.y = pg8::cvt_pk_bf16(v0[2], v0[3]); w.z = pg8::cvt_pk_bf16(v1[0], v1[1]); w.w = pg8::cvt_pk_bf16(v1[2], v1[3]);
          *(pg8::u32x4*)(rowp + bj * 128) = w; } }
  }
};

struct ALoadNorm {
  const float* x; const float* rstd; const float* g; const float* mod; int rows_per_b; int fixed_mrow; int sc_off, sh_off;
  DEV float4 operator()(int row, int k) const {
    const int mr = fixed_mrow >= 0 ? fixed_mrow : row / rows_per_b;
    const float4 xv = ld4(x + (size_t)row * kD + k), gv = ld4(g + k);
    const float4 sc = ld4(mod + mr * 6144 + sc_off + k), sh = ld4(mod + mr * 6144 + sh_off + k);
    const float r = rstd[row];
    return make_float4(xv.x * r * gv.x * (1.f + sc.x) + sh.x, xv.y * r * gv.y * (1.f + sc.y) + sh.y,
                       xv.z * r * gv.z * (1.f + sc.z) + sh.z, xv.w * r * gv.w * (1.f + sc.w) + sh.w);
  }
};
struct BLoadPlain { const float* b; int ldb; int coff; DEV float4 operator()(int, int k, int n) const { return ld4(b + (size_t)k * ldb + coff + n); } };
struct EpiStore { float* c; int ldc; DEV void operator()(int r, int col, float v) const { c[(size_t)r * ldc + col] = v; } };

__device__ void phase_rstd(const float* ctx, float* rstdc, int bid, int nb) {
  const int lane = tidx() & 63, wid = tidx() >> 6;
  for (int row = bid * 8 + wid; row < kB * kCTX; row += nb * 8) {
    const float* p = ctx + (size_t)row * kD;
    float s = 0.f;
#pragma unroll
    for (int i = 0; i < 4; ++i) { const float4 v = ld4(p + i * 256 + lane * 4); s += v.x * v.x + v.y * v.y + v.z * v.z + v.w * v.w; }
    s = wave_sum(s);
    if (lane == 0) rstdc[row] = rsqrtf(s * (1.0f / kD) + 1e-6f);
  }
}
__device__ void phase_mod(float* lds, const float* c, const float* cctx, const float* modw, const float* modb, float* mod, int bid, int nb) {
  float* sc = lds;
  float* red = lds + 5120;
  const int tid = tidx(), kk = tid >> 6, nl = tid & 63;
  bool loaded = false;
  for (int item = bid; item < 96; item += nb) {
    if (!loaded) {
      for (int i = tid; i < 5120; i += NTHR) { const int v = i >> 10, k = i & 1023; const float cv = v < 4 ? c[v * kD + k] : cctx[k]; sc[i] = siluf_(cv); }
      loaded = true;
    }
    __syncthreads();
    const int n = item * 64 + nl;
    float acc[5] = {0.f, 0.f, 0.f, 0.f, 0.f};
#pragma unroll 8
    for (int k = kk * 128; k < kk * 128 + 128; ++k) {
      const float w = modw[(size_t)k * 6144 + n];
#pragma unroll
      for (int v = 0; v < 5; ++v) acc[v] += sc[v * 1024 + k] * w;
    }
#pragma unroll
    for (int v = 0; v < 5; ++v) red[(kk * 5 + v) * 64 + nl] = acc[v];
    __syncthreads();
    if (tid < 320) {
      const int v = tid >> 6;
      float s = 0.f;
#pragma unroll
      for (int q = 0; q < 8; ++q) s += red[(q * 5 + v) * 64 + nl];
      mod[v * 6144 + n] = s + modb[n];
    }
    __syncthreads();
  }
}

__device__ void phase_filter(float* lds, const Params& p, float* circT, int bid, int nb) {
  float* feat = lds;
  float* h1 = lds + 32 * 33;
  float* h2 = h1 + 32 * 64;
  const float* w1 = p.in[I_HW1]; const float* b1 = p.in[I_HB1]; const float* w2 = p.in[I_HW2]; const float* b2 = p.in[I_HB2];
  const float* w3 = p.in[I_HW3]; const float* fr = p.in[I_HFREQ];
  const int tid = tidx();
  for (int item = bid; item < kT / 32; item += nb) {
    const int l0 = item * 32;
    __syncthreads();
    for (int i = tid; i < 32 * 33; i += NTHR) {
      const int pz = i / 33, f = i % 33, l = l0 + pz;
      float v;
      if (f == 0) v = (float)l / (float)(kT - 1);
      else {
        const int j = (f - 1) & 15;
        const float band = 1e-4f + (float)j * ((15.0f - 1e-4f) / 15.0f);
        const float ang = (6.283185307179586f / (float)kT) * (float)l;
        float sn, cs; sincos_cw(band * ang, sn, cs); v = f <= 16 ? cs : -sn;
      }
      feat[i] = v;
    }
    __syncthreads();
    for (int i = tid; i < 32 * 64; i += NTHR) {
      const int pz = i >> 6, o = i & 63;
      float s = b1[o];
#pragma unroll 3
      for (int f = 0; f < 33; ++f) s += feat[pz * 33 + f] * w1[f * 64 + o];
      h1[i] = sin_cw(fr[o] * s);
    }
    __syncthreads();
    for (int i = tid; i < 32 * 64; i += NTHR) {
      const int pz = i >> 6, o = i & 63;
      float s = b2[o];
#pragma unroll 4
      for (int f = 0; f < 64; ++f) s += h1[pz * 64 + f] * w2[f * 64 + o];
      h2[i] = sin_cw(fr[o] * s);
    }
    __syncthreads();
#pragma unroll 1
    for (int half = 0; half < 2; ++half) {
      const int n = tid + half * 512;
      const int c = tid;
      float wr[64];
#pragma unroll
      for (int o = 0; o < 64; ++o) wr[o] = w3[o * 1024 + n];
      const float dlo = -4.605170185988091f / 1.5f, dhi = -4.605170185988091f / 0.3f;
      const float delta = fabsf(dlo + (float)c * ((dhi - dlo) / 511.0f));
      float asum = 0.f;
#pragma unroll 1
      for (int q = 0; q < 32; ++q) {
        float a = 0.f;
#pragma unroll
        for (int o = 0; o < 64; ++o) a += h2[q * 64 + o] * wr[o];
        const int l = l0 + q;
        const float tt = (float)l / (float)(kT - 1);
        const float v = a * expf(-tt * delta);
        if (half == 0) circT[(size_t)c * 16384 + l] = v;
        else circT[(size_t)c * 16384 + 16384 - l - (l == 0 ? 8192 : 0)] = (l == 0 ? 0.f : v);
      }
      (void)asum;
    }
  }
}

DEV float ldcol(const float* p, size_t i) { return p[i]; }
DEV float ldcol(const bf16_t* p, size_t i) { return bf2f(p[i]); }
namespace rs {
typedef short bf16x8 __attribute__((ext_vector_type(8)));
typedef float f32x4 __attribute__((ext_vector_type(4)));
constexpr int LD = 72, LDR = 40;
template <int K>
DEV f32x4 tmma(f32x4 acc, const bf16_t* A, int lda, const bf16_t* B, int ldb, int lane) {
  const bf16_t* ap = A + (lane & 15) * lda + 8 * (lane >> 4);
  const bf16_t* bp = B + (lane & 15) * ldb + 8 * (lane >> 4);
#pragma unroll
  for (int k = 0; k < K; k += 32)
    acc = __builtin_amdgcn_mfma_f32_16x16x32_bf16(*reinterpret_cast<const bf16x8*>(ap + k), *reinterpret_cast<const bf16x8*>(bp + k), acc, 0, 0, 0);
  return acc;
}
DEV void st4(bf16_t* p, f32x4 v) { *reinterpret_cast<uint2*>(p) = make_uint2(pg8::cvt_pk_bf16(v[0], v[1]), pg8::cvt_pk_bf16(v[2], v[3])); }
DEV float ftanh(float x) { const float e = __expf(2.f * x); return 1.f - 2.f / (e + 1.f); }

template <int NC> struct Lay {
  static constexpr int ZTB = NC * LD * 2;
  static constexpr int W = 0, ZT0 = 18432, ZT1 = ZT0 + ZTB, AT = ZT1 + ZTB, BTt = AT + 9216, KTt = BTt + 9216, Vt = KTt + 9216,
                       RT = Vt + 9216, X = (NC == 64 ? RT + 9216 : RT), L = X + 18432, D = L + (NC == 64 ? 36864 : 32768);
  static constexpr int LWt = X, LA = X + 9216, BT = X, KT = X + 9216, UT = X, RHS = (NC == 64 ? X + 9216 : L + 18432);
  static constexpr int CS = L, AG = L + 16384, LAK = L, LOFF = L + 9216, LRB = L + 18432, LRK = L + 27648;
  static constexpr int LDG = D, TDG = D + 4352, WCV = TDG + 5120, SEG = WCV + 256, TF = SEG + 2048, END = TF + 4352;
};
static_assert(Lay<64>::END <= (int)LDS_BYTES && Lay<128>::END <= (int)LDS_BYTES, "scan LDS layout");

template <int NC, bool EMIT, class CT>
__device__ void scan_task(float* ldsf, const Params& p, const CT* cols, int ldc, int Tlen, int cR, int cK, int cV, int cLW, int cLA, int muoff,
                          int b, int h, int dir, int step0, const float* Zinit  , float* Zout  , bf16_t* Y, float* BSo) {
  typedef Lay<NC> LY;
  char* lds = reinterpret_cast<char*>(ldsf);
  const int tid = tidx(), lane = tid & 63, w = tid >> 6;
  bf16_t* sWup = (bf16_t*)(lds + LY::W); bf16_t* sAup = sWup + 64 * LD;
  bf16_t* sAT = (bf16_t*)(lds + LY::AT); bf16_t* sBTt = (bf16_t*)(lds + LY::BTt); bf16_t* sKTt = (bf16_t*)(lds + LY::KTt); bf16_t* sVt = (bf16_t*)(lds + LY::Vt);
  bf16_t* sRT = (bf16_t*)(lds + LY::RT);
  bf16_t* sLWt = (bf16_t*)(lds + LY::LWt); bf16_t* sLA = (bf16_t*)(lds + LY::LA); bf16_t* sBT = (bf16_t*)(lds + LY::BT); bf16_t* sKT = (bf16_t*)(lds + LY::KT);
  bf16_t* sUT = (bf16_t*)(lds + LY::UT); bf16_t* sRHS = (bf16_t*)(lds + LY::RHS);
  float* sCS = (float*)(lds + LY::CS); float* sAG = (float*)(lds + LY::AG);
  bf16_t* sLak = (bf16_t*)(lds + LY::LAK); bf16_t* sLoff = (bf16_t*)(lds + LY::LOFF); bf16_t* sLrb = (bf16_t*)(lds + LY::LRB); bf16_t* sLrk = (bf16_t*)(lds + LY::LRK);
  float* sLdg = (float*)(lds + LY::LDG); bf16_t* sTdg = (bf16_t*)(lds + LY::TDG); float* sWC = (float*)(lds + LY::WCV); float* sSeg = (float*)(lds + LY::SEG); float* sTf = (float*)(lds + LY::TF);
  const float* mu = p.in[I_MU];
  const int hj = h * 64 + lane;
  const CT* base = cols + (size_t)b * Tlen * ldc;
  constexpr int NT = NC / 16 * 4 / 8;
  f32x4 Zm[NT];

  __syncthreads();
  for (int i = tid; i < 4096; i += NTHR) { const int ii = i >> 6, j = i & 63;
    sWup[j * LD + ii] = f2bf(p.in[I_WUP][((size_t)dir * 64 + ii) * 512 + h * 64 + j]);
    sAup[j * LD + ii] = f2bf(p.in[I_AUP][((size_t)dir * 64 + ii) * 512 + h * 64 + j]); }
#pragma unroll
  for (int m = 0; m < NT; ++m) {
    const int id = w + 8 * m, tj = id & 3, tn = id >> 2, col = tn * 16 + (lane & 15), j0 = tj * 16 + 4 * (lane >> 4);
#pragma unroll
    for (int q = 0; q < 4; ++q) {
      float v = 0.f;
      if (NC == 128) v = (col < 64 && col == j0 + q) ? 1.f : 0.f;
      else if (Zinit) v = Zinit[col * 64 + j0 + q];
      Zm[m][q] = v;
    }
    st4((bf16_t*)(lds + LY::ZT0) + col * LD + j0, Zm[m]);
  }
  int zcur = 0;
#pragma unroll 1
  for (int ci = 0; ci < 4; ++ci) {
    const int s0 = step0 + ci * 64;
    bf16_t* sZT = (bf16_t*)(lds + (zcur ? LY::ZT1 : LY::ZT0));
    bf16_t* sZN = (bf16_t*)(lds + (zcur ? LY::ZT0 : LY::ZT1));
    __syncthreads();
#pragma unroll 2
    for (int q = 0; q < 8; ++q) {
      const int tl = w * 8 + q, tok = dir ? (Tlen - 1 - (s0 + tl)) : (s0 + tl);
#pragma unroll
      for (int a = 0; a < 2; ++a) {
        const int col = (a ? cLA : cLW) + lane;
        const float cur = ldcol(base, (size_t)tok * ldc + col);
        const float prv = tok > 0 ? ldcol(base, (size_t)(tok - 1) * ldc + col) : 0.f;
        const float nxt = tok < Tlen - 1 ? ldcol(base, (size_t)(tok + 1) * ldc + col) : 0.f;
        const float z = cur + mu[col + muoff] * (prv - cur) + mu[kRWC + col + muoff] * (nxt - cur);
        if (a) sLA[tl * LD + lane] = f2bf(z); else sLWt[tl * LD + lane] = f2bf(ftanh(z));
      }
    }
    __syncthreads();
#pragma unroll
    for (int m = 0; m < 2; ++m) {
      const int id = w * 2 + m, tm = id >> 2, tn = id & 3;
      f32x4 aw = {0.f, 0.f, 0.f, 0.f}, aa = {0.f, 0.f, 0.f, 0.f};
      aw = tmma<64>(aw, sLWt + tm * 16 * LD, LD, sWup + tn * 16 * LD, LD, lane);
      aa = tmma<64>(aa, sLA + tm * 16 * LD, LD, sAup + tn * 16 * LD, LD, lane);
      const int j = tn * 16 + (lane & 15);
      const float w0 = p.in[I_W0][dir * 512 + h * 64 + j], a0 = p.in[I_A0][dir * 512 + h * 64 + j];
#pragma unroll
      for (int q = 0; q < 4; ++q) {
        const int t = tm * 16 + 4 * (lane >> 4) + q;
        const float x = -(w0 + aw[q]);
        const float sp = x > 20.f ? x : __logf(1.f + __expf(x));
        sCS[t * 64 + j] = __expf(-sp - 0.5f);
        sAG[t * 64 + j] = fsigmoid(a0 + aa[q]);
      }
    }
    __syncthreads();
    {
      const int j = tid & 63, seg = tid >> 6;
      float v[8]; float run = 0.f;
#pragma unroll
      for (int q = 0; q < 8; ++q) { run += sCS[(seg * 8 + q) * 64 + j]; v[q] = run; }
      sSeg[seg * 64 + j] = run;
      __syncthreads();
      float off = 0.f;
#pragma unroll
      for (int s = 0; s < 8; ++s) off += (s < seg) ? sSeg[s * 64 + j] : 0.f;
#pragma unroll
      for (int q = 0; q < 8; ++q) sCS[(seg * 8 + q) * 64 + j] = v[q] + off;
    }
    __syncthreads();
    {
      const float kkw = p.in[I_KK][hj], kaw = p.in[I_KA][hj], rkw = p.in[I_RK][hj];
#pragma unroll 2
      for (int q = 0; q < 8; ++q) {
        const int tl = w * 8 + q, tok = dir ? (Tlen - 1 - (s0 + tl)) : (s0 + tl);
        float rkv[3];
#pragma unroll
        for (int a = 0; a < 3; ++a) {
          if (a == 0 && !EMIT) { rkv[0] = 0.f; continue; }
          const int col = (a == 0 ? cR : a == 1 ? cK : cV) + h * 64 + lane;
          const float cur = ldcol(base, (size_t)tok * ldc + col);
          const float prv = tok > 0 ? ldcol(base, (size_t)(tok - 1) * ldc + col) : 0.f;
          const float nxt = tok < Tlen - 1 ? ldcol(base, (size_t)(tok + 1) * ldc + col) : 0.f;
          rkv[a] = cur + mu[col + muoff] * (prv - cur) + mu[kRWC + col + muoff] * (nxt - cur);
        }
        const float ag = sAG[tl * 64 + lane], cs = sCS[tl * 64 + lane], csm = tl > 0 ? sCS[(tl - 1) * 64 + lane] : 0.f;
        const float kkv = rkv[1] * kkw;
        const float ss = wave_sum(kkv * kkv);
        const float kkn = kkv * rsqrtf(fmaxf(ss, 1e-24f));
        const float km = rkv[1] * (1.f + (ag - 1.f) * kaw);
        const float ew = __expf(cs), ewi = __expf(-cs);
        const bf16_t at = f2bf(-kkn * __expf(-csm)), bt = f2bf(kkn * ag * ew), kt = f2bf(km * ew), vt = f2bf(rkv[2]);
        sAT[tl * LD + lane] = at; sBT[tl * LD + lane] = bt; sKT[tl * LD + lane] = kt;
        sBTt[lane * LD + tl] = bt; sKTt[lane * LD + tl] = kt; sVt[lane * LD + tl] = vt;
        if (EMIT) {
          sRT[tl * LD + lane] = f2bf(rkv[0] * ewi);
          const float bsum = wave_sum(rkv[0] * km * rkw);
          if (lane == 0) BSo[((size_t)dir * kROWS + (size_t)b * Tlen + tok) * 8 + h] = bsum;
        }
        if (tl == 63) sWC[lane] = ewi;
      }
    }
    __syncthreads();
    {
      constexpr int NP = EMIT ? 4 : 2;
#pragma unroll
      for (int pr = 0; pr < NP; ++pr) {
        const bf16_t* Lsrc = (pr < 2) ? sAT : sRT;
        const bf16_t* Rsrc = (pr & 1) ? sKT : sBT;
        bf16_t* dst = pr == 0 ? sLoff : pr == 1 ? sLak : pr == 2 ? sLrb : sLrk;
#pragma unroll
        for (int m = 0; m < 2; ++m) {
          const int id = w + 8 * m, tt = id >> 2, tu = id & 3;
          f32x4 acc = {0.f, 0.f, 0.f, 0.f};
          if (tu <= tt) acc = tmma<64>(acc, Rsrc + tu * 16 * LD, LD, Lsrc + tt * 16 * LD, LD, lane);
          const int t = tt * 16 + (lane & 15), u0 = tu * 16 + 4 * (lane >> 4);
#pragma unroll
          for (int q = 0; q < 4; ++q) { const bool keep = (pr < 2) ? (u0 + q < t) : (u0 + q <= t); acc[q] = keep ? acc[q] : 0.f; }
          if (pr == 0 && tu == tt) {
            float* dg = sLdg + tt * 272 + (lane & 15) * 17 + 4 * (lane >> 4);
            dg[0] = acc[0]; dg[1] = acc[1]; dg[2] = acc[2]; dg[3] = acc[3];
            acc = (f32x4){0.f, 0.f, 0.f, 0.f};
          }
          st4(dst + t * LD + u0, acc);
        }
      }
    }
    __syncthreads();
    if (w < 4) {
      float* Pm = sLdg + w * 272; float* Tm = sTf + w * 272;
      const int c = lane & 15, kq = lane >> 4, r4 = 4 * kq;
#pragma unroll
      for (int q = 0; q < 4; ++q) Tm[(r4 + q) * 17 + c] = Pm[(r4 + q) * 17 + c] + ((r4 + q) == c ? 1.f : 0.f);
#pragma unroll 1
      for (int lev = 0; lev < 3; ++lev) {
        f32x4 acc = {0.f, 0.f, 0.f, 0.f};
#pragma unroll
        for (int s4 = 0; s4 < 4; ++s4) acc = __builtin_amdgcn_mfma_f32_16x16x4f32(Pm[c * 17 + 4 * s4 + kq], Pm[(4 * s4 + kq) * 17 + c], acc, 0, 0, 0);
#pragma unroll
        for (int q = 0; q < 4; ++q) Pm[(r4 + q) * 17 + c] = acc[q];
        f32x4 acc2 = {0.f, 0.f, 0.f, 0.f};
#pragma unroll
        for (int s4 = 0; s4 < 4; ++s4) acc2 = __builtin_amdgcn_mfma_f32_16x16x4f32(Tm[c * 17 + 4 * s4 + kq], Pm[(4 * s4 + kq) * 17 + c], acc2, 0, 0, 0);
#pragma unroll
        for (int q = 0; q < 4; ++q) Tm[(r4 + q) * 17 + c] += acc2[q];
      }
#pragma unroll
      for (int q = 0; q < 4; ++q) { sTdg[(w * 16 + r4 + q) * LDR + c] = f2bf(Tm[(r4 + q) * 17 + c]); sTdg[(w * 16 + r4 + q) * LDR + 16 + c] = (bf16_t)0; }
    }
    for (int i = tid; i < NC * LD / 2; i += NTHR) reinterpret_cast<unsigned*>(sUT)[i] = 0u;
    for (int i = tid; i < NC * LDR / 2; i += NTHR) reinterpret_cast<unsigned*>(sRHS)[i] = 0u;
    __syncthreads();
#pragma unroll 1
    for (int bk = 0; bk < 4; ++bk) {
      if (w < NC / 16) {
        const int tn = w;
        f32x4 acc = {0.f, 0.f, 0.f, 0.f};
        acc = tmma<64>(acc, sAT + bk * 16 * LD, LD, sZT + tn * 16 * LD, LD, lane);
        if (NC == 64 || tn >= 4) acc = tmma<64>(acc, sLak + bk * 16 * LD, LD, sVt + (NC == 64 ? tn : tn - 4) * 16 * LD, LD, lane);
        if (bk > 0) acc = tmma<64>(acc, sLoff + bk * 16 * LD, LD, sUT + tn * 16 * LD, LD, lane);
        st4(sRHS + (tn * 16 + (lane & 15)) * LDR + 4 * (lane >> 4), acc);
      }
      __syncthreads();
      if (w < NC / 16) {
        const int tn = w;
        f32x4 acc = {0.f, 0.f, 0.f, 0.f};
        acc = tmma<32>(acc, sTdg + bk * 16 * LDR, LDR, sRHS + tn * 16 * LDR, LDR, lane);
        st4(sUT + (tn * 16 + (lane & 15)) * LD + bk * 16 + 4 * (lane >> 4), acc);
      }
      __syncthreads();
    }
    if (EMIT) {
#pragma unroll
      for (int m = 0; m < 2; ++m) {
        const int id = w + 8 * m, ti = id & 3, tt = id >> 2;
        f32x4 acc = {0.f, 0.f, 0.f, 0.f};
        acc = tmma<64>(acc, sZT + ti * 16 * LD, LD, sRT + tt * 16 * LD, LD, lane);
        acc = tmma<64>(acc, sUT + ti * 16 * LD, LD, sLrb + tt * 16 * LD, LD, lane);
        acc = tmma<64>(acc, sVt + ti * 16 * LD, LD, sLrk + tt * 16 * LD, LD, lane);
        const int tl = tt * 16 + (lane & 15), tok = dir ? (Tlen - 1 - (s0 + tl)) : (s0 + tl);
        st4(Y + (size_t)dir * kROWS * 512 + ((size_t)b * Tlen + tok) * 512 + h * 64 + ti * 16 + 4 * (lane >> 4), acc);
      }
    }
#pragma unroll
    for (int m = 0; m < NT; ++m) {
      const int id = w + 8 * m, tj = id & 3, tn = id >> 2;
      f32x4 acc = {0.f, 0.f, 0.f, 0.f};
      acc = tmma<64>(acc, sBTt + tj * 16 * LD, LD, sUT + tn * 16 * LD, LD, lane);
      if (NC == 64 || tn >= 4) acc = tmma<64>(acc, sKTt + tj * 16 * LD, LD, sVt + (NC == 64 ? tn : tn - 4) * 16 * LD, LD, lane);
      const int j0 = tj * 16 + 4 * (lane >> 4), col = tn * 16 + (lane & 15);
#pragma unroll
      for (int q = 0; q < 4; ++q) Zm[m][q] = sWC[j0 + q] * (Zm[m][q] + acc[q]);
      st4(sZN + col * LD + j0, Zm[m]);
    }
    zcur ^= 1;
  }
#pragma unroll
  for (int m = 0; m < NT; ++m) {
    const int id = w + 8 * m, tj = id & 3, tn = id >> 2, j0 = tj * 16 + 4 * (lane >> 4), col = tn * 16 + (lane & 15);
    if (Zout) *reinterpret_cast<f32x4*>(Zout + (size_t)col * 64 + j0) = Zm[m];
  }
  __syncthreads();
}
}

__device__ void scan_passB(float* lds, int chain, const float* sinit, const float* PQ, float* S0) {
  float* sS = lds;
  float* sP = lds + 64 * 65;
  const int tid = tidx(), i = tid >> 3, jq = (tid & 7) * 8;
  __syncthreads();
  for (int e = tid; e < 4096; e += NTHR) sS[(e >> 6) * 65 + (e & 63)] = sinit[e];
  for (int sc = 0; sc < 32; ++sc) {
    const size_t task = (size_t)chain * 32 + sc;
    __syncthreads();
    for (int e = tid; e < 2048; e += NTHR) reinterpret_cast<float4*>(sP)[e] = reinterpret_cast<const float4*>(PQ + task * 8192)[e];
    for (int e = tid; e < 4096; e += NTHR) S0[task * 4096 + e] = sS[(e >> 6) * 65 + (e & 63)];
    __syncthreads();
    float acc[8];
#pragma unroll
    for (int q = 0; q < 8; ++q) acc[q] = sP[(64 + i) * 64 + jq + q];
#pragma unroll 8
    for (int jp = 0; jp < 64; ++jp) {
      const float s = sS[i * 65 + jp];
      const float4 z0 = *reinterpret_cast<const float4*>(&sP[jp * 64 + jq]), z1 = *reinterpret_cast<const float4*>(&sP[jp * 64 + jq + 4]);
      acc[0] += s * z0.x; acc[1] += s * z0.y; acc[2] += s * z0.z; acc[3] += s * z0.w;
      acc[4] += s * z1.x; acc[5] += s * z1.y; acc[6] += s * z1.z; acc[7] += s * z1.w;
    }
    __syncthreads();
#pragma unroll
    for (int q = 0; q < 8; ++q) sS[i * 65 + jq + q] = acc[q];
  }
  __syncthreads();
}

typedef float2 cf;
DEV cf cmul(cf a, cf b) { return make_float2(a.x * b.x - a.y * b.y, a.x * b.y + a.y * b.x); }
DEV cf cadd(cf a, cf b) { return make_float2(a.x + b.x, a.y + b.y); }
DEV cf csub(cf a, cf b) { return make_float2(a.x - b.x, a.y - b.y); }
DEV int PADI(int i) { return i + (i >> 4); }
constexpr int FFT_N = 16384, FFT_PAD = FFT_N + FFT_N / 16;
DEV void dft4(cf& x0, cf& x1, cf& x2, cf& x3) {
  const cf a0 = cadd(x0, x2), a1 = csub(x0, x2), a2 = cadd(x1, x3), d = csub(x1, x3);
  const cf a3 = make_float2(d.y, -d.x);
  x0 = cadd(a0, a2); x1 = cadd(a1, a3); x2 = csub(a0, a2); x3 = csub(a1, a3);
}
DEV void dft16(cf (&v)[16]) {
#pragma unroll
  for (int a = 0; a < 4; ++a) dft4(v[a], v[a + 4], v[a + 8], v[a + 12]);
  const cf w1 = make_float2(0.9238795325112867f, -0.3826834323650898f), w2 = make_float2(0.7071067811865476f, -0.7071067811865476f);
  const cf w3 = make_float2(0.3826834323650898f, -0.9238795325112867f), w6 = make_float2(-0.7071067811865476f, -0.7071067811865476f);
  const cf w9 = make_float2(-0.9238795325112867f, 0.3826834323650898f);
  v[1 + 4] = cmul(v[1 + 4], w1); v[1 + 8] = cmul(v[1 + 8], w2); v[1 + 12] = cmul(v[1 + 12], w3);
  v[2 + 4] = cmul(v[2 + 4], w2); v[2 + 8] = make_float2(v[2 + 8].y, -v[2 + 8].x); v[2 + 12] = cmul(v[2 + 12], w6);
  v[3 + 4] = cmul(v[3 + 4], w3); v[3 + 8] = cmul(v[3 + 8], w6); v[3 + 12] = cmul(v[3 + 12], w9);
#pragma unroll
  for (int c = 0; c < 4; ++c) dft4(v[4 * c], v[4 * c + 1], v[4 * c + 2], v[4 * c + 3]);
}
template <int PASS>
DEV void fft_pass16(cf* buf, int tid) {
  constexpr int lg = 4 * PASS, Ns = 1 << lg;
  cf v0[16], v1[16];
  const cf* rd = buf + PADI(tid);
#pragma unroll
  for (int r = 0; r < 16; ++r) { v0[r] = rd[1088 * r]; v1[r] = rd[1088 * r + 544]; }
  __syncthreads();
#pragma unroll
  for (int h = 0; h < 2; ++h) {
    cf (&v)[16] = h ? v1 : v0;
    int tl = tid; asm volatile("" : "+v"(tl) :: "memory");
    const int j = tl + 512 * h, k = j & (Ns - 1);
    if (PASS > 0) {
      float sn, cs; sincos_cw(-6.283185307179586f * (float)k / (float)(Ns * 16), sn, cs);
      const cf w = make_float2(cs, sn); cf pw = w;
#pragma unroll
      for (int r = 1; r < 16; ++r) { v[r] = cmul(v[r], pw); if (r < 15) pw = cmul(pw, w); }
    }
    dft16(v);
    const int j0 = ((j >> lg) << (lg + 4)) + k;
    cf* wr = buf + PADI(j0);
    constexpr int step = PASS == 0 ? 1 : Ns + Ns / 16;
#pragma unroll
    for (int r = 0; r < 16; ++r) wr[step * r] = v[4 * (r & 3) + (r >> 2)];
  }
  __syncthreads();
}
__device__ void fft16384(cf* buf) {
  int tid = tidx(); asm volatile("" : "+v"(tid));
  fft_pass16<0>(buf, tid);
  fft_pass16<1>(buf, tid);
  fft_pass16<2>(buf, tid);
#pragma unroll 2
  for (int q = 0; q < 8; ++q) {
    const int j = tid + 512 * q;
    cf* pp = buf + PADI(j);
    cf x0 = pp[0], x1 = pp[4352], x2 = pp[8704], x3 = pp[13056];
    float sn, cs; sincos_cw(-6.283185307179586f * (float)j / 16384.0f, sn, cs);
    const cf w1 = make_float2(cs, sn), w2 = cmul(w1, w1), w3 = cmul(w2, w1);
    x1 = cmul(x1, w1); x2 = cmul(x2, w2); x3 = cmul(x3, w3);
    dft4(x0, x1, x2, x3);
    pp[0] = x0; pp[4352] = x1; pp[8704] = x2; pp[13056] = x3;
  }
  __syncthreads();
}
DEV float hy_conv3t(const Params& p, const bf16_t* hyt, int col, int b, int t) {
  const bf16_t* q = hyt + (size_t)col * kROWS + b * kT;
  const float* cw = p.in[I_HCW];
  const float cur = bf2f(q[t]), prv = t > 0 ? bf2f(q[t - 1]) : 0.f, nxt = t < kT - 1 ? bf2f(q[t + 1]) : 0.f;
  return cw[col] * prv + cw[kHYC + col] * cur + cw[2 * kHYC + col] * nxt + p.in[I_HCB][col];
}
__device__ void fftconv_channel(float* ldsf, const Params& p, int c, const float* circT, const bf16_t* hyt, bf16_t* hyot) {
  cf* buf = reinterpret_cast<cf*>(ldsf);
  float* red = ldsf + 2 * FFT_PAD;
  const int tid = tidx(), lane = tid & 63, wid = tid >> 6;
  const float* cc = circT + (size_t)c * FFT_N;
  const float hbias = p.in[I_HBIAS][c];
  unsigned H[32];
#pragma unroll
  for (int m = 0; m < 32; ++m) H[m] = 0u;
  float inrm = 0.f;
  __syncthreads();
#pragma unroll 1
  for (int ph = 0; ph < 5; ++ph) {
    const int pair = (ph - 1) >> 1, b0 = 2 * pair, b1 = b0 + 1;
    if (ph == 0) {
      float asum = 0.f;
#pragma unroll 4
      for (int m = 0; m < 32; ++m) { const float f = cc[tid + 512 * m]; asum += fabsf(f); buf[PADI(tid) + 544 * m] = make_float2(f, 0.f); }
      asum = wave_sum(asum);
      if (lane == 0) red[wid] = asum;
    } else if (ph & 1) {
#pragma unroll 1
      for (int m = 0; m < 16; ++m) {
        const int t = tid + 512 * m;
        const float z0 = hy_conv3t(p, hyt, 1024 + c, b0, t) * hy_conv3t(p, hyt, 512 + c, b0, t);
        const float z1 = hy_conv3t(p, hyt, 1024 + c, b1, t) * hy_conv3t(p, hyt, 512 + c, b1, t);
        buf[PADI(t)] = make_float2(z0, z1);
        buf[PADI(t + 8192)] = make_float2(0.f, 0.f);
      }
    }
    __syncthreads();
    if (ph == 0) { float nrm = 0.f;
#pragma unroll
      for (int w = 0; w < 8; ++w) nrm += red[w];
      inrm = 1.0f / nrm; }
    fft16384(buf);
    if (ph == 0) {
#pragma unroll
      for (int m = 0; m < 32; ++m) { const cf hv = buf[PADI(tid) + 544 * m]; const __half2 hh = __floats2half2_rn(hv.x * inrm, hv.y * inrm); H[m] = *reinterpret_cast<const unsigned*>(&hh); }
    } else if (ph & 1) {
#pragma unroll
      for (int m = 0; m < 32; ++m) { const int i = PADI(tid) + 544 * m; const unsigned hu = H[m]; const float2 hf = __half22float2(*reinterpret_cast<const __half2*>(&hu)); const cf w = cmul(buf[i], hf); buf[i] = make_float2(w.y, w.x); }
    } else {
      const float scale = 1.0f / (float)FFT_N;
#pragma unroll 1
      for (int m = 0; m < 16; ++m) {
        const int t = tid + 512 * m;
        const cf val = buf[PADI(t)];
        const float y0 = val.y * scale, y1 = val.x * scale;
        const float z0 = hy_conv3t(p, hyt, 1024 + c, b0, t) * hy_conv3t(p, hyt, 512 + c, b0, t);
        const float z1 = hy_conv3t(p, hyt, 1024 + c, b1, t) * hy_conv3t(p, hyt, 512 + c, b1, t);
        hyot[(size_t)c * kROWS + b0 * kT + t] = f2bf((y0 + hbias * z0) * hy_conv3t(p, hyt, c, b0, t));
        hyot[(size_t)c * kROWS + b1 * kT + t] = f2bf((y1 + hbias * z1) * hy_conv3t(p, hyt, c, b1, t));
      }
    }
    __syncthreads();
  }
}
__device__ void phase_hyo_transpose(float* ldsf, const bf16_t* hyot, bf16_t* hyo, int bid, int nb) {
  bf16_t* tl = reinterpret_cast<bf16_t*>(ldsf);
  const int tid = tidx();
  for (int item = bid; item < 8 * 512; item += nb) {
    const int c0 = (item & 7) * 64, t0 = (item >> 3) * 64;
    __syncthreads();
    { const int cl = tid >> 3, t8 = (tid & 7) * 8;
      const uint4 u = *reinterpret_cast<const uint4*>(hyot + (size_t)(c0 + cl) * kROWS + t0 + t8);
      *reinterpret_cast<uint4*>(tl + cl * 72 + t8) = u; }
    __syncthreads();
    { const int tl_ = tid >> 3, c8 = (tid & 7) * 8;
      unsigned w[4];
#pragma unroll
      for (int i = 0; i < 4; ++i) w[i] = (unsigned)tl[(c8 + 2 * i) * 72 + tl_] | ((unsigned)tl[(c8 + 2 * i + 1) * 72 + tl_] << 16);
      *reinterpret_cast<uint4*>(hyo + (size_t)(t0 + tl_) * 512 + c0 + c8) = make_uint4(w[0], w[1], w[2], w[3]); }
  }
}

__device__ void phase_rwout(float* lds, const Params& p, const bf16_t* rwc, const bf16_t* Y0, const bf16_t* Y1, const float* BS, bf16_t* rwo, int bid, int nb) {
  const int lane = tidx() & 63, wid = tidx() >> 6;
  float* lg = lds + wid * 128;
  const float* mu = p.in[I_MU]; const float* gup = p.in[I_GUP]; const float* lng = p.in[I_LNG]; const float* lnb = p.in[I_LNB];
  for (int row = bid * 8 + wid; row < kROWS; row += nb * 8) {
    const int t = row & (kT - 1);
    const bf16_t* cur = rwc + (size_t)row * kRWC;
    for (int i = lane; i < 128; i += 64) {
      const int col = 1664 + i;
      const float cv = bf2f(cur[col]), pv = t > 0 ? bf2f(cur[col - kRWC]) : 0.f, nv = t < kT - 1 ? bf2f(cur[col + kRWC]) : 0.f;
      lg[i] = sigmoidf_(cv + mu[col] * (pv - cv) + mu[kRWC + col] * (nv - cv));
    }
    __syncthreads();
    const int c0 = lane * 8, h = lane >> 3;
    float y[8], g[8];
    float sum = 0.f;
    {
      const uint4 u0 = *reinterpret_cast<const uint4*>(Y0 + (size_t)row * 512 + c0), u1 = *reinterpret_cast<const uint4*>(Y1 + (size_t)row * 512 + c0);
      y[0] = bflo(u0.x) + bflo(u1.x); y[1] = bfhi(u0.x) + bfhi(u1.x); y[2] = bflo(u0.y) + bflo(u1.y); y[3] = bfhi(u0.y) + bfhi(u1.y);
      y[4] = bflo(u0.z) + bflo(u1.z); y[5] = bfhi(u0.z) + bfhi(u1.z); y[6] = bflo(u0.w) + bflo(u1.w); y[7] = bfhi(u0.w) + bfhi(u1.w);
    }
#pragma unroll
    for (int j = 0; j < 8; ++j) { sum += y[j]; g[j] = 0.f; }
    sum += __shfl_xor(sum, 1); sum += __shfl_xor(sum, 2); sum += __shfl_xor(sum, 4);
    const float mean = sum * (1.0f / 64.0f);
    float var = 0.f;
#pragma unroll
    for (int j = 0; j < 8; ++j) { const float d = y[j] - mean; var += d * d; }
    var += __shfl_xor(var, 1); var += __shfl_xor(var, 2); var += __shfl_xor(var, 4);
    const float rs = rsqrtf(var * (1.0f / 64.0f) + 64e-5f);
#pragma unroll 4
    for (int i = 0; i < 128; ++i) {
      const float sg = lg[i];
      const float4 u0 = ld4(gup + i * 512 + c0), u1 = ld4(gup + i * 512 + c0 + 4);
      g[0] += sg * u0.x; g[1] += sg * u0.y; g[2] += sg * u0.z; g[3] += sg * u0.w;
      g[4] += sg * u1.x; g[5] += sg * u1.y; g[6] += sg * u1.z; g[7] += sg * u1.w;
    }
    const float bsum = BS[(size_t)row * 8 + h] + BS[((size_t)kROWS + row) * 8 + h];
    float o[8];
#pragma unroll
    for (int j = 0; j < 8; ++j) {
      const int col = 1024 + c0 + j;
      const float cv = bf2f(cur[col]), pv = t > 0 ? bf2f(cur[col - kRWC]) : 0.f, nv = t < kT - 1 ? bf2f(cur[col + kRWC]) : 0.f;
      const float vm = cv + mu[col] * (pv - cv) + mu[kRWC + col] * (nv - cv);
      const float yn = (y[j] - mean) * rs * lng[c0 + j] + lnb[c0 + j];
      o[j] = (yn + bsum * vm) * g[j];
    }
    *reinterpret_cast<uint4*>(rwo + (size_t)row * 512 + c0) = make_uint4(pg8::cvt_pk_bf16(o[0], o[1]), pg8::cvt_pk_bf16(o[2], o[3]), pg8::cvt_pk_bf16(o[4], o[5]), pg8::cvt_pk_bf16(o[6], o[7]));
    __syncthreads();
  }
}

__device__ void phase_post(const Params& p, float* mx, bf16_t* h2o, float* aff, const float* mod, int bid, int nb) {
  const int lane = tidx() & 63, wid = tidx() >> 6;
  const float* x = p.in[I_X]; const float* n1post = p.in[I_N1POST]; const float* n2pre = p.in[I_N2PRE]; const float* rw = p.in[I_ROUTER];
  for (int row = bid * 8 + wid; row < kROWS; row += nb * 8) {
    const int b = row / kT;
    float m[16], xv[16];
    float ss = 0.f;
#pragma unroll
    for (int i = 0; i < 4; ++i) { const float4 v = ld4(mx + (size_t)row * kD + i * 256 + lane * 4);
      m[i * 4] = v.x; m[i * 4 + 1] = v.y; m[i * 4 + 2] = v.z; m[i * 4 + 3] = v.w; ss += v.x * v.x + v.y * v.y + v.z * v.z + v.w * v.w; }
    ss = wave_sum(ss);
    const float r1 = rsqrtf(ss * (1.0f / kD) + 1e-6f);
    float s2 = 0.f;
#pragma unroll
    for (int i = 0; i < 4; ++i) {
      const int k = i * 256 + lane * 4;
      const float4 xx = ld4(x + (size_t)row * kD + k), gp = ld4(n1post + k), gt = ld4(mod + b * 6144 + 2048 + k);
      xv[i * 4] = xx.x + gt.x * m[i * 4] * r1 * gp.x; xv[i * 4 + 1] = xx.y + gt.y * m[i * 4 + 1] * r1 * gp.y;
      xv[i * 4 + 2] = xx.z + gt.z * m[i * 4 + 2] * r1 * gp.z; xv[i * 4 + 3] = xx.w + gt.w * m[i * 4 + 3] * r1 * gp.w;
      *reinterpret_cast<float4*>(mx + (size_t)row * kD + k) = make_float4(xv[i * 4], xv[i * 4 + 1], xv[i * 4 + 2], xv[i * 4 + 3]);
#pragma unroll
      for (int j = 0; j < 4; ++j) s2 += xv[i * 4 + j] * xv[i * 4 + j];
    }
    s2 = wave_sum(s2);
    const float r2 = rsqrtf(s2 * (1.0f / kD) + 1e-6f);
    float lgt[16];
#pragma unroll
    for (int e = 0; e < 16; ++e) lgt[e] = 0.f;
#pragma unroll
    for (int i = 0; i < 4; ++i) {
      const int k0 = i * 256 + lane * 4;
      const float4 gn = ld4(n2pre + k0), sc = ld4(mod + b * 6144 + 4096 + k0), sh = ld4(mod + b * 6144 + 3072 + k0);
      float hh[4];
      hh[0] = xv[i * 4] * r2 * gn.x * (1.f + sc.x) + sh.x; hh[1] = xv[i * 4 + 1] * r2 * gn.y * (1.f + sc.y) + sh.y;
      hh[2] = xv[i * 4 + 2] * r2 * gn.z * (1.f + sc.z) + sh.z; hh[3] = xv[i * 4 + 3] * r2 * gn.w * (1.f + sc.w) + sh.w;
      *reinterpret_cast<uint2*>(h2o + (size_t)row * kD + k0) = make_uint2(pg8::cvt_pk_bf16(hh[0], hh[1]), pg8::cvt_pk_bf16(hh[2], hh[3]));
#pragma unroll
      for (int j = 0; j < 4; ++j) {
        const int k = k0 + j; const float h2 = hh[j];
        const float4 w0 = ld4(rw + k * 16), w1 = ld4(rw + k * 16 + 4), w2 = ld4(rw + k * 16 + 8), w3 = ld4(rw + k * 16 + 12);
        lgt[0] += h2 * w0.x; lgt[1] += h2 * w0.y; lgt[2] += h2 * w0.z; lgt[3] += h2 * w0.w;
        lgt[4] += h2 * w1.x; lgt[5] += h2 * w1.y; lgt[6] += h2 * w1.z; lgt[7] += h2 * w1.w;
        lgt[8] += h2 * w2.x; lgt[9] += h2 * w2.y; lgt[10] += h2 * w2.z; lgt[11] += h2 * w2.w;
        lgt[12] += h2 * w3.x; lgt[13] += h2 * w3.y; lgt[14] += h2 * w3.z; lgt[15] += h2 * w3.w;
      }
    }
    float mxv = -1e30f;
#pragma unroll
    for (int e = 0; e < 16; ++e) { lgt[e] = wave_sum(lgt[e]); mxv = fmaxf(mxv, lgt[e]); }
    float den = 0.f;
#pragma unroll
    for (int e = 0; e < 16; ++e) { lgt[e] = expf(lgt[e] - mxv); den += lgt[e]; }
    const float inv = 1.0f / den;
    float mine = 0.f;
#pragma unroll
    for (int e = 0; e < 16; ++e) if (lane == e) mine = lgt[e] * inv;
    if (lane < 16) aff[(size_t)row * 16 + lane] = mine;
  }
}

__device__ void phase_topk(float* lds, const float* aff, int* idx, float* gate, int* sel, int bid, int nb) {
  unsigned long long* keys = reinterpret_cast<unsigned long long*>(lds);
  const int tid = tidx();
  for (int item = bid; item < kB * kE; item += nb) {
    const int b = item / kE, e = item % kE;
    __syncthreads();
    for (int t = tid; t < kT; t += NTHR) {
      const float a = aff[((size_t)b * kT + t) * 16 + e];
      keys[t] = ((unsigned long long)__float_as_uint(a) << 32) | (unsigned)(0xFFFFFFFFu - (unsigned)t);
    }
    __syncthreads();
    for (int k = 2; k <= kT; k <<= 1) {
      for (int j = k >> 1; j > 0; j >>= 1) {
        for (int i = tid; i < kT; i += NTHR) {
          const int ixj = i ^ j;
          if (ixj > i) {
            const unsigned long long a = keys[i], c = keys[ixj];
            const bool desc = (i & k) == 0;
            if (desc ? (a < c) : (a > c)) { keys[i] = c; keys[ixj] = a; }
          }
        }
        __syncthreads();
      }
    }
    for (int c = tid; c < kT; c += NTHR) {
      const unsigned long long kv = keys[c];
      const int t = (int)(0xFFFFFFFFu - (unsigned)(kv & 0xFFFFFFFFull));
      sel[((size_t)b * kT + t) * 16 + e] = c < kCAP ? c : -1;
      if (c < kCAP) { idx[(e * kB + b) * kCAP + c] = b * kT + t; gate[item * kCAP + c] = __uint_as_float((unsigned)(kv >> 32)); }
    }
  }
}

__device__ void phase_final(const Params& p, const bf16_t* ye, const int* sel, float* out, const float* mod, int bid, int nb) {
  const int lane = tidx() & 63, wid = tidx() >> 6;
  const float* n2post = p.in[I_N2POST];
  for (int row = bid * 8 + wid; row < kROWS; row += nb * 8) {
    const int b = row / kT;
    float m[16];
#pragma unroll
    for (int i = 0; i < 16; ++i) m[i] = 0.f;
    const int myc = lane < 16 ? sel[(size_t)row * 16 + lane] : -1;
#pragma unroll 1
    for (int e = 0; e < 16; ++e) {
      const int c = __shfl(myc, e);
      if (c >= 0) {
        const bf16_t* src = ye + ((size_t)(b * kE + e) * kCAP + c) * kD;
#pragma unroll
        for (int i = 0; i < 4; ++i) { const uint2 u = *reinterpret_cast<const uint2*>(src + i * 256 + lane * 4);
          m[i * 4] += bflo(u.x); m[i * 4 + 1] += bfhi(u.x); m[i * 4 + 2] += bflo(u.y); m[i * 4 + 3] += bfhi(u.y); }
      }
    }
    float ss = 0.f;
#pragma unroll
    for (int i = 0; i < 16; ++i) ss += m[i] * m[i];
    ss = wave_sum(ss);
    const float r = rsqrtf(ss * (1.0f / kD) + 1e-6f);
#pragma unroll
    for (int i = 0; i < 4; ++i) {
      const int k = i * 256 + lane * 4;
      float4 o = ld4(out + (size_t)row * kD + k);
      const float4 gp = ld4(n2post + k), gt = ld4(mod + b * 6144 + 5120 + k);
      o.x += gt.x * m[i * 4] * r * gp.x; o.y += gt.y * m[i * 4 + 1] * r * gp.y; o.z += gt.z * m[i * 4 + 2] * r * gp.z; o.w += gt.w * m[i * 4 + 3] * r * gp.w;
      *reinterpret_cast<float4*>(out + (size_t)row * kD + k) = o;
    }
  }
}

template <class Epi, class Sched, bool G>
DEV void run_gemm(float* lds, int K, const Sched& S, const Epi& E) {
  __syncthreads();
  pg8::gemm_phase<Epi, Sched, G>((PG8_LAS unsigned char*)lds, K, S, E);
  __syncthreads();
}

__global__ void __launch_bounds__(NTHR, 2) fwd_megakernel(Params p) {
  extern __shared__ __attribute__((aligned(16))) float lds[];
  cg::grid_group grid = cg::this_grid();
  const int bid = blockIdx.x, nb = gridDim.x;
  char* const ws = p.ws;
  constexpr size_t MB = 1048576;
#define b_mod   ((float*)(ws + OFF_MOD))
#define b_rstdc ((float*)(ws + OFF_RSTDC))
#define b_sctx  ((float*)(ws + OFF_SCTX))
#define b_BS    ((float*)(ws + OFF_BS))
#define b_aff   ((float*)(ws + OFF_AFF))
#define b_idx   ((int*)(ws + OFF_IDX))
#define b_gate  ((float*)(ws + OFF_GATE))
#define b_CC    (p.out)
#define b_kfu   ((float*)(ws + OFF_KFU))
#define b_sel   ((int*)(ws + OFF_SEL))
#define b_winT  ((const char*)(ws + OFF_WINT))
#define b_hpT   ((const char*)(ws + OFF_HPT))
#define b_rpT   ((const char*)(ws + OFF_RPT))
#define b_woT   ((const char*)(ws + OFF_WOT))
#define b_w13T  ((const char*)(ws + OFF_W13T))
#define b_w2T   ((const char*)(ws + OFF_W2T))
#define b_hb    ((bf16_t*)(ws + OFF_A0))
#define b_A1    (ws + OFF_A1)
#define b_HYT   ((bf16_t*)(b_A1))
#define b_RWC   ((bf16_t*)(b_A1 + 96 * MB))
#define b_HYOT  ((bf16_t*)(b_A1 + 208 * MB))
#define b_HYO   ((bf16_t*)(b_A1))
#define b_RWO   ((bf16_t*)(b_A1 + 32 * MB))
#define b_YH    ((bf16_t*)(b_A1 + 96 * MB))
#define b_YR    ((bf16_t*)(b_A1 + 160 * MB))
#define b_PRE   ((bf16_t*)(b_A1))
#define b_HID0  ((bf16_t*)(b_A1))
#define b_YE    ((bf16_t*)(b_A1 + 128 * MB))
#define b_Y0    ((bf16_t*)(p.out + (size_t)kROWS * 512))
#define b_Y1    (b_Y0 + (size_t)kROWS * 512)
#define b_PQ    (p.out)
#define b_S0    ((float*)(ws + OFF_KFU))

  phase_mod(lds, p.in[I_C], p.in[I_CCTX], p.in[I_MODW], p.in[I_MODB], b_mod, bid, nb);
  phase_filter(lds, p, b_kfu, bid, nb);
  phase_rstd(p.in[I_CTX], b_rstdc, bid, nb);
  phase_wprep(lds, p, ws, bid, nb);
  grid.sync();
  phase_hb(p, b_mod, b_hb, bid, nb);
  {
    ALoadNorm al{p.in[I_CTX], b_rstdc, p.in[I_N1PRE], b_mod, 1, 4, 1024, 0};
    BLoadPlain bl{p.in[I_WIN], kINC, 2048};
    EpiStore ep{b_CC, kCC};
    gemm_f32(lds, kB * kCTX, kCC, kD, al, bl, ep, bid, nb);
  }
  grid.sync();
  if (bid < 64) {
    const int dir = bid >> 5, b = (bid >> 3) & 3, h = bid & 7;
    rs::scan_task<64, false, float>(lds, p, b_CC, kCC, kCTX, 0, 0, 512, 1024, 1088, 512, b, h, dir, 0, nullptr, b_sctx + (size_t)bid * 4096, nullptr, nullptr);
  }
  {
    SchedPlain S; S.o.init(kROWS / 256, 7, nb, bid); S.A = (const char*)b_hb; S.B = b_winT + (size_t)1536 * kD * 2; S.tstep = (size_t)256 * kD * 2;
    EpiBf16Split E{b_RWC, kRWC, 7, b_RWC, kRWC};
    run_gemm<EpiBf16Split, SchedPlain, false>(lds, kD, S, E);
    SchedPlain S2; S2.o.init(6, kROWS / 256, nb, bid); S2.A = b_winT; S2.B = (const char*)b_hb; S2.tstep = (size_t)256 * kD * 2;
    EpiBf16Split E2{b_HYT, kROWS, kROWS / 256, b_HYT, kROWS};
    run_gemm<EpiBf16Split, SchedPlain, false>(lds, kD, S2, E2);
  }
  grid.sync();
  for (int c = bid; c < 512; c += nb) fftconv_channel(lds, p, c, b_kfu, b_HYT, b_HYOT);
  for (int task = bid; task < 2048; task += nb) {
    const int chain = task >> 5, sc = task & 31, dir = chain >> 5, b = (chain >> 3) & 3, h = chain & 7;
    rs::scan_task<128, false, bf16_t>(lds, p, b_RWC, kRWC, kT, 0, 512, 1024, 1536, 1600, 0, b, h, dir, sc * 256, nullptr, b_PQ + (size_t)task * 8192, nullptr, nullptr);
  }
  grid.sync();
  if (bid < 64) scan_passB(lds, bid, b_sctx + (size_t)bid * 4096, b_PQ, b_S0);
  phase_hyo_transpose(lds, b_HYOT, b_HYO, bid, nb);
  grid.sync();
  for (int task = bid; task < 2048; task += nb) {
    const int chain = task >> 5, sc = task & 31, dir = chain >> 5, b = (chain >> 3) & 3, h = chain & 7;
    rs::scan_task<64, true, bf16_t>(lds, p, b_RWC, kRWC, kT, 0, 512, 1024, 1536, 1600, 0, b, h, dir, sc * 256, b_S0 + (size_t)task * 4096, nullptr, b_Y0, b_BS);
  }
  grid.sync();
  phase_rwout(lds, p, b_RWC, b_Y0, b_Y1, b_BS, b_RWO, bid, nb);
  grid.sync();
  {
    SchedPlain S; S.o.init(kROWS / 256, 4, nb, bid); S.A = (const char*)b_HYO; S.B = b_hpT; S.tstep = (size_t)256 * 512 * 2;
    EpiBf16Split E{b_YH, kD, 4, b_YH, kD};
    run_gemm<EpiBf16Split, SchedPlain, false>(lds, 512, S, E);
    SchedPlain S2; S2.o.init(kROWS / 256, 4, nb, bid); S2.A = (const char*)b_RWO; S2.B = b_rpT; S2.tstep = (size_t)256 * 512 * 2;
    EpiBf16Split E2{b_YR, kD, 4, b_YR, kD};
    run_gemm<EpiBf16Split, SchedPlain, false>(lds, 512, S2, E2);
  }
  grid.sync();
  {
    SchedPlain S; S.o.init(kROWS / 256, 8, nb, bid); S.A = (const char*)b_hb; S.B = b_winT + (size_t)3328 * kD * 2; S.tstep = (size_t)256 * kD * 2;
    EpiGatesMerge E{b_YH, b_YR, b_PRE};
    run_gemm<EpiGatesMerge, SchedPlain, false>(lds, kD, S, E);
  }
  grid.sync();
  {
    SchedPlain S; S.o.init(kROWS / 256, 4, nb, bid); S.A = (const char*)b_PRE; S.B = b_woT; S.tstep = (size_t)256 * kD * 2;
    EpiF32Store E{p.out, kD};
    run_gemm<EpiF32Store, SchedPlain, false>(lds, kD, S, E);
  }
  grid.sync();
  phase_post(p, p.out, b_hb, b_aff, b_mod, bid, nb);
  grid.sync();
  phase_topk(lds, b_aff, b_idx, b_gate, b_sel, bid, nb);
  grid.sync();
  for (int g = 0; g <= 4; ++g) {
    if (g < 4) {
      SchedExp1 S; S.o.init(64, 16, nb, bid); S.H2 = (const char*)b_hb; S.W13T = b_w13T; S.idx = b_idx + g * 4 * 4096; S.e0 = g * 4;
      EpiSwiGLU E{b_HID0 + (size_t)(g & 1) * 16384 * kF};
      run_gemm<EpiSwiGLU, SchedExp1, true>(lds, kD, S, E);
    }
    if (g > 0) {
      SchedExp2 S; S.o.init(64, 4, nb, bid); S.HID = (const char*)(b_HID0 + (size_t)((g - 1) & 1) * 16384 * kF); S.W2T = b_w2T; S.e0 = (g - 1) * 4;
      EpiYE E{b_YE, b_gate, (g - 1) * 4};
      run_gemm<EpiYE, SchedExp2, false>(lds, kF, S, E);
    }
    grid.sync();
  }
  phase_final(p, b_YE, b_sel, p.out, b_mod, bid, nb);
}

#undef b_mod
#undef b_rstdc
#undef b_sctx
#undef b_BS
#undef b_aff
#undef b_idx
#undef b_gate
#undef b_CC
#undef b_kfu
#undef b_sel
#undef b_winT
#undef b_hpT
#undef b_rpT
#undef b_woT
#undef b_w13T
#undef b_w2T
#undef b_hb
#undef b_A1
#undef b_HYT
#undef b_RWC
#undef b_HYOT
#undef b_HYO
#undef b_RWO
#undef b_YH
#undef b_YR
#undef b_PRE
#undef b_HID0
#undef b_YE
#undef b_Y0
#undef b_Y1
#undef b_PQ
#undef b_S0
extern "C" void kernel_launch(void* const* d_in, const int* in_sizes, int n_in, void* d_out, int out_size, void* d_ws, size_t ws_size,
                              hipStream_t stream) {
  static int grid_blocks = 0;
  if (!grid_blocks) {
    int dev = 0, cus = 0, per_cu = 0;
    (void)hipGetDevice(&dev);
    (void)hipDeviceGetAttribute(&cus, hipDeviceAttributeMultiprocessorCount, dev);
    (void)hipFuncSetAttribute((const void*)fwd_megakernel, hipFuncAttributeMaxDynamicSharedMemorySize, (int)LDS_BYTES);
    (void)hipOccupancyMaxActiveBlocksPerMultiprocessor(&per_cu, fwd_megakernel, NTHR, LDS_BYTES);
    if (per_cu < 1) per_cu = 1;
    if (per_cu > 1) per_cu = 1;
    grid_blocks = cus * per_cu;
    if (ws_size < WS_TOTAL) fprintf(stderr, "kernel_launch: workspace too small: %zu < %zu\n", ws_size, (size_t)WS_TOTAL);
  }
  if (ws_size < WS_TOTAL) return;
  Params p{};
  for (int i = 0; i < 38; ++i) p.in[i] = (const float*)d_in[i];
  p.out = (float*)d_out;
  p.ws = (char*)d_ws;
    void* args[] = {&p};
  hipError_t e = hipLaunchCooperativeKernel((void*)fwd_megakernel, dim3(grid_blocks), dim3(NTHR), args, LDS_BYTES, stream);
  if (e != hipSuccess) fprintf(stderr, "cooperative launch failed: %s (grid %d)\n", hipGetErrorString(e), grid_blocks);
}
```

```cpp
#include <hip/hip_runtime.h>
#include <hip/hip_cooperative_groups.h>
#include <hip/hip_fp16.h>
#include <cstdio>
#include <cstdint>
namespace cg = cooperative_groups;

#define DEV __device__ __forceinline__
typedef float f32x16 __attribute__((ext_vector_type(16)));

constexpr int kD = 1024, kB = 4, kT = 8192, kCTX = 256, kROWS = kB * kT;
constexpr int kHYW = 512, kHYC = 1536, kRWW = 512, kRWC = 1792, kINC = 5376;
constexpr int kH = 8, kE = 16, kF = 2048, kCAP = 1024;
constexpr int kSCC = 16, kNSC = kT / (64 * kSCC);
constexpr int kCC = 1280;
constexpr int NTHR = 512;
constexpr size_t LDS_BYTES = 160 * 1024;

constexpr size_t OFF_MOD   = 0;
constexpr size_t OFF_RSTDC = OFF_MOD + 131072;
constexpr size_t OFF_NORM  = OFF_RSTDC + 4096;
constexpr size_t OFF_CNT   = OFF_NORM + 2048;
constexpr size_t OFF_SCTX  = OFF_CNT + 256;
constexpr size_t OFF_BS    = OFF_SCTX + 1048576;
constexpr size_t OFF_AFF   = OFF_BS + 2097152;
constexpr size_t OFF_IDX   = OFF_AFF + 2097152;
constexpr size_t OFF_GATE  = OFF_IDX + 262144;
constexpr size_t OFF_KFU   = OFF_GATE + 262144;
constexpr size_t OFF_SEL   = OFF_KFU + 33554432;
constexpr size_t OFF_WINT  = OFF_SEL + 2097152;
constexpr size_t OFF_HPT   = OFF_WINT + 11010048;
constexpr size_t OFF_RPT   = OFF_HPT + 1048576;
constexpr size_t OFF_WOT   = OFF_RPT + 1048576;
constexpr size_t OFF_W13T  = OFF_WOT + 2097152;
constexpr size_t OFF_W2T   = OFF_W13T + 134217728;
constexpr size_t OFF_A0    = OFF_W2T + 67108864;
constexpr size_t OFF_A1    = OFF_A0 + 67108864;
constexpr size_t A1_BYTES  = 268435456;
constexpr size_t WS_TOTAL  = OFF_A1 + A1_BYTES;
static_assert(WS_TOTAL <= 597000000, "workspace budget");

struct Params {
  const float* in[38];
  float* out;
  char* ws;
};
constexpr int TP_LO = -1, TP_HI = -1;


enum { I_X = 0, I_C, I_CTX, I_CCTX, I_MODW, I_MODB, I_N1PRE, I_N1POST, I_N2PRE, I_N2POST, I_WIN,
       I_HCW, I_HCB, I_HW1, I_HB1, I_HW2, I_HB2, I_HW3, I_HFREQ, I_HBIAS, I_HPROJ,
       I_MU, I_W0, I_WUP, I_A0, I_AUP, I_GUP, I_KK, I_KA, I_RK, I_LNG, I_LNB, I_RWPROJ, I_WOUT, I_ROUTER,
       I_EW1, I_EW3, I_EW2 };

constexpr int TIDTAB_OFF = 160 * 1024 - 256;
DEV int hw_wave_slot() { return (int)(__builtin_amdgcn_s_getreg((5 << 11) | 4) & 0x3f); }
extern __shared__ __attribute__((aligned(16))) float lds_dyn_[];
DEV int tidx() {
  const int lane = (int)__builtin_amdgcn_mbcnt_hi(~0u, __builtin_amdgcn_mbcnt_lo(~0u, 0u));
  const int wv = __builtin_amdgcn_readfirstlane(reinterpret_cast<const int*>(reinterpret_cast<const char*>(lds_dyn_) + TIDTAB_OFF)[hw_wave_slot()]);
  int t = (wv << 6) | lane; asm volatile("" : "+v"(t)); return t;
}
DEV float wave_sum(float v) {
  int x;
  x = __builtin_amdgcn_update_dpp(0, __float_as_int(v), 0xB1, 0xF, 0xF, false); v += __int_as_float(x);
  x = __builtin_amdgcn_update_dpp(0, __float_as_int(v), 0x4E, 0xF, 0xF, false); v += __int_as_float(x);
  x = __builtin_amdgcn_update_dpp(0, __float_as_int(v), 0x141, 0xF, 0xF, false); v += __int_as_float(x);
  x = __builtin_amdgcn_update_dpp(0, __float_as_int(v), 0x140, 0xF, 0xF, false); v += __int_as_float(x);
  const float r0 = __int_as_float(__builtin_amdgcn_readlane(__float_as_int(v), 0)), r1 = __int_as_float(__builtin_amdgcn_readlane(__float_as_int(v), 16));
  const float r2 = __int_as_float(__builtin_amdgcn_readlane(__float_as_int(v), 32)), r3 = __int_as_float(__builtin_amdgcn_readlane(__float_as_int(v), 48));
  return (r0 + r1) + (r2 + r3);
}
DEV float sigmoidf_(float x) { return 1.0f / (1.0f + expf(-x)); }
DEV float siluf_(float x) { return x / (1.0f + expf(-x)); }
DEV float softplusf_(float x) { return x > 20.f ? x : log1pf(expf(x)); }
DEV void sincos_cw(float x, float& sn, float& cs) {
  const float kf = rintf(x * 0.6366197723675814f);
  const int k = (int)kf;
  float r = fmaf(kf, -1.5703125f, x);
  r = fmaf(kf, -4.837512969970703125e-4f, r);
  r = fmaf(kf, -7.54978995489188216e-8f, r);
  const float r2 = r * r;
  const float sp = r + r * r2 * (-1.6666654611e-1f + r2 * (8.3321608736e-3f + r2 * (-1.9515295891e-4f)));
  const float cp = 1.0f - 0.5f * r2 + r2 * r2 * (4.166664568298827e-2f + r2 * (-1.388731625493765e-3f + r2 * 2.443315711809948e-5f));
  const float s0 = (k & 1) ? cp : sp, c0 = (k & 1) ? sp : cp;
  sn = (k & 2) ? -s0 : s0;
  cs = ((k + 1) & 2) ? -c0 : c0;
}
DEV float sin_cw(float x) { float a, b; sincos_cw(x, a, b); return a; }
DEV float4 ld4(const float* p) { return *reinterpret_cast<const float4*>(p); }

namespace pg8 {
#define PG8_LAS __attribute__((address_space(3)))
typedef unsigned short bf16_t;
typedef short bf16x8 __attribute__((ext_vector_type(8)));
typedef float f32x4 __attribute__((ext_vector_type(4)));
typedef unsigned u32x4 __attribute__((ext_vector_type(4)));
typedef unsigned u32x2 __attribute__((ext_vector_type(2)));
constexpr int BM = 256, BK = 64, HALF = 128, HTB = HALF * BK * 2, STAGE_BYTES = 8 * HTB, NXCD = 8, WGM = 8;
__host__ __device__ __forceinline__ int lds_byte(int r, int c) { const int st = (r >> 4) * 2 + (c >> 5), rr = r & 15, cc = c & 31, ob = rr * 64 + cc * 2; return st * 1024 + (ob ^ (((ob >> 9) & 1) << 5)); }
__host__ __device__ __forceinline__ void stage_rc(int b, int& R, int& C) { const int st = b / 1024, sb = b % 1024, swz = sb ^ (((sb >> 9) & 1) << 5); R = (st >> 1) * 16 + swz / 64; C = (st & 1) * 32 + (swz % 64) / 2; }
__host__ __device__ __forceinline__ int perm32(int rho) { const int n = rho >> 4, i = rho & 15; return 8 * (i >> 2) + 4 * n + (i & 3); }
typedef __bf16 bf16v2 __attribute__((ext_vector_type(2)));
typedef float f32v2 __attribute__((ext_vector_type(2)));
__device__ __forceinline__ unsigned cvt_pk_bf16(float lo, float hi) { const f32v2 v = {lo, hi}; const bf16v2 r = __builtin_convertvector(v, bf16v2); return __builtin_bit_cast(unsigned, r); }

struct Unit { int pm, pn; const char* a; const char* b; };

struct TileOrder {
  int nM, nN, nwg, G, c;
  __device__ void init(int nM_, int nN_, int G_, int c_) { nM = nM_; nN = nN_; nwg = nM * nN; G = G_; c = c_; }
  __device__ bool tile(int i, int& pm, int& pn) const {
    const long L = (long)i * G + c; if (L >= nwg) return false;
    int wgid = (int)L; { const int q = nwg / NXCD, r = nwg % NXCD, xcd = wgid % NXCD, off = wgid / NXCD; wgid = (xcd < r ? xcd * (q + 1) : r * (q + 1) + (xcd - r) * q) + off; }
    const int nig = WGM * nN, gid = wgid / nig, fm = gid * WGM, gsz = (nM - fm) < WGM ? (nM - fm) : WGM;
    pm = fm + ((wgid % nig) % gsz); pn = (wgid % nig) / gsz; return true;
  }
};

template <class Epi, class Sched, bool GATHER>
__device__ __forceinline__ void gemm_phase(PG8_LAS unsigned char* lds, const int K, const Sched& S, const Epi& E) {
  int tid_ = tidx(); asm volatile("" : "+v"(tid_));
  const int tid = tid_, wid = __builtin_amdgcn_readfirstlane(tid >> 6), lane = tid & 63, wr = wid >> 2, wc = wid & 3, fr = lane & 15, fq = lane >> 4;
  const int nt = K / BK;
  unsigned voffA[2], voffB[2];
#pragma unroll
  for (int i = 0; i < 2; ++i) { int R, C; stage_rc(tid * 16 + i * 8192, R, C); const int Rb = Epi::PERM ? ((R & ~31) + perm32(R & 31)) : R;
    voffA[i] = (unsigned)(R * K + C) * 2u; voffB[i] = (unsigned)(Rb * K + C) * 2u; }
  const size_t kstep = (size_t)(BK * 2);
  const size_t hstep = (size_t)HALF * K * 2;
  const unsigned ldsw = (unsigned)wid * 1024u;
  const int aoff = lds_byte(wr * 64 + fr, fq * 8), boff = lds_byte(wc * 32 + fr, fq * 8);
#define PG8_SA(b, h) (((b) * 2 + (h)) * HTB)
#define PG8_SB(b, h) ((4 + (b) * 2 + (h)) * HTB)
#define PG8_STAGE(bufoff, gbase, voff) do { _Pragma("unroll") for (int _i = 0; _i < 2; ++_i) \
    __builtin_amdgcn_global_load_lds((const unsigned*)((const char*)(gbase) + (voff)[_i]), (PG8_LAS unsigned*)(lds + (bufoff) + ldsw + _i * 8192), 16, 0, 0); } while (0)
#define PG8_STAGE_A(bufoff, gbase, h) do { if constexpr (GATHER) { PG8_STAGE(bufoff, gbase, vAc[h]); } else { PG8_STAGE(bufoff, (gbase) + (h) * hstep, voffA); } } while (0)
#define PG8_GATHER_OFFS(dst, u) do { _Pragma("unroll") for (int _h = 0; _h < 2; ++_h) _Pragma("unroll") for (int _i = 0; _i < 2; ++_i) { int _R, _C; stage_rc(tid * 16 + _i * 8192, _R, _C); \
    dst[_h][_i] = (unsigned)S.row(u, _h * HALF + _R) * (unsigned)(K * 2) + (unsigned)(_C * 2); } } while (0)
#define PG8_LDA(dst, b, h) do { _Pragma("unroll") for (int m = 0; m < 4; ++m) _Pragma("unroll") for (int k = 0; k < 2; ++k) dst[m][k] = *(const PG8_LAS bf16x8*)(lds + PG8_SA(b, h) + aoff + m * 2048 + k * 1024); } while (0)
#define PG8_LDB(dst, b, h) do { _Pragma("unroll") for (int n = 0; n < 2; ++n) _Pragma("unroll") for (int k = 0; k < 2; ++k) dst[n][k] = *(const PG8_LAS bf16x8*)(lds + PG8_SB(b, h) + boff + n * 2048 + k * 1024); } while (0)
#define PG8_MMA(ai, bj, At, Bt) do { __builtin_amdgcn_s_setprio(1); _Pragma("unroll") for (int m = 0; m < 4; ++m) _Pragma("unroll") for (int n = 0; n < 2; ++n) _Pragma("unroll") for (int k = 0; k < 2; ++k) \
    acc[ai][bj][m][n] = __builtin_amdgcn_mfma_f32_16x16x32_bf16(Bt[n][k], At[m][k], acc[ai][bj][m][n], 0, 0, 0); __builtin_amdgcn_s_setprio(0); } while (0)
#define PG8_WAIT_V(n) asm volatile("s_waitcnt vmcnt(" #n ")" ::: "memory")
#define PG8_WAIT_L(n) asm volatile("s_waitcnt lgkmcnt(" #n ")" ::: "memory")
#define PG8_BAR __builtin_amdgcn_s_barrier()
#define PG8_SCHED __builtin_amdgcn_sched_barrier(0)
  Unit cur, nxt; int ui = 0;
  if (!S.next(0, cur)) return;
  unsigned vAc[2][2];
  if constexpr (GATHER) { PG8_GATHER_OFFS(vAc, cur); }
  else { vAc[0][0] = vAc[0][1] = vAc[1][0] = vAc[1][1] = 0u; }
  f32x4 acc[2][2][4][2];
#pragma unroll
  for (int a = 0; a < 2; ++a)
#pragma unroll
    for (int b = 0; b < 2; ++b)
#pragma unroll
      for (int m = 0; m < 4; ++m)
#pragma unroll
        for (int n = 0; n < 2; ++n) acc[a][b][m][n] = (f32x4){0.f, 0.f, 0.f, 0.f};
  bf16x8 At[4][2], B0[2][2], B1[2][2];
  const char* cA = cur.a; const char* cB = cur.b;
  PG8_STAGE(PG8_SB(0, 0), cB, voffB); PG8_STAGE_A(PG8_SA(0, 0), cA, 0); PG8_STAGE(PG8_SB(0, 1), cB + hstep, voffB); PG8_STAGE_A(PG8_SA(0, 1), cA, 1);
  if (wr == 1) PG8_BAR;
  PG8_WAIT_V(4); PG8_BAR;
  PG8_STAGE(PG8_SB(1, 0), cB + kstep, voffB); PG8_STAGE_A(PG8_SA(1, 0), cA + kstep, 0); PG8_STAGE(PG8_SB(1, 1), cB + hstep + kstep, voffB);
  PG8_WAIT_V(6); PG8_BAR;
  for (;;) {
    const bool has_next = S.next(ui + 1, nxt);
    const char* nA = has_next ? nxt.a : cA; const char* nB = has_next ? nxt.b : cB;
    for (int t = 0; t < nt; t += 2) {
      const bool last = (t == nt - 2);
      const char* a1 = cA + (size_t)(t + 1) * kstep;
      const char* a2 = last ? nA : cA + (size_t)(t + 2) * kstep; const char* b2 = last ? nB : cB + (size_t)(t + 2) * kstep;
      const char* a3 = a2 + kstep; const char* b3 = b2 + kstep;
      unsigned vAn[2][2];
      if constexpr (GATHER) { PG8_SCHED; if (last && has_next) { PG8_GATHER_OFFS(vAn, nxt); } PG8_SCHED; }
      PG8_LDB(B0, 0, 0); PG8_SCHED; PG8_LDA(At, 0, 0); PG8_STAGE_A(PG8_SA(1, 1), a1, 1);
      PG8_WAIT_L(8); PG8_BAR; PG8_WAIT_L(0); PG8_MMA(0, 0, At, B0); PG8_BAR; PG8_SCHED;
      if constexpr (GATHER) { if (last && has_next) { vAc[0][0] = vAn[0][0]; vAc[0][1] = vAn[0][1]; vAc[1][0] = vAn[1][0]; vAc[1][1] = vAn[1][1]; } }
      PG8_LDB(B1, 0, 1); PG8_STAGE(PG8_SB(0, 0), b2, voffB);
      PG8_BAR; PG8_WAIT_L(0); PG8_MMA(0, 1, At, B1); PG8_BAR;
      PG8_LDA(At, 0, 1); PG8_STAGE_A(PG8_SA(0, 0), a2, 0);
      PG8_BAR; PG8_WAIT_L(0); PG8_MMA(1, 0, At, B0); PG8_BAR; PG8_SCHED;
      PG8_STAGE(PG8_SB(0, 1), b2 + hstep, voffB);
      PG8_WAIT_V(6); PG8_BAR; PG8_MMA(1, 1, At, B1); PG8_BAR;
      PG8_LDB(B0, 1, 0); PG8_SCHED; PG8_LDA(At, 1, 0); PG8_STAGE_A(PG8_SA(0, 1), a2, 1);
      PG8_WAIT_L(8); PG8_BAR; PG8_WAIT_L(0); PG8_MMA(0, 0, At, B0); PG8_BAR; PG8_SCHED;
      PG8_LDB(B1, 1, 1); PG8_STAGE(PG8_SB(1, 0), b3, voffB);
      PG8_BAR; PG8_WAIT_L(0); PG8_MMA(0, 1, At, B1); PG8_BAR;
      PG8_LDA(At, 1, 1); PG8_STAGE_A(PG8_SA(1, 0), a3, 0);
      PG8_BAR; PG8_WAIT_L(0); PG8_MMA(1, 0, At, B0); PG8_BAR; PG8_SCHED;
      PG8_STAGE(PG8_SB(1, 1), b3 + hstep, voffB);
      PG8_WAIT_V(6); PG8_BAR; PG8_MMA(1, 1, At, B1); PG8_BAR;
    }
    E(acc, cur, wr, wc, fr, fq);
    if (!has_next) break;
#pragma unroll
    for (int a = 0; a < 2; ++a)
#pragma unroll
      for (int b = 0; b < 2; ++b)
#pragma unroll
        for (int m = 0; m < 4; ++m)
#pragma unroll
          for (int n = 0; n < 2; ++n) acc[a][b][m][n] = (f32x4){0.f, 0.f, 0.f, 0.f};
    cur = nxt; cA = nA; cB = nB; ++ui;
  }
  PG8_WAIT_V(0);
  if (wr == 0) PG8_BAR;
  PG8_BAR;
#undef PG8_SA
#undef PG8_SB
#undef PG8_STAGE
#undef PG8_STAGE_A
#undef PG8_GATHER_OFFS
#undef PG8_LDA
#undef PG8_LDB
#undef PG8_MMA
#undef PG8_WAIT_V
#undef PG8_WAIT_L
#undef PG8_BAR
#undef PG8_SCHED
}
}

__device__ void transpose_tile(float* tl, const float* src, int ld, int scol0, unsigned short* dst, int K, int n0, int k0) {
  const int tid = tidx();
  __syncthreads();
#pragma unroll
  for (int ps = 0; ps < 4; ++ps) {
    const int kr = ps * 32 + (tid >> 4), c4 = (tid & 15) * 4;
    const float4 v = ld4(src + (size_t)(k0 + kr) * ld + scol0 + c4);
    tl[kr * 65 + c4] = v.x; tl[kr * 65 + c4 + 1] = v.y; tl[kr * 65 + c4 + 2] = v.z; tl[kr * 65 + c4 + 3] = v.w;
  }
  __syncthreads();
  const int n = tid >> 3, kq = (tid & 7) * 16;
  unsigned w[8];
#pragma unroll
  for (int i = 0; i < 8; ++i) w[i] = pg8::cvt_pk_bf16(tl[(kq + 2 * i) * 65 + n], tl[(kq + 2 * i + 1) * 65 + n]);
  uint4* o = reinterpret_cast<uint4*>(dst + (size_t)(n0 + n) * K + k0 + kq);
  o[0] = make_uint4(w[0], w[1], w[2], w[3]); o[1] = make_uint4(w[4], w[5], w[6], w[7]);
}

typedef unsigned short bf16_t;
DEV float bf2f(bf16_t v) { return __uint_as_float((unsigned)v << 16); }
DEV float bflo(unsigned w) { return __uint_as_float(w << 16); }
DEV float bfhi(unsigned w) { return __uint_as_float(w & 0xffff0000u); }
DEV bf16_t f2bf(float f) { return (bf16_t)(pg8::cvt_pk_bf16(f, 0.f) & 0xffffu); }
DEV float fsigmoid(float x) { return 1.0f / (1.0f + __expf(-x)); }

__device__ void phase_wprep(float* lds, const Params& p, char* ws, int bid, int nb) {
  bf16_t* winT = (bf16_t*)(ws + OFF_WINT); bf16_t* hpT = (bf16_t*)(ws + OFF_HPT); bf16_t* rpT = (bf16_t*)(ws + OFF_RPT);
  bf16_t* woT = (bf16_t*)(ws + OFF_WOT); bf16_t* w13T = (bf16_t*)(ws + OFF_W13T); bf16_t* w2T = (bf16_t*)(ws + OFF_W2T);
  constexpr int N0 = 672, N1 = N0 + 64, N2 = N1 + 64, N3 = N2 + 128, N4 = N3 + 8192, N5 = N4 + 4096;
  for (int item = bid; item < N5; item += nb) {
    if (item < N0) {
      const int nt = item >> 3, kt = item & 7, n0 = nt * 64;
      int scol;
      if (n0 < 3328) scol = n0;
      else { const int r = n0 - 3328, j = r >> 8, q = r & 255; scol = 3328 + (q < 128 ? 0 : 1024) + j * 128 + (q & 127); }
      transpose_tile(lds, p.in[I_WIN], kINC, scol, winT, kD, n0, kt * 128);
    } else if (item < N1) { const int it = item - N0; transpose_tile(lds, p.in[I_HPROJ], kD, (it >> 2) * 64, hpT, 512, (it >> 2) * 64, (it & 3) * 128);
    } else if (item < N2) { const int it = item - N1; transpose_tile(lds, p.in[I_RWPROJ], kD, (it >> 2) * 64, rpT, 512, (it >> 2) * 64, (it & 3) * 128);
    } else if (item < N3) { const int it = item - N2; transpose_tile(lds, p.in[I_WOUT], kD, (it >> 3) * 64, woT, kD, (it >> 3) * 64, (it & 7) * 128);
    } else if (item < N4) {
      const int it = item - N3, e = it >> 9, nt = (it >> 3) & 63, kt = it & 7, n0 = nt * 64, j = n0 >> 8, q = n0 & 255;
      const float* src = (q < 128 ? p.in[I_EW1] : p.in[I_EW3]) + (size_t)e * kD * kF;
      transpose_tile(lds, src, kF, j * 128 + (q & 127), w13T + (size_t)e * 4096 * kD, kD, n0, kt * 128);
    } else {
      const int it = item - N4, e = it >> 8, nt = (it >> 4) & 15, kt = it & 15;
      transpose_tile(lds, p.in[I_EW2] + (size_t)e * kF * kD, kD, nt * 64, w2T + (size_t)e * kD * kF, kF, nt * 64, kt * 128);
    }
  }
}

__device__ void phase_hb(const Params& p, const float* mod, bf16_t* hb, bf16_t* hc, int bid, int nb) {
  const int lane = tidx() & 63, wid = tidx() >> 6;
  const float* g = p.in[I_N1PRE];
  const int rstep = nb * 8, rend = kROWS + kB * kCTX;
  int row = bid * 8 + wid;
  float4 nv[4];
  { const float* xr = row >= kROWS ? p.in[I_CTX] + (size_t)(row - kROWS) * kD : p.in[I_X] + (size_t)row * kD;
#pragma unroll
    for (int i = 0; i < 4; ++i) nv[i] = row < rend ? ld4(xr + i * 256 + lane * 4) : make_float4(0.f, 0.f, 0.f, 0.f); }
  for (; row < rend; row += rstep) {
    const bool isctx = row >= kROWS;
    const int mr = isctx ? 4 : row / kT;
    bf16_t* dst = isctx ? hc + (size_t)(row - kROWS) * kD : hb + (size_t)row * kD;
    float4 v[4]; float ss = 0.f;
#pragma unroll
    for (int i = 0; i < 4; ++i) { v[i] = nv[i]; ss += v[i].x * v[i].x + v[i].y * v[i].y + v[i].z * v[i].z + v[i].w * v[i].w; }
    { const int nr = row + rstep < rend ? row + rstep : row;
      const float* xr = nr >= kROWS ? p.in[I_CTX] + (size_t)(nr - kROWS) * kD : p.in[I_X] + (size_t)nr * kD;
#pragma unroll
      for (int i = 0; i < 4; ++i) nv[i] = ld4(xr + i * 256 + lane * 4); }
    ss = wave_sum(ss);
    const float r = rsqrtf(ss * (1.0f / kD) + 1e-6f);
#pragma unroll
    for (int i = 0; i < 4; ++i) {
      const int k = i * 256 + lane * 4;
      const float4 gv = ld4(g + k), sc = ld4(mod + mr * 6144 + 1024 + k), sh = ld4(mod + mr * 6144 + k);
      const float h0 = v[i].x * r * gv.x * (1.f + sc.x) + sh.x, h1 = v[i].y * r * gv.y * (1.f + sc.y) + sh.y;
      const float h2 = v[i].z * r * gv.z * (1.f + sc.z) + sh.z, h3 = v[i].w * r * gv.w * (1.f + sc.w) + sh.w;
      *reinterpret_cast<uint2*>(dst + k) = make_uint2(pg8::cvt_pk_bf16(h0, h1), pg8::cvt_pk_bf16(h2, h3));
    }
  }
}

struct SchedPlain {
  pg8::TileOrder o; const char* A; const char* B; size_t tstep;
  __device__ bool next(int i, pg8::Unit& u) const { if (!o.tile(i, u.pm, u.pn)) return false; u.a = A + (size_t)u.pm * tstep; u.b = B + (size_t)u.pn * tstep; return true; }
  __device__ int row(const pg8::Unit&, int) const { return 0; }
};
struct SchedExp1 {
  pg8::TileOrder o; const char* H2; const char* W13T; const int* idx; int e0;
  __device__ bool next(int i, pg8::Unit& u) const { if (!o.tile(i, u.pm, u.pn)) return false;
    const int e = e0 + (u.pm >> 4); u.a = H2; u.b = W13T + ((size_t)e * 4096 + (size_t)u.pn * 256) * kD * 2; return true; }
  __device__ int row(const pg8::Unit& u, int r) const { return idx[(unsigned)(u.pm * 256 + r)]; }
};
struct SchedExp2 {
  pg8::TileOrder o; const char* HID; const char* W2T; int e0;
  __device__ bool next(int i, pg8::Unit& u) const { if (!o.tile(i, u.pm, u.pn)) return false;
    const int e = e0 + (u.pm >> 4); u.a = HID + (size_t)u.pm * 256 * kF * 2; u.b = W2T + ((size_t)e * kD + (size_t)u.pn * 256) * kF * 2; return true; }
  __device__ int row(const pg8::Unit&, int) const { return 0; }
};

struct EpiBf16Split {
  static constexpr bool PERM = true;
  bf16_t* o0; int ld0; int nt0; bf16_t* o1; int ld1;
  __device__ __forceinline__ void operator()(const pg8::f32x4 (&acc)[2][2][4][2], const pg8::Unit& u, int wr, int wc, int fr, int fq) const {
    bf16_t* base; int ldc, colt;
    if (u.pn < nt0) { base = o0; ldc = ld0; colt = u.pn * 256; } else { base = o1; ldc = ld1; colt = (u.pn - nt0) * 256; }
    const int row0 = u.pm * 256 + wr * 64 + fr, col0 = colt + wc * 32 + 8 * fq;
#pragma unroll
    for (int ai = 0; ai < 2; ++ai)
#pragma unroll
      for (int m = 0; m < 4; ++m) { bf16_t* rowp = base + (size_t)(row0 + ai * 128 + m * 16) * ldc + col0;
#pragma unroll
        for (int bj = 0; bj < 2; ++bj) { const pg8::f32x4 v0 = acc[ai][bj][m][0], v1 = acc[ai][bj][m][1];
          pg8::u32x4 w; w.x = pg8::cvt_pk_bf16(v0[0], v0[1]); w.y = pg8::cvt_pk_bf16(v0[2], v0[3]); w.z = pg8::cvt_pk_bf16(v1[0], v1[1]); w.w = pg8::cvt_pk_bf16(v1[2], v1[3]);
          *(pg8::u32x4*)(rowp + bj * 128) = w; } }
  }
};
struct EpiF32Store {
  static constexpr bool PERM = false;
  float* C; int ldc;
  __device__ __forceinline__ void operator()(const pg8::f32x4 (&acc)[2][2][4][2], const pg8::Unit& u, int wr, int wc, int fr, int fq) const {
    const int row0 = u.pm * 256 + wr * 64 + fr, col0 = u.pn * 256 + wc * 32 + 4 * fq;
#pragma unroll
    for (int ai = 0; ai < 2; ++ai)
#pragma unroll
      for (int m = 0; m < 4; ++m) { float* rowp = C + (size_t)(row0 + ai * 128 + m * 16) * ldc + col0;
#pragma unroll
        for (int bj = 0; bj < 2; ++bj)
#pragma unroll
          for (int n = 0; n < 2; ++n) *(pg8::f32x4*)(rowp + bj * 128 + n * 16) = acc[ai][bj][m][n]; }
  }
};
struct EpiGatesMerge {
  static constexpr bool PERM = true;
  const bf16_t* yh; const bf16_t* yr; bf16_t* pre;
  __device__ __forceinline__ void operator()(const pg8::f32x4 (&acc)[2][2][4][2], const pg8::Unit& u, int wr, int wc, int fr, int fq) const {
    const int row0 = u.pm * 256 + wr * 64 + fr, col0 = u.pn * 128 + wc * 32 + 8 * fq;
#pragma unroll
    for (int ai = 0; ai < 2; ++ai)
#pragma unroll
      for (int m = 0; m < 4; ++m) { const size_t off = (size_t)(row0 + ai * 128 + m * 16) * kD + col0;
        const pg8::u32x4 a = *(const pg8::u32x4*)(yh + off), b = *(const pg8::u32x4*)(yr + off);
        const pg8::f32x4 g0 = acc[ai][0][m][0], g1 = acc[ai][0][m][1], r0 = acc[ai][1][m][0], r1 = acc[ai][1][m][1];
        float o[8];
        o[0] = fsigmoid(g0[0]) * bflo(a.x) + fsigmoid(r0[0]) * bflo(b.x); o[1] = fsigmoid(g0[1]) * bfhi(a.x) + fsigmoid(r0[1]) * bfhi(b.x);
        o[2] = fsigmoid(g0[2]) * bflo(a.y) + fsigmoid(r0[2]) * bflo(b.y); o[3] = fsigmoid(g0[3]) * bfhi(a.y) + fsigmoid(r0[3]) * bfhi(b.y);
        o[4] = fsigmoid(g1[0]) * bflo(a.z) + fsigmoid(r1[0]) * bflo(b.z); o[5] = fsigmoid(g1[1]) * bfhi(a.z) + fsigmoid(r1[1]) * bfhi(b.z);
        o[6] = fsigmoid(g1[2]) * bflo(a.w) + fsigmoid(r1[2]) * bflo(b.w); o[7] = fsigmoid(g1[3]) * bfhi(a.w) + fsigmoid(r1[3]) * bfhi(b.w);
        pg8::u32x4 w; w.x = pg8::cvt_pk_bf16(o[0], o[1]); w.y = pg8::cvt_pk_bf16(o[2], o[3]); w.z = pg8::cvt_pk_bf16(o[4], o[5]); w.w = pg8::cvt_pk_bf16(o[6], o[7]);
        *(pg8::u32x4*)(pre + off) = w; }
  }
};
struct EpiSwiGLU {
  static constexpr bool PERM = true;
  bf16_t* hid;
  __device__ __forceinline__ void operator()(const pg8::f32x4 (&acc)[2][2][4][2], const pg8::Unit& u, int wr, int wc, int fr, int fq) const {
    const int row0 = u.pm * 256 + wr * 64 + fr, col0 = u.pn * 128 + wc * 32 + 8 * fq;
#pragma unroll
    for (int ai = 0; ai < 2; ++ai)
#pragma unroll
      for (int m = 0; m < 4; ++m) { const size_t off = (size_t)(row0 + ai * 128 + m * 16) * kF + col0;
        float o[8];
#pragma unroll
        for (int n = 0; n < 2; ++n)
#pragma unroll
          for (int j = 0; j < 4; ++j) { const float a = acc[ai][0][m][n][j]; o[n * 4 + j] = a * fsigmoid(a) * acc[ai][1][m][n][j]; }
        pg8::u32x4 w; w.x = pg8::cvt_pk_bf16(o[0], o[1]); w.y = pg8::cvt_pk_bf16(o[2], o[3]); w.z = pg8::cvt_pk_bf16(o[4], o[5]); w.w = pg8::cvt_pk_bf16(o[6], o[7]);
        *(pg8::u32x4*)(hid + off) = w; }
  }
};
struct EpiYE {
  static constexpr bool PERM = true;
  bf16_t* ye; const float* gate; int e0;
  __device__ __forceinline__ void operator()(const pg8::f32x4 (&acc)[2][2][4][2], const pg8::Unit& u, int wr, int wc, int fr, int fq) const {
    const int e = e0 + (u.pm >> 4), s0 = (u.pm & 15) * 256 + wr * 64 + fr, col0 = u.pn * 256 + wc * 32 + 8 * fq;
#pragma unroll
    for (int ai = 0; ai < 2; ++ai)
#pragma unroll
      for (int m = 0; m < 4; ++m) { const int s = s0 + ai * 128 + m * 16, b = s >> 10, c = s & 1023, slot = (b * kE + e) * kCAP + c;
        const float g = gate[slot]; bf16_t* rowp = ye + (size_t)slot * kD + col0;
#pragma unroll
        for (int bj = 0; bj < 2; ++bj) { const pg8::f32x4 v0 = acc[ai][bj][m][0] * g, v1 = acc[ai][bj][m][1] * g;
          pg8::u32x4 w; w.x = pg8::cvt_pk_bf16(v0[0], v0[1]); w.y = pg8::cvt_pk_bf16(v0[2], v0[3]); w.z = pg8::cvt_pk_bf16(v1[0], v1[1]); w.w = pg8::cvt_pk_bf16(v1[2], v1[3]);
          *(pg8::u32x4*)(rowp + bj * 128) = w; } }
  }
};

__device__ void phase_mod(float* lds, const float* c, const float* cctx, const float* modw, const float* modb, float* mod, int bid, int nb) {
  float* sc = lds;
  float* red = lds + 5120;
  const int tid = tidx(), kk = tid >> 6, nl = tid & 63;
  bool loaded = false;
  for (int item = bid; item < 96; item += nb) {
    if (!loaded) {
      for (int i = tid; i < 5120; i += NTHR) { const int v = i >> 10, k = i & 1023; const float cv = v < 4 ? c[v * kD + k] : cctx[k]; sc[i] = siluf_(cv); }
      loaded = true;
    }
    __syncthreads();
    const int n = item * 64 + nl;
    float acc[5] = {0.f, 0.f, 0.f, 0.f, 0.f};
#pragma unroll 8
    for (int k = kk * 128; k < kk * 128 + 128; ++k) {
      const float w = modw[(size_t)k * 6144 + n];
#pragma unroll
      for (int v = 0; v < 5; ++v) acc[v] += sc[v * 1024 + k] * w;
    }
#pragma unroll
    for (int v = 0; v < 5; ++v) red[(kk * 5 + v) * 64 + nl] = acc[v];
    __syncthreads();
    if (tid < 320) {
      const int v = tid >> 6;
      float s = 0.f;
#pragma unroll
      for (int q = 0; q < 8; ++q) s += red[(q * 5 + v) * 64 + nl];
      mod[v * 6144 + n] = s + modb[n];
    }
    __syncthreads();
  }
}

__device__ void phase_filter(float* lds, const Params& p, float* circT, int bid, int nb) {
  float* feat = lds;
  float* h1 = lds + 32 * 33;
  float* h2 = h1 + 32 * 64;
  const float* w1 = p.in[I_HW1]; const float* b1 = p.in[I_HB1]; const float* w2 = p.in[I_HW2]; const float* b2 = p.in[I_HB2];
  const float* w3 = p.in[I_HW3]; const float* fr = p.in[I_HFREQ];
  const int tid = tidx();
  for (int item = bid; item < kT / 32; item += nb) {
    const int l0 = item * 32;
    __syncthreads();
    for (int i = tid; i < 32 * 33; i += NTHR) {
      const int pz = i / 33, f = i % 33, l = l0 + pz;
      float v;
      if (f == 0) v = (float)l / (float)(kT - 1);
      else {
        const int j = (f - 1) & 15;
        const float band = 1e-4f + (float)j * ((15.0f - 1e-4f) / 15.0f);
        const float ang = (6.283185307179586f / (float)kT) * (float)l;
        float sn, cs; sincos_cw(band * ang, sn, cs); v = f <= 16 ? cs : -sn;
      }
      feat[i] = v;
    }
    __syncthreads();
    for (int i = tid; i < 32 * 64; i += NTHR) {
      const int pz = i >> 6, o = i & 63;
      float s = b1[o];
#pragma unroll 3
      for (int f = 0; f < 33; ++f) s += feat[pz * 33 + f] * w1[f * 64 + o];
      h1[i] = sin_cw(fr[o] * s);
    }
    __syncthreads();
    for (int i = tid; i < 32 * 64; i += NTHR) {
      const int pz = i >> 6, o = i & 63;
      float s = b2[o];
#pragma unroll 4
      for (int f = 0; f < 64; ++f) s += h1[pz * 64 + f] * w2[f * 64 + o];
      h2[i] = sin_cw(fr[o] * s);
    }
    __syncthreads();
#pragma unroll 1
    for (int half = 0; half < 2; ++half) {
      const int n = tid + half * 512;
      const int c = tid;
      float wr[64];
#pragma unroll
      for (int o = 0; o < 64; ++o) wr[o] = w3[o * 1024 + n];
      const float dlo = -4.605170185988091f / 1.5f, dhi = -4.605170185988091f / 0.3f;
      const float delta = fabsf(dlo + (float)c * ((dhi - dlo) / 511.0f));
      float asum = 0.f;
#pragma unroll 1
      for (int q = 0; q < 32; ++q) {
        float a = 0.f;
#pragma unroll
        for (int o = 0; o < 64; ++o) a += h2[q * 64 + o] * wr[o];
        const int l = l0 + q;
        const float tt = (float)l / (float)(kT - 1);
        const float v = a * expf(-tt * delta);
        if (half == 0) circT[(size_t)c * 16384 + l] = v;
        else circT[(size_t)c * 16384 + 16384 - l - (l == 0 ? 8192 : 0)] = (l == 0 ? 0.f : v);
      }
      (void)asum;
    }
  }
}

DEV float ldcol(const float* p, size_t i) { return p[i]; }
DEV float ldcol(const bf16_t* p, size_t i) { return bf2f(p[i]); }
namespace rs {
typedef short bf16x8 __attribute__((ext_vector_type(8)));
typedef float f32x4 __attribute__((ext_vector_type(4)));
constexpr int LD = 72, LDR = 40;
template <int K>
DEV f32x4 tmma(f32x4 acc, const bf16_t* A, int lda, const bf16_t* B, int ldb, int lane) {
  const bf16_t* ap = A + (lane & 15) * lda + 8 * (lane >> 4);
  const bf16_t* bp = B + (lane & 15) * ldb + 8 * (lane >> 4);
#pragma unroll
  for (int k = 0; k < K; k += 32)
    acc = __builtin_amdgcn_mfma_f32_16x16x32_bf16(*reinterpret_cast<const bf16x8*>(ap + k), *reinterpret_cast<const bf16x8*>(bp + k), acc, 0, 0, 0);
  return acc;
}
DEV void st4(bf16_t* p, f32x4 v) { *reinterpret_cast<uint2*>(p) = make_uint2(pg8::cvt_pk_bf16(v[0], v[1]), pg8::cvt_pk_bf16(v[2], v[3])); }
DEV float ftanh(float x) { const float e = __expf(2.f * x); return 1.f - 2.f / (e + 1.f); }

template <int NC> struct Lay {
  static constexpr int ZTB = NC * LD * 2;
  static constexpr int W = 0, ZT0 = 18432, ZT1 = ZT0 + ZTB, AT = ZT1 + ZTB, BTt = AT + 9216, KTt = BTt + 9216, Vt = KTt + 9216,
                       RT = Vt + 9216, X = (NC == 64 ? RT + 9216 : RT), L = X + 18432, D = L + (NC == 64 ? 36864 : 32768);
  static constexpr int LWt = X, LA = X + 9216, BT = X, KT = X + 9216, UT = X, RHS = (NC == 64 ? X + 9216 : L + 18432);
  static constexpr int CS = L, AG = L + 16384, LAK = L, LOFF = L + 9216, LRB = L + 18432, LRK = L + 27648;
  static constexpr int LDG = D, TDG = D + 4352, WCV = TDG + 5120, SEG = WCV + 256, TF = SEG + 2048, END = TF + 4352;
};
static_assert(Lay<64>::END <= (int)LDS_BYTES && Lay<128>::END <= (int)LDS_BYTES, "scan LDS layout");

template <int NC, bool EMIT>
__device__ void scan_task(float* ldsf, const Params& p, const bf16_t* cols, int ldc, int Tlen, int cR, int cK, int cV, int cLW, int cLA, int muoff,
                          int b, int h, int dir, int step0, int nchunks, const float* Zinit  , float* Zout  , bf16_t* Y, float* BSo) {
  typedef Lay<NC> LY;
  char* lds = reinterpret_cast<char*>(ldsf);
  const int tid = tidx(), lane = tid & 63, w = tid >> 6;
  bf16_t* sWup = (bf16_t*)(lds + LY::W); bf16_t* sAup = sWup + 64 * LD;
  bf16_t* sAT = (bf16_t*)(lds + LY::AT); bf16_t* sBTt = (bf16_t*)(lds + LY::BTt); bf16_t* sKTt = (bf16_t*)(lds + LY::KTt); bf16_t* sVt = (bf16_t*)(lds + LY::Vt);
  bf16_t* sRT = (bf16_t*)(lds + LY::RT);
  bf16_t* sLWt = (bf16_t*)(lds + LY::LWt); bf16_t* sLA = (bf16_t*)(lds + LY::LA); bf16_t* sBT = (bf16_t*)(lds + LY::BT); bf16_t* sKT = (bf16_t*)(lds + LY::KT);
  bf16_t* sUT = (bf16_t*)(lds + LY::UT); bf16_t* sRHS = (bf16_t*)(lds + LY::RHS);
  float* sCS = (float*)(lds + LY::CS); float* sAG = (float*)(lds + LY::AG);
  bf16_t* sLak = (bf16_t*)(lds + LY::LAK); bf16_t* sLoff = (bf16_t*)(lds + LY::LOFF); bf16_t* sLrb = (bf16_t*)(lds + LY::LRB); bf16_t* sLrk = (bf16_t*)(lds + LY::LRK);
  float* sLdg = (float*)(lds + LY::LDG); bf16_t* sTdg = (bf16_t*)(lds + LY::TDG); float* sWC = (float*)(lds + LY::WCV); float* sSeg = (float*)(lds + LY::SEG); float* sTf = (float*)(lds + LY::TF);
  const float* mu = p.in[I_MU];
  const int hj = h * 64 + lane;
  const bf16_t* base = cols + (size_t)b * Tlen * ldc;
  constexpr int NT = NC / 16 * 4 / 8;
  f32x4 Zm[NT];

  __syncthreads();
  for (int i = tid; i < 4096; i += NTHR) { const int ii = i >> 6, j = i & 63;
    sWup[j * LD + ii] = f2bf(p.in[I_WUP][((size_t)dir * 64 + ii) * 512 + h * 64 + j]);
    sAup[j * LD + ii] = f2bf(p.in[I_AUP][((size_t)dir * 64 + ii) * 512 + h * 64 + j]); }
#pragma unroll
  for (int m = 0; m < NT; ++m) {
    const int id = w + 8 * m, tj = id & 3, tn = id >> 2, col = tn * 16 + (lane & 15), j0 = tj * 16 + 4 * (lane >> 4);
#pragma unroll
    for (int q = 0; q < 4; ++q) {
      float v = 0.f;
      if (NC == 128) v = (col < 64 && col == j0 + q) ? 1.f : 0.f;
      else if (Zinit) v = Zinit[col * 64 + j0 + q];
      Zm[m][q] = v;
    }
    st4((bf16_t*)(lds + LY::ZT0) + col * LD + j0, Zm[m]);
  }
  for (int i = tid; i < NC * LD / 2; i += NTHR) reinterpret_cast<unsigned*>(sUT)[i] = 0u;
  int zcur = 0;
  unsigned pf[5][5];
  unsigned long long tprev = 0; const bool tpon = (TP_LO == 100) && EMIT && blockIdx.x == 0 && threadIdx.x == 0;
#define RS_T(k) do { if (TP_LO == 100 && EMIT) { if (tpon) { const unsigned long long tn_ = __builtin_amdgcn_s_memrealtime(); ((unsigned long long*)(p.ws + OFF_NORM + 512))[k] += tn_ - tprev; tprev = tn_; } } } while (0)
#pragma unroll 1
  for (int ci = 0; ci < nchunks; ++ci) {
    const int s0 = step0 + ci * 64;
    bf16_t* sZT = (bf16_t*)(lds + (zcur ? LY::ZT1 : LY::ZT0));
    bf16_t* sZN = (bf16_t*)(lds + (zcur ? LY::ZT0 : LY::ZT1));
    __syncthreads();
    if (TP_LO == 100 && EMIT) { if (tpon) tprev = __builtin_amdgcn_s_memrealtime(); }
    const int stepb = s0 + w * 8 - 1;
#define RS_PREFETCH(a_lo, a_hi, stepb) do { _Pragma("unroll") for (int a = a_lo; a < a_hi; ++a) { if (a == 0 && !EMIT) continue; \
      const bf16_t* rp = base + (a == 0 ? cR + h * 64 : a == 1 ? cK + h * 64 : a == 2 ? cV + h * 64 : a == 3 ? cLW : cLA) + lane; \
      _Pragma("unroll") for (int i = 0; i < 5; ++i) { const int s0_ = stepb + 2 * i, s1_ = s0_ + 1, t0_ = dir ? (Tlen - 1 - s0_) : s0_, t1_ = dir ? (Tlen - 1 - s1_) : s1_; \
        const int c0_ = t0_ < 0 ? 0 : (t0_ >= Tlen ? Tlen - 1 : t0_), c1_ = t1_ < 0 ? 0 : (t1_ >= Tlen ? Tlen - 1 : t1_);     \
        const unsigned l_ = (unsigned)rp[(size_t)c0_ * ldc], h_ = (unsigned)rp[(size_t)c1_ * ldc]; \
        pf[a][i] = ((t0_ == c0_) ? l_ : 0u) | (((t1_ == c1_) ? h_ : 0u) << 16); } } } while (0)
#define RS_ROW(a, i) (((i) & 1) ? __uint_as_float(pf[a][(i) >> 1] & 0xffff0000u) : __uint_as_float(pf[a][(i) >> 1] << 16))
    if (ci == 0) RS_PREFETCH(3, 5, stepb);
    {
      const float m0w = mu[cLW + lane + muoff], m1w = mu[kRWC + cLW + lane + muoff], m0a = mu[cLA + lane + muoff], m1a = mu[kRWC + cLA + lane + muoff];
#pragma unroll
      for (int q = 0; q < 8; ++q) {
        const int tl = w * 8 + q;
        const float wc = RS_ROW(3, q + 1), wp = dir ? RS_ROW(3, q + 2) : RS_ROW(3, q), wn = dir ? RS_ROW(3, q) : RS_ROW(3, q + 2);
        const float ac = RS_ROW(4, q + 1), ap = dir ? RS_ROW(4, q + 2) : RS_ROW(4, q), an = dir ? RS_ROW(4, q) : RS_ROW(4, q + 2);
        const float zw = wc + m0w * (wp - wc) + m1w * (wn - wc);
        const float za = ac + m0a * (ap - ac) + m1a * (an - ac);
        sLWt[tl * LD + lane] = f2bf(ftanh(zw)); sLA[tl * LD + lane] = f2bf(za);
      }
    }
    RS_PREFETCH(0, 3, stepb);
    __syncthreads(); RS_T(2);
#pragma unroll 1
    for (int m = 0; m < 2; ++m) {
      const int id = w * 2 + m, tm = id >> 2, tn = id & 3;
      f32x4 aw = {0.f, 0.f, 0.f, 0.f}, aa = {0.f, 0.f, 0.f, 0.f};
      aw = tmma<64>(aw, sLWt + tm * 16 * LD, LD, sWup + tn * 16 * LD, LD, lane);
      aa = tmma<64>(aa, sLA + tm * 16 * LD, LD, sAup + tn * 16 * LD, LD, lane);
      const int j = tn * 16 + (lane & 15);
      const float w0 = p.in[I_W0][dir * 512 + h * 64 + j], a0 = p.in[I_A0][dir * 512 + h * 64 + j];
#pragma unroll
      for (int q = 0; q < 4; ++q) {
        const int t = tm * 16 + 4 * (lane >> 4) + q;
        const float x = -(w0 + aw[q]);
        const float sp = x > 20.f ? x : __logf(1.f + __expf(x));
        sCS[t * 64 + j] = __expf(-sp - 0.5f);
        sAG[t * 64 + j] = fsigmoid(a0 + aa[q]);
      }
    }
    __syncthreads(); RS_T(3);
    {
      const int j = tid & 63, seg = tid >> 6;
      float v[8]; float run = 0.f;
#pragma unroll
      for (int q = 0; q < 8; ++q) { run += sCS[(seg * 8 + q) * 64 + j]; v[q] = run; }
      sSeg[seg * 64 + j] = run;
      __syncthreads();
      float off = 0.f;
#pragma unroll
      for (int s = 0; s < 8; ++s) off += (s < seg) ? sSeg[s * 64 + j] : 0.f;
#pragma unroll
      for (int q = 0; q < 8; ++q) sCS[(seg * 8 + q) * 64 + j] = v[q] + off;
    }
    __syncthreads(); RS_T(4);
    {
      const float kkw = p.in[I_KK][hj], kaw = p.in[I_KA][hj], rkw = p.in[I_RK][hj];
      float m0[3], m1[3];
#pragma unroll
      for (int a = 0; a < 3; ++a) { const int col = (a == 0 ? cR : a == 1 ? cK : cV) + h * 64 + lane; m0[a] = mu[col + muoff]; m1[a] = mu[kRWC + col + muoff]; }
#pragma unroll
      for (int q = 0; q < 8; ++q) {
        const int tl = w * 8 + q, tok = dir ? (Tlen - 1 - (s0 + tl)) : (s0 + tl);
        float rkv[3];
#pragma unroll
        for (int a = 0; a < 3; ++a) { const float xc = RS_ROW(a, q + 1), xp = dir ? RS_ROW(a, q + 2) : RS_ROW(a, q), xn = dir ? RS_ROW(a, q) : RS_ROW(a, q + 2);
          rkv[a] = (a == 0 && !EMIT) ? 0.f : xc + m0[a] * (xp - xc) + m1[a] * (xn - xc); }
        const float ag = sAG[tl * 64 + lane], cs = sCS[tl * 64 + lane], csm = tl > 0 ? sCS[(tl - 1) * 64 + lane] : 0.f;
        const float kkv = rkv[1] * kkw;
        const float ss = wave_sum(kkv * kkv);
        const float kkn = kkv * rsqrtf(fmaxf(ss, 1e-24f));
        const float km = rkv[1] * (1.f + (ag - 1.f) * kaw);
        const float ew = __expf(cs), ewi = __expf(-cs);
        const bf16_t at = f2bf(-kkn * __expf(-csm)), bt = f2bf(kkn * ag * ew), kt = f2bf(km * ew), vt = f2bf(rkv[2]);
        sAT[tl * LD + lane] = at; sBT[tl * LD + lane] = bt; sKT[tl * LD + lane] = kt;
        sBTt[lane * LD + tl] = bt; sKTt[lane * LD + tl] = kt; sVt[lane * LD + tl] = vt;
        if (EMIT) {
          sRT[tl * LD + lane] = f2bf(rkv[0] * ewi);
          const float bsum = wave_sum(rkv[0] * km * rkw);
          if (lane == 0) BSo[((size_t)dir * kROWS + (size_t)b * Tlen + tok) * 8 + h] = bsum;
        }
        if (tl == 63) sWC[lane] = ewi;
        __builtin_amdgcn_sched_barrier(0);
      }
    }
    __syncthreads(); RS_T(5);
    if (w < 4) {
      f32x4 acc = {0.f, 0.f, 0.f, 0.f};
      acc = tmma<64>(acc, sBT + w * 16 * LD, LD, sAT + w * 16 * LD, LD, lane);
      const int c = lane & 15, kq = lane >> 4, r4 = 4 * kq;
      float* Pm = sLdg + w * 272; float* Tm = sTf + w * 272;
#pragma unroll
      for (int q = 0; q < 4; ++q) { const float lv = (r4 + q < c) ? acc[q] : 0.f;
        Pm[c * 17 + r4 + q] = lv; Tm[c * 17 + r4 + q] = lv + ((r4 + q) == c ? 1.f : 0.f); }
#pragma unroll 1
      for (int lev = 0; lev < 3; ++lev) {
        f32x4 a2 = {0.f, 0.f, 0.f, 0.f};
#pragma unroll
        for (int s4 = 0; s4 < 4; ++s4) a2 = __builtin_amdgcn_mfma_f32_16x16x4f32(Pm[c * 17 + 4 * s4 + kq], Pm[(4 * s4 + kq) * 17 + c], a2, 0, 0, 0);
#pragma unroll
        for (int q = 0; q < 4; ++q) Pm[(r4 + q) * 17 + c] = a2[q];
        f32x4 a3 = {0.f, 0.f, 0.f, 0.f};
#pragma unroll
        for (int s4 = 0; s4 < 4; ++s4) a3 = __builtin_amdgcn_mfma_f32_16x16x4f32(Tm[c * 17 + 4 * s4 + kq], Pm[(4 * s4 + kq) * 17 + c], a3, 0, 0, 0);
#pragma unroll
        for (int q = 0; q < 4; ++q) Tm[(r4 + q) * 17 + c] += a3[q];
      }
#pragma unroll
      for (int q = 0; q < 4; ++q) { sTdg[(w * 16 + r4 + q) * LDR + c] = f2bf(Tm[(r4 + q) * 17 + c]); sTdg[(w * 16 + r4 + q) * LDR + 16 + c] = (bf16_t)0; }
    }
    {
      constexpr int NP = EMIT ? 4 : 2;
#pragma unroll 1
      for (int pr = 0; pr < NP; ++pr) {
        const bf16_t* Lsrc = (pr < 2) ? sAT : sRT;
        const bf16_t* Rsrc = (pr & 1) ? sKT : sBT;
        bf16_t* dst = pr == 0 ? sLoff : pr == 1 ? sLak : pr == 2 ? sLrb : sLrk;
#pragma unroll 1
        for (int m = 0; m < 2; ++m) {
          const int id = w + 8 * m, tt = id >> 2, tu = id & 3;
          f32x4 acc = {0.f, 0.f, 0.f, 0.f};
          if (tu < tt || (pr != 0 && tu == tt)) acc = tmma<64>(acc, Rsrc + tu * 16 * LD, LD, Lsrc + tt * 16 * LD, LD, lane);
          const int t = tt * 16 + (lane & 15), u0 = tu * 16 + 4 * (lane >> 4);
#pragma unroll
          for (int q = 0; q < 4; ++q) { const bool keep = (pr < 2) ? (u0 + q < t) : (u0 + q <= t); acc[q] = keep ? acc[q] : 0.f; }
          st4(dst + t * LD + u0, acc);
        }
      }
    }
    __syncthreads(); RS_T(6);
    for (int i = tid; i < NC * 8; i += NTHR) reinterpret_cast<unsigned*>(sRHS)[(i >> 3) * (LDR / 2) + 8 + (i & 7)] = 0u;
    RS_T(7);
    if (ci + 1 < nchunks) { const int stepn = stepb + 64; RS_PREFETCH(3, 5, stepn); }
#pragma unroll 1
    for (int bk = 0; bk < 4; ++bk) {
      if (w < NC / 16) {
        const int tn = w;
        f32x4 acc = {0.f, 0.f, 0.f, 0.f};
        acc = tmma<64>(acc, sAT + bk * 16 * LD, LD, sZT + tn * 16 * LD, LD, lane);
        if (NC == 64 || tn >= 4) acc = tmma<64>(acc, sLak + bk * 16 * LD, LD, sVt + (NC == 64 ? tn : tn - 4) * 16 * LD, LD, lane);
        if (bk > 0) acc = tmma<64>(acc, sLoff + bk * 16 * LD, LD, sUT + tn * 16 * LD, LD, lane);
        st4(sRHS + (tn * 16 + (lane & 15)) * LDR + 4 * (lane >> 4), acc);
      }
      __syncthreads();
      if (w < NC / 16) {
        const int tn = w;
        f32x4 acc = {0.f, 0.f, 0.f, 0.f};
        acc = tmma<32>(acc, sTdg + bk * 16 * LDR, LDR, sRHS + tn * 16 * LDR, LDR, lane);
        st4(sUT + (tn * 16 + (lane & 15)) * LD + bk * 16 + 4 * (lane >> 4), acc);
      }
      __syncthreads();
    }
    RS_T(8);
    if (EMIT) {
#pragma unroll 1
      for (int m = 0; m < 2; ++m) {
        const int id = w + 8 * m, ti = id & 3, tt = id >> 2;
        f32x4 acc = {0.f, 0.f, 0.f, 0.f};
        acc = tmma<64>(acc, sZT + ti * 16 * LD, LD, sRT + tt * 16 * LD, LD, lane);
        acc = tmma<64>(acc, sUT + ti * 16 * LD, LD, sLrb + tt * 16 * LD, LD, lane);
        acc = tmma<64>(acc, sVt + ti * 16 * LD, LD, sLrk + tt * 16 * LD, LD, lane);
        const int tl = tt * 16 + (lane & 15), tok = dir ? (Tlen - 1 - (s0 + tl)) : (s0 + tl);
        st4(Y + (size_t)dir * kROWS * 512 + ((size_t)b * Tlen + tok) * 512 + h * 64 + ti * 16 + 4 * (lane >> 4), acc);
      }
    }
#pragma unroll
    for (int m = 0; m < NT; ++m) {
      const int id = w + 8 * m, tj = id & 3, tn = id >> 2;
      f32x4 acc = {0.f, 0.f, 0.f, 0.f};
      acc = tmma<64>(acc, sBTt + tj * 16 * LD, LD, sUT + tn * 16 * LD, LD, lane);
      if (NC == 64 || tn >= 4) acc = tmma<64>(acc, sKTt + tj * 16 * LD, LD, sVt + (NC == 64 ? tn : tn - 4) * 16 * LD, LD, lane);
      const int j0 = tj * 16 + 4 * (lane >> 4), col = tn * 16 + (lane & 15);
#pragma unroll
      for (int q = 0; q < 4; ++q) Zm[m][q] = sWC[j0 + q] * (Zm[m][q] + acc[q]);
      st4(sZN + col * LD + j0, Zm[m]);
    }
    zcur ^= 1;
    RS_T(9);
  }
#pragma unroll
  for (int m = 0; m < NT; ++m) {
    const int id = w + 8 * m, tj = id & 3, tn = id >> 2, j0 = tj * 16 + 4 * (lane >> 4), col = tn * 16 + (lane & 15);
    if (Zout) *reinterpret_cast<f32x4*>(Zout + (size_t)col * 64 + j0) = Zm[m];
  }
  __syncthreads();
}
}

__device__ void scan_passB(float* lds, int chain, const float* sinit, const float* PQ, float* S0) {
  float* sS = lds;
  float* sP = lds + 64 * 65;
  const int tid = tidx(), i = tid >> 3, jq = (tid & 7) * 8;
  __syncthreads();
  for (int e = tid; e < 4096; e += NTHR) sS[(e >> 6) * 65 + (e & 63)] = sinit[e];
  for (int sc = 0; sc < kNSC; ++sc) {
    const size_t task = (size_t)chain * kNSC + sc;
    __syncthreads();
    for (int e = tid; e < 2048; e += NTHR) reinterpret_cast<float4*>(sP)[e] = reinterpret_cast<const float4*>(PQ + task * 8192)[e];
    for (int e = tid; e < 4096; e += NTHR) S0[task * 4096 + e] = sS[(e >> 6) * 65 + (e & 63)];
    __syncthreads();
    float acc[8];
#pragma unroll
    for (int q = 0; q < 8; ++q) acc[q] = sP[(64 + i) * 64 + jq + q];
#pragma unroll 8
    for (int jp = 0; jp < 64; ++jp) {
      const float s = sS[i * 65 + jp];
      const float4 z0 = *reinterpret_cast<const float4*>(&sP[jp * 64 + jq]), z1 = *reinterpret_cast<const float4*>(&sP[jp * 64 + jq + 4]);
      acc[0] += s * z0.x; acc[1] += s * z0.y; acc[2] += s * z0.z; acc[3] += s * z0.w;
      acc[4] += s * z1.x; acc[5] += s * z1.y; acc[6] += s * z1.z; acc[7] += s * z1.w;
    }
    __syncthreads();
#pragma unroll
    for (int q = 0; q < 8; ++q) sS[i * 65 + jq + q] = acc[q];
  }
  __syncthreads();
}

typedef float2 cf;
DEV cf cmul(cf a, cf b) { return make_float2(a.x * b.x - a.y * b.y, a.x * b.y + a.y * b.x); }
DEV cf cadd(cf a, cf b) { return make_float2(a.x + b.x, a.y + b.y); }
DEV cf csub(cf a, cf b) { return make_float2(a.x - b.x, a.y - b.y); }
DEV int PADI(int i) { return i + (i >> 4); }
constexpr int FFT_N = 16384, FFT_PAD = FFT_N + FFT_N / 16;
DEV void dft4(cf& x0, cf& x1, cf& x2, cf& x3) {
  const cf a0 = cadd(x0, x2), a1 = csub(x0, x2), a2 = cadd(x1, x3), d = csub(x1, x3);
  const cf a3 = make_float2(d.y, -d.x);
  x0 = cadd(a0, a2); x1 = cadd(a1, a3); x2 = csub(a0, a2); x3 = csub(a1, a3);
}
DEV void dft16(cf (&v)[16]) {
#pragma unroll
  for (int a = 0; a < 4; ++a) dft4(v[a], v[a + 4], v[a + 8], v[a + 12]);
  const cf w1 = make_float2(0.9238795325112867f, -0.3826834323650898f), w2 = make_float2(0.7071067811865476f, -0.7071067811865476f);
  const cf w3 = make_float2(0.3826834323650898f, -0.9238795325112867f), w6 = make_float2(-0.7071067811865476f, -0.7071067811865476f);
  const cf w9 = make_float2(-0.9238795325112867f, 0.3826834323650898f);
  v[1 + 4] = cmul(v[1 + 4], w1); v[1 + 8] = cmul(v[1 + 8], w2); v[1 + 12] = cmul(v[1 + 12], w3);
  v[2 + 4] = cmul(v[2 + 4], w2); v[2 + 8] = make_float2(v[2 + 8].y, -v[2 + 8].x); v[2 + 12] = cmul(v[2 + 12], w6);
  v[3 + 4] = cmul(v[3 + 4], w3); v[3 + 8] = cmul(v[3 + 8], w6); v[3 + 12] = cmul(v[3 + 12], w9);
#pragma unroll
  for (int c = 0; c < 4; ++c) dft4(v[4 * c], v[4 * c + 1], v[4 * c + 2], v[4 * c + 3]);
}
template <int PASS>
DEV void fft_pass16(cf* buf, int tid) {
  constexpr int lg = 4 * PASS, Ns = 1 << lg;
  cf v0[16], v1[16];
  const cf* rd = buf + PADI(tid);
#pragma unroll
  for (int r = 0; r < 16; ++r) { v0[r] = rd[1088 * r]; v1[r] = rd[1088 * r + 544]; }
  __syncthreads();
#pragma unroll
  for (int h = 0; h < 2; ++h) {
    cf (&v)[16] = h ? v1 : v0;
    int tl = tid; asm volatile("" : "+v"(tl) :: "memory");
    const int j = tl + 512 * h, k = j & (Ns - 1);
    if (PASS > 0) {
      float sn, cs; sincos_cw(-6.283185307179586f * (float)k / (float)(Ns * 16), sn, cs);
      const cf w = make_float2(cs, sn); cf pw = w;
#pragma unroll
      for (int r = 1; r < 16; ++r) { v[r] = cmul(v[r], pw); if (r < 15) pw = cmul(pw, w); }
    }
    dft16(v);
    const int j0 = ((j >> lg) << (lg + 4)) + k;
    cf* wr = buf + PADI(j0);
    constexpr int step = PASS == 0 ? 1 : Ns + Ns / 16;
#pragma unroll
    for (int r = 0; r < 16; ++r) wr[step * r] = v[4 * (r & 3) + (r >> 2)];
  }
  __syncthreads();
}
__device__ void fft16384(cf* buf) {
  int tid = tidx(); asm volatile("" : "+v"(tid));
  fft_pass16<0>(buf, tid);
  fft_pass16<1>(buf, tid);
  fft_pass16<2>(buf, tid);
#pragma unroll 2
  for (int q = 0; q < 8; ++q) {
    const int j = tid + 512 * q;
    cf* pp = buf + PADI(j);
    cf x0 = pp[0], x1 = pp[4352], x2 = pp[8704], x3 = pp[13056];
    float sn, cs; sincos_cw(-6.283185307179586f * (float)j / 16384.0f, sn, cs);
    const cf w1 = make_float2(cs, sn), w2 = cmul(w1, w1), w3 = cmul(w2, w1);
    x1 = cmul(x1, w1); x2 = cmul(x2, w2); x3 = cmul(x3, w3);
    dft4(x0, x1, x2, x3);
    pp[0] = x0; pp[4352] = x1; pp[8704] = x2; pp[13056] = x3;
  }
  __syncthreads();
}
DEV float hy_conv3t(const Params& p, const bf16_t* hyt, int col, int b, int t) {
  const bf16_t* q = hyt + (size_t)col * kROWS + b * kT;
  const float* cw = p.in[I_HCW];
  const float cur = bf2f(q[t]), prv = t > 0 ? bf2f(q[t - 1]) : 0.f, nxt = t < kT - 1 ? bf2f(q[t + 1]) : 0.f;
  return cw[col] * prv + cw[kHYC + col] * cur + cw[2 * kHYC + col] * nxt + p.in[I_HCB][col];
}
__device__ void fftconv_channel(float* ldsf, const Params& p, int c, const float* circT, const bf16_t* hyt, bf16_t* hyot) {
  cf* buf = reinterpret_cast<cf*>(ldsf);
  float* red = ldsf + 2 * FFT_PAD;
  const int tid = tidx(), lane = tid & 63, wid = tid >> 6;
  const float* cc = circT + (size_t)c * FFT_N;
  const float hbias = p.in[I_HBIAS][c];
  unsigned H[32];
#pragma unroll
  for (int m = 0; m < 32; ++m) H[m] = 0u;
  float inrm = 0.f;
  __syncthreads();
#pragma unroll 1
  for (int ph = 0; ph < 5; ++ph) {
    const int pair = (ph - 1) >> 1, b0 = 2 * pair, b1 = b0 + 1;
    if (ph == 0) {
      float asum = 0.f;
#pragma unroll 4
      for (int m = 0; m < 32; ++m) { const float f = cc[tid + 512 * m]; asum += fabsf(f); buf[PADI(tid) + 544 * m] = make_float2(f, 0.f); }
      asum = wave_sum(asum);
      if (lane == 0) red[wid] = asum;
    } else if (ph & 1) {
#pragma unroll 1
      for (int m = 0; m < 16; ++m) {
        const int t = tid + 512 * m;
        const float z0 = hy_conv3t(p, hyt, 1024 + c, b0, t) * hy_conv3t(p, hyt, 512 + c, b0, t);
        const float z1 = hy_conv3t(p, hyt, 1024 + c, b1, t) * hy_conv3t(p, hyt, 512 + c, b1, t);
        buf[PADI(t)] = make_float2(z0, z1);
        buf[PADI(t + 8192)] = make_float2(0.f, 0.f);
      }
    }
    __syncthreads();
    if (ph == 0) { float nrm = 0.f;
#pragma unroll
      for (int w = 0; w < 8; ++w) nrm += red[w];
      inrm = 1.0f / nrm; }
    fft16384(buf);
    if (ph == 0) {
#pragma unroll
      for (int m = 0; m < 32; ++m) { const cf hv = buf[PADI(tid) + 544 * m]; const __half2 hh = __floats2half2_rn(hv.x * inrm, hv.y * inrm); H[m] = *reinterpret_cast<const unsigned*>(&hh); }
    } else if (ph & 1) {
#pragma unroll
      for (int m = 0; m < 32; ++m) { const int i = PADI(tid) + 544 * m; const unsigned hu = H[m]; const float2 hf = __half22float2(*reinterpret_cast<const __half2*>(&hu)); const cf w = cmul(buf[i], hf); buf[i] = make_float2(w.y, w.x); }
    } else {
      const float scale = 1.0f / (float)FFT_N;
#pragma unroll 1
      for (int m = 0; m < 16; ++m) {
        const int t = tid + 512 * m;
        const cf val = buf[PADI(t)];
        const float y0 = val.y * scale, y1 = val.x * scale;
        const float z0 = hy_conv3t(p, hyt, 1024 + c, b0, t) * hy_conv3t(p, hyt, 512 + c, b0, t);
        const float z1 = hy_conv3t(p, hyt, 1024 + c, b1, t) * hy_conv3t(p, hyt, 512 + c, b1, t);
        hyot[(size_t)c * kROWS + b0 * kT + t] = f2bf((y0 + hbias * z0) * hy_conv3t(p, hyt, c, b0, t));
        hyot[(size_t)c * kROWS + b1 * kT + t] = f2bf((y1 + hbias * z1) * hy_conv3t(p, hyt, c, b1, t));
      }
    }
    __syncthreads();
  }
}
__device__ void phase_hyo_transpose(float* ldsf, const bf16_t* hyot, bf16_t* hyo, int bid, int nb) {
  bf16_t* tl = reinterpret_cast<bf16_t*>(ldsf);
  const int tid = tidx();
  for (int item = bid; item < 8 * 512; item += nb) {
    const int c0 = (item & 7) * 64, t0 = (item >> 3) * 64;
    __syncthreads();
    { const int cl = tid >> 3, t8 = (tid & 7) * 8;
      const uint4 u = *reinterpret_cast<const uint4*>(hyot + (size_t)(c0 + cl) * kROWS + t0 + t8);
      *reinterpret_cast<uint4*>(tl + cl * 72 + t8) = u; }
    __syncthreads();
    { const int tl_ = tid >> 3, c8 = (tid & 7) * 8;
      unsigned w[4];
#pragma unroll
      for (int i = 0; i < 4; ++i) w[i] = (unsigned)tl[(c8 + 2 * i) * 72 + tl_] | ((unsigned)tl[(c8 + 2 * i + 1) * 72 + tl_] << 16);
      *reinterpret_cast<uint4*>(hyo + (size_t)(t0 + tl_) * 512 + c0 + c8) = make_uint4(w[0], w[1], w[2], w[3]); }
  }
}

__device__ void phase_rwout(float* lds, const Params& p, const bf16_t* rwc, const bf16_t* Y0, const bf16_t* Y1, const float* BS, bf16_t* rwo, int bid, int nb) {
  const int tid = tidx(), lane = tid & 63, wid = tid >> 6;
  bf16_t* sG = reinterpret_cast<bf16_t*>(lds);
  float* sLg = lds + 32768 + wid * 256;
  const float* mu = p.in[I_MU]; const float* gup = p.in[I_GUP]; const float* lng = p.in[I_LNG]; const float* lnb = p.in[I_LNB];
  __syncthreads();
  for (int e = tid; e < 128 * 512 / 4; e += NTHR) { const float4 v = ld4(gup + (size_t)e * 4);
    *reinterpret_cast<uint2*>(sG + (size_t)e * 4) = make_uint2(pg8::cvt_pk_bf16(v.x, v.y), pg8::cvt_pk_bf16(v.z, v.w)); }
  __syncthreads();
  const int c0 = lane * 8, h = lane >> 3;
  for (int rp = bid * 8 + wid; rp < kROWS / 2; rp += nb * 8) {
#pragma unroll
    for (int r = 0; r < 2; ++r) {
      const int row = 2 * rp + r, t = row & (kT - 1);
      const bf16_t* cur = rwc + (size_t)row * kRWC;
#pragma unroll
      for (int k = 0; k < 2; ++k) {
        const int col = 1664 + lane + 64 * k;
        const float cv = bf2f(cur[col]), pv = t > 0 ? bf2f(cur[col - kRWC]) : 0.f, nv = t < kT - 1 ? bf2f(cur[col + kRWC]) : 0.f;
        sLg[r * 128 + lane + 64 * k] = sigmoidf_(cv + mu[col] * (pv - cv) + mu[kRWC + col] * (nv - cv));
      }
    }
    __syncthreads();
    float g0[8], g1[8];
#pragma unroll
    for (int j = 0; j < 8; ++j) { g0[j] = 0.f; g1[j] = 0.f; }
#pragma unroll 4
    for (int i = 0; i < 128; ++i) {
      const uint4 u = *reinterpret_cast<const uint4*>(sG + i * 512 + c0);
      const float s0 = sLg[i], s1 = sLg[128 + i];
      const float w0 = bflo(u.x), w1 = bfhi(u.x), w2 = bflo(u.y), w3 = bfhi(u.y), w4 = bflo(u.z), w5 = bfhi(u.z), w6 = bflo(u.w), w7 = bfhi(u.w);
      g0[0] += s0 * w0; g0[1] += s0 * w1; g0[2] += s0 * w2; g0[3] += s0 * w3; g0[4] += s0 * w4; g0[5] += s0 * w5; g0[6] += s0 * w6; g0[7] += s0 * w7;
      g1[0] += s1 * w0; g1[1] += s1 * w1; g1[2] += s1 * w2; g1[3] += s1 * w3; g1[4] += s1 * w4; g1[5] += s1 * w5; g1[6] += s1 * w6; g1[7] += s1 * w7;
    }
#pragma unroll
    for (int r = 0; r < 2; ++r) {
      const int row = 2 * rp + r, t = row & (kT - 1);
      const bf16_t* cur = rwc + (size_t)row * kRWC;
      float y[8];
      {
        const uint4 u0 = *reinterpret_cast<const uint4*>(Y0 + (size_t)row * 512 + c0), u1 = *reinterpret_cast<const uint4*>(Y1 + (size_t)row * 512 + c0);
        y[0] = bflo(u0.x) + bflo(u1.x); y[1] = bfhi(u0.x) + bfhi(u1.x); y[2] = bflo(u0.y) + bflo(u1.y); y[3] = bfhi(u0.y) + bfhi(u1.y);
        y[4] = bflo(u0.z) + bflo(u1.z); y[5] = bfhi(u0.z) + bfhi(u1.z); y[6] = bflo(u0.w) + bflo(u1.w); y[7] = bfhi(u0.w) + bfhi(u1.w);
      }
      float sum = 0.f;
#pragma unroll
      for (int j = 0; j < 8; ++j) sum += y[j];
      sum += __shfl_xor(sum, 1); sum += __shfl_xor(sum, 2); sum += __shfl_xor(sum, 4);
      const float mean = sum * (1.0f / 64.0f);
      float var = 0.f;
#pragma unroll
      for (int j = 0; j < 8; ++j) { const float d = y[j] - mean; var += d * d; }
      var += __shfl_xor(var, 1); var += __shfl_xor(var, 2); var += __shfl_xor(var, 4);
      const float rs = rsqrtf(var * (1.0f / 64.0f) + 64e-5f);
      const float bsum = BS[(size_t)row * 8 + h] + BS[((size_t)kROWS + row) * 8 + h];
      const uint4 vc = *reinterpret_cast<const uint4*>(cur + 1024 + c0);
      const uint4 vp = t > 0 ? *reinterpret_cast<const uint4*>(cur - kRWC + 1024 + c0) : make_uint4(0u, 0u, 0u, 0u);
      const uint4 vn = t < kT - 1 ? *reinterpret_cast<const uint4*>(cur + kRWC + 1024 + c0) : make_uint4(0u, 0u, 0u, 0u);
      const unsigned cw[4] = {vc.x, vc.y, vc.z, vc.w}, pw[4] = {vp.x, vp.y, vp.z, vp.w}, nw[4] = {vn.x, vn.y, vn.z, vn.w};
      float o[8];
#pragma unroll
      for (int j = 0; j < 8; ++j) {
        const int col = 1024 + c0 + j;
        const float cv = (j & 1) ? bfhi(cw[j >> 1]) : bflo(cw[j >> 1]), pv = (j & 1) ? bfhi(pw[j >> 1]) : bflo(pw[j >> 1]), nv = (j & 1) ? bfhi(nw[j >> 1]) : bflo(nw[j >> 1]);
        const float vm = cv + mu[col] * (pv - cv) + mu[kRWC + col] * (nv - cv);
        const float yn = (y[j] - mean) * rs * lng[c0 + j] + lnb[c0 + j];
        o[j] = (yn + bsum * vm) * (r ? g1[j] : g0[j]);
      }
      *reinterpret_cast<uint4*>(rwo + (size_t)row * 512 + c0) = make_uint4(pg8::cvt_pk_bf16(o[0], o[1]), pg8::cvt_pk_bf16(o[2], o[3]), pg8::cvt_pk_bf16(o[4], o[5]), pg8::cvt_pk_bf16(o[6], o[7]));
    }
    __syncthreads();
  }
}

__device__ void phase_post(float* lds, const Params& p, float* mx, bf16_t* h2o, float* aff, const float* mod, int bid, int nb) {
  const int lane = tidx() & 63, wid = tidx() >> 6;
  __syncthreads();
  for (int e = tidx(); e < 1024 * 16 / 4; e += NTHR) reinterpret_cast<float4*>(lds)[e] = ld4(p.in[I_ROUTER] + (size_t)e * 4);
  __syncthreads();
  const float* x = p.in[I_X]; const float* n1post = p.in[I_N1POST]; const float* n2pre = p.in[I_N2PRE]; const float* rw = p.in[I_ROUTER];
  float4 nm[4], nx[4];
  { const int r0 = bid * 8 + wid;
#pragma unroll
    for (int i = 0; i < 4; ++i) { nm[i] = ld4(mx + (size_t)r0 * kD + i * 256 + lane * 4); nx[i] = ld4(x + (size_t)r0 * kD + i * 256 + lane * 4); } }
  for (int row = bid * 8 + wid; row < kROWS; row += nb * 8) {
    const int b = row / kT;
    float m[16], xv[16];
    float4 xc[4];
    float ss = 0.f;
#pragma unroll
    for (int i = 0; i < 4; ++i) { const float4 v = nm[i]; xc[i] = nx[i];
      m[i * 4] = v.x; m[i * 4 + 1] = v.y; m[i * 4 + 2] = v.z; m[i * 4 + 3] = v.w; ss += v.x * v.x + v.y * v.y + v.z * v.z + v.w * v.w; }
    { const int nr = row + nb * 8 < kROWS ? row + nb * 8 : row;
#pragma unroll
      for (int i = 0; i < 4; ++i) { nm[i] = ld4(mx + (size_t)nr * kD + i * 256 + lane * 4); nx[i] = ld4(x + (size_t)nr * kD + i * 256 + lane * 4); } }
    ss = wave_sum(ss);
    const float r1 = rsqrtf(ss * (1.0f / kD) + 1e-6f);
    float s2 = 0.f;
#pragma unroll
    for (int i = 0; i < 4; ++i) {
      const int k = i * 256 + lane * 4;
      const float4 xx = xc[i], gp = ld4(n1post + k), gt = ld4(mod + b * 6144 + 2048 + k);
      xv[i * 4] = xx.x + gt.x * m[i * 4] * r1 * gp.x; xv[i * 4 + 1] = xx.y + gt.y * m[i * 4 + 1] * r1 * gp.y;
      xv[i * 4 + 2] = xx.z + gt.z * m[i * 4 + 2] * r1 * gp.z; xv[i * 4 + 3] = xx.w + gt.w * m[i * 4 + 3] * r1 * gp.w;
      *reinterpret_cast<float4*>(mx + (size_t)row * kD + k) = make_float4(xv[i * 4], xv[i * 4 + 1], xv[i * 4 + 2], xv[i * 4 + 3]);
#pragma unroll
      for (int j = 0; j < 4; ++j) s2 += xv[i * 4 + j] * xv[i * 4 + j];
    }
    s2 = wave_sum(s2);
    const float r2 = rsqrtf(s2 * (1.0f / kD) + 1e-6f);
    float lgt[16];
#pragma unroll
    for (int e = 0; e < 16; ++e) lgt[e] = 0.f;
#pragma unroll
    for (int i = 0; i < 4; ++i) {
      const int k0 = i * 256 + lane * 4;
      const float4 gn = ld4(n2pre + k0), sc = ld4(mod + b * 6144 + 4096 + k0), sh = ld4(mod + b * 6144 + 3072 + k0);
      float hh[4];
      hh[0] = xv[i * 4] * r2 * gn.x * (1.f + sc.x) + sh.x; hh[1] = xv[i * 4 + 1] * r2 * gn.y * (1.f + sc.y) + sh.y;
      hh[2] = xv[i * 4 + 2] * r2 * gn.z * (1.f + sc.z) + sh.z; hh[3] = xv[i * 4 + 3] * r2 * gn.w * (1.f + sc.w) + sh.w;
      *reinterpret_cast<uint2*>(h2o + (size_t)row * kD + k0) = make_uint2(pg8::cvt_pk_bf16(hh[0], hh[1]), pg8::cvt_pk_bf16(hh[2], hh[3]));
#pragma unroll
      for (int j = 0; j < 4; ++j) {
        const int k = k0 + j; const float h2 = hh[j];
        const float4 w0 = *reinterpret_cast<const float4*>(lds + k * 16), w1 = *reinterpret_cast<const float4*>(lds + k * 16 + 4), w2 = *reinterpret_cast<const float4*>(lds + k * 16 + 8), w3 = *reinterpret_cast<const float4*>(lds + k * 16 + 12);
        lgt[0] += h2 * w0.x; lgt[1] += h2 * w0.y; lgt[2] += h2 * w0.z; lgt[3] += h2 * w0.w;
        lgt[4] += h2 * w1.x; lgt[5] += h2 * w1.y; lgt[6] += h2 * w1.z; lgt[7] += h2 * w1.w;
        lgt[8] += h2 * w2.x; lgt[9] += h2 * w2.y; lgt[10] += h2 * w2.z; lgt[11] += h2 * w2.w;
        lgt[12] += h2 * w3.x; lgt[13] += h2 * w3.y; lgt[14] += h2 * w3.z; lgt[15] += h2 * w3.w;
        __builtin_amdgcn_sched_barrier(0);
      }
    }
    float mxv = -1e30f;
#pragma unroll
    for (int e = 0; e < 16; ++e) { lgt[e] = wave_sum(lgt[e]); mxv = fmaxf(mxv, lgt[e]); }
    float den = 0.f;
#pragma unroll
    for (int e = 0; e < 16; ++e) { lgt[e] = expf(lgt[e] - mxv); den += lgt[e]; }
    const float inv = 1.0f / den;
    float mine = 0.f;
#pragma unroll
    for (int e = 0; e < 16; ++e) if (lane == e) mine = lgt[e] * inv;
    if (lane < 16) aff[(size_t)row * 16 + lane] = mine;
  }
}

__device__ void phase_topk(float* lds, const float* aff, int* idx, float* gate, int* sel, int bid, int nb) {
  unsigned* keys = reinterpret_cast<unsigned*>(lds);
  unsigned* hist = keys + kT;
  unsigned* misc = hist + 256;
  unsigned* wtot = misc + 4;
  const int tid = tidx(), lane = tid & 63, wid = tid >> 6;
  for (int item = bid; item < kB * kE; item += nb) {
    const int b = item / kE, e = item % kE;
    __syncthreads();
    for (int t = tid; t < kT; t += NTHR) keys[t] = __float_as_uint(aff[((size_t)b * kT + t) * 16 + e]);
    if (tid == 0) { misc[0] = 0u; misc[1] = (unsigned)kCAP; }
    __syncthreads();
#pragma unroll 1
    for (int pass = 0; pass < 4; ++pass) {
      const int shift = 24 - 8 * pass;
      if (tid < 256) hist[tid] = 0u;
      __syncthreads();
      const unsigned prefix = misc[0];
      for (int t = tid; t < kT; t += NTHR) { const unsigned k = keys[t];
        if (pass == 0 || (k >> (shift + 8)) == (prefix >> (shift + 8))) atomicAdd(&hist[(k >> shift) & 255u], 1u); }
      __syncthreads();
      if (tid == 0) {
        unsigned need = misc[1], above = 0u; int d = 255;
        for (; d > 0; --d) { const unsigned h = hist[d]; if (above + h >= need) break; above += h; }
        misc[0] = prefix | ((unsigned)d << shift); misc[1] = need - above;
      }
      __syncthreads();
    }
    const unsigned thr = misc[0], need = misc[1];
    unsigned cg = 0u, ce = 0u;
#pragma unroll
    for (int q = 0; q < 16; ++q) { const unsigned k = keys[tid * 16 + q]; cg += (k > thr); ce += (k == thr); }
    const float wg = wave_sum((float)cg), we = wave_sum((float)ce);
    if (lane == 0) { wtot[wid] = (unsigned)wg; wtot[8 + wid] = (unsigned)we; }
    __syncthreads();
    unsigned pg = cg, pe = ce;
#pragma unroll
    for (int o = 1; o < 64; o <<= 1) { const unsigned ug = __shfl_up(pg, o), ue = __shfl_up(pe, o); if (lane >= o) { pg += ug; pe += ue; } }
    unsigned og = pg - cg, oe = pe - ce;
    for (int w = 0; w < wid; ++w) { og += wtot[w]; oe += wtot[8 + w]; }
#pragma unroll 1
    for (int q = 0; q < 16; ++q) {
      const int t = tid * 16 + q; const unsigned k = keys[t];
      const bool isg = k > thr, ise = k == thr;
      const bool take = isg || (ise && oe < need);
      const unsigned pos = og + (oe < need ? oe : need);
      if (take) { idx[(e * kB + b) * kCAP + pos] = b * kT + t; gate[item * kCAP + pos] = __uint_as_float(k); }
      sel[((size_t)b * kT + t) * 16 + e] = take ? (int)pos : -1;
      og += isg; oe += ise;
    }
  }
}

__device__ void phase_final(const Params& p, const bf16_t* ye, const int* sel, float* out, const float* mod, int bid, int nb, int tsn) {
  float tscale = 1.f;
  if (TP_LO == 100) { const unsigned long long* ta = (const unsigned long long*)(p.ws + OFF_NORM + 512); float tot = 0.f; for (int k = 2; k <= 9; ++k) tot += (float)ta[k]; tscale = 1.f + sqrtf(1.0e-3f * (float)ta[TP_HI] / tot); }
  else if (TP_LO >= 0) { const unsigned long long* ts = (const unsigned long long*)(p.ws + OFF_NORM); const float tot = (float)(ts[tsn - 2] - ts[0]), part = (float)(ts[TP_HI] - ts[TP_LO]); tscale = 1.f + sqrtf(1.0e-3f * part / tot); }
  const int lane = tidx() & 63, wid = tidx() >> 6;
  const float* n2post = p.in[I_N2POST];
  int nmyc = lane < 16 ? sel[(size_t)(bid * 8 + wid) * 16 + lane] : -1;
  float4 no[4];
#pragma unroll
  for (int i = 0; i < 4; ++i) no[i] = ld4(out + (size_t)(bid * 8 + wid) * kD + i * 256 + lane * 4);
  for (int row = bid * 8 + wid; row < kROWS; row += nb * 8) {
    const int b = row / kT;
    float m[16];
#pragma unroll
    for (int i = 0; i < 16; ++i) m[i] = 0.f;
    const int myc = nmyc;
    float4 oc[4];
#pragma unroll
    for (int i = 0; i < 4; ++i) oc[i] = no[i];
    { const int nr = row + nb * 8 < kROWS ? row + nb * 8 : row;
      nmyc = lane < 16 ? sel[(size_t)nr * 16 + lane] : -1;
#pragma unroll
      for (int i = 0; i < 4; ++i) no[i] = ld4(out + (size_t)nr * kD + i * 256 + lane * 4); }
    unsigned long long msk = __ballot(myc >= 0) & 0xffffull;
#pragma unroll 1
    while (msk) {
      const int e1 = __builtin_ctzll(msk); msk &= msk - 1;
      const bool two = msk != 0ull;
      const int e2 = two ? __builtin_ctzll(msk) : e1; if (two) msk &= msk - 1;
      const int c1 = __shfl(myc, e1), c2 = __shfl(myc, e2);
      const bf16_t* s1 = ye + ((size_t)(b * kE + e1) * kCAP + c1) * kD;
      const bf16_t* s2 = ye + ((size_t)(b * kE + e2) * kCAP + c2) * kD;
      uint2 u1[4], u2[4];
#pragma unroll
      for (int i = 0; i < 4; ++i) { u1[i] = *reinterpret_cast<const uint2*>(s1 + i * 256 + lane * 4); u2[i] = *reinterpret_cast<const uint2*>(s2 + i * 256 + lane * 4); }
      const float f2 = two ? 1.f : 0.f;
#pragma unroll
      for (int i = 0; i < 4; ++i) {
        m[i * 4] += bflo(u1[i].x) + f2 * bflo(u2[i].x); m[i * 4 + 1] += bfhi(u1[i].x) + f2 * bfhi(u2[i].x);
        m[i * 4 + 2] += bflo(u1[i].y) + f2 * bflo(u2[i].y); m[i * 4 + 3] += bfhi(u1[i].y) + f2 * bfhi(u2[i].y);
      }
    }
    float ss = 0.f;
#pragma unroll
    for (int i = 0; i < 16; ++i) ss += m[i] * m[i];
    ss = wave_sum(ss);
    const float r = rsqrtf(ss * (1.0f / kD) + 1e-6f);
#pragma unroll
    for (int i = 0; i < 4; ++i) {
      const int k = i * 256 + lane * 4;
      float4 o = oc[i];
      const float4 gp = ld4(n2post + k), gt = ld4(mod + b * 6144 + 5120 + k);
      o.x += gt.x * m[i * 4] * r * gp.x; o.y += gt.y * m[i * 4 + 1] * r * gp.y; o.z += gt.z * m[i * 4 + 2] * r * gp.z; o.w += gt.w * m[i * 4 + 3] * r * gp.w;
      if (TP_LO >= 0) { o.x *= tscale; o.y *= tscale; o.z *= tscale; o.w *= tscale; }
      *reinterpret_cast<float4*>(out + (size_t)row * kD + k) = o;
    }
  }
}


DEV void grid_barrier(unsigned* cnt, unsigned target) {
  asm volatile("s_waitcnt vmcnt(0) lgkmcnt(0)" ::: "memory");
  __syncthreads();
  if (tidx() == 0) {
    __builtin_amdgcn_fence(__ATOMIC_RELEASE, "agent");
    asm volatile("s_waitcnt vmcnt(0)" ::: "memory");
    __hip_atomic_fetch_add(cnt, 1u, __ATOMIC_RELAXED, __HIP_MEMORY_SCOPE_AGENT);
    while (__hip_atomic_load(cnt, __ATOMIC_RELAXED, __HIP_MEMORY_SCOPE_AGENT) < target) __builtin_amdgcn_s_sleep(2);
    __builtin_amdgcn_fence(__ATOMIC_ACQUIRE, "agent");
    asm volatile("s_waitcnt vmcnt(0)" ::: "memory");
  }
  __syncthreads();
}

template <class Epi, class Sched, bool G>
DEV void run_gemm(float* lds, int K, const Sched& S, const Epi& E) {
  __syncthreads();
  pg8::gemm_phase<Epi, Sched, G>((PG8_LAS unsigned char*)lds, K, S, E);
  __syncthreads();
}

#if defined(__HIP_DEVICE_COMPILE__)
typedef __attribute__((address_space(4))) const Params* kargs_ptr;
DEV kargs_ptr kargs() { kargs_ptr k = (kargs_ptr)__builtin_amdgcn_kernarg_segment_ptr(); asm volatile("" : "+s"(k)); return k; }
#else
typedef const Params* kargs_ptr;
__device__ inline kargs_ptr kargs() { return nullptr; }
#endif
__global__ void __launch_bounds__(NTHR, 2) fwd_megakernel(Params p_by_value_unused) {
#define p (*kargs())
  float* const lds = lds_dyn_;
  if ((threadIdx.x & 63) == 0) reinterpret_cast<int*>(reinterpret_cast<char*>(lds_dyn_) + TIDTAB_OFF)[hw_wave_slot()] = (int)(threadIdx.x >> 6);
  __syncthreads();
  cg::grid_group grid = cg::this_grid();
  const int bid = blockIdx.x, nb = gridDim.x;
  int tsn = 0;
  unsigned gb_n = 0;
#define GBAR() do { ++gb_n; grid_barrier((unsigned*)(p.ws + OFF_CNT), gb_n * (unsigned)nb); } while (0)
#define STAMP() do { if (TP_LO >= 0) { if (bid == 0 && tidx() == 0) ((unsigned long long*)(p.ws + OFF_NORM))[tsn] = __builtin_amdgcn_s_memrealtime(); ++tsn; } } while (0)
  STAMP();
  if (TP_LO == 100 && bid == 0 && tidx() < 16) ((unsigned long long*)(p.ws + OFF_NORM + 512))[tidx()] = 0ull;
  char* const ws = p.ws;
  constexpr size_t MB = 1048576;
#define b_mod   ((float*)(ws + OFF_MOD))
#define b_rstdc ((float*)(ws + OFF_RSTDC))
#define b_sctx  ((float*)(ws + OFF_SCTX))
#define b_BS    ((float*)(ws + OFF_BS))
#define b_aff   ((float*)(ws + OFF_AFF))
#define b_idx   ((int*)(ws + OFF_IDX))
#define b_gate  ((float*)(ws + OFF_GATE))
#define b_HC    ((bf16_t*)(ws + OFF_A1 + 244 * MB))
#define b_CC    ((bf16_t*)(ws + OFF_A1 + 240 * MB))
#define b_kfu   ((float*)(ws + OFF_KFU))
#define b_sel   ((int*)(ws + OFF_SEL))
#define b_winT  ((const char*)(ws + OFF_WINT))
#define b_hpT   ((const char*)(ws + OFF_HPT))
#define b_rpT   ((const char*)(ws + OFF_RPT))
#define b_woT   ((const char*)(ws + OFF_WOT))
#define b_w13T  ((const char*)(ws + OFF_W13T))
#define b_w2T   ((const char*)(ws + OFF_W2T))
#define b_hb    ((bf16_t*)(ws + OFF_A0))
#define b_A1    (ws + OFF_A1)
#define b_HYT   ((bf16_t*)(b_A1))
#define b_RWC   ((bf16_t*)(b_A1 + 96 * MB))
#define b_HYOT  ((bf16_t*)(b_A1 + 208 * MB))
#define b_HYO   ((bf16_t*)(b_A1))
#define b_RWO   ((bf16_t*)(b_A1 + 32 * MB))
#define b_YH    ((bf16_t*)(b_A1 + 96 * MB))
#define b_YR    ((bf16_t*)(b_A1 + 160 * MB))
#define b_PRE   ((bf16_t*)(b_A1))
#define b_HID0  ((bf16_t*)(b_A1))
#define b_YE    ((bf16_t*)(b_A1 + 128 * MB))
#define b_Y0    ((bf16_t*)(p.out + (size_t)kROWS * 512))
#define b_Y1    (b_Y0 + (size_t)kROWS * 512)
#define b_PQ    (p.out)
#define b_S0    ((float*)(ws + OFF_KFU))

  phase_mod(lds, p.in[I_C], p.in[I_CCTX], p.in[I_MODW], p.in[I_MODB], b_mod, bid, nb);
  phase_filter(lds, p, b_kfu, bid, nb);
  phase_wprep(lds, p, ws, bid, nb);
  grid.sync(); STAMP();
  phase_hb(p, b_mod, b_hb, b_HC, bid, nb);
  GBAR(); STAMP();
  {
    SchedPlain S0; S0.o.init(4, 5, nb, bid); S0.A = (const char*)b_HC; S0.B = b_winT + (size_t)2048 * kD * 2; S0.tstep = (size_t)256 * kD * 2;
    EpiBf16Split E0{b_CC, kCC, 5, b_CC, kCC};
    run_gemm<EpiBf16Split, SchedPlain, false>(lds, kD, S0, E0);
    SchedPlain S; S.o.init(kROWS / 256, 7, nb, bid); S.A = (const char*)b_hb; S.B = b_winT + (size_t)1536 * kD * 2; S.tstep = (size_t)256 * kD * 2;
    EpiBf16Split E{b_RWC, kRWC, 7, b_RWC, kRWC};
    run_gemm<EpiBf16Split, SchedPlain, false>(lds, kD, S, E);
    SchedPlain S2; S2.o.init(6, kROWS / 256, nb, bid); S2.A = b_winT; S2.B = (const char*)b_hb; S2.tstep = (size_t)256 * kD * 2;
    EpiBf16Split E2{b_HYT, kROWS, kROWS / 256, b_HYT, kROWS};
    run_gemm<EpiBf16Split, SchedPlain, false>(lds, kD, S2, E2);
  }
  GBAR(); STAMP();
  if (bid < 64) {
    const int dir = bid >> 5, b = (bid >> 3) & 3, h = bid & 7;
    rs::scan_task<64, false>(lds, p, b_CC, kCC, kCTX, 0, 0, 512, 1024, 1088, 512, b, h, dir, 0, 4, nullptr, b_sctx + (size_t)bid * 4096, nullptr, nullptr);
  }
  for (int c = bid; c < 512; c += nb) fftconv_channel(lds, p, c, b_kfu, b_HYT, b_HYOT);
  for (int task = bid; task < 64 * kNSC; task += nb) {
    const int chain = task / kNSC, sc = task % kNSC, dir = chain >> 5, b = (chain >> 3) & 3, h = chain & 7;
    rs::scan_task<128, false>(lds, p, b_RWC, kRWC, kT, 0, 512, 1024, 1536, 1600, 0, b, h, dir, sc * kSCC * 64, kSCC, nullptr, b_PQ + (size_t)task * 8192, nullptr, nullptr);
  }
  GBAR(); STAMP();
  if (bid < 64) scan_passB(lds, bid, b_sctx + (size_t)bid * 4096, b_PQ, b_S0);
  phase_hyo_transpose(lds, b_HYOT, b_HYO, bid, nb);
  GBAR(); STAMP();
  for (int task = bid; task < 64 * kNSC; task += nb) {
    const int chain = task / kNSC, sc = task % kNSC, dir = chain >> 5, b = (chain >> 3) & 3, h = chain & 7;
    rs::scan_task<64, true>(lds, p, b_RWC, kRWC, kT, 0, 512, 1024, 1536, 1600, 0, b, h, dir, sc * kSCC * 64, kSCC, b_S0 + (size_t)task * 4096, nullptr, b_Y0, b_BS);
  }
  GBAR(); STAMP();
  phase_rwout(lds, p, b_RWC, b_Y0, b_Y1, b_BS, b_RWO, bid, nb);
  GBAR(); STAMP();
  {
    SchedPlain S; S.o.init(kROWS / 256, 4, nb, bid); S.A = (const char*)b_HYO; S.B = b_hpT; S.tstep = (size_t)256 * 512 * 2;
    EpiBf16Split E{b_YH, kD, 4, b_YH, kD};
    run_gemm<EpiBf16Split, SchedPlain, false>(lds, 512, S, E);
    SchedPlain S2; S2.o.init(kROWS / 256, 4, nb, bid); S2.A = (const char*)b_RWO; S2.B = b_rpT; S2.tstep = (size_t)256 * 512 * 2;
    EpiBf16Split E2{b_YR, kD, 4, b_YR, kD};
    run_gemm<EpiBf16Split, SchedPlain, false>(lds, 512, S2, E2);
  }
  GBAR(); STAMP();
  {
    SchedPlain S; S.o.init(kROWS / 256, 8, nb, bid); S.A = (const char*)b_hb; S.B = b_winT + (size_t)3328 * kD * 2; S.tstep = (size_t)256 * kD * 2;
    EpiGatesMerge E{b_YH, b_YR, b_PRE};
    run_gemm<EpiGatesMerge, SchedPlain, false>(lds, kD, S, E);
  }
  GBAR(); STAMP();
  {
    SchedPlain S; S.o.init(kROWS / 256, 4, nb, bid); S.A = (const char*)b_PRE; S.B = b_woT; S.tstep = (size_t)256 * kD * 2;
    EpiF32Store E{p.out, kD};
    run_gemm<EpiF32Store, SchedPlain, false>(lds, kD, S, E);
  }
  GBAR(); STAMP();
  phase_post(lds, p, p.out, b_hb, b_aff, b_mod, bid, nb);
  GBAR(); STAMP();
  phase_topk(lds, b_aff, b_idx, b_gate, b_sel, bid, nb);
  GBAR(); STAMP();
  for (int g = 0; g <= 4; ++g) {
    if (g < 4) {
      SchedExp1 S; S.o.init(64, 16, nb, bid); S.H2 = (const char*)b_hb; S.W13T = b_w13T; S.idx = b_idx + g * 4 * 4096; S.e0 = g * 4;
      EpiSwiGLU E{b_HID0 + (size_t)(g & 1) * 16384 * kF};
      run_gemm<EpiSwiGLU, SchedExp1, true>(lds, kD, S, E);
    }
    if (g > 0) {
      SchedExp2 S; S.o.init(64, 4, nb, bid); S.HID = (const char*)(b_HID0 + (size_t)((g - 1) & 1) * 16384 * kF); S.W2T = b_w2T; S.e0 = (g - 1) * 4;
      EpiYE E{b_YE, b_gate, (g - 1) * 4};
      run_gemm<EpiYE, SchedExp2, false>(lds, kF, S, E);
    }
    GBAR(); STAMP();
  }
  phase_final(p, b_YE, b_sel, p.out, b_mod, bid, nb, tsn);
}

#undef b_mod
#undef b_rstdc
#undef b_sctx
#undef b_BS
#undef b_aff
#undef b_idx
#undef b_gate
#undef b_CC
#undef b_HC
#undef b_kfu
#undef b_sel
#undef b_winT
#undef b_hpT
#undef b_rpT
#undef b_woT
#undef b_w13T
#undef b_w2T
#undef b_hb
#undef b_A1
#undef b_HYT
#undef b_RWC
#undef b_HYOT
#undef b_HYO
#undef b_RWO
#undef b_YH
#undef b_YR
#undef b_PRE
#undef b_HID0
#undef b_YE
#undef b_Y0
#undef b_Y1
#undef p
#undef b_PQ
#undef b_S0
extern "C" void kernel_launch(void* const* d_in, const int* in_sizes, int n_in, void* d_out, int out_size, void* d_ws, size_t ws_size,
                              hipStream_t stream) {
  static int grid_blocks = 0;
  if (!grid_blocks) {
    int dev = 0, cus = 0, per_cu = 0;
    (void)hipGetDevice(&dev);
    (void)hipDeviceGetAttribute(&cus, hipDeviceAttributeMultiprocessorCount, dev);
    (void)hipFuncSetAttribute((const void*)fwd_megakernel, hipFuncAttributeMaxDynamicSharedMemorySize, (int)LDS_BYTES);
    (void)hipOccupancyMaxActiveBlocksPerMultiprocessor(&per_cu, fwd_megakernel, NTHR, LDS_BYTES);
    if (per_cu < 1) per_cu = 1;
    if (per_cu > 1) per_cu = 1;
    grid_blocks = cus * per_cu;
    if (ws_size < WS_TOTAL) fprintf(stderr, "kernel_launch: workspace too small: %zu < %zu\n", ws_size, (size_t)WS_TOTAL);
  }
  if (ws_size < WS_TOTAL) return;
  Params p{};
  for (int i = 0; i < 38; ++i) p.in[i] = (const float*)d_in[i];
  p.out = (float*)d_out;
  p.ws = (char*)d_ws;
    (void)hipMemsetAsync((char*)d_ws + OFF_CNT, 0, 256, stream);
  void* args[] = {&p};
  hipError_t e = hipLaunchCooperativeKernel((void*)fwd_megakernel, dim3(grid_blocks), dim3(NTHR), args, LDS_BYTES, stream);
  if (e != hipSuccess) fprintf(stderr, "cooperative launch failed: %s (grid %d)\n", hipGetErrorString(e), grid_blocks);
}
```

```cpp
#include <hip/hip_runtime.h>
#include <hip/hip_cooperative_groups.h>
#include <hip/hip_fp16.h>
#include <cstdio>
#include <cstdint>
namespace cg = cooperative_groups;

#define DEV __device__ __forceinline__
typedef float f32x16 __attribute__((ext_vector_type(16)));

constexpr int kD = 1024, kB = 4, kT = 8192, kCTX = 256, kROWS = kB * kT;
constexpr int kHYW = 512, kHYC = 1536, kRWW = 512, kRWC = 1792, kINC = 5376;
constexpr int kH = 8, kE = 16, kF = 2048, kCAP = 1024;
constexpr int kSCC = 16, kNSC = kT / (64 * kSCC);
constexpr int kCC = 1280;
constexpr int NTHR = 512;
constexpr size_t LDS_BYTES = 160 * 1024;

constexpr size_t OFF_MOD   = 0;
constexpr size_t OFF_RSTDC = OFF_MOD + 131072;
constexpr size_t OFF_NORM  = OFF_RSTDC + 4096;
constexpr size_t OFF_CNT   = OFF_NORM + 2048;
constexpr size_t OFF_SCTX  = OFF_CNT + 256;
constexpr size_t OFF_BS    = OFF_SCTX + 1048576;
constexpr size_t OFF_AFF   = OFF_BS + 2097152;
constexpr size_t OFF_IDX   = OFF_AFF + 2097152;
constexpr size_t OFF_GATE  = OFF_IDX + 262144;
constexpr size_t OFF_KFU   = OFF_GATE + 262144;
constexpr size_t OFF_SEL   = OFF_KFU + 33554432;
constexpr size_t OFF_WINT  = OFF_SEL + 2097152;
constexpr size_t OFF_HPT   = OFF_WINT + 11010048;
constexpr size_t OFF_RPT   = OFF_HPT + 1048576;
constexpr size_t OFF_WOT   = OFF_RPT + 1048576;
constexpr size_t OFF_W13T  = OFF_WOT + 2097152;
constexpr size_t OFF_W2T   = OFF_W13T + 134217728;
constexpr size_t OFF_A0    = OFF_W2T + 67108864;
constexpr size_t OFF_A1    = OFF_A0 + 67108864;
constexpr size_t A1_BYTES  = 268435456;
constexpr size_t WS_TOTAL  = OFF_A1 + A1_BYTES;
static_assert(WS_TOTAL <= 597000000, "workspace budget");

struct Params {
  const float* in[38];
  float* out;
  char* ws;
};
constexpr int TP_LO = -1, TP_HI = -1;


enum { I_X = 0, I_C, I_CTX, I_CCTX, I_MODW, I_MODB, I_N1PRE, I_N1POST, I_N2PRE, I_N2POST, I_WIN,
       I_HCW, I_HCB, I_HW1, I_HB1, I_HW2, I_HB2, I_HW3, I_HFREQ, I_HBIAS, I_HPROJ,
       I_MU, I_W0, I_WUP, I_A0, I_AUP, I_GUP, I_KK, I_KA, I_RK, I_LNG, I_LNB, I_RWPROJ, I_WOUT, I_ROUTER,
       I_EW1, I_EW3, I_EW2 };

DEV int tidx() { int t = threadIdx.x; asm volatile("" : "+v"(t)); return t; }
DEV float wave_sum(float v) {
  int x;
  x = __builtin_amdgcn_update_dpp(0, __float_as_int(v), 0xB1, 0xF, 0xF, false); v += __int_as_float(x);
  x = __builtin_amdgcn_update_dpp(0, __float_as_int(v), 0x4E, 0xF, 0xF, false); v += __int_as_float(x);
  x = __builtin_amdgcn_update_dpp(0, __float_as_int(v), 0x141, 0xF, 0xF, false); v += __int_as_float(x);
  x = __builtin_amdgcn_update_dpp(0, __float_as_int(v), 0x140, 0xF, 0xF, false); v += __int_as_float(x);
  const float r0 = __int_as_float(__builtin_amdgcn_readlane(__float_as_int(v), 0)), r1 = __int_as_float(__builtin_amdgcn_readlane(__float_as_int(v), 16));
  const float r2 = __int_as_float(__builtin_amdgcn_readlane(__float_as_int(v), 32)), r3 = __int_as_float(__builtin_amdgcn_readlane(__float_as_int(v), 48));
  return (r0 + r1) + (r2 + r3);
}
DEV float sigmoidf_(float x) { return 1.0f / (1.0f + expf(-x)); }
DEV float siluf_(float x) { return x / (1.0f + expf(-x)); }
DEV float softplusf_(float x) { return x > 20.f ? x : log1pf(expf(x)); }
DEV void sincos_cw(float x, float& sn, float& cs) {
  const float kf = rintf(x * 0.6366197723675814f);
  const int k = (int)kf;
  float r = fmaf(kf, -1.5703125f, x);
  r = fmaf(kf, -4.837512969970703125e-4f, r);
  r = fmaf(kf, -7.54978995489188216e-8f, r);
  const float r2 = r * r;
  const float sp = r + r * r2 * (-1.6666654611e-1f + r2 * (8.3321608736e-3f + r2 * (-1.9515295891e-4f)));
  const float cp = 1.0f - 0.5f * r2 + r2 * r2 * (4.166664568298827e-2f + r2 * (-1.388731625493765e-3f + r2 * 2.443315711809948e-5f));
  const float s0 = (k & 1) ? cp : sp, c0 = (k & 1) ? sp : cp;
  sn = (k & 2) ? -s0 : s0;
  cs = ((k + 1) & 2) ? -c0 : c0;
}
DEV float sin_cw(float x) { float a, b; sincos_cw(x, a, b); return a; }
DEV float4 ld4(const float* p) { return *reinterpret_cast<const float4*>(p); }

namespace pg8 {
#define PG8_LAS __attribute__((address_space(3)))
typedef unsigned short bf16_t;
typedef short bf16x8 __attribute__((ext_vector_type(8)));
typedef float f32x4 __attribute__((ext_vector_type(4)));
typedef unsigned u32x4 __attribute__((ext_vector_type(4)));
typedef unsigned u32x2 __attribute__((ext_vector_type(2)));
constexpr int BM = 256, BK = 64, HALF = 128, HTB = HALF * BK * 2, STAGE_BYTES = 8 * HTB, NXCD = 8, WGM = 8;
__host__ __device__ __forceinline__ int lds_byte(int r, int c) { const int st = (r >> 4) * 2 + (c >> 5), rr = r & 15, cc = c & 31, ob = rr * 64 + cc * 2; return st * 1024 + (ob ^ (((ob >> 9) & 1) << 5)); }
__host__ __device__ __forceinline__ void stage_rc(int b, int& R, int& C) { const int st = b / 1024, sb = b % 1024, swz = sb ^ (((sb >> 9) & 1) << 5); R = (st >> 1) * 16 + swz / 64; C = (st & 1) * 32 + (swz % 64) / 2; }
__host__ __device__ __forceinline__ int perm32(int rho) { const int n = rho >> 4, i = rho & 15; return 8 * (i >> 2) + 4 * n + (i & 3); }
typedef __bf16 bf16v2 __attribute__((ext_vector_type(2)));
typedef float f32v2 __attribute__((ext_vector_type(2)));
__device__ __forceinline__ unsigned cvt_pk_bf16(float lo, float hi) { const f32v2 v = {lo, hi}; const bf16v2 r = __builtin_convertvector(v, bf16v2); return __builtin_bit_cast(unsigned, r); }

struct Unit { int pm, pn; const char* a; const char* b; };

struct TileOrder {
  int nM, nN, nwg, G, c;
  __device__ void init(int nM_, int nN_, int G_, int c_) { nM = nM_; nN = nN_; nwg = nM * nN; G = G_; c = c_; }
  __device__ bool tile(int i, int& pm, int& pn) const {
    const long L = (long)i * G + c; if (L >= nwg) return false;
    int wgid = (int)L; { const int q = nwg / NXCD, r = nwg % NXCD, xcd = wgid % NXCD, off = wgid / NXCD; wgid = (xcd < r ? xcd * (q + 1) : r * (q + 1) + (xcd - r) * q) + off; }
    const int nig = WGM * nN, gid = wgid / nig, fm = gid * WGM, gsz = (nM - fm) < WGM ? (nM - fm) : WGM;
    pm = fm + ((wgid % nig) % gsz); pn = (wgid % nig) / gsz; return true;
  }
};

template <class Epi, class Sched, bool GATHER>
__device__ __forceinline__ void gemm_phase(PG8_LAS unsigned char* lds, const int K, const Sched& S, const Epi& E) {
  int tid_ = tidx(); asm volatile("" : "+v"(tid_));
  const int tid = tid_, wid = __builtin_amdgcn_readfirstlane(tid >> 6), lane = tid & 63, wr = wid >> 2, wc = wid & 3, fr = lane & 15, fq = lane >> 4;
  const int nt = K / BK;
  unsigned voffA[2], voffB[2];
#pragma unroll
  for (int i = 0; i < 2; ++i) { int R, C; stage_rc(tid * 16 + i * 8192, R, C); const int Rb = Epi::PERM ? ((R & ~31) + perm32(R & 31)) : R;
    voffA[i] = (unsigned)(R * K + C) * 2u; voffB[i] = (unsigned)(Rb * K + C) * 2u; }
  const size_t kstep = (size_t)(BK * 2);
  const size_t hstep = (size_t)HALF * K * 2;
  const unsigned ldsw = (unsigned)wid * 1024u;
  const int aoff = lds_byte(wr * 64 + fr, fq * 8), boff = lds_byte(wc * 32 + fr, fq * 8);
#define PG8_SA(b, h) (((b) * 2 + (h)) * HTB)
#define PG8_SB(b, h) ((4 + (b) * 2 + (h)) * HTB)
#define PG8_STAGE(bufoff, gbase, voff) do { _Pragma("unroll") for (int _i = 0; _i < 2; ++_i) \
    __builtin_amdgcn_global_load_lds((const unsigned*)((const char*)(gbase) + (voff)[_i]), (PG8_LAS unsigned*)(lds + (bufoff) + ldsw + _i * 8192), 16, 0, 0); } while (0)
#define PG8_STAGE_A(bufoff, gbase, h) do { if constexpr (GATHER) { PG8_STAGE(bufoff, gbase, vAc[h]); } else { PG8_STAGE(bufoff, (gbase) + (h) * hstep, voffA); } } while (0)
#define PG8_GATHER_OFFS(dst, u) do { _Pragma("unroll") for (int _h = 0; _h < 2; ++_h) _Pragma("unroll") for (int _i = 0; _i < 2; ++_i) { int _R, _C; stage_rc(tid * 16 + _i * 8192, _R, _C); \
    dst[_h][_i] = (unsigned)S.row(u, _h * HALF + _R) * (unsigned)(K * 2) + (unsigned)(_C * 2); } } while (0)
#define PG8_LDA(dst, b, h) do { _Pragma("unroll") for (int m = 0; m < 4; ++m) _Pragma("unroll") for (int k = 0; k < 2; ++k) dst[m][k] = *(const PG8_LAS bf16x8*)(lds + PG8_SA(b, h) + aoff + m * 2048 + k * 1024); } while (0)
#define PG8_LDB(dst, b, h) do { _Pragma("unroll") for (int n = 0; n < 2; ++n) _Pragma("unroll") for (int k = 0; k < 2; ++k) dst[n][k] = *(const PG8_LAS bf16x8*)(lds + PG8_SB(b, h) + boff + n * 2048 + k * 1024); } while (0)
#define PG8_MMA(ai, bj, At, Bt) do { __builtin_amdgcn_s_setprio(1); _Pragma("unroll") for (int m = 0; m < 4; ++m) _Pragma("unroll") for (int n = 0; n < 2; ++n) _Pragma("unroll") for (int k = 0; k < 2; ++k) \
    acc[ai][bj][m][n] = __builtin_amdgcn_mfma_f32_16x16x32_bf16(Bt[n][k], At[m][k], acc[ai][bj][m][n], 0, 0, 0); __builtin_amdgcn_s_setprio(0); } while (0)
#define PG8_WAIT_V(n) asm volatile("s_waitcnt vmcnt(" #n ")" ::: "memory")
#define PG8_WAIT_L(n) asm volatile("s_waitcnt lgkmcnt(" #n ")" ::: "memory")
#define PG8_BAR __builtin_amdgcn_s_barrier()
#define PG8_SCHED __builtin_amdgcn_sched_barrier(0)
  Unit cur, nxt; int ui = 0;
  if (!S.next(0, cur)) return;
  unsigned vAc[2][2];
  if constexpr (GATHER) { PG8_GATHER_OFFS(vAc, cur); }
  else { vAc[0][0] = vAc[0][1] = vAc[1][0] = vAc[1][1] = 0u; }
  f32x4 acc[2][2][4][2];
#pragma unroll
  for (int a = 0; a < 2; ++a)
#pragma unroll
    for (int b = 0; b < 2; ++b)
#pragma unroll
      for (int m = 0; m < 4; ++m)
#pragma unroll
        for (int n = 0; n < 2; ++n) acc[a][b][m][n] = (f32x4){0.f, 0.f, 0.f, 0.f};
  bf16x8 At[4][2], B0[2][2], B1[2][2];
  const char* cA = cur.a; const char* cB = cur.b;
  PG8_STAGE(PG8_SB(0, 0), cB, voffB); PG8_STAGE_A(PG8_SA(0, 0), cA, 0); PG8_STAGE(PG8_SB(0, 1), cB + hstep, voffB); PG8_STAGE_A(PG8_SA(0, 1), cA, 1);
  if (wr == 1) PG8_BAR;
  PG8_WAIT_V(4); PG8_BAR;
  PG8_STAGE(PG8_SB(1, 0), cB + kstep, voffB); PG8_STAGE_A(PG8_SA(1, 0), cA + kstep, 0); PG8_STAGE(PG8_SB(1, 1), cB + hstep + kstep, voffB);
  PG8_WAIT_V(6); PG8_BAR;
  for (;;) {
    const bool has_next = S.next(ui + 1, nxt);
    const char* nA = has_next ? nxt.a : cA; const char* nB = has_next ? nxt.b : cB;
    for (int t = 0; t < nt; t += 2) {
      const bool last = (t == nt - 2);
      const char* a1 = cA + (size_t)(t + 1) * kstep;
      const char* a2 = last ? nA : cA + (size_t)(t + 2) * kstep; const char* b2 = last ? nB : cB + (size_t)(t + 2) * kstep;
      const char* a3 = a2 + kstep; const char* b3 = b2 + kstep;
      unsigned vAn[2][2];
      if constexpr (GATHER) { PG8_SCHED; if (last && has_next) { PG8_GATHER_OFFS(vAn, nxt); } PG8_SCHED; }
      PG8_LDB(B0, 0, 0); PG8_SCHED; PG8_LDA(At, 0, 0); PG8_STAGE_A(PG8_SA(1, 1), a1, 1);
      PG8_WAIT_L(8); PG8_BAR; PG8_WAIT_L(0); PG8_MMA(0, 0, At, B0); PG8_BAR; PG8_SCHED;
      if constexpr (GATHER) { if (last && has_next) { vAc[0][0] = vAn[0][0]; vAc[0][1] = vAn[0][1]; vAc[1][0] = vAn[1][0]; vAc[1][1] = vAn[1][1]; } }
      PG8_LDB(B1, 0, 1); PG8_STAGE(PG8_SB(0, 0), b2, voffB);
      PG8_BAR; PG8_WAIT_L(0); PG8_MMA(0, 1, At, B1); PG8_BAR;
      PG8_LDA(At, 0, 1); PG8_STAGE_A(PG8_SA(0, 0), a2, 0);
      PG8_BAR; PG8_WAIT_L(0); PG8_MMA(1, 0, At, B0); PG8_BAR; PG8_SCHED;
      PG8_STAGE(PG8_SB(0, 1), b2 + hstep, voffB);
      PG8_WAIT_V(6); PG8_BAR; PG8_MMA(1, 1, At, B1); PG8_BAR;
      PG8_LDB(B0, 1, 0); PG8_SCHED; PG8_LDA(At, 1, 0); PG8_STAGE_A(PG8_SA(0, 1), a2, 1);
      PG8_WAIT_L(8); PG8_BAR; PG8_WAIT_L(0); PG8_MMA(0, 0, At, B0); PG8_BAR; PG8_SCHED;
      PG8_LDB(B1, 1, 1); PG8_STAGE(PG8_SB(1, 0), b3, voffB);
      PG8_BAR; PG8_WAIT_L(0); PG8_MMA(0, 1, At, B1); PG8_BAR;
      PG8_LDA(At, 1, 1); PG8_STAGE_A(PG8_SA(1, 0), a3, 0);
      PG8_BAR; PG8_WAIT_L(0); PG8_MMA(1, 0, At, B0); PG8_BAR; PG8_SCHED;
      PG8_STAGE(PG8_SB(1, 1), b3 + hstep, voffB);
      PG8_WAIT_V(6); PG8_BAR; PG8_MMA(1, 1, At, B1); PG8_BAR;
    }
    E(acc, cur, wr, wc, fr, fq);
    if (!has_next) break;
#pragma unroll
    for (int a = 0; a < 2; ++a)
#pragma unroll
      for (int b = 0; b < 2; ++b)
#pragma unroll
        for (int m = 0; m < 4; ++m)
#pragma unroll
          for (int n = 0; n < 2; ++n) acc[a][b][m][n] = (f32x4){0.f, 0.f, 0.f, 0.f};
    cur = nxt; cA = nA; cB = nB; ++ui;
  }
  PG8_WAIT_V(0);
  if (wr == 0) PG8_BAR;
  PG8_BAR;
#undef PG8_SA
#undef PG8_SB
#undef PG8_STAGE
#undef PG8_STAGE_A
#undef PG8_GATHER_OFFS
#undef PG8_LDA
#undef PG8_LDB
#undef PG8_MMA
#undef PG8_WAIT_V
#undef PG8_WAIT_L
#undef PG8_BAR
#undef PG8_SCHED
}
}

__device__ void transpose_tile(float* tl, const float* src, int ld, int scol0, unsigned short* dst, int K, int n0, int k0) {
  const int tid = tidx();
  __syncthreads();
#pragma unroll
  for (int ps = 0; ps < 4; ++ps) {
    const int kr = ps * 32 + (tid >> 4), c4 = (tid & 15) * 4;
    const float4 v = ld4(src + (size_t)(k0 + kr) * ld + scol0 + c4);
    tl[kr * 65 + c4] = v.x; tl[kr * 65 + c4 + 1] = v.y; tl[kr * 65 + c4 + 2] = v.z; tl[kr * 65 + c4 + 3] = v.w;
  }
  __syncthreads();
  const int n = tid >> 3, kq = (tid & 7) * 16;
  unsigned w[8];
#pragma unroll
  for (int i = 0; i < 8; ++i) w[i] = pg8::cvt_pk_bf16(tl[(kq + 2 * i) * 65 + n], tl[(kq + 2 * i + 1) * 65 + n]);
  uint4* o = reinterpret_cast<uint4*>(dst + (size_t)(n0 + n) * K + k0 + kq);
  o[0] = make_uint4(w[0], w[1], w[2], w[3]); o[1] = make_uint4(w[4], w[5], w[6], w[7]);
}

typedef unsigned short bf16_t;
DEV float bf2f(bf16_t v) { return __uint_as_float((unsigned)v << 16); }
DEV float bflo(unsigned w) { return __uint_as_float(w << 16); }
DEV float bfhi(unsigned w) { return __uint_as_float(w & 0xffff0000u); }
DEV bf16_t f2bf(float f) { return (bf16_t)(pg8::cvt_pk_bf16(f, 0.f) & 0xffffu); }
DEV float fsigmoid(float x) { return 1.0f / (1.0f + __expf(-x)); }

__device__ void phase_wprep(float* lds, const Params& p, char* ws, int bid, int nb) {
  bf16_t* winT = (bf16_t*)(ws + OFF_WINT); bf16_t* hpT = (bf16_t*)(ws + OFF_HPT); bf16_t* rpT = (bf16_t*)(ws + OFF_RPT);
  bf16_t* woT = (bf16_t*)(ws + OFF_WOT); bf16_t* w13T = (bf16_t*)(ws + OFF_W13T); bf16_t* w2T = (bf16_t*)(ws + OFF_W2T);
  constexpr int N0 = 672, N1 = N0 + 64, N2 = N1 + 64, N3 = N2 + 128, N4 = N3 + 8192, N5 = N4 + 4096;
  for (int item = bid; item < N5; item += nb) {
    if (item < N0) {
      const int nt = item >> 3, kt = item & 7, n0 = nt * 64;
      int scol;
      if (n0 < 3328) scol = n0;
      else { const int r = n0 - 3328, j = r >> 8, q = r & 255; scol = 3328 + (q < 128 ? 0 : 1024) + j * 128 + (q & 127); }
      transpose_tile(lds, p.in[I_WIN], kINC, scol, winT, kD, n0, kt * 128);
    } else if (item < N1) { const int it = item - N0; transpose_tile(lds, p.in[I_HPROJ], kD, (it >> 2) * 64, hpT, 512, (it >> 2) * 64, (it & 3) * 128);
    } else if (item < N2) { const int it = item - N1; transpose_tile(lds, p.in[I_RWPROJ], kD, (it >> 2) * 64, rpT, 512, (it >> 2) * 64, (it & 3) * 128);
    } else if (item < N3) { const int it = item - N2; transpose_tile(lds, p.in[I_WOUT], kD, (it >> 3) * 64, woT, kD, (it >> 3) * 64, (it & 7) * 128);
    } else if (item < N4) {
      const int it = item - N3, e = it >> 9, nt = (it >> 3) & 63, kt = it & 7, n0 = nt * 64, j = n0 >> 8, q = n0 & 255;
      const float* src = (q < 128 ? p.in[I_EW1] : p.in[I_EW3]) + (size_t)e * kD * kF;
      transpose_tile(lds, src, kF, j * 128 + (q & 127), w13T + (size_t)e * 4096 * kD, kD, n0, kt * 128);
    } else {
      const int it = item - N4, e = it >> 8, nt = (it >> 4) & 15, kt = it & 15;
      transpose_tile(lds, p.in[I_EW2] + (size_t)e * kF * kD, kD, nt * 64, w2T + (size_t)e * kD * kF, kF, nt * 64, kt * 128);
    }
  }
}

__device__ void phase_hb(const Params& p, const float* mod, bf16_t* hb, bf16_t* hc, int bid, int nb) {
  const int lane = tidx() & 63, wid = tidx() >> 6;
  const float* g = p.in[I_N1PRE];
  const int rstep = nb * 8, rend = kROWS + kB * kCTX;
  int row = bid * 8 + wid;
  float4 nv[4];
  { const float* xr = row >= kROWS ? p.in[I_CTX] + (size_t)(row - kROWS) * kD : p.in[I_X] + (size_t)row * kD;
#pragma unroll
    for (int i = 0; i < 4; ++i) nv[i] = row < rend ? ld4(xr + i * 256 + lane * 4) : make_float4(0.f, 0.f, 0.f, 0.f); }
  for (; row < rend; row += rstep) {
    const bool isctx = row >= kROWS;
    const int mr = isctx ? 4 : row / kT;
    bf16_t* dst = isctx ? hc + (size_t)(row - kROWS) * kD : hb + (size_t)row * kD;
    float4 v[4]; float ss = 0.f;
#pragma unroll
    for (int i = 0; i < 4; ++i) { v[i] = nv[i]; ss += v[i].x * v[i].x + v[i].y * v[i].y + v[i].z * v[i].z + v[i].w * v[i].w; }
    { const int nr = row + rstep < rend ? row + rstep : row;
      const float* xr = nr >= kROWS ? p.in[I_CTX] + (size_t)(nr - kROWS) * kD : p.in[I_X] + (size_t)nr * kD;
#pragma unroll
      for (int i = 0; i < 4; ++i) nv[i] = ld4(xr + i * 256 + lane * 4); }
    ss = wave_sum(ss);
    const float r = rsqrtf(ss * (1.0f / kD) + 1e-6f);
#pragma unroll
    for (int i = 0; i < 4; ++i) {
      const int k = i * 256 + lane * 4;
      const float4 gv = ld4(g + k), sc = ld4(mod + mr * 6144 + 1024 + k), sh = ld4(mod + mr * 6144 + k);
      const float h0 = v[i].x * r * gv.x * (1.f + sc.x) + sh.x, h1 = v[i].y * r * gv.y * (1.f + sc.y) + sh.y;
      const float h2 = v[i].z * r * gv.z * (1.f + sc.z) + sh.z, h3 = v[i].w * r * gv.w * (1.f + sc.w) + sh.w;
      *reinterpret_cast<uint2*>(dst + k) = make_uint2(pg8::cvt_pk_bf16(h0, h1), pg8::cvt_pk_bf16(h2, h3));
    }
  }
}

struct SchedPlain {
  pg8::TileOrder o; const char* A; const char* B; size_t tstep;
  __device__ bool next(int i, pg8::Unit& u) const { if (!o.tile(i, u.pm, u.pn)) return false; u.a = A + (size_t)u.pm * tstep; u.b = B + (size_t)u.pn * tstep; return true; }
  __device__ int row(const pg8::Unit&, int) const { return 0; }
};
struct SchedExp1 {
  pg8::TileOrder o; const char* H2; const char* W13T; const int* idx; int e0;
  __device__ bool next(int i, pg8::Unit& u) const { if (!o.tile(i, u.pm, u.pn)) return false;
    const int e = e0 + (u.pm >> 4); u.a = H2; u.b = W13T + ((size_t)e * 4096 + (size_t)u.pn * 256) * kD * 2; return true; }
  __device__ int row(const pg8::Unit& u, int r) const { return idx[(unsigned)(u.pm * 256 + r)]; }
};
struct SchedExp2 {
  pg8::TileOrder o; const char* HID; const char* W2T; int e0;
  __device__ bool next(int i, pg8::Unit& u) const { if (!o.tile(i, u.pm, u.pn)) return false;
    const int e = e0 + (u.pm >> 4); u.a = HID + (size_t)u.pm * 256 * kF * 2; u.b = W2T + ((size_t)e * kD + (size_t)u.pn * 256) * kF * 2; return true; }
  __device__ int row(const pg8::Unit&, int) const { return 0; }
};

struct EpiBf16Split {
  static constexpr bool PERM = true;
  bf16_t* o0; int ld0; int nt0; bf16_t* o1; int ld1;
  __device__ __forceinline__ void operator()(const pg8::f32x4 (&acc)[2][2][4][2], const pg8::Unit& u, int wr, int wc, int fr, int fq) const {
    bf16_t* base; int ldc, colt;
    if (u.pn < nt0) { base = o0; ldc = ld0; colt = u.pn * 256; } else { base = o1; ldc = ld1; colt = (u.pn - nt0) * 256; }
    const int row0 = u.pm * 256 + wr * 64 + fr, col0 = colt + wc * 32 + 8 * fq;
#pragma unroll
    for (int ai = 0; ai < 2; ++ai)
#pragma unroll
      for (int m = 0; m < 4; ++m) { bf16_t* rowp = base + (size_t)(row0 + ai * 128 + m * 16) * ldc + col0;
#pragma unroll
        for (int bj = 0; bj < 2; ++bj) { const pg8::f32x4 v0 = acc[ai][bj][m][0], v1 = acc[ai][bj][m][1];
          pg8::u32x4 w; w.x = pg8::cvt_pk_bf16(v0[0], v0[1]); w.y = pg8::cvt_pk_bf16(v0[2], v0[3]); w.z = pg8::cvt_pk_bf16(v1[0], v1[1]); w.w = pg8::cvt_pk_bf16(v1[2], v1[3]);
          *(pg8::u32x4*)(rowp + bj * 128) = w; } }
  }
};
struct EpiF32Store {
  static constexpr bool PERM = false;
  float* C; int ldc;
  __device__ __forceinline__ void operator()(const pg8::f32x4 (&acc)[2][2][4][2], const pg8::Unit& u, int wr, int wc, int fr, int fq) const {
    const int row0 = u.pm * 256 + wr * 64 + fr, col0 = u.pn * 256 + wc * 32 + 4 * fq;
#pragma unroll
    for (int ai = 0; ai < 2; ++ai)
#pragma unroll
      for (int m = 0; m < 4; ++m) { float* rowp = C + (size_t)(row0 + ai * 128 + m * 16) * ldc + col0;
#pragma unroll
        for (int bj = 0; bj < 2; ++bj)
#pragma unroll
          for (int n = 0; n < 2; ++n) *(pg8::f32x4*)(rowp + bj * 128 + n * 16) = acc[ai][bj][m][n]; }
  }
};
struct EpiGatesMerge {
  static constexpr bool PERM = true;
  const bf16_t* yh; const bf16_t* yr; bf16_t* pre;
  __device__ __forceinline__ void operator()(const pg8::f32x4 (&acc)[2][2][4][2], const pg8::Unit& u, int wr, int wc, int fr, int fq) const {
    const int row0 = u.pm * 256 + wr * 64 + fr, col0 = u.pn * 128 + wc * 32 + 8 * fq;
#pragma unroll
    for (int ai = 0; ai < 2; ++ai)
#pragma unroll
      for (int m = 0; m < 4; ++m) { const size_t off = (size_t)(row0 + ai * 128 + m * 16) * kD + col0;
        const pg8::u32x4 a = *(const pg8::u32x4*)(yh + off), b = *(const pg8::u32x4*)(yr + off);
        const pg8::f32x4 g0 = acc[ai][0][m][0], g1 = acc[ai][0][m][1], r0 = acc[ai][1][m][0], r1 = acc[ai][1][m][1];
        float o[8];
        o[0] = fsigmoid(g0[0]) * bflo(a.x) + fsigmoid(r0[0]) * bflo(b.x); o[1] = fsigmoid(g0[1]) * bfhi(a.x) + fsigmoid(r0[1]) * bfhi(b.x);
        o[2] = fsigmoid(g0[2]) * bflo(a.y) + fsigmoid(r0[2]) * bflo(b.y); o[3] = fsigmoid(g0[3]) * bfhi(a.y) + fsigmoid(r0[3]) * bfhi(b.y);
        o[4] = fsigmoid(g1[0]) * bflo(a.z) + fsigmoid(r1[0]) * bflo(b.z); o[5] = fsigmoid(g1[1]) * bfhi(a.z) + fsigmoid(r1[1]) * bfhi(b.z);
        o[6] = fsigmoid(g1[2]) * bflo(a.w) + fsigmoid(r1[2]) * bflo(b.w); o[7] = fsigmoid(g1[3]) * bfhi(a.w) + fsigmoid(r1[3]) * bfhi(b.w);
        pg8::u32x4 w; w.x = pg8::cvt_pk_bf16(o[0], o[1]); w.y = pg8::cvt_pk_bf16(o[2], o[3]); w.z = pg8::cvt_pk_bf16(o[4], o[5]); w.w = pg8::cvt_pk_bf16(o[6], o[7]);
        *(pg8::u32x4*)(pre + off) = w; }
  }
};
struct EpiSwiGLU {
  static constexpr bool PERM = true;
  bf16_t* hid;
  __device__ __forceinline__ void operator()(const pg8::f32x4 (&acc)[2][2][4][2], const pg8::Unit& u, int wr, int wc, int fr, int fq) const {
    const int row0 = u.pm * 256 + wr * 64 + fr, col0 = u.pn * 128 + wc * 32 + 8 * fq;
#pragma unroll
    for (int ai = 0; ai < 2; ++ai)
#pragma unroll
      for (int m = 0; m < 4; ++m) { const size_t off = (size_t)(row0 + ai * 128 + m * 16) * kF + col0;
        float o[8];
#pragma unroll
        for (int n = 0; n < 2; ++n)
#pragma unroll
          for (int j = 0; j < 4; ++j) { const float a = acc[ai][0][m][n][j]; o[n * 4 + j] = a * fsigmoid(a) * acc[ai][1][m][n][j]; }
        pg8::u32x4 w; w.x = pg8::cvt_pk_bf16(o[0], o[1]); w.y = pg8::cvt_pk_bf16(o[2], o[3]); w.z = pg8::cvt_pk_bf16(o[4], o[5]); w.w = pg8::cvt_pk_bf16(o[6], o[7]);
        *(pg8::u32x4*)(hid + off) = w; }
  }
};
struct EpiYE {
  static constexpr bool PERM = true;
  bf16_t* ye; const float* gate; int e0;
  __device__ __forceinline__ void operator()(const pg8::f32x4 (&acc)[2][2][4][2], const pg8::Unit& u, int wr, int wc, int fr, int fq) const {
    const int e = e0 + (u.pm >> 4), s0 = (u.pm & 15) * 256 + wr * 64 + fr, col0 = u.pn * 256 + wc * 32 + 8 * fq;
#pragma unroll
    for (int ai = 0; ai < 2; ++ai)
#pragma unroll
      for (int m = 0; m < 4; ++m) { const int s = s0 + ai * 128 + m * 16, b = s >> 10, c = s & 1023, slot = (b * kE + e) * kCAP + c;
        const float g = gate[slot]; bf16_t* rowp = ye + (size_t)slot * kD + col0;
#pragma unroll
        for (int bj = 0; bj < 2; ++bj) { const pg8::f32x4 v0 = acc[ai][bj][m][0] * g, v1 = acc[ai][bj][m][1] * g;
          pg8::u32x4 w; w.x = pg8::cvt_pk_bf16(v0[0], v0[1]); w.y = pg8::cvt_pk_bf16(v0[2], v0[3]); w.z = pg8::cvt_pk_bf16(v1[0], v1[1]); w.w = pg8::cvt_pk_bf16(v1[2], v1[3]);
          *(pg8::u32x4*)(rowp + bj * 128) = w; } }
  }
};

__device__ void phase_mod(float* lds, const float* c, const float* cctx, const float* modw, const float* modb, float* mod, int bid, int nb) {
  float* sc = lds;
  float* red = lds + 5120;
  const int tid = tidx(), kk = tid >> 6, nl = tid & 63;
  bool loaded = false;
  for (int item = bid; item < 96; item += nb) {
    if (!loaded) {
      for (int i = tid; i < 5120; i += NTHR) { const int v = i >> 10, k = i & 1023; const float cv = v < 4 ? c[v * kD + k] : cctx[k]; sc[i] = siluf_(cv); }
      loaded = true;
    }
    __syncthreads();
    const int n = item * 64 + nl;
    float acc[5] = {0.f, 0.f, 0.f, 0.f, 0.f};
#pragma unroll 8
    for (int k = kk * 128; k < kk * 128 + 128; ++k) {
      const float w = modw[(size_t)k * 6144 + n];
#pragma unroll
      for (int v = 0; v < 5; ++v) acc[v] += sc[v * 1024 + k] * w;
    }
#pragma unroll
    for (int v = 0; v < 5; ++v) red[(kk * 5 + v) * 64 + nl] = acc[v];
    __syncthreads();
    if (tid < 320) {
      const int v = tid >> 6;
      float s = 0.f;
#pragma unroll
      for (int q = 0; q < 8; ++q) s += red[(q * 5 + v) * 64 + nl];
      mod[v * 6144 + n] = s + modb[n];
    }
    __syncthreads();
  }
}

__device__ void phase_filter(float* lds, const Params& p, float* circT, int bid, int nb) {
  float* feat = lds;
  float* h1 = lds + 32 * 33;
  float* h2 = h1 + 32 * 64;
  const float* w1 = p.in[I_HW1]; const float* b1 = p.in[I_HB1]; const float* w2 = p.in[I_HW2]; const float* b2 = p.in[I_HB2];
  const float* w3 = p.in[I_HW3]; const float* fr = p.in[I_HFREQ];
  const int tid = tidx();
  for (int item = bid; item < kT / 32; item += nb) {
    const int l0 = item * 32;
    __syncthreads();
    for (int i = tid; i < 32 * 33; i += NTHR) {
      const int pz = i / 33, f = i % 33, l = l0 + pz;
      float v;
      if (f == 0) v = (float)l / (float)(kT - 1);
      else {
        const int j = (f - 1) & 15;
        const float band = 1e-4f + (float)j * ((15.0f - 1e-4f) / 15.0f);
        const float ang = (6.283185307179586f / (float)kT) * (float)l;
        float sn, cs; sincos_cw(band * ang, sn, cs); v = f <= 16 ? cs : -sn;
      }
      feat[i] = v;
    }
    __syncthreads();
    for (int i = tid; i < 32 * 64; i += NTHR) {
      const int pz = i >> 6, o = i & 63;
      float s = b1[o];
#pragma unroll 3
      for (int f = 0; f < 33; ++f) s += feat[pz * 33 + f] * w1[f * 64 + o];
      h1[i] = sin_cw(fr[o] * s);
    }
    __syncthreads();
    for (int i = tid; i < 32 * 64; i += NTHR) {
      const int pz = i >> 6, o = i & 63;
      float s = b2[o];
#pragma unroll 4
      for (int f = 0; f < 64; ++f) s += h1[pz * 64 + f] * w2[f * 64 + o];
      h2[i] = sin_cw(fr[o] * s);
    }
    __syncthreads();
#pragma unroll 1
    for (int half = 0; half < 2; ++half) {
      const int n = tid + half * 512;
      const int c = tid;
      float wr[64];
#pragma unroll
      for (int o = 0; o < 64; ++o) wr[o] = w3[o * 1024 + n];
      const float dlo = -4.605170185988091f / 1.5f, dhi = -4.605170185988091f / 0.3f;
      const float delta = fabsf(dlo + (float)c * ((dhi - dlo) / 511.0f));
      float asum = 0.f;
#pragma unroll 1
      for (int q = 0; q < 32; ++q) {
        float a = 0.f;
#pragma unroll
        for (int o = 0; o < 64; ++o) a += h2[q * 64 + o] * wr[o];
        const int l = l0 + q;
        const float tt = (float)l / (float)(kT - 1);
        const float v = a * expf(-tt * delta);
        if (half == 0) circT[(size_t)c * 16384 + l] = v;
        else circT[(size_t)c * 16384 + 16384 - l - (l == 0 ? 8192 : 0)] = (l == 0 ? 0.f : v);
      }
      (void)asum;
    }
  }
}

DEV float ldcol(const float* p, size_t i) { return p[i]; }
DEV float ldcol(const bf16_t* p, size_t i) { return bf2f(p[i]); }
namespace rs {
typedef short bf16x8 __attribute__((ext_vector_type(8)));
typedef float f32x4 __attribute__((ext_vector_type(4)));
constexpr int LD = 72, LDR = 40;
#define RS_LAS __attribute__((address_space(3)))
typedef RS_LAS bf16_t* lbf; typedef const RS_LAS bf16_t* clbf; typedef RS_LAS float* lf32;
DEV void lds_barrier() { asm volatile("s_waitcnt lgkmcnt(0)" ::: "memory"); __builtin_amdgcn_s_barrier(); asm volatile("" ::: "memory"); }
template <int K>
DEV f32x4 tmma(f32x4 acc, clbf A, int lda, clbf B, int ldb, int lane) {
  clbf ap = A + (lane & 15) * lda + 8 * (lane >> 4);
  clbf bp = B + (lane & 15) * ldb + 8 * (lane >> 4);
#pragma unroll
  for (int k = 0; k < K; k += 32)
    acc = __builtin_amdgcn_mfma_f32_16x16x32_bf16(*(const RS_LAS bf16x8*)(ap + k), *(const RS_LAS bf16x8*)(bp + k), acc, 0, 0, 0);
  return acc;
}
typedef unsigned u32x2v __attribute__((ext_vector_type(2)));
DEV void st4(lbf p, f32x4 v) { const u32x2v w = {pg8::cvt_pk_bf16(v[0], v[1]), pg8::cvt_pk_bf16(v[2], v[3])}; *(RS_LAS u32x2v*)p = w; }
DEV void st4g(bf16_t* p, f32x4 v) { *reinterpret_cast<uint2*>(p) = make_uint2(pg8::cvt_pk_bf16(v[0], v[1]), pg8::cvt_pk_bf16(v[2], v[3])); }
DEV float ftanh(float x) { const float e = __expf(2.f * x); return 1.f - 2.f / (e + 1.f); }

template <int NC> struct Lay {
  static constexpr int ZTB = NC * LD * 2;
  static constexpr int W = 0, ZT0 = 18432, ZT1 = ZT0 + ZTB, AT = ZT1 + ZTB, BTt = AT + 9216, KTt = BTt + 9216, Vt = KTt + 9216,
                       RT = Vt + 9216, X = (NC == 64 ? RT + 9216 : RT), L = X + 18432, D = L + (NC == 64 ? 36864 : 32768);
  static constexpr int LWt = X, LA = X + 9216, BT = X, KT = X + 9216, UT = X, RHS = (NC == 64 ? X + 9216 : L + 18432);
  static constexpr int CS = L, AG = L + 16384, LAK = L, LOFF = L + 9216, LRB = L + 18432, LRK = L + 27648;
  static constexpr int LDG = D, TDG = D + 4352, WCV = TDG + 5120, SEG = WCV + 256, TF = SEG + 2048, END = TF + 4352;
};
static_assert(Lay<64>::END <= (int)LDS_BYTES && Lay<128>::END <= (int)LDS_BYTES, "scan LDS layout");

template <int NC, bool EMIT>
__device__ void scan_task(float* ldsf, const Params& p, const bf16_t* cols, int ldc, int Tlen, int cR, int cK, int cV, int cLW, int cLA, int muoff,
                          int b, int h, int dir, int step0, int nchunks, const float* Zinit  , float* Zout  , bf16_t* Y, float* BSo) {
  typedef Lay<NC> LY;
  RS_LAS char* lds = (RS_LAS char*)ldsf;
  const int tid = tidx(), lane = tid & 63, w = tid >> 6;
  lbf sWup = (lbf)(lds + LY::W); lbf sAup = sWup + 64 * LD;
  lbf sAT = (lbf)(lds + LY::AT); lbf sBTt = (lbf)(lds + LY::BTt); lbf sKTt = (lbf)(lds + LY::KTt); lbf sVt = (lbf)(lds + LY::Vt);
  lbf sRT = (lbf)(lds + LY::RT);
  lbf sLWt = (lbf)(lds + LY::LWt); lbf sLA = (lbf)(lds + LY::LA); lbf sBT = (lbf)(lds + LY::BT); lbf sKT = (lbf)(lds + LY::KT);
  lbf sUT = (lbf)(lds + LY::UT); lbf sRHS = (lbf)(lds + LY::RHS);
  lf32 sCS = (lf32)(lds + LY::CS); lf32 sAG = (lf32)(lds + LY::AG);
  lbf sLak = (lbf)(lds + LY::LAK); lbf sLoff = (lbf)(lds + LY::LOFF); lbf sLrb = (lbf)(lds + LY::LRB); lbf sLrk = (lbf)(lds + LY::LRK);
  lf32 sLdg = (lf32)(lds + LY::LDG); lbf sTdg = (lbf)(lds + LY::TDG); lf32 sWC = (lf32)(lds + LY::WCV); lf32 sSeg = (lf32)(lds + LY::SEG); lf32 sTf = (lf32)(lds + LY::TF);
  const float* mu = p.in[I_MU];
  const int hj = h * 64 + lane;
  const bf16_t* base = cols + (size_t)b * Tlen * ldc;
  constexpr int NT = NC / 16 * 4 / 8;
  f32x4 Zm[NT];

  __syncthreads();
  for (int i = tid; i < 4096; i += NTHR) { const int ii = i >> 6, j = i & 63;
    sWup[j * LD + ii] = f2bf(p.in[I_WUP][((size_t)dir * 64 + ii) * 512 + h * 64 + j]);
    sAup[j * LD + ii] = f2bf(p.in[I_AUP][((size_t)dir * 64 + ii) * 512 + h * 64 + j]); }
#pragma unroll
  for (int m = 0; m < NT; ++m) {
    const int id = w + 8 * m, tj = id & 3, tn = id >> 2, col = tn * 16 + (lane & 15), j0 = tj * 16 + 4 * (lane >> 4);
#pragma unroll
    for (int q = 0; q < 4; ++q) {
      float v = 0.f;
      if (NC == 128) v = (col < 64 && col == j0 + q) ? 1.f : 0.f;
      else if (Zinit) v = Zinit[col * 64 + j0 + q];
      Zm[m][q] = v;
    }
    st4((lbf)(lds + LY::ZT0) + col * LD + j0, Zm[m]);
  }
  for (int i = tid; i < NC * LD / 2; i += NTHR) ((RS_LAS unsigned*)sUT)[i] = 0u;
  int zcur = 0;
  unsigned long long tprev = 0; const bool tpon = (TP_LO == 100) && EMIT && blockIdx.x == 0 && threadIdx.x == 0;
#define RS_T(k) do { if (TP_LO == 100 && EMIT) { if (tpon) { const unsigned long long tn_ = __builtin_amdgcn_s_memrealtime(); ((unsigned long long*)(p.ws + OFF_NORM + 512))[k] += tn_ - tprev; tprev = tn_; } } } while (0)
#pragma unroll 1
  for (int ci = 0; ci < nchunks; ++ci) {
    const int s0 = step0 + ci * 64;
    lbf sZT = (lbf)(lds + (zcur ? LY::ZT1 : LY::ZT0));
    lbf sZN = (lbf)(lds + (zcur ? LY::ZT0 : LY::ZT1));
    lds_barrier();
    if (TP_LO == 100 && EMIT) { if (tpon) tprev = __builtin_amdgcn_s_memrealtime(); }
    const int stepb = s0 + w * 8 - 1;
    unsigned pf[5][5];
#define RS_PREFETCH(a_lo, a_hi) do { _Pragma("unroll") for (int a = a_lo; a < a_hi; ++a) { if (a == 0 && !EMIT) continue; \
      const bf16_t* rp = base + (a == 0 ? cR + h * 64 : a == 1 ? cK + h * 64 : a == 2 ? cV + h * 64 : a == 3 ? cLW : cLA) + lane; \
      _Pragma("unroll") for (int i = 0; i < 5; ++i) { const int s0_ = stepb + 2 * i, s1_ = s0_ + 1, t0_ = dir ? (Tlen - 1 - s0_) : s0_, t1_ = dir ? (Tlen - 1 - s1_) : s1_; \
        const int c0_ = t0_ < 0 ? 0 : (t0_ >= Tlen ? Tlen - 1 : t0_), c1_ = t1_ < 0 ? 0 : (t1_ >= Tlen ? Tlen - 1 : t1_);     \
        const unsigned l_ = (unsigned)rp[(size_t)c0_ * ldc], h_ = (unsigned)rp[(size_t)c1_ * ldc]; \
        pf[a][i] = ((t0_ == c0_) ? l_ : 0u) | (((t1_ == c1_) ? h_ : 0u) << 16); } } } while (0)
#define RS_ROW(a, i) (((i) & 1) ? __uint_as_float(pf[a][(i) >> 1] & 0xffff0000u) : __uint_as_float(pf[a][(i) >> 1] << 16))
    RS_PREFETCH(3, 5);
    {
      const float m0w = mu[cLW + lane + muoff], m1w = mu[kRWC + cLW + lane + muoff], m0a = mu[cLA + lane + muoff], m1a = mu[kRWC + cLA + lane + muoff];
#pragma unroll
      for (int q = 0; q < 8; ++q) {
        const int tl = w * 8 + q;
        const float wc = RS_ROW(3, q + 1), wp = dir ? RS_ROW(3, q + 2) : RS_ROW(3, q), wn = dir ? RS_ROW(3, q) : RS_ROW(3, q + 2);
        const float ac = RS_ROW(4, q + 1), ap = dir ? RS_ROW(4, q + 2) : RS_ROW(4, q), an = dir ? RS_ROW(4, q) : RS_ROW(4, q + 2);
        const float zw = wc + m0w * (wp - wc) + m1w * (wn - wc);
        const float za = ac + m0a * (ap - ac) + m1a * (an - ac);
        sLWt[tl * LD + lane] = f2bf(ftanh(zw)); sLA[tl * LD + lane] = f2bf(za);
      }
    }
    RS_PREFETCH(0, 3);
    lds_barrier(); RS_T(2);
#pragma unroll 1
    for (int m = 0; m < 2; ++m) {
      const int id = w * 2 + m, tm = id >> 2, tn = id & 3;
      f32x4 aw = {0.f, 0.f, 0.f, 0.f}, aa = {0.f, 0.f, 0.f, 0.f};
      aw = tmma<64>(aw, sLWt + tm * 16 * LD, LD, sWup + tn * 16 * LD, LD, lane);
      aa = tmma<64>(aa, sLA + tm * 16 * LD, LD, sAup + tn * 16 * LD, LD, lane);
      const int j = tn * 16 + (lane & 15);
      const float w0 = p.in[I_W0][dir * 512 + h * 64 + j], a0 = p.in[I_A0][dir * 512 + h * 64 + j];
#pragma unroll
      for (int q = 0; q < 4; ++q) {
        const int t = tm * 16 + 4 * (lane >> 4) + q;
        const float x = -(w0 + aw[q]);
        const float sp = x > 20.f ? x : __logf(1.f + __expf(x));
        sCS[t * 64 + j] = __expf(-sp - 0.5f);
        sAG[t * 64 + j] = fsigmoid(a0 + aa[q]);
      }
    }
    lds_barrier(); RS_T(3);
    {
      const int j = tid & 63, seg = tid >> 6;
      float v[8]; float run = 0.f;
#pragma unroll
      for (int q = 0; q < 8; ++q) { run += sCS[(seg * 8 + q) * 64 + j]; v[q] = run; }
      sSeg[seg * 64 + j] = run;
      lds_barrier();
      float off = 0.f;
#pragma unroll
      for (int s = 0; s < 8; ++s) off += (s < seg) ? sSeg[s * 64 + j] : 0.f;
#pragma unroll
      for (int q = 0; q < 8; ++q) sCS[(seg * 8 + q) * 64 + j] = v[q] + off;
    }
    lds_barrier(); RS_T(4);
    {
      const float kkw = p.in[I_KK][hj], kaw = p.in[I_KA][hj], rkw = p.in[I_RK][hj];
      float m0[3], m1[3];
#pragma unroll
      for (int a = 0; a < 3; ++a) { const int col = (a == 0 ? cR : a == 1 ? cK : cV) + h * 64 + lane; m0[a] = mu[col + muoff]; m1[a] = mu[kRWC + col + muoff]; }
#pragma unroll
      for (int q = 0; q < 8; ++q) {
        const int tl = w * 8 + q, tok = dir ? (Tlen - 1 - (s0 + tl)) : (s0 + tl);
        float rkv[3];
#pragma unroll
        for (int a = 0; a < 3; ++a) { const float xc = RS_ROW(a, q + 1), xp = dir ? RS_ROW(a, q + 2) : RS_ROW(a, q), xn = dir ? RS_ROW(a, q) : RS_ROW(a, q + 2);
          rkv[a] = (a == 0 && !EMIT) ? 0.f : xc + m0[a] * (xp - xc) + m1[a] * (xn - xc); }
        const float ag = sAG[tl * 64 + lane], cs = sCS[tl * 64 + lane], csm = tl > 0 ? sCS[(tl - 1) * 64 + lane] : 0.f;
        const float kkv = rkv[1] * kkw;
        const float ss = wave_sum(kkv * kkv);
        const float kkn = kkv * rsqrtf(fmaxf(ss, 1e-24f));
        const float km = rkv[1] * (1.f + (ag - 1.f) * kaw);
        const float ew = __expf(cs), ewi = __expf(-cs);
        const bf16_t at = f2bf(-kkn * __expf(-csm)), bt = f2bf(kkn * ag * ew), kt = f2bf(km * ew), vt = f2bf(rkv[2]);
        sAT[tl * LD + lane] = at; sBT[tl * LD + lane] = bt; sKT[tl * LD + lane] = kt;
        sBTt[lane * LD + tl] = bt; sKTt[lane * LD + tl] = kt; sVt[lane * LD + tl] = vt;
        if (EMIT) {
          sRT[tl * LD + lane] = f2bf(rkv[0] * ewi);
          const float bsum = wave_sum(rkv[0] * km * rkw);
          if (lane == 0) BSo[((size_t)dir * kROWS + (size_t)b * Tlen + tok) * 8 + h] = bsum;
        }
        if (tl == 63) sWC[lane] = ewi;
        __builtin_amdgcn_sched_barrier(0);
      }
    }
    lds_barrier(); RS_T(5);
    if (w < 4) {
      f32x4 acc = {0.f, 0.f, 0.f, 0.f};
      acc = tmma<64>(acc, sBT + w * 16 * LD, LD, sAT + w * 16 * LD, LD, lane);
      const int c = lane & 15, kq = lane >> 4, r4 = 4 * kq;
      lf32 Pm = sLdg + w * 272; lf32 Tm = sTf + w * 272;
#pragma unroll
      for (int q = 0; q < 4; ++q) { const float lv = (r4 + q < c) ? acc[q] : 0.f;
        Pm[c * 17 + r4 + q] = lv; Tm[c * 17 + r4 + q] = lv + ((r4 + q) == c ? 1.f : 0.f); }
#pragma unroll 1
      for (int lev = 0; lev < 3; ++lev) {
        f32x4 a2 = {0.f, 0.f, 0.f, 0.f};
#pragma unroll
        for (int s4 = 0; s4 < 4; ++s4) a2 = __builtin_amdgcn_mfma_f32_16x16x4f32(Pm[c * 17 + 4 * s4 + kq], Pm[(4 * s4 + kq) * 17 + c], a2, 0, 0, 0);
#pragma unroll
        for (int q = 0; q < 4; ++q) Pm[(r4 + q) * 17 + c] = a2[q];
        f32x4 a3 = {0.f, 0.f, 0.f, 0.f};
#pragma unroll
        for (int s4 = 0; s4 < 4; ++s4) a3 = __builtin_amdgcn_mfma_f32_16x16x4f32(Tm[c * 17 + 4 * s4 + kq], Pm[(4 * s4 + kq) * 17 + c], a3, 0, 0, 0);
#pragma unroll
        for (int q = 0; q < 4; ++q) Tm[(r4 + q) * 17 + c] += a3[q];
      }
#pragma unroll
      for (int q = 0; q < 4; ++q) { sTdg[(w * 16 + r4 + q) * LDR + c] = f2bf(Tm[(r4 + q) * 17 + c]); sTdg[(w * 16 + r4 + q) * LDR + 16 + c] = (bf16_t)0; }
    }
    {
      constexpr int NP = EMIT ? 4 : 2;
#pragma unroll 1
      for (int pr = 0; pr < NP; ++pr) {
        clbf Lsrc = (pr < 2) ? sAT : sRT;
        clbf Rsrc = (pr & 1) ? sKT : sBT;
        lbf dst = pr == 0 ? sLoff : pr == 1 ? sLak : pr == 2 ? sLrb : sLrk;
#pragma unroll 1
        for (int m = 0; m < 2; ++m) {
          const int id = w + 8 * m, tt = id >> 2, tu = id & 3;
          f32x4 acc = {0.f, 0.f, 0.f, 0.f};
          if (tu < tt || (pr != 0 && tu == tt)) acc = tmma<64>(acc, Rsrc + tu * 16 * LD, LD, Lsrc + tt * 16 * LD, LD, lane);
          const int t = tt * 16 + (lane & 15), u0 = tu * 16 + 4 * (lane >> 4);
#pragma unroll
          for (int q = 0; q < 4; ++q) { const bool keep = (pr < 2) ? (u0 + q < t) : (u0 + q <= t); acc[q] = keep ? acc[q] : 0.f; }
          st4(dst + t * LD + u0, acc);
        }
      }
    }
    lds_barrier(); RS_T(6);
    for (int i = tid; i < NC * 8; i += NTHR) ((RS_LAS unsigned*)sRHS)[(i >> 3) * (LDR / 2) + 8 + (i & 7)] = 0u;
    RS_T(7);
#pragma unroll 1
    for (int bk = 0; bk < 4; ++bk) {
      if (w < NC / 16) {
        const int tn = w;
        f32x4 acc = {0.f, 0.f, 0.f, 0.f};
        acc = tmma<64>(acc, sAT + bk * 16 * LD, LD, sZT + tn * 16 * LD, LD, lane);
        if (NC == 64 || tn >= 4) acc = tmma<64>(acc, sLak + bk * 16 * LD, LD, sVt + (NC == 64 ? tn : tn - 4) * 16 * LD, LD, lane);
        if (bk > 0) acc = tmma<64>(acc, sLoff + bk * 16 * LD, LD, sUT + tn * 16 * LD, LD, lane);
        st4(sRHS + (tn * 16 + (lane & 15)) * LDR + 4 * (lane >> 4), acc);
      }
      lds_barrier();
      if (w < NC / 16) {
        const int tn = w;
        f32x4 acc = {0.f, 0.f, 0.f, 0.f};
        acc = tmma<32>(acc, sTdg + bk * 16 * LDR, LDR, sRHS + tn * 16 * LDR, LDR, lane);
        st4(sUT + (tn * 16 + (lane & 15)) * LD + bk * 16 + 4 * (lane >> 4), acc);
      }
      lds_barrier();
    }
    RS_T(8);
    if (EMIT) {
#pragma unroll 1
      for (int m = 0; m < 2; ++m) {
        const int id = w + 8 * m, ti = id & 3, tt = id >> 2;
        f32x4 acc = {0.f, 0.f, 0.f, 0.f};
        acc = tmma<64>(acc, sZT + ti * 16 * LD, LD, sRT + tt * 16 * LD, LD, lane);
        acc = tmma<64>(acc, sUT + ti * 16 * LD, LD, sLrb + tt * 16 * LD, LD, lane);
        acc = tmma<64>(acc, sVt + ti * 16 * LD, LD, sLrk + tt * 16 * LD, LD, lane);
        const int tl = tt * 16 + (lane & 15), tok = dir ? (Tlen - 1 - (s0 + tl)) : (s0 + tl);
        st4g(Y + (size_t)dir * kROWS * 512 + ((size_t)b * Tlen + tok) * 512 + h * 64 + ti * 16 + 4 * (lane >> 4), acc);
      }
    }
#pragma unroll
    for (int m = 0; m < NT; ++m) {
      const int id = w + 8 * m, tj = id & 3, tn = id >> 2;
      f32x4 acc = {0.f, 0.f, 0.f, 0.f};
      acc = tmma<64>(acc, sBTt + tj * 16 * LD, LD, sUT + tn * 16 * LD, LD, lane);
      if (NC == 64 || tn >= 4) acc = tmma<64>(acc, sKTt + tj * 16 * LD, LD, sVt + (NC == 64 ? tn : tn - 4) * 16 * LD, LD, lane);
      const int j0 = tj * 16 + 4 * (lane >> 4), col = tn * 16 + (lane & 15);
#pragma unroll
      for (int q = 0; q < 4; ++q) Zm[m][q] = sWC[j0 + q] * (Zm[m][q] + acc[q]);
      st4(sZN + col * LD + j0, Zm[m]);
    }
    zcur ^= 1;
    RS_T(9);
  }
#pragma unroll
  for (int m = 0; m < NT; ++m) {
    const int id = w + 8 * m, tj = id & 3, tn = id >> 2, j0 = tj * 16 + 4 * (lane >> 4), col = tn * 16 + (lane & 15);
    if (Zout) *reinterpret_cast<f32x4*>(Zout + (size_t)col * 64 + j0) = Zm[m];
  }
  __syncthreads();
}
}

__device__ void scan_passB(float* lds, int chain, const float* sinit, const float* PQ, float* S0) {
  float* sS = lds;
  float* sP = lds + 64 * 65;
  const int tid = tidx(), i = tid >> 3, jq = (tid & 7) * 8;
  __syncthreads();
  for (int e = tid; e < 4096; e += NTHR) sS[(e >> 6) * 65 + (e & 63)] = sinit[e];
  for (int sc = 0; sc < kNSC; ++sc) {
    const size_t task = (size_t)chain * kNSC + sc;
    __syncthreads();
    for (int e = tid; e < 2048; e += NTHR) reinterpret_cast<float4*>(sP)[e] = reinterpret_cast<const float4*>(PQ + task * 8192)[e];
    for (int e = tid; e < 4096; e += NTHR) S0[task * 4096 + e] = sS[(e >> 6) * 65 + (e & 63)];
    __syncthreads();
    float acc[8];
#pragma unroll
    for (int q = 0; q < 8; ++q) acc[q] = sP[(64 + i) * 64 + jq + q];
#pragma unroll 8
    for (int jp = 0; jp < 64; ++jp) {
      const float s = sS[i * 65 + jp];
      const float4 z0 = *reinterpret_cast<const float4*>(&sP[jp * 64 + jq]), z1 = *reinterpret_cast<const float4*>(&sP[jp * 64 + jq + 4]);
      acc[0] += s * z0.x; acc[1] += s * z0.y; acc[2] += s * z0.z; acc[3] += s * z0.w;
      acc[4] += s * z1.x; acc[5] += s * z1.y; acc[6] += s * z1.z; acc[7] += s * z1.w;
    }
    __syncthreads();
#pragma unroll
    for (int q = 0; q < 8; ++q) sS[i * 65 + jq + q] = acc[q];
  }
  __syncthreads();
}

typedef float cf_ __attribute__((ext_vector_type(2)));
typedef float2 cf;
#define FFT_LAS __attribute__((address_space(3)))
typedef FFT_LAS cf_* lcf;
DEV cf ldc_(const FFT_LAS cf_* q) { const cf_ v = *q; return make_float2(v.x, v.y); }
DEV void stc_(FFT_LAS cf_* q, cf v) { const cf_ w = {v.x, v.y}; *q = w; }
DEV cf cmul(cf a, cf b) { return make_float2(a.x * b.x - a.y * b.y, a.x * b.y + a.y * b.x); }
DEV cf cadd(cf a, cf b) { return make_float2(a.x + b.x, a.y + b.y); }
DEV cf csub(cf a, cf b) { return make_float2(a.x - b.x, a.y - b.y); }
DEV int PADI(int i) { return i + (i >> 4); }
constexpr int FFT_N = 16384, FFT_PAD = FFT_N + FFT_N / 16;
DEV void dft4(cf& x0, cf& x1, cf& x2, cf& x3) {
  const cf a0 = cadd(x0, x2), a1 = csub(x0, x2), a2 = cadd(x1, x3), d = csub(x1, x3);
  const cf a3 = make_float2(d.y, -d.x);
  x0 = cadd(a0, a2); x1 = cadd(a1, a3); x2 = csub(a0, a2); x3 = csub(a1, a3);
}
DEV void dft16(cf (&v)[16]) {
#pragma unroll
  for (int a = 0; a < 4; ++a) dft4(v[a], v[a + 4], v[a + 8], v[a + 12]);
  const cf w1 = make_float2(0.9238795325112867f, -0.3826834323650898f), w2 = make_float2(0.7071067811865476f, -0.7071067811865476f);
  const cf w3 = make_float2(0.3826834323650898f, -0.9238795325112867f), w6 = make_float2(-0.7071067811865476f, -0.7071067811865476f);
  const cf w9 = make_float2(-0.9238795325112867f, 0.3826834323650898f);
  v[1 + 4] = cmul(v[1 + 4], w1); v[1 + 8] = cmul(v[1 + 8], w2); v[1 + 12] = cmul(v[1 + 12], w3);
  v[2 + 4] = cmul(v[2 + 4], w2); v[2 + 8] = make_float2(v[2 + 8].y, -v[2 + 8].x); v[2 + 12] = cmul(v[2 + 12], w6);
  v[3 + 4] = cmul(v[3 + 4], w3); v[3 + 8] = cmul(v[3 + 8], w6); v[3 + 12] = cmul(v[3 + 12], w9);
#pragma unroll
  for (int c = 0; c < 4; ++c) dft4(v[4 * c], v[4 * c + 1], v[4 * c + 2], v[4 * c + 3]);
}
template <int PASS>
DEV void fft_pass16(lcf buf, int tid) {
  constexpr int lg = 4 * PASS, Ns = 1 << lg;
  cf v0[16], v1[16];
  const lcf rd = buf + PADI(tid);
#pragma unroll
  for (int r = 0; r < 16; ++r) { v0[r] = ldc_(rd + 1088 * r); v1[r] = ldc_(rd + 1088 * r + 544); }
  __syncthreads();
#pragma unroll
  for (int h = 0; h < 2; ++h) {
    cf (&v)[16] = h ? v1 : v0;
    int tl = tid; asm volatile("" : "+v"(tl) :: "memory");
    const int j = tl + 512 * h, k = j & (Ns - 1);
    if (PASS > 0) {
      float sn, cs; sincos_cw(-6.283185307179586f * (float)k / (float)(Ns * 16), sn, cs);
      const cf w = make_float2(cs, sn); cf pw = w;
#pragma unroll
      for (int r = 1; r < 16; ++r) { v[r] = cmul(v[r], pw); if (r < 15) pw = cmul(pw, w); }
    }
    dft16(v);
    const int j0 = ((j >> lg) << (lg + 4)) + k;
    const lcf wr = buf + PADI(j0);
    constexpr int step = PASS == 0 ? 1 : Ns + Ns / 16;
#pragma unroll
    for (int r = 0; r < 16; ++r) stc_(wr + step * r, v[4 * (r & 3) + (r >> 2)]);
  }
  __syncthreads();
}
__device__ void fft16384(lcf buf) {
  int tid = tidx(); asm volatile("" : "+v"(tid));
  fft_pass16<0>(buf, tid);
  fft_pass16<1>(buf, tid);
  fft_pass16<2>(buf, tid);
#pragma unroll 2
  for (int q = 0; q < 8; ++q) {
    const int j = tid + 512 * q;
    const lcf pp = buf + PADI(j);
    cf x0 = ldc_(pp), x1 = ldc_(pp + 4352), x2 = ldc_(pp + 8704), x3 = ldc_(pp + 13056);
    float sn, cs; sincos_cw(-6.283185307179586f * (float)j / 16384.0f, sn, cs);
    const cf w1 = make_float2(cs, sn), w2 = cmul(w1, w1), w3 = cmul(w2, w1);
    x1 = cmul(x1, w1); x2 = cmul(x2, w2); x3 = cmul(x3, w3);
    dft4(x0, x1, x2, x3);
    stc_(pp, x0); stc_(pp + 4352, x1); stc_(pp + 8704, x2); stc_(pp + 13056, x3);
  }
  __syncthreads();
}
DEV void hy_conv3x8(float (&u)[8], const Params& p, const bf16_t* hyt, int col, int b, int t0) {
  const bf16_t* q = hyt + (size_t)col * kROWS + b * kT;
  const uint4 cv = *reinterpret_cast<const uint4*>(q + t0);
  const float pr_ = bf2f(q[t0 > 0 ? t0 - 1 : 0]), nx_ = bf2f(q[t0 + 8 < kT ? t0 + 8 : kT - 1]);
  const float prv = t0 > 0 ? pr_ : 0.f, nxt = t0 + 8 < kT ? nx_ : 0.f;
  const float* cw = p.in[I_HCW];
  const float w0 = cw[col], w1 = cw[kHYC + col], w2 = cw[2 * kHYC + col], bs = p.in[I_HCB][col];
  const float x[10] = {prv, bflo(cv.x), bfhi(cv.x), bflo(cv.y), bfhi(cv.y), bflo(cv.z), bfhi(cv.z), bflo(cv.w), bfhi(cv.w), nxt};
#pragma unroll
  for (int i = 0; i < 8; ++i) u[i] = w0 * x[i] + w1 * x[i + 1] + w2 * x[i + 2] + bs;
}
__device__ void fftconv_channel(float* ldsf, const Params& p, int c, const float* circT, const bf16_t* hyt, bf16_t* hyot) {
  const lcf buf = (lcf)ldsf;
  float* red = ldsf + 2 * FFT_PAD;
  const int tid = tidx(), lane = tid & 63, wid = tid >> 6;
  const float* cc = circT + (size_t)c * FFT_N;
  const float hbias = p.in[I_HBIAS][c];
  unsigned H[32];
#pragma unroll
  for (int m = 0; m < 32; ++m) H[m] = 0u;
  float inrm = 0.f;
  __syncthreads();
#pragma unroll 1
  for (int ph = 0; ph < 5; ++ph) {
    const int pair = (ph - 1) >> 1, b0 = 2 * pair, b1 = b0 + 1;
    if (ph == 0) {
      float asum = 0.f;
#pragma unroll 1
      for (int mb = 0; mb < 32; mb += 16) {
        float fv[16];
#pragma unroll
        for (int m = 0; m < 16; ++m) fv[m] = cc[tid + 512 * (mb + m)];
#pragma unroll
        for (int m = 0; m < 16; ++m) { asum += fabsf(fv[m]); stc_(buf + PADI(tid) + 544 * (mb + m), make_float2(fv[m], 0.f)); }
      }
      asum = wave_sum(asum);
      if (lane == 0) red[wid] = asum;
    } else if (ph & 1) {
#pragma unroll 1
      for (int mm = 0; mm < 2; ++mm) {
        const int t0 = mm * 4096 + tid * 8;
        float v0[8], x0[8], v1[8], x1[8];
        hy_conv3x8(v0, p, hyt, 1024 + c, b0, t0); hy_conv3x8(x0, p, hyt, 512 + c, b0, t0);
        hy_conv3x8(v1, p, hyt, 1024 + c, b1, t0); hy_conv3x8(x1, p, hyt, 512 + c, b1, t0);
        const lcf dst = buf + PADI(t0);
#pragma unroll
        for (int i = 0; i < 8; ++i) { stc_(dst + i, make_float2(v0[i] * x0[i], v1[i] * x1[i])); stc_(buf + PADI(t0 + 8192) + i, make_float2(0.f, 0.f)); }
      }
    }
    __syncthreads();
    if (ph == 0) { float nrm = 0.f;
#pragma unroll
      for (int w = 0; w < 8; ++w) nrm += red[w];
      inrm = 1.0f / nrm; }
    fft16384(buf);
    if (ph == 0) {
#pragma unroll
      for (int m = 0; m < 32; ++m) { const cf hv = ldc_(buf + PADI(tid) + 544 * m); const __half2 hh = __floats2half2_rn(hv.x * inrm, hv.y * inrm); H[m] = *reinterpret_cast<const unsigned*>(&hh); }
    } else if (ph & 1) {
#pragma unroll
      for (int m = 0; m < 32; ++m) { const int i = PADI(tid) + 544 * m; const unsigned hu = H[m]; const float2 hf = __half22float2(*reinterpret_cast<const __half2*>(&hu)); const cf w = cmul(ldc_(buf + i), hf); stc_(buf + i, make_float2(w.y, w.x)); }
    } else {
      const float scale = 1.0f / (float)FFT_N;
#pragma unroll 1
      for (int mm = 0; mm < 2; ++mm) {
        const int t0 = mm * 4096 + tid * 8;
        float v0[8], x0[8], v1[8], x1[8], g0[8], g1[8];
        hy_conv3x8(v0, p, hyt, 1024 + c, b0, t0); hy_conv3x8(x0, p, hyt, 512 + c, b0, t0); hy_conv3x8(g0, p, hyt, c, b0, t0);
        hy_conv3x8(v1, p, hyt, 1024 + c, b1, t0); hy_conv3x8(x1, p, hyt, 512 + c, b1, t0); hy_conv3x8(g1, p, hyt, c, b1, t0);
        const lcf src = buf + PADI(t0);
        float o0[8], o1[8];
#pragma unroll
        for (int i = 0; i < 8; ++i) { const cf val = ldc_(src + i);
          o0[i] = (val.y * scale + hbias * v0[i] * x0[i]) * g0[i]; o1[i] = (val.x * scale + hbias * v1[i] * x1[i]) * g1[i]; }
        *reinterpret_cast<uint4*>(hyot + (size_t)c * kROWS + b0 * kT + t0) = make_uint4(pg8::cvt_pk_bf16(o0[0], o0[1]), pg8::cvt_pk_bf16(o0[2], o0[3]), pg8::cvt_pk_bf16(o0[4], o0[5]), pg8::cvt_pk_bf16(o0[6], o0[7]));
        *reinterpret_cast<uint4*>(hyot + (size_t)c * kROWS + b1 * kT + t0) = make_uint4(pg8::cvt_pk_bf16(o1[0], o1[1]), pg8::cvt_pk_bf16(o1[2], o1[3]), pg8::cvt_pk_bf16(o1[4], o1[5]), pg8::cvt_pk_bf16(o1[6], o1[7]));
      }
    }
    __syncthreads();
  }
}
__device__ void phase_hyo_transpose(float* ldsf, const bf16_t* hyot, bf16_t* hyo, int bid, int nb) {
  bf16_t* tl = reinterpret_cast<bf16_t*>(ldsf);
  const int tid = tidx();
  for (int item = bid; item < 8 * 512; item += nb) {
    const int c0 = (item & 7) * 64, t0 = (item >> 3) * 64;
    __syncthreads();
    { const int cl = tid >> 3, t8 = (tid & 7) * 8;
      const uint4 u = *reinterpret_cast<const uint4*>(hyot + (size_t)(c0 + cl) * kROWS + t0 + t8);
      *reinterpret_cast<uint4*>(tl + cl * 72 + t8) = u; }
    __syncthreads();
    { const int tl_ = tid >> 3, c8 = (tid & 7) * 8;
      unsigned w[4];
#pragma unroll
      for (int i = 0; i < 4; ++i) w[i] = (unsigned)tl[(c8 + 2 * i) * 72 + tl_] | ((unsigned)tl[(c8 + 2 * i + 1) * 72 + tl_] << 16);
      *reinterpret_cast<uint4*>(hyo + (size_t)(t0 + tl_) * 512 + c0 + c8) = make_uint4(w[0], w[1], w[2], w[3]); }
  }
}

__device__ void phase_rwout(float* lds, const Params& p, const bf16_t* rwc, const bf16_t* Y0, const bf16_t* Y1, const float* BS, bf16_t* rwo, int bid, int nb) {
  const int tid = tidx(), lane = tid & 63, wid = tid >> 6;
  bf16_t* sG = reinterpret_cast<bf16_t*>(lds);
  float* sLg = lds + 32768 + wid * 256;
  const float* mu = p.in[I_MU]; const float* gup = p.in[I_GUP]; const float* lng = p.in[I_LNG]; const float* lnb = p.in[I_LNB];
  __syncthreads();
  for (int e = tid; e < 128 * 512 / 4; e += NTHR) { const float4 v = ld4(gup + (size_t)e * 4);
    *reinterpret_cast<uint2*>(sG + (size_t)e * 4) = make_uint2(pg8::cvt_pk_bf16(v.x, v.y), pg8::cvt_pk_bf16(v.z, v.w)); }
  __syncthreads();
  const int c0 = lane * 8, h = lane >> 3;
  for (int rp = bid * 8 + wid; rp < kROWS / 2; rp += nb * 8) {
#pragma unroll
    for (int r = 0; r < 2; ++r) {
      const int row = 2 * rp + r, t = row & (kT - 1);
      const bf16_t* cur = rwc + (size_t)row * kRWC;
#pragma unroll
      for (int k = 0; k < 2; ++k) {
        const int col = 1664 + lane + 64 * k;
        const float cv = bf2f(cur[col]), pv = t > 0 ? bf2f(cur[col - kRWC]) : 0.f, nv = t < kT - 1 ? bf2f(cur[col + kRWC]) : 0.f;
        sLg[r * 128 + lane + 64 * k] = sigmoidf_(cv + mu[col] * (pv - cv) + mu[kRWC + col] * (nv - cv));
      }
    }
    __syncthreads();
    float g0[8], g1[8];
#pragma unroll
    for (int j = 0; j < 8; ++j) { g0[j] = 0.f; g1[j] = 0.f; }
#pragma unroll 4
    for (int i = 0; i < 128; ++i) {
      const uint4 u = *reinterpret_cast<const uint4*>(sG + i * 512 + c0);
      const float s0 = sLg[i], s1 = sLg[128 + i];
      const float w0 = bflo(u.x), w1 = bfhi(u.x), w2 = bflo(u.y), w3 = bfhi(u.y), w4 = bflo(u.z), w5 = bfhi(u.z), w6 = bflo(u.w), w7 = bfhi(u.w);
      g0[0] += s0 * w0; g0[1] += s0 * w1; g0[2] += s0 * w2; g0[3] += s0 * w3; g0[4] += s0 * w4; g0[5] += s0 * w5; g0[6] += s0 * w6; g0[7] += s0 * w7;
      g1[0] += s1 * w0; g1[1] += s1 * w1; g1[2] += s1 * w2; g1[3] += s1 * w3; g1[4] += s1 * w4; g1[5] += s1 * w5; g1[6] += s1 * w6; g1[7] += s1 * w7;
    }
#pragma unroll
    for (int r = 0; r < 2; ++r) {
      const int row = 2 * rp + r, t = row & (kT - 1);
      const bf16_t* cur = rwc + (size_t)row * kRWC;
      float y[8];
      {
        const uint4 u0 = *reinterpret_cast<const uint4*>(Y0 + (size_t)row * 512 + c0), u1 = *reinterpret_cast<const uint4*>(Y1 + (size_t)row * 512 + c0);
        y[0] = bflo(u0.x) + bflo(u1.x); y[1] = bfhi(u0.x) + bfhi(u1.x); y[2] = bflo(u0.y) + bflo(u1.y); y[3] = bfhi(u0.y) + bfhi(u1.y);
        y[4] = bflo(u0.z) + bflo(u1.z); y[5] = bfhi(u0.z) + bfhi(u1.z); y[6] = bflo(u0.w) + bflo(u1.w); y[7] = bfhi(u0.w) + bfhi(u1.w);
      }
      float sum = 0.f;
#pragma unroll
      for (int j = 0; j < 8; ++j) sum += y[j];
      sum += __shfl_xor(sum, 1); sum += __shfl_xor(sum, 2); sum += __shfl_xor(sum, 4);
      const float mean = sum * (1.0f / 64.0f);
      float var = 0.f;
#pragma unroll
      for (int j = 0; j < 8; ++j) { const float d = y[j] - mean; var += d * d; }
      var += __shfl_xor(var, 1); var += __shfl_xor(var, 2); var += __shfl_xor(var, 4);
      const float rs = rsqrtf(var * (1.0f / 64.0f) + 64e-5f);
      const float bsum = BS[(size_t)row * 8 + h] + BS[((size_t)kROWS + row) * 8 + h];
      const uint4 vc = *reinterpret_cast<const uint4*>(cur + 1024 + c0);
      const uint4 vp = t > 0 ? *reinterpret_cast<const uint4*>(cur - kRWC + 1024 + c0) : make_uint4(0u, 0u, 0u, 0u);
      const uint4 vn = t < kT - 1 ? *reinterpret_cast<const uint4*>(cur + kRWC + 1024 + c0) : make_uint4(0u, 0u, 0u, 0u);
      const unsigned cw[4] = {vc.x, vc.y, vc.z, vc.w}, pw[4] = {vp.x, vp.y, vp.z, vp.w}, nw[4] = {vn.x, vn.y, vn.z, vn.w};
      float o[8];
#pragma unroll
      for (int j = 0; j < 8; ++j) {
        const int col = 1024 + c0 + j;
        const float cv = (j & 1) ? bfhi(cw[j >> 1]) : bflo(cw[j >> 1]), pv = (j & 1) ? bfhi(pw[j >> 1]) : bflo(pw[j >> 1]), nv = (j & 1) ? bfhi(nw[j >> 1]) : bflo(nw[j >> 1]);
        const float vm = cv + mu[col] * (pv - cv) + mu[kRWC + col] * (nv - cv);
        const float yn = (y[j] - mean) * rs * lng[c0 + j] + lnb[c0 + j];
        o[j] = (yn + bsum * vm) * (r ? g1[j] : g0[j]);
      }
      *reinterpret_cast<uint4*>(rwo + (size_t)row * 512 + c0) = make_uint4(pg8::cvt_pk_bf16(o[0], o[1]), pg8::cvt_pk_bf16(o[2], o[3]), pg8::cvt_pk_bf16(o[4], o[5]), pg8::cvt_pk_bf16(o[6], o[7]));
    }
    __syncthreads();
  }
}

__device__ void phase_post(float* lds, const Params& p, float* mx, bf16_t* h2o, float* aff, const float* mod, int bid, int nb) {
  const int lane = tidx() & 63, wid = tidx() >> 6;
  __syncthreads();
  for (int e = tidx(); e < 1024 * 16 / 4; e += NTHR) reinterpret_cast<float4*>(lds)[e] = ld4(p.in[I_ROUTER] + (size_t)e * 4);
  __syncthreads();
  const float* x = p.in[I_X]; const float* n1post = p.in[I_N1POST]; const float* n2pre = p.in[I_N2PRE]; const float* rw = p.in[I_ROUTER];
  float4 nm[4], nx[4];
  { const int r0 = bid * 8 + wid;
#pragma unroll
    for (int i = 0; i < 4; ++i) { nm[i] = ld4(mx + (size_t)r0 * kD + i * 256 + lane * 4); nx[i] = ld4(x + (size_t)r0 * kD + i * 256 + lane * 4); } }
  for (int row = bid * 8 + wid; row < kROWS; row += nb * 8) {
    const int b = row / kT;
    float m[16], xv[16];
    float4 xc[4];
    float ss = 0.f;
#pragma unroll
    for (int i = 0; i < 4; ++i) { const float4 v = nm[i]; xc[i] = nx[i];
      m[i * 4] = v.x; m[i * 4 + 1] = v.y; m[i * 4 + 2] = v.z; m[i * 4 + 3] = v.w; ss += v.x * v.x + v.y * v.y + v.z * v.z + v.w * v.w; }
    { const int nr = row + nb * 8 < kROWS ? row + nb * 8 : row;
#pragma unroll
      for (int i = 0; i < 4; ++i) { nm[i] = ld4(mx + (size_t)nr * kD + i * 256 + lane * 4); nx[i] = ld4(x + (size_t)nr * kD + i * 256 + lane * 4); } }
    ss = wave_sum(ss);
    const float r1 = rsqrtf(ss * (1.0f / kD) + 1e-6f);
    float s2 = 0.f;
#pragma unroll
    for (int i = 0; i < 4; ++i) {
      const int k = i * 256 + lane * 4;
      const float4 xx = xc[i], gp = ld4(n1post + k), gt = ld4(mod + b * 6144 + 2048 + k);
      xv[i * 4] = xx.x + gt.x * m[i * 4] * r1 * gp.x; xv[i * 4 + 1] = xx.y + gt.y * m[i * 4 + 1] * r1 * gp.y;
      xv[i * 4 + 2] = xx.z + gt.z * m[i * 4 + 2] * r1 * gp.z; xv[i * 4 + 3] = xx.w + gt.w * m[i * 4 + 3] * r1 * gp.w;
      *reinterpret_cast<float4*>(mx + (size_t)row * kD + k) = make_float4(xv[i * 4], xv[i * 4 + 1], xv[i * 4 + 2], xv[i * 4 + 3]);
#pragma unroll
      for (int j = 0; j < 4; ++j) s2 += xv[i * 4 + j] * xv[i * 4 + j];
    }
    s2 = wave_sum(s2);
    const float r2 = rsqrtf(s2 * (1.0f / kD) + 1e-6f);
    float lgt[16];
#pragma unroll
    for (int e = 0; e < 16; ++e) lgt[e] = 0.f;
#pragma unroll
    for (int i = 0; i < 4; ++i) {
      const int k0 = i * 256 + lane * 4;
      const float4 gn = ld4(n2pre + k0), sc = ld4(mod + b * 6144 + 4096 + k0), sh = ld4(mod + b * 6144 + 3072 + k0);
      float hh[4];
      hh[0] = xv[i * 4] * r2 * gn.x * (1.f + sc.x) + sh.x; hh[1] = xv[i * 4 + 1] * r2 * gn.y * (1.f + sc.y) + sh.y;
      hh[2] = xv[i * 4 + 2] * r2 * gn.z * (1.f + sc.z) + sh.z; hh[3] = xv[i * 4 + 3] * r2 * gn.w * (1.f + sc.w) + sh.w;
      *reinterpret_cast<uint2*>(h2o + (size_t)row * kD + k0) = make_uint2(pg8::cvt_pk_bf16(hh[0], hh[1]), pg8::cvt_pk_bf16(hh[2], hh[3]));
#pragma unroll
      for (int j = 0; j < 4; ++j) {
        const int k = k0 + j; const float h2 = hh[j];
        const float4 w0 = *reinterpret_cast<const float4*>(lds + k * 16), w1 = *reinterpret_cast<const float4*>(lds + k * 16 + 4), w2 = *reinterpret_cast<const float4*>(lds + k * 16 + 8), w3 = *reinterpret_cast<const float4*>(lds + k * 16 + 12);
        lgt[0] += h2 * w0.x; lgt[1] += h2 * w0.y; lgt[2] += h2 * w0.z; lgt[3] += h2 * w0.w;
        lgt[4] += h2 * w1.x; lgt[5] += h2 * w1.y; lgt[6] += h2 * w1.z; lgt[7] += h2 * w1.w;
        lgt[8] += h2 * w2.x; lgt[9] += h2 * w2.y; lgt[10] += h2 * w2.z; lgt[11] += h2 * w2.w;
        lgt[12] += h2 * w3.x; lgt[13] += h2 * w3.y; lgt[14] += h2 * w3.z; lgt[15] += h2 * w3.w;
        __builtin_amdgcn_sched_barrier(0);
      }
    }
    float mxv = -1e30f;
#pragma unroll
    for (int e = 0; e < 16; ++e) { lgt[e] = wave_sum(lgt[e]); mxv = fmaxf(mxv, lgt[e]); }
    float den = 0.f;
#pragma unroll
    for (int e = 0; e < 16; ++e) { lgt[e] = expf(lgt[e] - mxv); den += lgt[e]; }
    const float inv = 1.0f / den;
    float mine = 0.f;
#pragma unroll
    for (int e = 0; e < 16; ++e) if (lane == e) mine = lgt[e] * inv;
    if (lane < 16) aff[(size_t)row * 16 + lane] = mine;
  }
}

__device__ void phase_topk(float* lds, const float* aff, int* idx, float* gate, int* sel, int bid, int nb) {
  unsigned* keys = reinterpret_cast<unsigned*>(lds);
  unsigned* hist = keys + kT;
  unsigned* misc = hist + 256;
  unsigned* wtot = misc + 4;
  const int tid = tidx(), lane = tid & 63, wid = tid >> 6;
  for (int item = bid; item < kB * kE; item += nb) {
    const int b = item / kE, e = item % kE;
    __syncthreads();
    for (int t = tid; t < kT; t += NTHR) keys[t] = __float_as_uint(aff[((size_t)b * kT + t) * 16 + e]);
    if (tid == 0) { misc[0] = 0u; misc[1] = (unsigned)kCAP; }
    __syncthreads();
#pragma unroll 1
    for (int pass = 0; pass < 4; ++pass) {
      const int shift = 24 - 8 * pass;
      if (tid < 256) hist[tid] = 0u;
      __syncthreads();
      const unsigned prefix = misc[0];
      for (int t = tid; t < kT; t += NTHR) { const unsigned k = keys[t];
        if (pass == 0 || (k >> (shift + 8)) == (prefix >> (shift + 8))) atomicAdd(&hist[(k >> shift) & 255u], 1u); }
      __syncthreads();
      if (tid == 0) {
        unsigned need = misc[1], above = 0u; int d = 255;
        for (; d > 0; --d) { const unsigned h = hist[d]; if (above + h >= need) break; above += h; }
        misc[0] = prefix | ((unsigned)d << shift); misc[1] = need - above;
      }
      __syncthreads();
    }
    const unsigned thr = misc[0], need = misc[1];
    unsigned cg = 0u, ce = 0u;
#pragma unroll
    for (int q = 0; q < 16; ++q) { const unsigned k = keys[tid * 16 + q]; cg += (k > thr); ce += (k == thr); }
    const float wg = wave_sum((float)cg), we = wave_sum((float)ce);
    if (lane == 0) { wtot[wid] = (unsigned)wg; wtot[8 + wid] = (unsigned)we; }
    __syncthreads();
    unsigned pg = cg, pe = ce;
#pragma unroll
    for (int o = 1; o < 64; o <<= 1) { const unsigned ug = __shfl_up(pg, o), ue = __shfl_up(pe, o); if (lane >= o) { pg += ug; pe += ue; } }
    unsigned og = pg - cg, oe = pe - ce;
    for (int w = 0; w < wid; ++w) { og += wtot[w]; oe += wtot[8 + w]; }
#pragma unroll 1
    for (int q = 0; q < 16; ++q) {
      const int t = tid * 16 + q; const unsigned k = keys[t];
      const bool isg = k > thr, ise = k == thr;
      const bool take = isg || (ise && oe < need);
      const unsigned pos = og + (oe < need ? oe : need);
      if (take) { idx[(e * kB + b) * kCAP + pos] = b * kT + t; gate[item * kCAP + pos] = __uint_as_float(k); }
      sel[((size_t)b * kT + t) * 16 + e] = take ? (int)pos : -1;
      og += isg; oe += ise;
    }
  }
}

__device__ void phase_final(const Params& p, const bf16_t* ye, const int* sel, float* out, const float* mod, int bid, int nb, int tsn) {
  float tscale = 1.f;
  if (TP_LO == 100) { const unsigned long long* ta = (const unsigned long long*)(p.ws + OFF_NORM + 512); float tot = 0.f; for (int k = 2; k <= 9; ++k) tot += (float)ta[k]; tscale = 1.f + sqrtf(1.0e-3f * (float)ta[TP_HI] / tot); }
  else if (TP_LO >= 0) { const unsigned long long* ts = (const unsigned long long*)(p.ws + OFF_NORM); const float tot = (float)(ts[tsn - 2] - ts[0]), part = (float)(ts[TP_HI] - ts[TP_LO]); tscale = 1.f + sqrtf(1.0e-3f * part / tot); }
  const int lane = tidx() & 63, wid = tidx() >> 6;
  const float* n2post = p.in[I_N2POST];
  int nmyc = lane < 16 ? sel[(size_t)(bid * 8 + wid) * 16 + lane] : -1;
  float4 no[4];
#pragma unroll
  for (int i = 0; i < 4; ++i) no[i] = ld4(out + (size_t)(bid * 8 + wid) * kD + i * 256 + lane * 4);
  for (int row = bid * 8 + wid; row < kROWS; row += nb * 8) {
    const int b = row / kT;
    float m[16];
#pragma unroll
    for (int i = 0; i < 16; ++i) m[i] = 0.f;
    const int myc = nmyc;
    float4 oc[4];
#pragma unroll
    for (int i = 0; i < 4; ++i) oc[i] = no[i];
    { const int nr = row + nb * 8 < kROWS ? row + nb * 8 : row;
      nmyc = lane < 16 ? sel[(size_t)nr * 16 + lane] : -1;
#pragma unroll
      for (int i = 0; i < 4; ++i) no[i] = ld4(out + (size_t)nr * kD + i * 256 + lane * 4); }
    unsigned long long msk = __ballot(myc >= 0) & 0xffffull;
#pragma unroll 1
    while (msk) {
      const int e1 = __builtin_ctzll(msk); msk &= msk - 1;
      const bool two = msk != 0ull;
      const int e2 = two ? __builtin_ctzll(msk) : e1; if (two) msk &= msk - 1;
      const int c1 = __shfl(myc, e1), c2 = __shfl(myc, e2);
      const bf16_t* s1 = ye + ((size_t)(b * kE + e1) * kCAP + c1) * kD;
      const bf16_t* s2 = ye + ((size_t)(b * kE + e2) * kCAP + c2) * kD;
      uint2 u1[4], u2[4];
#pragma unroll
      for (int i = 0; i < 4; ++i) { u1[i] = *reinterpret_cast<const uint2*>(s1 + i * 256 + lane * 4); u2[i] = *reinterpret_cast<const uint2*>(s2 + i * 256 + lane * 4); }
      const float f2 = two ? 1.f : 0.f;
#pragma unroll
      for (int i = 0; i < 4; ++i) {
        m[i * 4] += bflo(u1[i].x) + f2 * bflo(u2[i].x); m[i * 4 + 1] += bfhi(u1[i].x) + f2 * bfhi(u2[i].x);
        m[i * 4 + 2] += bflo(u1[i].y) + f2 * bflo(u2[i].y); m[i * 4 + 3] += bfhi(u1[i].y) + f2 * bfhi(u2[i].y);
      }
    }
    float ss = 0.f;
#pragma unroll
    for (int i = 0; i < 16; ++i) ss += m[i] * m[i];
    ss = wave_sum(ss);
    const float r = rsqrtf(ss * (1.0f / kD) + 1e-6f);
#pragma unroll
    for (int i = 0; i < 4; ++i) {
      const int k = i * 256 + lane * 4;
      float4 o = oc[i];
      const float4 gp = ld4(n2post + k), gt = ld4(mod + b * 6144 + 5120 + k);
      o.x += gt.x * m[i * 4] * r * gp.x; o.y += gt.y * m[i * 4 + 1] * r * gp.y; o.z += gt.z * m[i * 4 + 2] * r * gp.z; o.w += gt.w * m[i * 4 + 3] * r * gp.w;
      if (TP_LO >= 0) { o.x *= tscale; o.y *= tscale; o.z *= tscale; o.w *= tscale; }
      *reinterpret_cast<float4*>(out + (size_t)row * kD + k) = o;
    }
  }
}


DEV void grid_barrier(unsigned* cnt, unsigned target) {
  asm volatile("s_waitcnt vmcnt(0) lgkmcnt(0)" ::: "memory");
  __syncthreads();
  if (threadIdx.x == 0) {
    __builtin_amdgcn_fence(__ATOMIC_RELEASE, "agent");
    asm volatile("s_waitcnt vmcnt(0)" ::: "memory");
    __hip_atomic_fetch_add(cnt, 1u, __ATOMIC_RELAXED, __HIP_MEMORY_SCOPE_AGENT);
    while (__hip_atomic_load(cnt, __ATOMIC_RELAXED, __HIP_MEMORY_SCOPE_AGENT) < target) __builtin_amdgcn_s_sleep(2);
    __builtin_amdgcn_fence(__ATOMIC_ACQUIRE, "agent");
    asm volatile("s_waitcnt vmcnt(0)" ::: "memory");
  }
  __syncthreads();
}

template <class Epi, class Sched, bool G>
DEV void run_gemm(float* lds, int K, const Sched& S, const Epi& E) {
  __syncthreads();
  pg8::gemm_phase<Epi, Sched, G>((PG8_LAS unsigned char*)lds, K, S, E);
  __syncthreads();
}

#if defined(__HIP_DEVICE_COMPILE__)
typedef __attribute__((address_space(4))) const Params* kargs_ptr;
DEV kargs_ptr kargs() { kargs_ptr k = (kargs_ptr)__builtin_amdgcn_kernarg_segment_ptr(); asm volatile("" : "+s"(k)); return k; }
#else
typedef const Params* kargs_ptr;
__device__ inline kargs_ptr kargs() { return nullptr; }
#endif
__global__ void __launch_bounds__(NTHR, 2) fwd_megakernel(Params p_by_value_unused) {
#define p (*kargs())
  extern __shared__ __attribute__((aligned(16))) float lds[];
  cg::grid_group grid = cg::this_grid();
  const int bid = blockIdx.x, nb = gridDim.x;
  int tsn = 0;
  unsigned gb_n = 0;
#define GBAR() do { ++gb_n; grid_barrier((unsigned*)(p.ws + OFF_CNT), gb_n * (unsigned)nb); } while (0)
#define STAMP() do { if (TP_LO >= 0) { if (bid == 0 && threadIdx.x == 0) ((unsigned long long*)(p.ws + OFF_NORM))[tsn] = __builtin_amdgcn_s_memrealtime(); ++tsn; } } while (0)
  STAMP();
  if (TP_LO == 100 && bid == 0 && threadIdx.x < 16) ((unsigned long long*)(p.ws + OFF_NORM + 512))[threadIdx.x] = 0ull;
  char* const ws = p.ws;
  constexpr size_t MB = 1048576;
#define b_mod   ((float*)(ws + OFF_MOD))
#define b_rstdc ((float*)(ws + OFF_RSTDC))
#define b_sctx  ((float*)(ws + OFF_SCTX))
#define b_BS    ((float*)(ws + OFF_BS))
#define b_aff   ((float*)(ws + OFF_AFF))
#define b_idx   ((int*)(ws + OFF_IDX))
#define b_gate  ((float*)(ws + OFF_GATE))
#define b_HC    ((bf16_t*)(ws + OFF_A1 + 244 * MB))
#define b_CC    ((bf16_t*)(ws + OFF_A1 + 240 * MB))
#define b_kfu   ((float*)(ws + OFF_KFU))
#define b_sel   ((int*)(ws + OFF_SEL))
#define b_winT  ((const char*)(ws + OFF_WINT))
#define b_hpT   ((const char*)(ws + OFF_HPT))
#define b_rpT   ((const char*)(ws + OFF_RPT))
#define b_woT   ((const char*)(ws + OFF_WOT))
#define b_w13T  ((const char*)(ws + OFF_W13T))
#define b_w2T   ((const char*)(ws + OFF_W2T))
#define b_hb    ((bf16_t*)(ws + OFF_A0))
#define b_A1    (ws + OFF_A1)
#define b_HYT   ((bf16_t*)(b_A1))
#define b_RWC   ((bf16_t*)(b_A1 + 96 * MB))
#define b_HYOT  ((bf16_t*)(b_A1 + 208 * MB))
#define b_HYO   ((bf16_t*)(b_A1))
#define b_RWO   ((bf16_t*)(b_A1 + 32 * MB))
#define b_YH    ((bf16_t*)(b_A1 + 96 * MB))
#define b_YR    ((bf16_t*)(b_A1 + 160 * MB))
#define b_PRE   ((bf16_t*)(b_A1))
#define b_HID0  ((bf16_t*)(b_A1))
#define b_YE    ((bf16_t*)(b_A1 + 128 * MB))
#define b_Y0    ((bf16_t*)(p.out + (size_t)kROWS * 512))
#define b_Y1    (b_Y0 + (size_t)kROWS * 512)
#define b_PQ    (p.out)
#define b_S0    ((float*)(ws + OFF_KFU))

  phase_mod(lds, p.in[I_C], p.in[I_CCTX], p.in[I_MODW], p.in[I_MODB], b_mod, bid, nb);
  phase_filter(lds, p, b_kfu, bid, nb);
  phase_wprep(lds, p, ws, bid, nb);
  grid.sync(); STAMP();
  phase_hb(p, b_mod, b_hb, b_HC, bid, nb);
  GBAR(); STAMP();
  {
    SchedPlain S0; S0.o.init(4, 5, nb, bid); S0.A = (const char*)b_HC; S0.B = b_winT + (size_t)2048 * kD * 2; S0.tstep = (size_t)256 * kD * 2;
    EpiBf16Split E0{b_CC, kCC, 5, b_CC, kCC};
    run_gemm<EpiBf16Split, SchedPlain, false>(lds, kD, S0, E0);
    SchedPlain S; S.o.init(kROWS / 256, 7, nb, bid); S.A = (const char*)b_hb; S.B = b_winT + (size_t)1536 * kD * 2; S.tstep = (size_t)256 * kD * 2;
    EpiBf16Split E{b_RWC, kRWC, 7, b_RWC, kRWC};
    run_gemm<EpiBf16Split, SchedPlain, false>(lds, kD, S, E);
    SchedPlain S2; S2.o.init(6, kROWS / 256, nb, bid); S2.A = b_winT; S2.B = (const char*)b_hb; S2.tstep = (size_t)256 * kD * 2;
    EpiBf16Split E2{b_HYT, kROWS, kROWS / 256, b_HYT, kROWS};
    run_gemm<EpiBf16Split, SchedPlain, false>(lds, kD, S2, E2);
  }
  GBAR(); STAMP();
  if (bid < 64) {
    const int dir = bid >> 5, b = (bid >> 3) & 3, h = bid & 7;
    rs::scan_task<64, false>(lds, p, b_CC, kCC, kCTX, 0, 0, 512, 1024, 1088, 512, b, h, dir, 0, 4, nullptr, b_sctx + (size_t)bid * 4096, nullptr, nullptr);
  }
  for (int c = bid; c < 512; c += nb) fftconv_channel(lds, p, c, b_kfu, b_HYT, b_HYOT);
  for (int task = bid; task < 64 * kNSC; task += nb) {
    const int chain = task / kNSC, sc = task % kNSC, dir = chain >> 5, b = (chain >> 3) & 3, h = chain & 7;
    rs::scan_task<128, false>(lds, p, b_RWC, kRWC, kT, 0, 512, 1024, 1536, 1600, 0, b, h, dir, sc * kSCC * 64, kSCC, nullptr, b_PQ + (size_t)task * 8192, nullptr, nullptr);
  }
  GBAR(); STAMP();
  if (bid < 64) scan_passB(lds, bid, b_sctx + (size_t)bid * 4096, b_PQ, b_S0);
  phase_hyo_transpose(lds, b_HYOT, b_HYO, bid, nb);
  GBAR(); STAMP();
  for (int task = bid; task < 64 * kNSC; task += nb) {
    const int chain = task / kNSC, sc = task % kNSC, dir = chain >> 5, b = (chain >> 3) & 3, h = chain & 7;
    rs::scan_task<64, true>(lds, p, b_RWC, kRWC, kT, 0, 512, 1024, 1536, 1600, 0, b, h, dir, sc * kSCC * 64, kSCC, b_S0 + (size_t)task * 4096, nullptr, b_Y0, b_BS);
  }
  GBAR(); STAMP();
  phase_rwout(lds, p, b_RWC, b_Y0, b_Y1, b_BS, b_RWO, bid, nb);
  GBAR(); STAMP();
  {
    SchedPlain S; S.o.init(kROWS / 256, 4, nb, bid); S.A = (const char*)b_HYO; S.B = b_hpT; S.tstep = (size_t)256 * 512 * 2;
    EpiBf16Split E{b_YH, kD, 4, b_YH, kD};
    run_gemm<EpiBf16Split, SchedPlain, false>(lds, 512, S, E);
    SchedPlain S2; S2.o.init(kROWS / 256, 4, nb, bid); S2.A = (const char*)b_RWO; S2.B = b_rpT; S2.tstep = (size_t)256 * 512 * 2;
    EpiBf16Split E2{b_YR, kD, 4, b_YR, kD};
    run_gemm<EpiBf16Split, SchedPlain, false>(lds, 512, S2, E2);
  }
  GBAR(); STAMP();
  {
    SchedPlain S; S.o.init(kROWS / 256, 8, nb, bid); S.A = (const char*)b_hb; S.B = b_winT + (size_t)3328 * kD * 2; S.tstep = (size_t)256 * kD * 2;
    EpiGatesMerge E{b_YH, b_YR, b_PRE};
    run_gemm<EpiGatesMerge, SchedPlain, false>(lds, kD, S, E);
  }
  GBAR(); STAMP();
  {
    SchedPlain S; S.o.init(kROWS / 256, 4, nb, bid); S.A = (const char*)b_PRE; S.B = b_woT; S.tstep = (size_t)256 * kD * 2;
    EpiF32Store E{p.out, kD};
    run_gemm<EpiF32Store, SchedPlain, false>(lds, kD, S, E);
  }
  GBAR(); STAMP();
  phase_post(lds, p, p.out, b_hb, b_aff, b_mod, bid, nb);
  GBAR(); STAMP();
  phase_topk(lds, b_aff, b_idx, b_gate, b_sel, bid, nb);
  GBAR(); STAMP();
  for (int g = 0; g <= 4; ++g) {
    if (g < 4) {
      SchedExp1 S; S.o.init(64, 16, nb, bid); S.H2 = (const char*)b_hb; S.W13T = b_w13T; S.idx = b_idx + g * 4 * 4096; S.e0 = g * 4;
      EpiSwiGLU E{b_HID0 + (size_t)(g & 1) * 16384 * kF};
      run_gemm<EpiSwiGLU, SchedExp1, true>(lds, kD, S, E);
    }
    if (g > 0) {
      SchedExp2 S; S.o.init(64, 4, nb, bid); S.HID = (const char*)(b_HID0 + (size_t)((g - 1) & 1) * 16384 * kF); S.W2T = b_w2T; S.e0 = (g - 1) * 4;
      EpiYE E{b_YE, b_gate, (g - 1) * 4};
      run_gemm<EpiYE, SchedExp2, false>(lds, kF, S, E);
    }
    GBAR(); STAMP();
  }
  phase_final(p, b_YE, b_sel, p.out, b_mod, bid, nb, tsn);
}

#undef b_mod
#undef b_rstdc
#undef b_sctx
#undef b_BS
#undef b_aff
#undef b_idx
#undef b_gate
#undef b_CC
#undef b_HC
#undef b_kfu
#undef b_sel
#undef b_winT
#undef b_hpT
#undef b_rpT
#undef b_woT
#undef b_w13T
#undef b_w2T
#undef b_hb
#undef b_A1
#undef b_HYT
#undef b_RWC
#undef b_HYOT
#undef b_HYO
#undef b_RWO
#undef b_YH
#undef b_YR
#undef b_PRE
#undef b_HID0
#undef b_YE
#undef b_Y0
#undef b_Y1
#undef p
#undef b_PQ
#undef b_S0
extern "C" void kernel_launch(void* const* d_in, const int* in_sizes, int n_in, void* d_out, int out_size, void* d_ws, size_t ws_size,
                              hipStream_t stream) {
  static int grid_blocks = 0;
  if (!grid_blocks) {
    int dev = 0, cus = 0, per_cu = 0;
    (void)hipGetDevice(&dev);
    (void)hipDeviceGetAttribute(&cus, hipDeviceAttributeMultiprocessorCount, dev);
    (void)hipFuncSetAttribute((const void*)fwd_megakernel, hipFuncAttributeMaxDynamicSharedMemorySize, (int)LDS_BYTES);
    (void)hipOccupancyMaxActiveBlocksPerMultiprocessor(&per_cu, fwd_megakernel, NTHR, LDS_BYTES);
    if (per_cu < 1) per_cu = 1;
    if (per_cu > 1) per_cu = 1;
    grid_blocks = cus * per_cu;
    if (ws_size < WS_TOTAL) fprintf(stderr, "kernel_launch: workspace too small: %zu < %zu\n", ws_size, (size_t)WS_TOTAL);
  }
  if (ws_size < WS_TOTAL) return;
  Params p{};
  for (int i = 0; i < 38; ++i) p.in[i] = (const float*)d_in[i];
  p.out = (float*)d_out;
  p.ws = (char*)d_ws;
    (void)hipMemsetAsync((char*)d_ws + OFF_CNT, 0, 256, stream);
  void* args[] = {&p};
  hipError_t e = hipLaunchCooperativeKernel((void*)fwd_megakernel, dim3(grid_blocks), dim3(NTHR), args, LDS_BYTES, stream);
  if (e != hipSuccess) fprintf(stderr, "cooperative launch failed: %s (grid %d)\n", hipGetErrorString(e), grid_blocks);
}
```

```cpp
#include <hip/hip_runtime.h>
#include <hip/hip_cooperative_groups.h>
#include <hip/hip_fp16.h>
#include <cstdio>
#include <cstdint>
namespace cg = cooperative_groups;

#define DEV __device__ __forceinline__
typedef float f32x16 __attribute__((ext_vector_type(16)));

constexpr int kD = 1024, kB = 4, kT = 8192, kCTX = 256, kROWS = kB * kT;
constexpr int kHYW = 512, kHYC = 1536, kRWW = 512, kRWC = 1792, kINC = 5376;
constexpr int kH = 8, kE = 16, kF = 2048, kCAP = 1024;
constexpr int kSCC = 16, kNSC = kT / (64 * kSCC);
constexpr int kCC = 1280;
constexpr int NTHR = 512;
constexpr size_t LDS_BYTES = 160 * 1024;

constexpr size_t OFF_MOD   = 0;
constexpr size_t OFF_RSTDC = OFF_MOD + 131072;
constexpr size_t OFF_NORM  = OFF_RSTDC + 4096;
constexpr size_t OFF_CNT   = OFF_NORM + 2048;
constexpr size_t OFF_SCTX  = OFF_CNT + 256;
constexpr size_t OFF_BS    = OFF_SCTX + 1048576;
constexpr size_t OFF_AFF   = OFF_BS + 2097152;
constexpr size_t OFF_IDX   = OFF_AFF + 2097152;
constexpr size_t OFF_GATE  = OFF_IDX + 262144;
constexpr size_t OFF_KFU   = OFF_GATE + 262144;
constexpr size_t OFF_SEL   = OFF_KFU + 33554432;
constexpr size_t OFF_WINT  = OFF_SEL + 2097152;
constexpr size_t OFF_HPT   = OFF_WINT + 11010048;
constexpr size_t OFF_RPT   = OFF_HPT + 1048576;
constexpr size_t OFF_WOT   = OFF_RPT + 1048576;
constexpr size_t OFF_W13T  = OFF_WOT + 2097152;
constexpr size_t OFF_W2T   = OFF_W13T + 134217728;
constexpr size_t OFF_A0    = OFF_W2T + 67108864;
constexpr size_t OFF_A1    = OFF_A0 + 67108864;
constexpr size_t A1_BYTES  = 268435456;
constexpr size_t WS_TOTAL  = OFF_A1 + A1_BYTES;
static_assert(WS_TOTAL <= 597000000, "workspace budget");

struct Params {
  const float* in[38];
  float* out;
  char* ws;
};
constexpr int TP_LO = -1, TP_HI = -1;


enum { I_X = 0, I_C, I_CTX, I_CCTX, I_MODW, I_MODB, I_N1PRE, I_N1POST, I_N2PRE, I_N2POST, I_WIN,
       I_HCW, I_HCB, I_HW1, I_HB1, I_HW2, I_HB2, I_HW3, I_HFREQ, I_HBIAS, I_HPROJ,
       I_MU, I_W0, I_WUP, I_A0, I_AUP, I_GUP, I_KK, I_KA, I_RK, I_LNG, I_LNB, I_RWPROJ, I_WOUT, I_ROUTER,
       I_EW1, I_EW3, I_EW2 };

DEV int tidx() { int t = threadIdx.x; asm volatile("" : "+v"(t)); return t; }
DEV float wave_sum(float v) {
  int x;
  x = __builtin_amdgcn_update_dpp(0, __float_as_int(v), 0xB1, 0xF, 0xF, false); v += __int_as_float(x);
  x = __builtin_amdgcn_update_dpp(0, __float_as_int(v), 0x4E, 0xF, 0xF, false); v += __int_as_float(x);
  x = __builtin_amdgcn_update_dpp(0, __float_as_int(v), 0x141, 0xF, 0xF, false); v += __int_as_float(x);
  x = __builtin_amdgcn_update_dpp(0, __float_as_int(v), 0x140, 0xF, 0xF, false); v += __int_as_float(x);
  const float r0 = __int_as_float(__builtin_amdgcn_readlane(__float_as_int(v), 0)), r1 = __int_as_float(__builtin_amdgcn_readlane(__float_as_int(v), 16));
  const float r2 = __int_as_float(__builtin_amdgcn_readlane(__float_as_int(v), 32)), r3 = __int_as_float(__builtin_amdgcn_readlane(__float_as_int(v), 48));
  return (r0 + r1) + (r2 + r3);
}
DEV float sigmoidf_(float x) { return 1.0f / (1.0f + expf(-x)); }
DEV float siluf_(float x) { return x / (1.0f + expf(-x)); }
DEV float softplusf_(float x) { return x > 20.f ? x : log1pf(expf(x)); }
DEV void sincos_cw(float x, float& sn, float& cs) {
  const float kf = rintf(x * 0.6366197723675814f);
  const int k = (int)kf;
  float r = fmaf(kf, -1.5703125f, x);
  r = fmaf(kf, -4.837512969970703125e-4f, r);
  r = fmaf(kf, -7.54978995489188216e-8f, r);
  const float r2 = r * r;
  const float sp = r + r * r2 * (-1.6666654611e-1f + r2 * (8.3321608736e-3f + r2 * (-1.9515295891e-4f)));
  const float cp = 1.0f - 0.5f * r2 + r2 * r2 * (4.166664568298827e-2f + r2 * (-1.388731625493765e-3f + r2 * 2.443315711809948e-5f));
  const float s0 = (k & 1) ? cp : sp, c0 = (k & 1) ? sp : cp;
  sn = (k & 2) ? -s0 : s0;
  cs = ((k + 1) & 2) ? -c0 : c0;
}
DEV float sin_cw(float x) { float a, b; sincos_cw(x, a, b); return a; }
DEV float4 ld4(const float* p) { return *reinterpret_cast<const float4*>(p); }

namespace pg8 {
#define PG8_LAS __attribute__((address_space(3)))
typedef unsigned short bf16_t;
typedef short bf16x8 __attribute__((ext_vector_type(8)));
typedef float f32x4 __attribute__((ext_vector_type(4)));
typedef unsigned u32x4 __attribute__((ext_vector_type(4)));
typedef unsigned u32x2 __attribute__((ext_vector_type(2)));
constexpr int BM = 256, BK = 64, HALF = 128, HTB = HALF * BK * 2, STAGE_BYTES = 8 * HTB, NXCD = 8, WGM = 8;
__host__ __device__ __forceinline__ int lds_byte(int r, int c) { const int st = (r >> 4) * 2 + (c >> 5), rr = r & 15, cc = c & 31, ob = rr * 64 + cc * 2; return st * 1024 + (ob ^ (((ob >> 9) & 1) << 5)); }
__host__ __device__ __forceinline__ void stage_rc(int b, int& R, int& C) { const int st = b / 1024, sb = b % 1024, swz = sb ^ (((sb >> 9) & 1) << 5); R = (st >> 1) * 16 + swz / 64; C = (st & 1) * 32 + (swz % 64) / 2; }
__host__ __device__ __forceinline__ int perm32(int rho) { const int n = rho >> 4, i = rho & 15; return 8 * (i >> 2) + 4 * n + (i & 3); }
typedef __bf16 bf16v2 __attribute__((ext_vector_type(2)));
typedef float f32v2 __attribute__((ext_vector_type(2)));
__device__ __forceinline__ unsigned cvt_pk_bf16(float lo, float hi) { const f32v2 v = {lo, hi}; const bf16v2 r = __builtin_convertvector(v, bf16v2); return __builtin_bit_cast(unsigned, r); }

struct Unit { int pm, pn; const char* a; const char* b; };

struct TileOrder {
  int nM, nN, nwg, G, c;
  __device__ void init(int nM_, int nN_, int G_, int c_) { nM = nM_; nN = nN_; nwg = nM * nN; G = G_; c = c_; }
  __device__ bool tile(int i, int& pm, int& pn) const {
    const long L = (long)i * G + c; if (L >= nwg) return false;
    int wgid = (int)L; { const int q = nwg / NXCD, r = nwg % NXCD, xcd = wgid % NXCD, off = wgid / NXCD; wgid = (xcd < r ? xcd * (q + 1) : r * (q + 1) + (xcd - r) * q) + off; }
    const int nig = WGM * nN, gid = wgid / nig, fm = gid * WGM, gsz = (nM - fm) < WGM ? (nM - fm) : WGM;
    pm = fm + ((wgid % nig) % gsz); pn = (wgid % nig) / gsz; return true;
  }
};

template <class Epi, class Sched, bool GATHER>
__device__ __forceinline__ void gemm_phase(PG8_LAS unsigned char* lds, const int K, const Sched& S, const Epi& E) {
  int tid_ = tidx(); asm volatile("" : "+v"(tid_));
  const int tid = tid_, wid = __builtin_amdgcn_readfirstlane(tid >> 6), lane = tid & 63, wr = wid >> 2, wc = wid & 3, fr = lane & 15, fq = lane >> 4;
  const int nt = K / BK;
  unsigned voffA[2], voffB[2];
#pragma unroll
  for (int i = 0; i < 2; ++i) { int R, C; stage_rc(tid * 16 + i * 8192, R, C); const int Rb = Epi::PERM ? ((R & ~31) + perm32(R & 31)) : R;
    voffA[i] = (unsigned)(R * K + C) * 2u; voffB[i] = (unsigned)(Rb * K + C) * 2u; }
  const size_t kstep = (size_t)(BK * 2);
  const size_t hstep = (size_t)HALF * K * 2;
  const unsigned ldsw = (unsigned)wid * 1024u;
  const int aoff = lds_byte(wr * 64 + fr, fq * 8), boff = lds_byte(wc * 32 + fr, fq * 8);
#define PG8_SA(b, h) (((b) * 2 + (h)) * HTB)
#define PG8_SB(b, h) ((4 + (b) * 2 + (h)) * HTB)
#define PG8_STAGE(bufoff, gbase, voff) do { _Pragma("unroll") for (int _i = 0; _i < 2; ++_i) \
    __builtin_amdgcn_global_load_lds((const unsigned*)((const char*)(gbase) + (voff)[_i]), (PG8_LAS unsigned*)(lds + (bufoff) + ldsw + _i * 8192), 16, 0, 0); } while (0)
#define PG8_STAGE_A(bufoff, gbase, h) do { if constexpr (GATHER) { PG8_STAGE(bufoff, gbase, vAc[h]); } else { PG8_STAGE(bufoff, (gbase) + (h) * hstep, voffA); } } while (0)
#define PG8_GATHER_OFFS(dst, u) do { _Pragma("unroll") for (int _h = 0; _h < 2; ++_h) _Pragma("unroll") for (int _i = 0; _i < 2; ++_i) { int _R, _C; stage_rc(tid * 16 + _i * 8192, _R, _C); \
    dst[_h][_i] = (unsigned)S.row(u, _h * HALF + _R) * (unsigned)(K * 2) + (unsigned)(_C * 2); } } while (0)
#define PG8_LDA(dst, b, h) do { _Pragma("unroll") for (int m = 0; m < 4; ++m) _Pragma("unroll") for (int k = 0; k < 2; ++k) dst[m][k] = *(const PG8_LAS bf16x8*)(lds + PG8_SA(b, h) + aoff + m * 2048 + k * 1024); } while (0)
#define PG8_LDB(dst, b, h) do { _Pragma("unroll") for (int n = 0; n < 2; ++n) _Pragma("unroll") for (int k = 0; k < 2; ++k) dst[n][k] = *(const PG8_LAS bf16x8*)(lds + PG8_SB(b, h) + boff + n * 2048 + k * 1024); } while (0)
#define PG8_MMA(ai, bj, At, Bt) do { __builtin_amdgcn_s_setprio(1); _Pragma("unroll") for (int m = 0; m < 4; ++m) _Pragma("unroll") for (int n = 0; n < 2; ++n) _Pragma("unroll") for (int k = 0; k < 2; ++k) \
    acc[ai][bj][m][n] = __builtin_amdgcn_mfma_f32_16x16x32_bf16(Bt[n][k], At[m][k], acc[ai][bj][m][n], 0, 0, 0); __builtin_amdgcn_s_setprio(0); } while (0)
#define PG8_WAIT_V(n) asm volatile("s_waitcnt vmcnt(" #n ")" ::: "memory")
#define PG8_WAIT_L(n) asm volatile("s_waitcnt lgkmcnt(" #n ")" ::: "memory")
#define PG8_BAR __builtin_amdgcn_s_barrier()
#define PG8_SCHED __builtin_amdgcn_sched_barrier(0)
  Unit cur, nxt; int ui = 0;
  if (!S.next(0, cur)) return;
  unsigned vAc[2][2];
  if constexpr (GATHER) { PG8_GATHER_OFFS(vAc, cur); }
  else { vAc[0][0] = vAc[0][1] = vAc[1][0] = vAc[1][1] = 0u; }
  f32x4 acc[2][2][4][2];
#pragma unroll
  for (int a = 0; a < 2; ++a)
#pragma unroll
    for (int b = 0; b < 2; ++b)
#pragma unroll
      for (int m = 0; m < 4; ++m)
#pragma unroll
        for (int n = 0; n < 2; ++n) acc[a][b][m][n] = (f32x4){0.f, 0.f, 0.f, 0.f};
  bf16x8 At[4][2], B0[2][2], B1[2][2];
  const char* cA = cur.a; const char* cB = cur.b;
  PG8_STAGE(PG8_SB(0, 0), cB, voffB); PG8_STAGE_A(PG8_SA(0, 0), cA, 0); PG8_STAGE(PG8_SB(0, 1), cB + hstep, voffB); PG8_STAGE_A(PG8_SA(0, 1), cA, 1);
  if (wr == 1) PG8_BAR;
  PG8_WAIT_V(4); PG8_BAR;
  PG8_STAGE(PG8_SB(1, 0), cB + kstep, voffB); PG8_STAGE_A(PG8_SA(1, 0), cA + kstep, 0); PG8_STAGE(PG8_SB(1, 1), cB + hstep + kstep, voffB);
  PG8_WAIT_V(6); PG8_BAR;
  for (;;) {
    const bool has_next = S.next(ui + 1, nxt);
    const char* nA = has_next ? nxt.a : cA; const char* nB = has_next ? nxt.b : cB;
    for (int t = 0; t < nt; t += 2) {
      const bool last = (t == nt - 2);
      const char* a1 = cA + (size_t)(t + 1) * kstep;
      const char* a2 = last ? nA : cA + (size_t)(t + 2) * kstep; const char* b2 = last ? nB : cB + (size_t)(t + 2) * kstep;
      const char* a3 = a2 + kstep; const char* b3 = b2 + kstep;
      unsigned vAn[2][2];
      if constexpr (GATHER) { PG8_SCHED; if (last && has_next) { PG8_GATHER_OFFS(vAn, nxt); } PG8_SCHED; }
      PG8_LDB(B0, 0, 0); PG8_SCHED; PG8_LDA(At, 0, 0); PG8_STAGE_A(PG8_SA(1, 1), a1, 1);
      PG8_WAIT_L(8); PG8_BAR; PG8_WAIT_L(0); PG8_MMA(0, 0, At, B0); PG8_BAR; PG8_SCHED;
      if constexpr (GATHER) { if (last && has_next) { vAc[0][0] = vAn[0][0]; vAc[0][1] = vAn[0][1]; vAc[1][0] = vAn[1][0]; vAc[1][1] = vAn[1][1]; } }
      PG8_LDB(B1, 0, 1); PG8_STAGE(PG8_SB(0, 0), b2, voffB);
      PG8_BAR; PG8_WAIT_L(0); PG8_MMA(0, 1, At, B1); PG8_BAR;
      PG8_LDA(At, 0, 1); PG8_STAGE_A(PG8_SA(0, 0), a2, 0);
      PG8_BAR; PG8_WAIT_L(0); PG8_MMA(1, 0, At, B0); PG8_BAR; PG8_SCHED;
      PG8_STAGE(PG8_SB(0, 1), b2 + hstep, voffB);
      PG8_WAIT_V(6); PG8_BAR; PG8_MMA(1, 1, At, B1); PG8_BAR;
      PG8_LDB(B0, 1, 0); PG8_SCHED; PG8_LDA(At, 1, 0); PG8_STAGE_A(PG8_SA(0, 1), a2, 1);
      PG8_WAIT_L(8); PG8_BAR; PG8_WAIT_L(0); PG8_MMA(0, 0, At, B0); PG8_BAR; PG8_SCHED;
      PG8_LDB(B1, 1, 1); PG8_STAGE(PG8_SB(1, 0), b3, voffB);
      PG8_BAR; PG8_WAIT_L(0); PG8_MMA(0, 1, At, B1); PG8_BAR;
      PG8_LDA(At, 1, 1); PG8_STAGE_A(PG8_SA(1, 0), a3, 0);
      PG8_BAR; PG8_WAIT_L(0); PG8_MMA(1, 0, At, B0); PG8_BAR; PG8_SCHED;
      PG8_STAGE(PG8_SB(1, 1), b3 + hstep, voffB);
      PG8_WAIT_V(6); PG8_BAR; PG8_MMA(1, 1, At, B1); PG8_BAR;
    }
    E(acc, cur, wr, wc, fr, fq);
    if (!has_next) break;
#pragma unroll
    for (int a = 0; a < 2; ++a)
#pragma unroll
      for (int b = 0; b < 2; ++b)
#pragma unroll
        for (int m = 0; m < 4; ++m)
#pragma unroll
          for (int n = 0; n < 2; ++n) acc[a][b][m][n] = (f32x4){0.f, 0.f, 0.f, 0.f};
    cur = nxt; cA = nA; cB = nB; ++ui;
  }
  PG8_WAIT_V(0);
  if (wr == 0) PG8_BAR;
  PG8_BAR;
#undef PG8_SA
#undef PG8_SB
#undef PG8_STAGE
#undef PG8_STAGE_A
#undef PG8_GATHER_OFFS
#undef PG8_LDA
#undef PG8_LDB
#undef PG8_MMA
#undef PG8_WAIT_V
#undef PG8_WAIT_L
#undef PG8_BAR
#undef PG8_SCHED
}
}

__device__ void transpose_tile(float* tl, const float* src, int ld, int scol0, unsigned short* dst, int K, int n0, int k0) {
  const int tid = tidx();
  __syncthreads();
#pragma unroll
  for (int ps = 0; ps < 4; ++ps) {
    const int kr = ps * 32 + (tid >> 4), c4 = (tid & 15) * 4;
    const float4 v = ld4(src + (size_t)(k0 + kr) * ld + scol0 + c4);
    tl[kr * 65 + c4] = v.x; tl[kr * 65 + c4 + 1] = v.y; tl[kr * 65 + c4 + 2] = v.z; tl[kr * 65 + c4 + 3] = v.w;
  }
  __syncthreads();
  const int n = tid >> 3, kq = (tid & 7) * 16;
  unsigned w[8];
#pragma unroll
  for (int i = 0; i < 8; ++i) w[i] = pg8::cvt_pk_bf16(tl[(kq + 2 * i) * 65 + n], tl[(kq + 2 * i + 1) * 65 + n]);
  uint4* o = reinterpret_cast<uint4*>(dst + (size_t)(n0 + n) * K + k0 + kq);
  o[0] = make_uint4(w[0], w[1], w[2], w[3]); o[1] = make_uint4(w[4], w[5], w[6], w[7]);
}

typedef unsigned short bf16_t;
DEV float bf2f(bf16_t v) { return __uint_as_float((unsigned)v << 16); }
DEV float bflo(unsigned w) { return __uint_as_float(w << 16); }
DEV float bfhi(unsigned w) { return __uint_as_float(w & 0xffff0000u); }
DEV bf16_t f2bf(float f) { return (bf16_t)(pg8::cvt_pk_bf16(f, 0.f) & 0xffffu); }
DEV float fsigmoid(float x) { return 1.0f / (1.0f + __expf(-x)); }

__device__ void phase_wprep(float* lds, const Params& p, char* ws, int bid, int nb) {
  bf16_t* winT = (bf16_t*)(ws + OFF_WINT); bf16_t* hpT = (bf16_t*)(ws + OFF_HPT); bf16_t* rpT = (bf16_t*)(ws + OFF_RPT);
  bf16_t* woT = (bf16_t*)(ws + OFF_WOT); bf16_t* w13T = (bf16_t*)(ws + OFF_W13T); bf16_t* w2T = (bf16_t*)(ws + OFF_W2T);
  constexpr int N0 = 672, N1 = N0 + 64, N2 = N1 + 64, N3 = N2 + 128, N4 = N3 + 8192, N5 = N4 + 4096;
  for (int item = bid; item < N5; item += nb) {
    if (item < N0) {
      const int nt = item >> 3, kt = item & 7, n0 = nt * 64;
      int scol;
      if (n0 < 3328) scol = n0;
      else { const int r = n0 - 3328, j = r >> 8, q = r & 255; scol = 3328 + (q < 128 ? 0 : 1024) + j * 128 + (q & 127); }
      transpose_tile(lds, p.in[I_WIN], kINC, scol, winT, kD, n0, kt * 128);
    } else if (item < N1) { const int it = item - N0; transpose_tile(lds, p.in[I_HPROJ], kD, (it >> 2) * 64, hpT, 512, (it >> 2) * 64, (it & 3) * 128);
    } else if (item < N2) { const int it = item - N1; transpose_tile(lds, p.in[I_RWPROJ], kD, (it >> 2) * 64, rpT, 512, (it >> 2) * 64, (it & 3) * 128);
    } else if (item < N3) { const int it = item - N2; transpose_tile(lds, p.in[I_WOUT], kD, (it >> 3) * 64, woT, kD, (it >> 3) * 64, (it & 7) * 128);
    } else if (item < N4) {
      const int it = item - N3, e = it >> 9, nt = (it >> 3) & 63, kt = it & 7, n0 = nt * 64, j = n0 >> 8, q = n0 & 255;
      const float* src = (q < 128 ? p.in[I_EW1] : p.in[I_EW3]) + (size_t)e * kD * kF;
      transpose_tile(lds, src, kF, j * 128 + (q & 127), w13T + (size_t)e * 4096 * kD, kD, n0, kt * 128);
    } else {
      const int it = item - N4, e = it >> 8, nt = (it >> 4) & 15, kt = it & 15;
      transpose_tile(lds, p.in[I_EW2] + (size_t)e * kF * kD, kD, nt * 64, w2T + (size_t)e * kD * kF, kF, nt * 64, kt * 128);
    }
  }
}

__device__ void phase_hb(const Params& p, const float* mod, bf16_t* hb, bf16_t* hc, int bid, int nb) {
  const int lane = tidx() & 63, wid = tidx() >> 6;
  const float* g = p.in[I_N1PRE];
  const int rstep = nb * 8, rend = kROWS + kB * kCTX;
  float4 hg[4], hsc[4], hsh[4]; int hm_ = -1;
#pragma unroll
  for (int i = 0; i < 4; ++i) hg[i] = ld4(g + i * 256 + lane * 4);
  int row = bid * 8 + wid;
  float4 nv[4];
  { const float* xr = row >= kROWS ? p.in[I_CTX] + (size_t)(row - kROWS) * kD : p.in[I_X] + (size_t)row * kD;
#pragma unroll
    for (int i = 0; i < 4; ++i) nv[i] = row < rend ? ld4(xr + i * 256 + lane * 4) : make_float4(0.f, 0.f, 0.f, 0.f); }
  for (; row < rend; row += rstep) {
    const bool isctx = row >= kROWS;
    const int mr = isctx ? 4 : row / kT;
    if (mr != hm_) { hm_ = mr;
#pragma unroll
      for (int i = 0; i < 4; ++i) { hsc[i] = ld4(mod + mr * 6144 + 1024 + i * 256 + lane * 4); hsh[i] = ld4(mod + mr * 6144 + i * 256 + lane * 4); } }
    bf16_t* dst = isctx ? hc + (size_t)(row - kROWS) * kD : hb + (size_t)row * kD;
    float4 v[4]; float ss = 0.f;
#pragma unroll
    for (int i = 0; i < 4; ++i) { v[i] = nv[i]; ss += v[i].x * v[i].x + v[i].y * v[i].y + v[i].z * v[i].z + v[i].w * v[i].w; }
    { const int nr = row + rstep < rend ? row + rstep : row;
      const float* xr = nr >= kROWS ? p.in[I_CTX] + (size_t)(nr - kROWS) * kD : p.in[I_X] + (size_t)nr * kD;
#pragma unroll
      for (int i = 0; i < 4; ++i) nv[i] = ld4(xr + i * 256 + lane * 4); }
    ss = wave_sum(ss);
    const float r = rsqrtf(ss * (1.0f / kD) + 1e-6f);
#pragma unroll
    for (int i = 0; i < 4; ++i) {
      const int k = i * 256 + lane * 4;
      const float4 gv = hg[i], sc = hsc[i], sh = hsh[i];
      const float h0 = v[i].x * r * gv.x * (1.f + sc.x) + sh.x, h1 = v[i].y * r * gv.y * (1.f + sc.y) + sh.y;
      const float h2 = v[i].z * r * gv.z * (1.f + sc.z) + sh.z, h3 = v[i].w * r * gv.w * (1.f + sc.w) + sh.w;
      *reinterpret_cast<uint2*>(dst + k) = make_uint2(pg8::cvt_pk_bf16(h0, h1), pg8::cvt_pk_bf16(h2, h3));
    }
  }
}

struct SchedPlain {
  pg8::TileOrder o; const char* A; const char* B; size_t tstep;
  __device__ bool next(int i, pg8::Unit& u) const { if (!o.tile(i, u.pm, u.pn)) return false; u.a = A + (size_t)u.pm * tstep; u.b = B + (size_t)u.pn * tstep; return true; }
  __device__ int row(const pg8::Unit&, int) const { return 0; }
};
struct SchedExp1 {
  pg8::TileOrder o; const char* H2; const char* W13T; const int* idx; int e0;
  __device__ bool next(int i, pg8::Unit& u) const { if (!o.tile(i, u.pm, u.pn)) return false;
    const int e = e0 + (u.pm >> 4); u.a = H2; u.b = W13T + ((size_t)e * 4096 + (size_t)u.pn * 256) * kD * 2; return true; }
  __device__ int row(const pg8::Unit& u, int r) const { return idx[(unsigned)(u.pm * 256 + r)]; }
};
struct SchedExp2 {
  pg8::TileOrder o; const char* HID; const char* W2T; int e0;
  __device__ bool next(int i, pg8::Unit& u) const { if (!o.tile(i, u.pm, u.pn)) return false;
    const int e = e0 + (u.pm >> 4); u.a = HID + (size_t)u.pm * 256 * kF * 2; u.b = W2T + ((size_t)e * kD + (size_t)u.pn * 256) * kF * 2; return true; }
  __device__ int row(const pg8::Unit&, int) const { return 0; }
};

struct EpiBf16Split {
  static constexpr bool PERM = true;
  bf16_t* o0; int ld0; int nt0; bf16_t* o1; int ld1;
  __device__ __forceinline__ void operator()(const pg8::f32x4 (&acc)[2][2][4][2], const pg8::Unit& u, int wr, int wc, int fr, int fq) const {
    bf16_t* base; int ldc, colt;
    if (u.pn < nt0) { base = o0; ldc = ld0; colt = u.pn * 256; } else { base = o1; ldc = ld1; colt = (u.pn - nt0) * 256; }
    const int row0 = u.pm * 256 + wr * 64 + fr, col0 = colt + wc * 32 + 8 * fq;
#pragma unroll
    for (int ai = 0; ai < 2; ++ai)
#pragma unroll
      for (int m = 0; m < 4; ++m) { bf16_t* rowp = base + (size_t)(row0 + ai * 128 + m * 16) * ldc + col0;
#pragma unroll
        for (int bj = 0; bj < 2; ++bj) { const pg8::f32x4 v0 = acc[ai][bj][m][0], v1 = acc[ai][bj][m][1];
          pg8::u32x4 w; w.x = pg8::cvt_pk_bf16(v0[0], v0[1]); w.y = pg8::cvt_pk_bf16(v0[2], v0[3]); w.z = pg8::cvt_pk_bf16(v1[0], v1[1]); w.w = pg8::cvt_pk_bf16(v1[2], v1[3]);
          *(pg8::u32x4*)(rowp + bj * 128) = w; } }
  }
};
struct EpiF32Store {
  static constexpr bool PERM = false;
  float* C; int ldc;
  __device__ __forceinline__ void operator()(const pg8::f32x4 (&acc)[2][2][4][2], const pg8::Unit& u, int wr, int wc, int fr, int fq) const {
    const int row0 = u.pm * 256 + wr * 64 + fr, col0 = u.pn * 256 + wc * 32 + 4 * fq;
#pragma unroll
    for (int ai = 0; ai < 2; ++ai)
#pragma unroll
      for (int m = 0; m < 4; ++m) { float* rowp = C + (size_t)(row0 + ai * 128 + m * 16) * ldc + col0;
#pragma unroll
        for (int bj = 0; bj < 2; ++bj)
#pragma unroll
          for (int n = 0; n < 2; ++n) *(pg8::f32x4*)(rowp + bj * 128 + n * 16) = acc[ai][bj][m][n]; }
  }
};
struct EpiGatesMerge {
  static constexpr bool PERM = true;
  const bf16_t* yh; const bf16_t* yr; bf16_t* pre;
  __device__ __forceinline__ void operator()(const pg8::f32x4 (&acc)[2][2][4][2], const pg8::Unit& u, int wr, int wc, int fr, int fq) const {
    const int row0 = u.pm * 256 + wr * 64 + fr, col0 = u.pn * 128 + wc * 32 + 8 * fq;
#pragma unroll
    for (int ai = 0; ai < 2; ++ai)
#pragma unroll
      for (int m = 0; m < 4; ++m) { const size_t off = (size_t)(row0 + ai * 128 + m * 16) * kD + col0;
        const pg8::u32x4 a = *(const pg8::u32x4*)(yh + off), b = *(const pg8::u32x4*)(yr + off);
        const pg8::f32x4 g0 = acc[ai][0][m][0], g1 = acc[ai][0][m][1], r0 = acc[ai][1][m][0], r1 = acc[ai][1][m][1];
        float o[8];
        o[0] = fsigmoid(g0[0]) * bflo(a.x) + fsigmoid(r0[0]) * bflo(b.x); o[1] = fsigmoid(g0[1]) * bfhi(a.x) + fsigmoid(r0[1]) * bfhi(b.x);
        o[2] = fsigmoid(g0[2]) * bflo(a.y) + fsigmoid(r0[2]) * bflo(b.y); o[3] = fsigmoid(g0[3]) * bfhi(a.y) + fsigmoid(r0[3]) * bfhi(b.y);
        o[4] = fsigmoid(g1[0]) * bflo(a.z) + fsigmoid(r1[0]) * bflo(b.z); o[5] = fsigmoid(g1[1]) * bfhi(a.z) + fsigmoid(r1[1]) * bfhi(b.z);
        o[6] = fsigmoid(g1[2]) * bflo(a.w) + fsigmoid(r1[2]) * bflo(b.w); o[7] = fsigmoid(g1[3]) * bfhi(a.w) + fsigmoid(r1[3]) * bfhi(b.w);
        pg8::u32x4 w; w.x = pg8::cvt_pk_bf16(o[0], o[1]); w.y = pg8::cvt_pk_bf16(o[2], o[3]); w.z = pg8::cvt_pk_bf16(o[4], o[5]); w.w = pg8::cvt_pk_bf16(o[6], o[7]);
        *(pg8::u32x4*)(pre + off) = w; }
  }
};
struct EpiSwiGLU {
  static constexpr bool PERM = true;
  bf16_t* hid;
  __device__ __forceinline__ void operator()(const pg8::f32x4 (&acc)[2][2][4][2], const pg8::Unit& u, int wr, int wc, int fr, int fq) const {
    const int row0 = u.pm * 256 + wr * 64 + fr, col0 = u.pn * 128 + wc * 32 + 8 * fq;
#pragma unroll
    for (int ai = 0; ai < 2; ++ai)
#pragma unroll
      for (int m = 0; m < 4; ++m) { const size_t off = (size_t)(row0 + ai * 128 + m * 16) * kF + col0;
        float o[8];
#pragma unroll
        for (int n = 0; n < 2; ++n)
#pragma unroll
          for (int j = 0; j < 4; ++j) { const float a = acc[ai][0][m][n][j]; o[n * 4 + j] = a * fsigmoid(a) * acc[ai][1][m][n][j]; }
        pg8::u32x4 w; w.x = pg8::cvt_pk_bf16(o[0], o[1]); w.y = pg8::cvt_pk_bf16(o[2], o[3]); w.z = pg8::cvt_pk_bf16(o[4], o[5]); w.w = pg8::cvt_pk_bf16(o[6], o[7]);
        *(pg8::u32x4*)(hid + off) = w; }
  }
};
struct EpiYE {
  static constexpr bool PERM = true;
  bf16_t* ye; const float* gate; int e0;
  __device__ __forceinline__ void operator()(const pg8::f32x4 (&acc)[2][2][4][2], const pg8::Unit& u, int wr, int wc, int fr, int fq) const {
    const int e = e0 + (u.pm >> 4), s0 = (u.pm & 15) * 256 + wr * 64 + fr, col0 = u.pn * 256 + wc * 32 + 8 * fq;
#pragma unroll
    for (int ai = 0; ai < 2; ++ai)
#pragma unroll
      for (int m = 0; m < 4; ++m) { const int s = s0 + ai * 128 + m * 16, b = s >> 10, c = s & 1023, slot = (b * kE + e) * kCAP + c;
        const float g = gate[slot]; bf16_t* rowp = ye + (size_t)slot * kD + col0;
#pragma unroll
        for (int bj = 0; bj < 2; ++bj) { const pg8::f32x4 v0 = acc[ai][bj][m][0] * g, v1 = acc[ai][bj][m][1] * g;
          pg8::u32x4 w; w.x = pg8::cvt_pk_bf16(v0[0], v0[1]); w.y = pg8::cvt_pk_bf16(v0[2], v0[3]); w.z = pg8::cvt_pk_bf16(v1[0], v1[1]); w.w = pg8::cvt_pk_bf16(v1[2], v1[3]);
          *(pg8::u32x4*)(rowp + bj * 128) = w; } }
  }
};

__device__ void phase_mod(float* lds, const float* c, const float* cctx, const float* modw, const float* modb, float* mod, int bid, int nb) {
  float* sc = lds;
  float* red = lds + 5120;
  const int tid = tidx(), kk = tid >> 5, nl = tid & 31;
  bool loaded = false;
  for (int item = bid; item < 192; item += nb) {
    if (!loaded) {
      for (int i = tid; i < 5120; i += NTHR) { const int v = i >> 10, k = i & 1023; const float cv = v < 4 ? c[v * kD + k] : cctx[k]; sc[i] = siluf_(cv); }
      loaded = true;
    }
    __syncthreads();
    const int n = item * 32 + nl;
    float acc[5] = {0.f, 0.f, 0.f, 0.f, 0.f};
#pragma unroll 16
    for (int k = kk * 64; k < kk * 64 + 64; ++k) {
      const float w = modw[(size_t)k * 6144 + n];
#pragma unroll
      for (int v = 0; v < 5; ++v) acc[v] += sc[v * 1024 + k] * w;
    }
#pragma unroll
    for (int v = 0; v < 5; ++v) red[(kk * 5 + v) * 32 + nl] = acc[v];
    __syncthreads();
    if (tid < 160) {
      const int v = tid >> 5;
      float s = 0.f;
#pragma unroll
      for (int q = 0; q < 16; ++q) s += red[(q * 5 + v) * 32 + nl];
      mod[v * 6144 + n] = s + modb[n];
    }
    __syncthreads();
  }
}

__device__ void phase_filter(float* lds, const Params& p, float* circT, int bid, int nb) {
  float* feat = lds;
  float* h1 = lds + 32 * 33;
  float* h2 = h1 + 32 * 64;
  const float* b1 = p.in[I_HB1]; const float* b2 = p.in[I_HB2];
  const float* w3 = p.in[I_HW3]; const float* fr = p.in[I_HFREQ];
  float* w1 = h2 + 32 * 64;
  float* w2 = w1 + 33 * 64;
  const int tid = tidx();
  for (int item = bid; item < kT / 32; item += nb) {
    const int l0 = item * 32;
    __syncthreads();
    for (int i = tid; i < 33 * 64; i += NTHR) w1[i] = p.in[I_HW1][i];
    for (int i = tid; i < 64 * 64; i += NTHR) w2[i] = p.in[I_HW2][i];
    for (int i = tid; i < 32 * 33; i += NTHR) {
      const int pz = i / 33, f = i % 33, l = l0 + pz;
      float v;
      if (f == 0) v = (float)l / (float)(kT - 1);
      else {
        const int j = (f - 1) & 15;
        const float band = 1e-4f + (float)j * ((15.0f - 1e-4f) / 15.0f);
        const float ang = (6.283185307179586f / (float)kT) * (float)l;
        float sn, cs; sincos_cw(band * ang, sn, cs); v = f <= 16 ? cs : -sn;
      }
      feat[i] = v;
    }
    __syncthreads();
    for (int i = tid; i < 32 * 64; i += NTHR) {
      const int pz = i >> 6, o = i & 63;
      float s = b1[o];
#pragma unroll 3
      for (int f = 0; f < 33; ++f) s += feat[pz * 33 + f] * w1[f * 64 + o];
      h1[i] = sin_cw(fr[o] * s);
    }
    __syncthreads();
    for (int i = tid; i < 32 * 64; i += NTHR) {
      const int pz = i >> 6, o = i & 63;
      float s = b2[o];
#pragma unroll 4
      for (int f = 0; f < 64; ++f) s += h1[pz * 64 + f] * w2[f * 64 + o];
      h2[i] = sin_cw(fr[o] * s);
    }
    __syncthreads();
#pragma unroll 1
    for (int half = 0; half < 2; ++half) {
      const int n = tid + half * 512;
      const int c = tid;
      float wr[64];
#pragma unroll
      for (int o = 0; o < 64; ++o) wr[o] = w3[o * 1024 + n];
      const float dlo = -4.605170185988091f / 1.5f, dhi = -4.605170185988091f / 0.3f;
      const float delta = fabsf(dlo + (float)c * ((dhi - dlo) / 511.0f));
      float asum = 0.f;
#pragma unroll 1
      for (int q = 0; q < 32; ++q) {
        float a = 0.f;
#pragma unroll
        for (int o = 0; o < 64; ++o) a += h2[q * 64 + o] * wr[o];
        const int l = l0 + q;
        const float tt = (float)l / (float)(kT - 1);
        const float v = a * expf(-tt * delta);
        if (half == 0) circT[(size_t)c * 16384 + l] = v;
        else circT[(size_t)c * 16384 + 16384 - l - (l == 0 ? 8192 : 0)] = (l == 0 ? 0.f : v);
      }
      (void)asum;
    }
  }
}

DEV float ldcol(const float* p, size_t i) { return p[i]; }
DEV float ldcol(const bf16_t* p, size_t i) { return bf2f(p[i]); }
namespace rs {
typedef short bf16x8 __attribute__((ext_vector_type(8)));
typedef float f32x4 __attribute__((ext_vector_type(4)));
constexpr int LD = 72, LDR = 40;
#define RS_LAS __attribute__((address_space(3)))
typedef RS_LAS bf16_t* lbf; typedef const RS_LAS bf16_t* clbf; typedef RS_LAS float* lf32;
DEV void lds_barrier() { asm volatile("s_waitcnt lgkmcnt(0)" ::: "memory"); __builtin_amdgcn_s_barrier(); asm volatile("" ::: "memory"); }
template <int K>
DEV f32x4 tmma(f32x4 acc, clbf A, int lda, clbf B, int ldb, int lane) {
  clbf ap = A + (lane & 15) * lda + 8 * (lane >> 4);
  clbf bp = B + (lane & 15) * ldb + 8 * (lane >> 4);
#pragma unroll
  for (int k = 0; k < K; k += 32)
    acc = __builtin_amdgcn_mfma_f32_16x16x32_bf16(*(const RS_LAS bf16x8*)(ap + k), *(const RS_LAS bf16x8*)(bp + k), acc, 0, 0, 0);
  return acc;
}
typedef unsigned u32x2v __attribute__((ext_vector_type(2)));
DEV void st4(lbf p, f32x4 v) { const u32x2v w = {pg8::cvt_pk_bf16(v[0], v[1]), pg8::cvt_pk_bf16(v[2], v[3])}; *(RS_LAS u32x2v*)p = w; }
DEV void st4g(bf16_t* p, f32x4 v) { *reinterpret_cast<uint2*>(p) = make_uint2(pg8::cvt_pk_bf16(v[0], v[1]), pg8::cvt_pk_bf16(v[2], v[3])); }
DEV float ftanh(float x) { const float e = __expf(2.f * x); return 1.f - 2.f / (e + 1.f); }

template <int NC> struct Lay {
  static constexpr int ZTB = NC * LD * 2;
  static constexpr int W = 0, ZT0 = 18432, ZT1 = ZT0 + ZTB, AT = ZT1 + ZTB, BTt = AT + 9216, KTt = BTt + 9216, Vt = KTt + 9216,
                       RT = Vt + 9216, X = (NC == 64 ? RT + 9216 : RT), L = X + 18432, D = L + (NC == 64 ? 36864 : 32768);
  static constexpr int LWt = X, LA = X + 9216, BT = X, KT = X + 9216, UT = X, RHS = (NC == 64 ? X + 9216 : L + 18432);
  static constexpr int CS = L, AG = L + 16384, LAK = L, LOFF = L + 9216, LRB = L + 18432, LRK = L + 27648;
  static constexpr int LDG = D, TDG = D + 4352, WCV = TDG + 5120, SEG = WCV + 256, TF = SEG + 2048, END = TF + 4352;
};
static_assert(Lay<64>::END <= (int)LDS_BYTES && Lay<128>::END <= (int)LDS_BYTES, "scan LDS layout");

template <int NC, bool EMIT>
__device__ void scan_task(float* ldsf, const Params& p, const bf16_t* cols, int ldc, int Tlen, int cR, int cK, int cV, int cLW, int cLA, int muoff,
                          int b, int h, int dir, int step0, int nchunks, const float* Zinit  , float* Zout  , bf16_t* Y, float* BSo) {
  typedef Lay<NC> LY;
  RS_LAS char* lds = (RS_LAS char*)ldsf;
  const int tid = tidx(), lane = tid & 63, w = tid >> 6;
  lbf sWup = (lbf)(lds + LY::W); lbf sAup = sWup + 64 * LD;
  lbf sAT = (lbf)(lds + LY::AT); lbf sBTt = (lbf)(lds + LY::BTt); lbf sKTt = (lbf)(lds + LY::KTt); lbf sVt = (lbf)(lds + LY::Vt);
  lbf sRT = (lbf)(lds + LY::RT);
  lbf sLWt = (lbf)(lds + LY::LWt); lbf sLA = (lbf)(lds + LY::LA); lbf sBT = (lbf)(lds + LY::BT); lbf sKT = (lbf)(lds + LY::KT);
  lbf sUT = (lbf)(lds + LY::UT); lbf sRHS = (lbf)(lds + LY::RHS);
  lf32 sCS = (lf32)(lds + LY::CS); lf32 sAG = (lf32)(lds + LY::AG);
  lbf sLak = (lbf)(lds + LY::LAK); lbf sLoff = (lbf)(lds + LY::LOFF); lbf sLrb = (lbf)(lds + LY::LRB); lbf sLrk = (lbf)(lds + LY::LRK);
  lf32 sLdg = (lf32)(lds + LY::LDG); lbf sTdg = (lbf)(lds + LY::TDG); lf32 sWC = (lf32)(lds + LY::WCV); lf32 sSeg = (lf32)(lds + LY::SEG); lf32 sTf = (lf32)(lds + LY::TF);
  const float* mu = p.in[I_MU];
  const int hj = h * 64 + lane;
  const bf16_t* base = cols + (size_t)b * Tlen * ldc;
  constexpr int NT = NC / 16 * 4 / 8;
  f32x4 Zm[NT];

  __syncthreads();
  for (int i = tid; i < 4096; i += NTHR) { const int ii = i >> 6, j = i & 63;
    sWup[j * LD + ii] = f2bf(p.in[I_WUP][((size_t)dir * 64 + ii) * 512 + h * 64 + j]);
    sAup[j * LD + ii] = f2bf(p.in[I_AUP][((size_t)dir * 64 + ii) * 512 + h * 64 + j]); }
#pragma unroll
  for (int m = 0; m < NT; ++m) {
    const int id = w + 8 * m, tj = id & 3, tn = id >> 2, col = tn * 16 + (lane & 15), j0 = tj * 16 + 4 * (lane >> 4);
#pragma unroll
    for (int q = 0; q < 4; ++q) {
      float v = 0.f;
      if (NC == 128) v = (col < 64 && col == j0 + q) ? 1.f : 0.f;
      else if (Zinit) v = Zinit[col * 64 + j0 + q];
      Zm[m][q] = v;
    }
    st4((lbf)(lds + LY::ZT0) + col * LD + j0, Zm[m]);
  }
  for (int i = tid; i < NC * LD / 2; i += NTHR) ((RS_LAS unsigned*)sUT)[i] = 0u;
  int zcur = 0;
  unsigned long long tprev = 0; const bool tpon = (TP_LO == 100) && EMIT && blockIdx.x == 0 && threadIdx.x == 0;
#define RS_T(k) do { if (TP_LO == 100 && EMIT) { if (tpon) { const unsigned long long tn_ = __builtin_amdgcn_s_memrealtime(); ((unsigned long long*)(p.ws + OFF_NORM + 512))[k] += tn_ - tprev; tprev = tn_; } } } while (0)
#pragma unroll 1
  for (int ci = 0; ci < nchunks; ++ci) {
    const int s0 = step0 + ci * 64;
    lbf sZT = (lbf)(lds + (zcur ? LY::ZT1 : LY::ZT0));
    lbf sZN = (lbf)(lds + (zcur ? LY::ZT0 : LY::ZT1));
    lds_barrier();
    if (TP_LO == 100 && EMIT) { if (tpon) tprev = __builtin_amdgcn_s_memrealtime(); }
    const int stepb = s0 + w * 8 - 1;
    unsigned pf[5][5];
#define RS_PREFETCH(a_lo, a_hi) do { _Pragma("unroll") for (int a = a_lo; a < a_hi; ++a) { if (a == 0 && !EMIT) continue; \
      const bf16_t* rp = base + (a == 0 ? cR + h * 64 : a == 1 ? cK + h * 64 : a == 2 ? cV + h * 64 : a == 3 ? cLW : cLA) + lane; \
      _Pragma("unroll") for (int i = 0; i < 5; ++i) { const int s0_ = stepb + 2 * i, s1_ = s0_ + 1, t0_ = dir ? (Tlen - 1 - s0_) : s0_, t1_ = dir ? (Tlen - 1 - s1_) : s1_; \
        const int c0_ = t0_ < 0 ? 0 : (t0_ >= Tlen ? Tlen - 1 : t0_), c1_ = t1_ < 0 ? 0 : (t1_ >= Tlen ? Tlen - 1 : t1_);     \
        const unsigned l_ = (unsigned)rp[(size_t)c0_ * ldc], h_ = (unsigned)rp[(size_t)c1_ * ldc]; \
        pf[a][i] = ((t0_ == c0_) ? l_ : 0u) | (((t1_ == c1_) ? h_ : 0u) << 16); } } } while (0)
#define RS_ROW(a, i) (((i) & 1) ? __uint_as_float(pf[a][(i) >> 1] & 0xffff0000u) : __uint_as_float(pf[a][(i) >> 1] << 16))
    RS_PREFETCH(3, 5);
    {
      const float m0w = mu[cLW + lane + muoff], m1w = mu[kRWC + cLW + lane + muoff], m0a = mu[cLA + lane + muoff], m1a = mu[kRWC + cLA + lane + muoff];
#pragma unroll
      for (int q = 0; q < 8; ++q) {
        const int tl = w * 8 + q;
        const float wc = RS_ROW(3, q + 1), wp = dir ? RS_ROW(3, q + 2) : RS_ROW(3, q), wn = dir ? RS_ROW(3, q) : RS_ROW(3, q + 2);
        const float ac = RS_ROW(4, q + 1), ap = dir ? RS_ROW(4, q + 2) : RS_ROW(4, q), an = dir ? RS_ROW(4, q) : RS_ROW(4, q + 2);
        const float zw = wc + m0w * (wp - wc) + m1w * (wn - wc);
        const float za = ac + m0a * (ap - ac) + m1a * (an - ac);
        sLWt[tl * LD + lane] = f2bf(ftanh(zw)); sLA[tl * LD + lane] = f2bf(za);
      }
    }
    RS_PREFETCH(0, 3);
    lds_barrier(); RS_T(2);
#pragma unroll 1
    for (int m = 0; m < 2; ++m) {
      const int id = w * 2 + m, tm = id >> 2, tn = id & 3;
      f32x4 aw = {0.f, 0.f, 0.f, 0.f}, aa = {0.f, 0.f, 0.f, 0.f};
      aw = tmma<64>(aw, sLWt + tm * 16 * LD, LD, sWup + tn * 16 * LD, LD, lane);
      aa = tmma<64>(aa, sLA + tm * 16 * LD, LD, sAup + tn * 16 * LD, LD, lane);
      const int j = tn * 16 + (lane & 15);
      const float w0 = p.in[I_W0][dir * 512 + h * 64 + j], a0 = p.in[I_A0][dir * 512 + h * 64 + j];
#pragma unroll
      for (int q = 0; q < 4; ++q) {
        const int t = tm * 16 + 4 * (lane >> 4) + q;
        const float x = -(w0 + aw[q]);
        const float sp = x > 20.f ? x : __logf(1.f + __expf(x));
        sCS[t * 64 + j] = __expf(-sp - 0.5f);
        sAG[t * 64 + j] = fsigmoid(a0 + aa[q]);
      }
    }
    lds_barrier(); RS_T(3);
    {
      const int j = tid & 63, seg = tid >> 6;
      float v[8]; float run = 0.f;
#pragma unroll
      for (int q = 0; q < 8; ++q) { run += sCS[(seg * 8 + q) * 64 + j]; v[q] = run; }
      sSeg[seg * 64 + j] = run;
      lds_barrier();
      float off = 0.f;
#pragma unroll
      for (int s = 0; s < 8; ++s) off += (s < seg) ? sSeg[s * 64 + j] : 0.f;
#pragma unroll
      for (int q = 0; q < 8; ++q) sCS[(seg * 8 + q) * 64 + j] = v[q] + off;
    }
    lds_barrier(); RS_T(4);
    {
      const float kkw = p.in[I_KK][hj], kaw = p.in[I_KA][hj], rkw = p.in[I_RK][hj];
      float m0[3], m1[3];
#pragma unroll
      for (int a = 0; a < 3; ++a) { const int col = (a == 0 ? cR : a == 1 ? cK : cV) + h * 64 + lane; m0[a] = mu[col + muoff]; m1[a] = mu[kRWC + col + muoff]; }
#pragma unroll
      for (int q = 0; q < 8; ++q) {
        const int tl = w * 8 + q, tok = dir ? (Tlen - 1 - (s0 + tl)) : (s0 + tl);
        float rkv[3];
#pragma unroll
        for (int a = 0; a < 3; ++a) { const float xc = RS_ROW(a, q + 1), xp = dir ? RS_ROW(a, q + 2) : RS_ROW(a, q), xn = dir ? RS_ROW(a, q) : RS_ROW(a, q + 2);
          rkv[a] = (a == 0 && !EMIT) ? 0.f : xc + m0[a] * (xp - xc) + m1[a] * (xn - xc); }
        const float ag = sAG[tl * 64 + lane], cs = sCS[tl * 64 + lane], csm = tl > 0 ? sCS[(tl - 1) * 64 + lane] : 0.f;
        const float kkv = rkv[1] * kkw;
        const float ss = wave_sum(kkv * kkv);
        const float kkn = kkv * rsqrtf(fmaxf(ss, 1e-24f));
        const float km = rkv[1] * (1.f + (ag - 1.f) * kaw);
        const float ew = __expf(cs), ewi = __expf(-cs);
        const bf16_t at = f2bf(-kkn * __expf(-csm)), bt = f2bf(kkn * ag * ew), kt = f2bf(km * ew), vt = f2bf(rkv[2]);
        sAT[tl * LD + lane] = at; sBT[tl * LD + lane] = bt; sKT[tl * LD + lane] = kt;
        sBTt[lane * LD + tl] = bt; sKTt[lane * LD + tl] = kt; sVt[lane * LD + tl] = vt;
        if (EMIT) {
          sRT[tl * LD + lane] = f2bf(rkv[0] * ewi);
          const float bsum = wave_sum(rkv[0] * km * rkw);
          if (lane == 0) BSo[((size_t)dir * kROWS + (size_t)b * Tlen + tok) * 8 + h] = bsum;
        }
        if (tl == 63) sWC[lane] = ewi;
        __builtin_amdgcn_sched_barrier(0);
      }
    }
    lds_barrier(); RS_T(5);
    if (w < 4) {
      f32x4 acc = {0.f, 0.f, 0.f, 0.f};
      acc = tmma<64>(acc, sBT + w * 16 * LD, LD, sAT + w * 16 * LD, LD, lane);
      const int c = lane & 15, kq = lane >> 4, r4 = 4 * kq;
      lf32 Pm = sLdg + w * 272; lf32 Tm = sTf + w * 272;
#pragma unroll
      for (int q = 0; q < 4; ++q) { const float lv = (r4 + q < c) ? acc[q] : 0.f;
        Pm[c * 17 + r4 + q] = lv; Tm[c * 17 + r4 + q] = lv + ((r4 + q) == c ? 1.f : 0.f); }
#pragma unroll 1
      for (int lev = 0; lev < 3; ++lev) {
        f32x4 a2 = {0.f, 0.f, 0.f, 0.f};
#pragma unroll
        for (int s4 = 0; s4 < 4; ++s4) a2 = __builtin_amdgcn_mfma_f32_16x16x4f32(Pm[c * 17 + 4 * s4 + kq], Pm[(4 * s4 + kq) * 17 + c], a2, 0, 0, 0);
#pragma unroll
        for (int q = 0; q < 4; ++q) Pm[(r4 + q) * 17 + c] = a2[q];
        f32x4 a3 = {0.f, 0.f, 0.f, 0.f};
#pragma unroll
        for (int s4 = 0; s4 < 4; ++s4) a3 = __builtin_amdgcn_mfma_f32_16x16x4f32(Tm[c * 17 + 4 * s4 + kq], Pm[(4 * s4 + kq) * 17 + c], a3, 0, 0, 0);
#pragma unroll
        for (int q = 0; q < 4; ++q) Tm[(r4 + q) * 17 + c] += a3[q];
      }
#pragma unroll
      for (int q = 0; q < 4; ++q) { sTdg[(w * 16 + r4 + q) * LDR + c] = f2bf(Tm[(r4 + q) * 17 + c]); sTdg[(w * 16 + r4 + q) * LDR + 16 + c] = (bf16_t)0; }
    }
    {
      constexpr int NP = EMIT ? 4 : 2;
#pragma unroll 1
      for (int pr = 0; pr < NP; ++pr) {
        clbf Lsrc = (pr < 2) ? sAT : sRT;
        clbf Rsrc = (pr & 1) ? sKT : sBT;
        lbf dst = pr == 0 ? sLoff : pr == 1 ? sLak : pr == 2 ? sLrb : sLrk;
#pragma unroll 1
        for (int m = 0; m < 2; ++m) {
          const int id = w + 8 * m, tt = id >> 2, tu = id & 3;
          f32x4 acc = {0.f, 0.f, 0.f, 0.f};
          if (tu < tt || (pr != 0 && tu == tt)) acc = tmma<64>(acc, Rsrc + tu * 16 * LD, LD, Lsrc + tt * 16 * LD, LD, lane);
          const int t = tt * 16 + (lane & 15), u0 = tu * 16 + 4 * (lane >> 4);
#pragma unroll
          for (int q = 0; q < 4; ++q) { const bool keep = (pr < 2) ? (u0 + q < t) : (u0 + q <= t); acc[q] = keep ? acc[q] : 0.f; }
          st4(dst + t * LD + u0, acc);
        }
      }
    }
    lds_barrier(); RS_T(6);
    for (int i = tid; i < NC * 8; i += NTHR) ((RS_LAS unsigned*)sRHS)[(i >> 3) * (LDR / 2) + 8 + (i & 7)] = 0u;
    RS_T(7);
#pragma unroll 1
    for (int bk = 0; bk < 4; ++bk) {
      if (w < NC / 16) {
        const int tn = w;
        f32x4 acc = {0.f, 0.f, 0.f, 0.f};
        acc = tmma<64>(acc, sAT + bk * 16 * LD, LD, sZT + tn * 16 * LD, LD, lane);
        if (NC == 64 || tn >= 4) acc = tmma<64>(acc, sLak + bk * 16 * LD, LD, sVt + (NC == 64 ? tn : tn - 4) * 16 * LD, LD, lane);
        if (bk > 0) acc = tmma<64>(acc, sLoff + bk * 16 * LD, LD, sUT + tn * 16 * LD, LD, lane);
        st4(sRHS + (tn * 16 + (lane & 15)) * LDR + 4 * (lane >> 4), acc);
      }
      lds_barrier();
      if (w < NC / 16) {
        const int tn = w;
        f32x4 acc = {0.f, 0.f, 0.f, 0.f};
        acc = tmma<32>(acc, sTdg + bk * 16 * LDR, LDR, sRHS + tn * 16 * LDR, LDR, lane);
        st4(sUT + (tn * 16 + (lane & 15)) * LD + bk * 16 + 4 * (lane >> 4), acc);
      }
      lds_barrier();
    }
    RS_T(8);
    if (EMIT) {
#pragma unroll 1
      for (int m = 0; m < 2; ++m) {
        const int id = w + 8 * m, ti = id & 3, tt = id >> 2;
        f32x4 acc = {0.f, 0.f, 0.f, 0.f};
        acc = tmma<64>(acc, sZT + ti * 16 * LD, LD, sRT + tt * 16 * LD, LD, lane);
        acc = tmma<64>(acc, sUT + ti * 16 * LD, LD, sLrb + tt * 16 * LD, LD, lane);
        acc = tmma<64>(acc, sVt + ti * 16 * LD, LD, sLrk + tt * 16 * LD, LD, lane);
        const int tl = tt * 16 + (lane & 15), tok = dir ? (Tlen - 1 - (s0 + tl)) : (s0 + tl);
        st4g(Y + (size_t)dir * kROWS * 512 + ((size_t)b * Tlen + tok) * 512 + h * 64 + ti * 16 + 4 * (lane >> 4), acc);
      }
    }
#pragma unroll
    for (int m = 0; m < NT; ++m) {
      const int id = w + 8 * m, tj = id & 3, tn = id >> 2;
      f32x4 acc = {0.f, 0.f, 0.f, 0.f};
      acc = tmma<64>(acc, sBTt + tj * 16 * LD, LD, sUT + tn * 16 * LD, LD, lane);
      if (NC == 64 || tn >= 4) acc = tmma<64>(acc, sKTt + tj * 16 * LD, LD, sVt + (NC == 64 ? tn : tn - 4) * 16 * LD, LD, lane);
      const int j0 = tj * 16 + 4 * (lane >> 4), col = tn * 16 + (lane & 15);
#pragma unroll
      for (int q = 0; q < 4; ++q) Zm[m][q] = sWC[j0 + q] * (Zm[m][q] + acc[q]);
      st4(sZN + col * LD + j0, Zm[m]);
    }
    zcur ^= 1;
    RS_T(9);
  }
#pragma unroll
  for (int m = 0; m < NT; ++m) {
    const int id = w + 8 * m, tj = id & 3, tn = id >> 2, j0 = tj * 16 + 4 * (lane >> 4), col = tn * 16 + (lane & 15);
    if (Zout) *reinterpret_cast<f32x4*>(Zout + (size_t)col * 64 + j0) = Zm[m];
  }
  __syncthreads();
}
}

__device__ void scan_passB(float* lds, int chain, const float* sinit, const float* PQ, float* S0) {
  float* sS = lds;
  float* sP = lds + 64 * 65;
  const int tid = tidx(), i = tid >> 3, jq = (tid & 7) * 8;
  __syncthreads();
  for (int e = tid; e < 4096; e += NTHR) sS[(e >> 6) * 65 + (e & 63)] = sinit[e];
  for (int sc = 0; sc < kNSC; ++sc) {
    const size_t task = (size_t)chain * kNSC + sc;
    __syncthreads();
    for (int e = tid; e < 4096; e += NTHR) S0[task * 4096 + e] = sS[(e >> 6) * 65 + (e & 63)];
    if (sc == kNSC - 1) break;
    for (int e = tid; e < 2048; e += NTHR) reinterpret_cast<float4*>(sP)[e] = reinterpret_cast<const float4*>(PQ + task * 8192)[e];
    __syncthreads();
    float acc[8];
#pragma unroll
    for (int q = 0; q < 8; ++q) acc[q] = sP[(64 + i) * 64 + jq + q];
#pragma unroll 8
    for (int jp = 0; jp < 64; ++jp) {
      const float s = sS[i * 65 + jp];
      const float4 z0 = *reinterpret_cast<const float4*>(&sP[jp * 64 + jq]), z1 = *reinterpret_cast<const float4*>(&sP[jp * 64 + jq + 4]);
      acc[0] += s * z0.x; acc[1] += s * z0.y; acc[2] += s * z0.z; acc[3] += s * z0.w;
      acc[4] += s * z1.x; acc[5] += s * z1.y; acc[6] += s * z1.z; acc[7] += s * z1.w;
    }
    __syncthreads();
#pragma unroll
    for (int q = 0; q < 8; ++q) sS[i * 65 + jq + q] = acc[q];
  }
  __syncthreads();
}

typedef float cf_ __attribute__((ext_vector_type(2)));
typedef float2 cf;
#define FFT_LAS __attribute__((address_space(3)))
typedef FFT_LAS cf_* lcf;
DEV cf ldc_(const FFT_LAS cf_* q) { const cf_ v = *q; return make_float2(v.x, v.y); }
DEV void stc_(FFT_LAS cf_* q, cf v) { const cf_ w = {v.x, v.y}; *q = w; }
DEV cf cmul(cf a, cf b) { return make_float2(a.x * b.x - a.y * b.y, a.x * b.y + a.y * b.x); }
DEV cf cadd(cf a, cf b) { return make_float2(a.x + b.x, a.y + b.y); }
DEV cf csub(cf a, cf b) { return make_float2(a.x - b.x, a.y - b.y); }
DEV int PADI(int i) { return i + (i >> 4); }
constexpr int FFT_N = 16384, FFT_PAD = FFT_N + FFT_N / 16;
DEV void dft4(cf& x0, cf& x1, cf& x2, cf& x3) {
  const cf a0 = cadd(x0, x2), a1 = csub(x0, x2), a2 = cadd(x1, x3), d = csub(x1, x3);
  const cf a3 = make_float2(d.y, -d.x);
  x0 = cadd(a0, a2); x1 = cadd(a1, a3); x2 = csub(a0, a2); x3 = csub(a1, a3);
}
DEV void dft16(cf (&v)[16]) {
#pragma unroll
  for (int a = 0; a < 4; ++a) dft4(v[a], v[a + 4], v[a + 8], v[a + 12]);
  const cf w1 = make_float2(0.9238795325112867f, -0.3826834323650898f), w2 = make_float2(0.7071067811865476f, -0.7071067811865476f);
  const cf w3 = make_float2(0.3826834323650898f, -0.9238795325112867f), w6 = make_float2(-0.7071067811865476f, -0.7071067811865476f);
  const cf w9 = make_float2(-0.9238795325112867f, 0.3826834323650898f);
  v[1 + 4] = cmul(v[1 + 4], w1); v[1 + 8] = cmul(v[1 + 8], w2); v[1 + 12] = cmul(v[1 + 12], w3);
  v[2 + 4] = cmul(v[2 + 4], w2); v[2 + 8] = make_float2(v[2 + 8].y, -v[2 + 8].x); v[2 + 12] = cmul(v[2 + 12], w6);
  v[3 + 4] = cmul(v[3 + 4], w3); v[3 + 8] = cmul(v[3 + 8], w6); v[3 + 12] = cmul(v[3 + 12], w9);
#pragma unroll
  for (int c = 0; c < 4; ++c) dft4(v[4 * c], v[4 * c + 1], v[4 * c + 2], v[4 * c + 3]);
}
template <int PASS>
DEV void fft_pass16(lcf buf, int tid) {
  constexpr int lg = 4 * PASS, Ns = 1 << lg;
  cf v0[16], v1[16];
  const lcf rd = buf + PADI(tid);
#pragma unroll
  for (int r = 0; r < 16; ++r) { v0[r] = ldc_(rd + 1088 * r); v1[r] = ldc_(rd + 1088 * r + 544); }
  __syncthreads();
#pragma unroll
  for (int h = 0; h < 2; ++h) {
    cf (&v)[16] = h ? v1 : v0;
    int tl = tid; asm volatile("" : "+v"(tl) :: "memory");
    const int j = tl + 512 * h, k = j & (Ns - 1);
    if (PASS > 0) {
      float sn, cs; sincos_cw(-6.283185307179586f * (float)k / (float)(Ns * 16), sn, cs);
      const cf w = make_float2(cs, sn); cf pw = w;
#pragma unroll
      for (int r = 1; r < 16; ++r) { v[r] = cmul(v[r], pw); if (r < 15) pw = cmul(pw, w); }
    }
    dft16(v);
    const int j0 = ((j >> lg) << (lg + 4)) + k;
    const lcf wr = buf + PADI(j0);
    constexpr int step = PASS == 0 ? 1 : Ns + Ns / 16;
#pragma unroll
    for (int r = 0; r < 16; ++r) stc_(wr + step * r, v[4 * (r & 3) + (r >> 2)]);
  }
  __syncthreads();
}
__device__ void fft16384(lcf buf) {
  int tid = tidx(); asm volatile("" : "+v"(tid));
  fft_pass16<0>(buf, tid);
  fft_pass16<1>(buf, tid);
  fft_pass16<2>(buf, tid);
#pragma unroll 2
  for (int q = 0; q < 8; ++q) {
    const int j = tid + 512 * q;
    const lcf pp = buf + PADI(j);
    cf x0 = ldc_(pp), x1 = ldc_(pp + 4352), x2 = ldc_(pp + 8704), x3 = ldc_(pp + 13056);
    float sn, cs; sincos_cw(-6.283185307179586f * (float)j / 16384.0f, sn, cs);
    const cf w1 = make_float2(cs, sn), w2 = cmul(w1, w1), w3 = cmul(w2, w1);
    x1 = cmul(x1, w1); x2 = cmul(x2, w2); x3 = cmul(x3, w3);
    dft4(x0, x1, x2, x3);
    stc_(pp, x0); stc_(pp + 4352, x1); stc_(pp + 8704, x2); stc_(pp + 13056, x3);
  }
  __syncthreads();
}
DEV void hy_conv3x8(float (&u)[8], const Params& p, const bf16_t* hyt, int col, int b, int t0) {
  const bf16_t* q = hyt + (size_t)col * kROWS + b * kT;
  const uint4 cv = *reinterpret_cast<const uint4*>(q + t0);
  const float pr_ = bf2f(q[t0 > 0 ? t0 - 1 : 0]), nx_ = bf2f(q[t0 + 8 < kT ? t0 + 8 : kT - 1]);
  const float prv = t0 > 0 ? pr_ : 0.f, nxt = t0 + 8 < kT ? nx_ : 0.f;
  const float* cw = p.in[I_HCW];
  const float w0 = cw[col], w1 = cw[kHYC + col], w2 = cw[2 * kHYC + col], bs = p.in[I_HCB][col];
  const float x[10] = {prv, bflo(cv.x), bfhi(cv.x), bflo(cv.y), bfhi(cv.y), bflo(cv.z), bfhi(cv.z), bflo(cv.w), bfhi(cv.w), nxt};
#pragma unroll
  for (int i = 0; i < 8; ++i) u[i] = w0 * x[i] + w1 * x[i + 1] + w2 * x[i + 2] + bs;
}
__device__ void fftconv_channel(float* ldsf, const Params& p, int c, const float* circT, const bf16_t* hyt, bf16_t* hyot) {
  const lcf buf = (lcf)ldsf;
  float* red = ldsf + 2 * FFT_PAD;
  const int tid = tidx(), lane = tid & 63, wid = tid >> 6;
  const float* cc = circT + (size_t)c * FFT_N;
  const float hbias = p.in[I_HBIAS][c];
  unsigned H[32];
#pragma unroll
  for (int m = 0; m < 32; ++m) H[m] = 0u;
  float inrm = 0.f;
  __syncthreads();
#pragma unroll 1
  for (int ph = 0; ph < 5; ++ph) {
    const int pair = (ph - 1) >> 1, b0 = 2 * pair, b1 = b0 + 1;
    if (ph == 0) {
      float asum = 0.f;
#pragma unroll 1
      for (int mb = 0; mb < 32; mb += 16) {
        float fv[16];
#pragma unroll
        for (int m = 0; m < 16; ++m) fv[m] = cc[tid + 512 * (mb + m)];
#pragma unroll
        for (int m = 0; m < 16; ++m) { asum += fabsf(fv[m]); stc_(buf + PADI(tid) + 544 * (mb + m), make_float2(fv[m], 0.f)); }
      }
      asum = wave_sum(asum);
      if (lane == 0) red[wid] = asum;
    } else if (ph & 1) {
#pragma unroll 1
      for (int mm = 0; mm < 2; ++mm) {
        const int t0 = mm * 4096 + tid * 8;
        float v0[8], x0[8], v1[8], x1[8];
        hy_conv3x8(v0, p, hyt, 1024 + c, b0, t0); hy_conv3x8(x0, p, hyt, 512 + c, b0, t0);
        hy_conv3x8(v1, p, hyt, 1024 + c, b1, t0); hy_conv3x8(x1, p, hyt, 512 + c, b1, t0);
        const lcf dst = buf + PADI(t0);
#pragma unroll
        for (int i = 0; i < 8; ++i) { stc_(dst + i, make_float2(v0[i] * x0[i], v1[i] * x1[i])); stc_(buf + PADI(t0 + 8192) + i, make_float2(0.f, 0.f)); }
      }
    }
    __syncthreads();
    if (ph == 0) { float nrm = 0.f;
#pragma unroll
      for (int w = 0; w < 8; ++w) nrm += red[w];
      inrm = 1.0f / nrm; }
    fft16384(buf);
    if (ph == 0) {
#pragma unroll
      for (int m = 0; m < 32; ++m) { const cf hv = ldc_(buf + PADI(tid) + 544 * m); const __half2 hh = __floats2half2_rn(hv.x * inrm, hv.y * inrm); H[m] = *reinterpret_cast<const unsigned*>(&hh); }
    } else if (ph & 1) {
#pragma unroll
      for (int m = 0; m < 32; ++m) { const int i = PADI(tid) + 544 * m; const unsigned hu = H[m]; const float2 hf = __half22float2(*reinterpret_cast<const __half2*>(&hu)); const cf w = cmul(ldc_(buf + i), hf); stc_(buf + i, make_float2(w.y, w.x)); }
    } else {
      const float scale = 1.0f / (float)FFT_N;
#pragma unroll 1
      for (int mm = 0; mm < 2; ++mm) {
        const int t0 = mm * 4096 + tid * 8;
        float v0[8], x0[8], v1[8], x1[8], g0[8], g1[8];
        hy_conv3x8(v0, p, hyt, 1024 + c, b0, t0); hy_conv3x8(x0, p, hyt, 512 + c, b0, t0); hy_conv3x8(g0, p, hyt, c, b0, t0);
        hy_conv3x8(v1, p, hyt, 1024 + c, b1, t0); hy_conv3x8(x1, p, hyt, 512 + c, b1, t0); hy_conv3x8(g1, p, hyt, c, b1, t0);
        const lcf src = buf + PADI(t0);
        float o0[8], o1[8];
#pragma unroll
        for (int i = 0; i < 8; ++i) { const cf val = ldc_(src + i);
          o0[i] = (val.y * scale + hbias * v0[i] * x0[i]) * g0[i]; o1[i] = (val.x * scale + hbias * v1[i] * x1[i]) * g1[i]; }
        *reinterpret_cast<uint4*>(hyot + (size_t)c * kROWS + b0 * kT + t0) = make_uint4(pg8::cvt_pk_bf16(o0[0], o0[1]), pg8::cvt_pk_bf16(o0[2], o0[3]), pg8::cvt_pk_bf16(o0[4], o0[5]), pg8::cvt_pk_bf16(o0[6], o0[7]));
        *reinterpret_cast<uint4*>(hyot + (size_t)c * kROWS + b1 * kT + t0) = make_uint4(pg8::cvt_pk_bf16(o1[0], o1[1]), pg8::cvt_pk_bf16(o1[2], o1[3]), pg8::cvt_pk_bf16(o1[4], o1[5]), pg8::cvt_pk_bf16(o1[6], o1[7]));
      }
    }
    __syncthreads();
  }
}
__device__ void phase_hyo_transpose(float* ldsf, const bf16_t* hyot, bf16_t* hyo, int bid, int nb) {
  bf16_t* tl = reinterpret_cast<bf16_t*>(ldsf);
  const int tid = tidx();
  for (int item = bid; item < 8 * 512; item += nb) {
    const int c0 = (item & 7) * 64, t0 = (item >> 3) * 64;
    __syncthreads();
    { const int cl = tid >> 3, t8 = (tid & 7) * 8;
      const uint4 u = *reinterpret_cast<const uint4*>(hyot + (size_t)(c0 + cl) * kROWS + t0 + t8);
      *reinterpret_cast<uint4*>(tl + cl * 72 + t8) = u; }
    __syncthreads();
    { const int tl_ = tid >> 3, c8 = (tid & 7) * 8;
      unsigned w[4];
#pragma unroll
      for (int i = 0; i < 4; ++i) w[i] = (unsigned)tl[(c8 + 2 * i) * 72 + tl_] | ((unsigned)tl[(c8 + 2 * i + 1) * 72 + tl_] << 16);
      *reinterpret_cast<uint4*>(hyo + (size_t)(t0 + tl_) * 512 + c0 + c8) = make_uint4(w[0], w[1], w[2], w[3]); }
  }
}

__device__ void phase_rwout(float* lds, const Params& p, const bf16_t* rwc, const bf16_t* Y0, const bf16_t* Y1, const float* BS, bf16_t* rwo, int bid, int nb) {
  const int tid = tidx(), lane = tid & 63, wid = tid >> 6;
  bf16_t* sG = reinterpret_cast<bf16_t*>(lds);
  float* sLg = lds + 32768 + wid * 256;
  const float* mu = p.in[I_MU]; const float* gup = p.in[I_GUP]; const float* lng = p.in[I_LNG]; const float* lnb = p.in[I_LNB];
  __syncthreads();
  for (int e = tid; e < 128 * 512 / 4; e += NTHR) { const float4 v = ld4(gup + (size_t)e * 4);
    *reinterpret_cast<uint2*>(sG + (size_t)e * 4) = make_uint2(pg8::cvt_pk_bf16(v.x, v.y), pg8::cvt_pk_bf16(v.z, v.w)); }
  __syncthreads();
  const int c0 = lane * 8, h = lane >> 3;
  for (int rp = bid * 8 + wid; rp < kROWS / 2; rp += nb * 8) {
#pragma unroll
    for (int r = 0; r < 2; ++r) {
      const int row = 2 * rp + r, t = row & (kT - 1);
      const bf16_t* cur = rwc + (size_t)row * kRWC;
#pragma unroll
      for (int k = 0; k < 2; ++k) {
        const int col = 1664 + lane + 64 * k;
        const float cv = bf2f(cur[col]), pv_ = bf2f(cur[col - (t > 0 ? kRWC : 0)]), nv_ = bf2f(cur[col + (t < kT - 1 ? kRWC : 0)]);
        const float pv = t > 0 ? pv_ : 0.f, nv = t < kT - 1 ? nv_ : 0.f;
        sLg[r * 128 + lane + 64 * k] = sigmoidf_(cv + mu[col] * (pv - cv) + mu[kRWC + col] * (nv - cv));
      }
    }
    __syncthreads();
    float g0[8], g1[8];
#pragma unroll
    for (int j = 0; j < 8; ++j) { g0[j] = 0.f; g1[j] = 0.f; }
#pragma unroll 4
    for (int i = 0; i < 128; ++i) {
      const uint4 u = *reinterpret_cast<const uint4*>(sG + i * 512 + c0);
      const float s0 = sLg[i], s1 = sLg[128 + i];
      const float w0 = bflo(u.x), w1 = bfhi(u.x), w2 = bflo(u.y), w3 = bfhi(u.y), w4 = bflo(u.z), w5 = bfhi(u.z), w6 = bflo(u.w), w7 = bfhi(u.w);
      g0[0] += s0 * w0; g0[1] += s0 * w1; g0[2] += s0 * w2; g0[3] += s0 * w3; g0[4] += s0 * w4; g0[5] += s0 * w5; g0[6] += s0 * w6; g0[7] += s0 * w7;
      g1[0] += s1 * w0; g1[1] += s1 * w1; g1[2] += s1 * w2; g1[3] += s1 * w3; g1[4] += s1 * w4; g1[5] += s1 * w5; g1[6] += s1 * w6; g1[7] += s1 * w7;
    }
#pragma unroll
    for (int r = 0; r < 2; ++r) {
      const int row = 2 * rp + r, t = row & (kT - 1);
      const bf16_t* cur = rwc + (size_t)row * kRWC;
      float y[8];
      {
        const uint4 u0 = *reinterpret_cast<const uint4*>(Y0 + (size_t)row * 512 + c0), u1 = *reinterpret_cast<const uint4*>(Y1 + (size_t)row * 512 + c0);
        y[0] = bflo(u0.x) + bflo(u1.x); y[1] = bfhi(u0.x) + bfhi(u1.x); y[2] = bflo(u0.y) + bflo(u1.y); y[3] = bfhi(u0.y) + bfhi(u1.y);
        y[4] = bflo(u0.z) + bflo(u1.z); y[5] = bfhi(u0.z) + bfhi(u1.z); y[6] = bflo(u0.w) + bflo(u1.w); y[7] = bfhi(u0.w) + bfhi(u1.w);
      }
      float sum = 0.f;
#pragma unroll
      for (int j = 0; j < 8; ++j) sum += y[j];
      sum += __shfl_xor(sum, 1); sum += __shfl_xor(sum, 2); sum += __shfl_xor(sum, 4);
      const float mean = sum * (1.0f / 64.0f);
      float var = 0.f;
#pragma unroll
      for (int j = 0; j < 8; ++j) { const float d = y[j] - mean; var += d * d; }
      var += __shfl_xor(var, 1); var += __shfl_xor(var, 2); var += __shfl_xor(var, 4);
      const float rs = rsqrtf(var * (1.0f / 64.0f) + 64e-5f);
      const float bsum = BS[(size_t)row * 8 + h] + BS[((size_t)kROWS + row) * 8 + h];
      const uint4 vc = *reinterpret_cast<const uint4*>(cur + 1024 + c0);
      uint4 vp = *reinterpret_cast<const uint4*>(cur - (t > 0 ? kRWC : 0) + 1024 + c0);
      uint4 vn = *reinterpret_cast<const uint4*>(cur + (t < kT - 1 ? kRWC : 0) + 1024 + c0);
      if (t == 0) vp = make_uint4(0u, 0u, 0u, 0u);
      if (t == kT - 1) vn = make_uint4(0u, 0u, 0u, 0u);
      const unsigned cw[4] = {vc.x, vc.y, vc.z, vc.w}, pw[4] = {vp.x, vp.y, vp.z, vp.w}, nw[4] = {vn.x, vn.y, vn.z, vn.w};
      float o[8];
#pragma unroll
      for (int j = 0; j < 8; ++j) {
        const int col = 1024 + c0 + j;
        const float cv = (j & 1) ? bfhi(cw[j >> 1]) : bflo(cw[j >> 1]), pv = (j & 1) ? bfhi(pw[j >> 1]) : bflo(pw[j >> 1]), nv = (j & 1) ? bfhi(nw[j >> 1]) : bflo(nw[j >> 1]);
        const float vm = cv + mu[col] * (pv - cv) + mu[kRWC + col] * (nv - cv);
        const float yn = (y[j] - mean) * rs * lng[c0 + j] + lnb[c0 + j];
        o[j] = (yn + bsum * vm) * (r ? g1[j] : g0[j]);
      }
      *reinterpret_cast<uint4*>(rwo + (size_t)row * 512 + c0) = make_uint4(pg8::cvt_pk_bf16(o[0], o[1]), pg8::cvt_pk_bf16(o[2], o[3]), pg8::cvt_pk_bf16(o[4], o[5]), pg8::cvt_pk_bf16(o[6], o[7]));
    }
    __syncthreads();
  }
}

__device__ void phase_post(float* lds, const Params& p, float* mx, bf16_t* h2o, float* aff, const float* mod, int bid, int nb) {
  const int lane = tidx() & 63, wid = tidx() >> 6;
  __syncthreads();
  for (int e = tidx(); e < 1024 * 16 / 4; e += NTHR) reinterpret_cast<float4*>(lds)[e] = ld4(p.in[I_ROUTER] + (size_t)e * 4);
  __syncthreads();
  const float* x = p.in[I_X]; const float* n1post = p.in[I_N1POST]; const float* n2pre = p.in[I_N2PRE]; const float* rw = p.in[I_ROUTER];
  float4 hgp[4], hgn[4], hgt[4], hsc[4], hsh[4]; int hb_ = -1;
#pragma unroll
  for (int i = 0; i < 4; ++i) { hgp[i] = ld4(n1post + i * 256 + lane * 4); hgn[i] = ld4(n2pre + i * 256 + lane * 4); }
  float4 nm[4], nx[4];
  { const int r0 = bid * 8 + wid;
#pragma unroll
    for (int i = 0; i < 4; ++i) { nm[i] = ld4(mx + (size_t)r0 * kD + i * 256 + lane * 4); nx[i] = ld4(x + (size_t)r0 * kD + i * 256 + lane * 4); } }
  for (int row = bid * 8 + wid; row < kROWS; row += nb * 8) {
    const int b = row / kT;
    if (b != hb_) { hb_ = b;
#pragma unroll
      for (int i = 0; i < 4; ++i) { const int k = i * 256 + lane * 4; hgt[i] = ld4(mod + b * 6144 + 2048 + k); hsc[i] = ld4(mod + b * 6144 + 4096 + k); hsh[i] = ld4(mod + b * 6144 + 3072 + k); } }
    float m[16], xv[16];
    float4 xc[4];
    float ss = 0.f;
#pragma unroll
    for (int i = 0; i < 4; ++i) { const float4 v = nm[i]; xc[i] = nx[i];
      m[i * 4] = v.x; m[i * 4 + 1] = v.y; m[i * 4 + 2] = v.z; m[i * 4 + 3] = v.w; ss += v.x * v.x + v.y * v.y + v.z * v.z + v.w * v.w; }
    { const int nr = row + nb * 8 < kROWS ? row + nb * 8 : row;
#pragma unroll
      for (int i = 0; i < 4; ++i) { nm[i] = ld4(mx + (size_t)nr * kD + i * 256 + lane * 4); nx[i] = ld4(x + (size_t)nr * kD + i * 256 + lane * 4); } }
    ss = wave_sum(ss);
    const float r1 = rsqrtf(ss * (1.0f / kD) + 1e-6f);
    float s2 = 0.f;
#pragma unroll
    for (int i = 0; i < 4; ++i) {
      const int k = i * 256 + lane * 4;
      const float4 xx = xc[i], gp = hgp[i], gt = hgt[i];
      xv[i * 4] = xx.x + gt.x * m[i * 4] * r1 * gp.x; xv[i * 4 + 1] = xx.y + gt.y * m[i * 4 + 1] * r1 * gp.y;
      xv[i * 4 + 2] = xx.z + gt.z * m[i * 4 + 2] * r1 * gp.z; xv[i * 4 + 3] = xx.w + gt.w * m[i * 4 + 3] * r1 * gp.w;
      *reinterpret_cast<float4*>(mx + (size_t)row * kD + k) = make_float4(xv[i * 4], xv[i * 4 + 1], xv[i * 4 + 2], xv[i * 4 + 3]);
#pragma unroll
      for (int j = 0; j < 4; ++j) s2 += xv[i * 4 + j] * xv[i * 4 + j];
    }
    s2 = wave_sum(s2);
    const float r2 = rsqrtf(s2 * (1.0f / kD) + 1e-6f);
    float lgt[16];
#pragma unroll
    for (int e = 0; e < 16; ++e) lgt[e] = 0.f;
#pragma unroll
    for (int i = 0; i < 4; ++i) {
      const int k0 = i * 256 + lane * 4;
      const float4 gn = hgn[i], sc = hsc[i], sh = hsh[i];
      float hh[4];
      hh[0] = xv[i * 4] * r2 * gn.x * (1.f + sc.x) + sh.x; hh[1] = xv[i * 4 + 1] * r2 * gn.y * (1.f + sc.y) + sh.y;
      hh[2] = xv[i * 4 + 2] * r2 * gn.z * (1.f + sc.z) + sh.z; hh[3] = xv[i * 4 + 3] * r2 * gn.w * (1.f + sc.w) + sh.w;
      *reinterpret_cast<uint2*>(h2o + (size_t)row * kD + k0) = make_uint2(pg8::cvt_pk_bf16(hh[0], hh[1]), pg8::cvt_pk_bf16(hh[2], hh[3]));
#pragma unroll
      for (int j = 0; j < 4; ++j) {
        const int k = k0 + j; const float h2 = hh[j];
        const float4 w0 = *reinterpret_cast<const float4*>(lds + k * 16), w1 = *reinterpret_cast<const float4*>(lds + k * 16 + 4), w2 = *reinterpret_cast<const float4*>(lds + k * 16 + 8), w3 = *reinterpret_cast<const float4*>(lds + k * 16 + 12);
        lgt[0] += h2 * w0.x; lgt[1] += h2 * w0.y; lgt[2] += h2 * w0.z; lgt[3] += h2 * w0.w;
        lgt[4] += h2 * w1.x; lgt[5] += h2 * w1.y; lgt[6] += h2 * w1.z; lgt[7] += h2 * w1.w;
        lgt[8] += h2 * w2.x; lgt[9] += h2 * w2.y; lgt[10] += h2 * w2.z; lgt[11] += h2 * w2.w;
        lgt[12] += h2 * w3.x; lgt[13] += h2 * w3.y; lgt[14] += h2 * w3.z; lgt[15] += h2 * w3.w;
        __builtin_amdgcn_sched_barrier(0);
      }
    }
    float mxv = -1e30f;
#pragma unroll
    for (int e = 0; e < 16; ++e) { lgt[e] = wave_sum(lgt[e]); mxv = fmaxf(mxv, lgt[e]); }
    float den = 0.f;
#pragma unroll
    for (int e = 0; e < 16; ++e) { lgt[e] = expf(lgt[e] - mxv); den += lgt[e]; }
    const float inv = 1.0f / den;
    float mine = 0.f;
#pragma unroll
    for (int e = 0; e < 16; ++e) if (lane == e) mine = lgt[e] * inv;
    if (lane < 16) aff[(size_t)row * 16 + lane] = mine;
  }
}

__device__ void phase_topk(float* lds, const float* aff, int* idx, float* gate, int* sel, int bid, int nb) {
  unsigned* keys = reinterpret_cast<unsigned*>(lds);
  unsigned* hist = keys + kT;
  unsigned* misc = hist + 256;
  unsigned* wtot = misc + 4;
  const int tid = tidx(), lane = tid & 63, wid = tid >> 6;
  for (int item = bid; item < kB * kE; item += nb) {
    const int b = item / kE, e = item % kE;
    __syncthreads();
    for (int t = tid; t < kT; t += NTHR) keys[t] = __float_as_uint(aff[((size_t)b * kT + t) * 16 + e]);
    if (tid == 0) { misc[0] = 0u; misc[1] = (unsigned)kCAP; }
    __syncthreads();
#pragma unroll 1
    for (int pass = 0; pass < 4; ++pass) {
      const int shift = 24 - 8 * pass;
      if (tid < 256) hist[tid] = 0u;
      __syncthreads();
      const unsigned prefix = misc[0];
      for (int t = tid; t < kT; t += NTHR) { const unsigned k = keys[t];
        if (pass == 0 || (k >> (shift + 8)) == (prefix >> (shift + 8))) atomicAdd(&hist[(k >> shift) & 255u], 1u); }
      __syncthreads();
      if (tid == 0) {
        unsigned need = misc[1], above = 0u; int d = 255;
        for (; d > 0; --d) { const unsigned h = hist[d]; if (above + h >= need) break; above += h; }
        misc[0] = prefix | ((unsigned)d << shift); misc[1] = need - above;
      }
      __syncthreads();
    }
    const unsigned thr = misc[0], need = misc[1];
    unsigned cg = 0u, ce = 0u;
#pragma unroll
    for (int q = 0; q < 16; ++q) { const unsigned k = keys[tid * 16 + q]; cg += (k > thr); ce += (k == thr); }
    const float wg = wave_sum((float)cg), we = wave_sum((float)ce);
    if (lane == 0) { wtot[wid] = (unsigned)wg; wtot[8 + wid] = (unsigned)we; }
    __syncthreads();
    unsigned pg = cg, pe = ce;
#pragma unroll
    for (int o = 1; o < 64; o <<= 1) { const unsigned ug = __shfl_up(pg, o), ue = __shfl_up(pe, o); if (lane >= o) { pg += ug; pe += ue; } }
    unsigned og = pg - cg, oe = pe - ce;
    for (int w = 0; w < wid; ++w) { og += wtot[w]; oe += wtot[8 + w]; }
#pragma unroll 1
    for (int q = 0; q < 16; ++q) {
      const int t = tid * 16 + q; const unsigned k = keys[t];
      const bool isg = k > thr, ise = k == thr;
      const bool take = isg || (ise && oe < need);
      const unsigned pos = og + (oe < need ? oe : need);
      if (take) { idx[(e * kB + b) * kCAP + pos] = b * kT + t; gate[item * kCAP + pos] = __uint_as_float(k); }
      sel[((size_t)b * kT + t) * 16 + e] = take ? (int)pos : -1;
      og += isg; oe += ise;
    }
  }
}

__device__ void phase_final(const Params& p, const bf16_t* ye, const int* sel, float* out, const float* mod, int bid, int nb, int tsn) {
  float tscale = 1.f;
  if (TP_LO == 100) { const unsigned long long* ta = (const unsigned long long*)(p.ws + OFF_NORM + 512); float tot = 0.f; for (int k = 2; k <= 9; ++k) tot += (float)ta[k]; tscale = 1.f + sqrtf(1.0e-3f * (float)ta[TP_HI] / tot); }
  else if (TP_LO >= 0) { const unsigned long long* ts = (const unsigned long long*)(p.ws + OFF_NORM); const float tot = (float)(ts[tsn - 2] - ts[0]), part = (float)(ts[TP_HI] - ts[TP_LO]); tscale = 1.f + sqrtf(1.0e-3f * part / tot); }
  const int lane = tidx() & 63, wid = tidx() >> 6;
  const float* n2post = p.in[I_N2POST];
  float4 hgp[4], hgt[4]; int hb_ = -1;
#pragma unroll
  for (int i = 0; i < 4; ++i) hgp[i] = ld4(n2post + i * 256 + lane * 4);
  int nmyc = lane < 16 ? sel[(size_t)(bid * 8 + wid) * 16 + lane] : -1;
  float4 no[4];
#pragma unroll
  for (int i = 0; i < 4; ++i) no[i] = ld4(out + (size_t)(bid * 8 + wid) * kD + i * 256 + lane * 4);
  for (int row = bid * 8 + wid; row < kROWS; row += nb * 8) {
    const int b = row / kT;
    if (b != hb_) { hb_ = b;
#pragma unroll
      for (int i = 0; i < 4; ++i) hgt[i] = ld4(mod + b * 6144 + 5120 + i * 256 + lane * 4); }
    float m[16];
#pragma unroll
    for (int i = 0; i < 16; ++i) m[i] = 0.f;
    const int myc = nmyc;
    float4 oc[4];
#pragma unroll
    for (int i = 0; i < 4; ++i) oc[i] = no[i];
    { const int nr = row + nb * 8 < kROWS ? row + nb * 8 : row;
      nmyc = lane < 16 ? sel[(size_t)nr * 16 + lane] : -1;
#pragma unroll
      for (int i = 0; i < 4; ++i) no[i] = ld4(out + (size_t)nr * kD + i * 256 + lane * 4); }
    unsigned long long msk = __ballot(myc >= 0) & 0xffffull;
#pragma unroll 1
    while (msk) {
      const int e1 = __builtin_ctzll(msk); msk &= msk - 1;
      const bool two = msk != 0ull;
      const int e2 = two ? __builtin_ctzll(msk) : e1; if (two) msk &= msk - 1;
      const int c1 = __shfl(myc, e1), c2 = __shfl(myc, e2);
      const bf16_t* s1 = ye + ((size_t)(b * kE + e1) * kCAP + c1) * kD;
      const bf16_t* s2 = ye + ((size_t)(b * kE + e2) * kCAP + c2) * kD;
      uint2 u1[4], u2[4];
#pragma unroll
      for (int i = 0; i < 4; ++i) { u1[i] = *reinterpret_cast<const uint2*>(s1 + i * 256 + lane * 4); u2[i] = *reinterpret_cast<const uint2*>(s2 + i * 256 + lane * 4); }
      const float f2 = two ? 1.f : 0.f;
#pragma unroll
      for (int i = 0; i < 4; ++i) {
        m[i * 4] += bflo(u1[i].x) + f2 * bflo(u2[i].x); m[i * 4 + 1] += bfhi(u1[i].x) + f2 * bfhi(u2[i].x);
        m[i * 4 + 2] += bflo(u1[i].y) + f2 * bflo(u2[i].y); m[i * 4 + 3] += bfhi(u1[i].y) + f2 * bfhi(u2[i].y);
      }
    }
    float ss = 0.f;
#pragma unroll
    for (int i = 0; i < 16; ++i) ss += m[i] * m[i];
    ss = wave_sum(ss);
    const float r = rsqrtf(ss * (1.0f / kD) + 1e-6f);
#pragma unroll
    for (int i = 0; i < 4; ++i) {
      const int k = i * 256 + lane * 4;
      float4 o = oc[i];
      const float4 gp = hgp[i], gt = hgt[i];
      o.x += gt.x * m[i * 4] * r * gp.x; o.y += gt.y * m[i * 4 + 1] * r * gp.y; o.z += gt.z * m[i * 4 + 2] * r * gp.z; o.w += gt.w * m[i * 4 + 3] * r * gp.w;
      if (TP_LO >= 0) { o.x *= tscale; o.y *= tscale; o.z *= tscale; o.w *= tscale; }
      *reinterpret_cast<float4*>(out + (size_t)row * kD + k) = o;
    }
  }
}


DEV void grid_barrier(unsigned* cnt, unsigned target) {
  asm volatile("s_waitcnt vmcnt(0) lgkmcnt(0)" ::: "memory");
  __syncthreads();
  if (threadIdx.x == 0) {
    __builtin_amdgcn_fence(__ATOMIC_RELEASE, "agent");
    asm volatile("s_waitcnt vmcnt(0)" ::: "memory");
    __hip_atomic_fetch_add(cnt, 1u, __ATOMIC_RELAXED, __HIP_MEMORY_SCOPE_AGENT);
    while (__hip_atomic_load(cnt, __ATOMIC_RELAXED, __HIP_MEMORY_SCOPE_AGENT) < target) __builtin_amdgcn_s_sleep(2);
    __builtin_amdgcn_fence(__ATOMIC_ACQUIRE, "agent");
    asm volatile("s_waitcnt vmcnt(0)" ::: "memory");
  }
  __syncthreads();
}

template <class Epi, class Sched, bool G>
DEV void run_gemm(float* lds, int K, const Sched& S, const Epi& E) {
  __syncthreads();
  pg8::gemm_phase<Epi, Sched, G>((PG8_LAS unsigned char*)lds, K, S, E);
  __syncthreads();
}

#if defined(__HIP_DEVICE_COMPILE__)
typedef __attribute__((address_space(4))) const Params* kargs_ptr;
DEV kargs_ptr kargs() { kargs_ptr k = (kargs_ptr)__builtin_amdgcn_kernarg_segment_ptr(); asm volatile("" : "+s"(k)); return k; }
#else
typedef const Params* kargs_ptr;
__device__ inline kargs_ptr kargs() { return nullptr; }
#endif
__global__ void __launch_bounds__(NTHR, 2) fwd_megakernel(Params p_by_value_unused) {
#define p (*kargs())
  extern __shared__ __attribute__((aligned(16))) float lds[];
  cg::grid_group grid = cg::this_grid();
  const int bid = blockIdx.x, nb = gridDim.x;
  char* const wsx = p.ws;
  int tsn = 0;
  unsigned gb_n = 0;
#define GBAR() do { ++gb_n; grid_barrier((unsigned*)(wsx + OFF_CNT), gb_n * (unsigned)nb); } while (0)
#define STAMP() do { if (TP_LO >= 0) { if (bid == 0 && threadIdx.x == 0) ((unsigned long long*)(wsx + OFF_NORM))[tsn] = __builtin_amdgcn_s_memrealtime(); ++tsn; } } while (0)
  STAMP();
  if (TP_LO == 100 && bid == 0 && threadIdx.x < 16) ((unsigned long long*)(wsx + OFF_NORM + 512))[threadIdx.x] = 0ull;
  char* const ws = p.ws;
  constexpr size_t MB = 1048576;
#define b_mod   ((float*)(ws + OFF_MOD))
#define b_rstdc ((float*)(ws + OFF_RSTDC))
#define b_sctx  ((float*)(ws + OFF_SCTX))
#define b_BS    ((float*)(ws + OFF_BS))
#define b_aff   ((float*)(ws + OFF_AFF))
#define b_idx   ((int*)(ws + OFF_IDX))
#define b_gate  ((float*)(ws + OFF_GATE))
#define b_HC    ((bf16_t*)(ws + OFF_A1 + 244 * MB))
#define b_CC    ((bf16_t*)(ws + OFF_A1 + 240 * MB))
#define b_kfu   ((float*)(ws + OFF_KFU))
#define b_sel   ((int*)(ws + OFF_SEL))
#define b_winT  ((const char*)(ws + OFF_WINT))
#define b_hpT   ((const char*)(ws + OFF_HPT))
#define b_rpT   ((const char*)(ws + OFF_RPT))
#define b_woT   ((const char*)(ws + OFF_WOT))
#define b_w13T  ((const char*)(ws + OFF_W13T))
#define b_w2T   ((const char*)(ws + OFF_W2T))
#define b_hb    ((bf16_t*)(ws + OFF_A0))
#define b_A1    (ws + OFF_A1)
#define b_HYT   ((bf16_t*)(b_A1))
#define b_RWC   ((bf16_t*)(b_A1 + 96 * MB))
#define b_HYOT  ((bf16_t*)(b_A1 + 208 * MB))
#define b_HYO   ((bf16_t*)(b_A1))
#define b_RWO   ((bf16_t*)(b_A1 + 32 * MB))
#define b_YH    ((bf16_t*)(b_A1 + 96 * MB))
#define b_YR    ((bf16_t*)(b_A1 + 160 * MB))
#define b_PRE   ((bf16_t*)(b_A1))
#define b_HID0  ((bf16_t*)(b_A1))
#define b_YE    ((bf16_t*)(b_A1 + 128 * MB))
#define b_Y0    ((bf16_t*)(p.out + (size_t)kROWS * 512))
#define b_Y1    (b_Y0 + (size_t)kROWS * 512)
#define b_PQ    (p.out)
#define b_S0    ((float*)(ws + OFF_KFU))

  phase_mod(lds, p.in[I_C], p.in[I_CCTX], p.in[I_MODW], p.in[I_MODB], b_mod, bid, nb);
  phase_filter(lds, p, b_kfu, bid, nb);
  phase_wprep(lds, p, ws, bid, nb);
  grid.sync(); STAMP();
  phase_hb(p, b_mod, b_hb, b_HC, bid, nb);
  GBAR(); STAMP();
  {
    SchedPlain S0; S0.o.init(4, 5, nb, bid); S0.A = (const char*)b_HC; S0.B = b_winT + (size_t)2048 * kD * 2; S0.tstep = (size_t)256 * kD * 2;
    EpiBf16Split E0{b_CC, kCC, 5, b_CC, kCC};
    run_gemm<EpiBf16Split, SchedPlain, false>(lds, kD, S0, E0);
    SchedPlain S; S.o.init(kROWS / 256, 7, nb, bid); S.A = (const char*)b_hb; S.B = b_winT + (size_t)1536 * kD * 2; S.tstep = (size_t)256 * kD * 2;
    EpiBf16Split E{b_RWC, kRWC, 7, b_RWC, kRWC};
    run_gemm<EpiBf16Split, SchedPlain, false>(lds, kD, S, E);
    SchedPlain S2; S2.o.init(6, kROWS / 256, nb, bid); S2.A = b_winT; S2.B = (const char*)b_hb; S2.tstep = (size_t)256 * kD * 2;
    EpiBf16Split E2{b_HYT, kROWS, kROWS / 256, b_HYT, kROWS};
    run_gemm<EpiBf16Split, SchedPlain, false>(lds, kD, S2, E2);
  }
  GBAR(); STAMP();
  {
    constexpr int NTA = 64 * (kNSC - 1);
    const bool bal = nb == 256, light = bal && bid >= 192;
    const int kc = light ? bid - 192 : bid;
    if (light || (!bal && bid < 64)) {
      const int dir = kc >> 5, b = (kc >> 3) & 3, h = kc & 7;
      rs::scan_task<64, false>(lds, p, b_CC, kCC, kCTX, 0, 0, 512, 1024, 1088, 512, b, h, dir, 0, 4, nullptr, b_sctx + (size_t)kc * 4096, nullptr, nullptr);
    }
    const int c0 = !bal ? bid : (light ? 320 + (bid - 192) * 3 : (bid < 128 ? bid : 256 + (bid - 128)));
    const int cstep = !bal ? nb : (light ? 1 : 128);
    const int cend = !bal ? 512 : (light ? c0 + 3 : (bid < 128 ? 256 : c0 + 1));
    for (int c = c0; c < cend; c += cstep) fftconv_channel(lds, p, c, b_kfu, b_HYT, b_HYOT);
    const int t0 = light ? 384 + (bid - 192) : bid, tstep = bal ? 192 : nb, tend = bal ? (light ? t0 + 1 : 384) : NTA;
    for (int task = t0; task < tend; task += tstep) {
      const int chain = task / (kNSC - 1), sc = task % (kNSC - 1), dir = chain >> 5, b = (chain >> 3) & 3, h = chain & 7;
      rs::scan_task<128, false>(lds, p, b_RWC, kRWC, kT, 0, 512, 1024, 1536, 1600, 0, b, h, dir, sc * kSCC * 64, kSCC, nullptr, b_PQ + ((size_t)chain * kNSC + sc) * 8192, nullptr, nullptr);
    }
  }
  GBAR(); STAMP();
  if (bid < 64) scan_passB(lds, bid, b_sctx + (size_t)bid * 4096, b_PQ, b_S0);
  phase_hyo_transpose(lds, b_HYOT, b_HYO, bid, nb);
  GBAR(); STAMP();
  for (int task = bid; task < 64 * kNSC; task += nb) {
    const int chain = task / kNSC, sc = task % kNSC, dir = chain >> 5, b = (chain >> 3) & 3, h = chain & 7;
    rs::scan_task<64, true>(lds, p, b_RWC, kRWC, kT, 0, 512, 1024, 1536, 1600, 0, b, h, dir, sc * kSCC * 64, kSCC, b_S0 + (size_t)task * 4096, nullptr, b_Y0, b_BS);
  }
  GBAR(); STAMP();
  phase_rwout(lds, p, b_RWC, b_Y0, b_Y1, b_BS, b_RWO, bid, nb);
  GBAR(); STAMP();
  {
    SchedPlain S; S.o.init(kROWS / 256, 4, nb, bid); S.A = (const char*)b_HYO; S.B = b_hpT; S.tstep = (size_t)256 * 512 * 2;
    EpiBf16Split E{b_YH, kD, 4, b_YH, kD};
    run_gemm<EpiBf16Split, SchedPlain, false>(lds, 512, S, E);
    SchedPlain S2; S2.o.init(kROWS / 256, 4, nb, bid); S2.A = (const char*)b_RWO; S2.B = b_rpT; S2.tstep = (size_t)256 * 512 * 2;
    EpiBf16Split E2{b_YR, kD, 4, b_YR, kD};
    run_gemm<EpiBf16Split, SchedPlain, false>(lds, 512, S2, E2);
  }
  GBAR(); STAMP();
  {
    SchedPlain S; S.o.init(kROWS / 256, 8, nb, bid); S.A = (const char*)b_hb; S.B = b_winT + (size_t)3328 * kD * 2; S.tstep = (size_t)256 * kD * 2;
    EpiGatesMerge E{b_YH, b_YR, b_PRE};
    run_gemm<EpiGatesMerge, SchedPlain, false>(lds, kD, S, E);
  }
  GBAR(); STAMP();
  {
    SchedPlain S; S.o.init(kROWS / 256, 4, nb, bid); S.A = (const char*)b_PRE; S.B = b_woT; S.tstep = (size_t)256 * kD * 2;
    EpiF32Store E{p.out, kD};
    run_gemm<EpiF32Store, SchedPlain, false>(lds, kD, S, E);
  }
  GBAR(); STAMP();
  phase_post(lds, p, p.out, b_hb, b_aff, b_mod, bid, nb);
  GBAR(); STAMP();
  phase_topk(lds, b_aff, b_idx, b_gate, b_sel, bid, nb);
  GBAR(); STAMP();
  for (int g = 0; g <= 4; ++g) {
    if (g < 4) {
      SchedExp1 S; S.o.init(64, 16, nb, bid); S.H2 = (const char*)b_hb; S.W13T = b_w13T; S.idx = b_idx + g * 4 * 4096; S.e0 = g * 4;
      EpiSwiGLU E{b_HID0 + (size_t)(g & 1) * 16384 * kF};
      run_gemm<EpiSwiGLU, SchedExp1, true>(lds, kD, S, E);
    }
    if (g > 0) {
      SchedExp2 S; S.o.init(64, 4, nb, bid); S.HID = (const char*)(b_HID0 + (size_t)((g - 1) & 1) * 16384 * kF); S.W2T = b_w2T; S.e0 = (g - 1) * 4;
      EpiYE E{b_YE, b_gate, (g - 1) * 4};
      run_gemm<EpiYE, SchedExp2, false>(lds, kF, S, E);
    }
    GBAR(); STAMP();
  }
  phase_final(p, b_YE, b_sel, p.out, b_mod, bid, nb, tsn);
}

#undef b_mod
#undef b_rstdc
#undef b_sctx
#undef b_BS
#undef b_aff
#undef b_idx
#undef b_gate
#undef b_CC
#undef b_HC
#undef b_kfu
#undef b_sel
#undef b_winT
#undef b_hpT
#undef b_rpT
#undef b_woT
#undef b_w13T
#undef b_w2T
#undef b_hb
#undef b_A1
#undef b_HYT
#undef b_RWC
#undef b_HYOT
#undef b_HYO
#undef b_RWO
#undef b_YH
#undef b_YR
#undef b_PRE
#undef b_HID0
#undef b_YE
#undef b_Y0
#undef b_Y1
#undef p
#undef b_PQ
#undef b_S0
extern "C" void kernel_launch(void* const* d_in, const int* in_sizes, int n_in, void* d_out, int out_size, void* d_ws, size_t ws_size,
                              hipStream_t stream) {
  static int grid_blocks = 0;
  if (!grid_blocks) {
    int dev = 0, cus = 0, per_cu = 0;
    (void)hipGetDevice(&dev);
    (void)hipDeviceGetAttribute(&cus, hipDeviceAttributeMultiprocessorCount, dev);
    (void)hipFuncSetAttribute((const void*)fwd_megakernel, hipFuncAttributeMaxDynamicSharedMemorySize, (int)LDS_BYTES);
    (void)hipOccupancyMaxActiveBlocksPerMultiprocessor(&per_cu, fwd_megakernel, NTHR, LDS_BYTES);
    if (per_cu < 1) per_cu = 1;
    if (per_cu > 1) per_cu = 1;
    grid_blocks = cus * per_cu;
    if (ws_size < WS_TOTAL) fprintf(stderr, "kernel_launch: workspace too small: %zu < %zu\n", ws_size, (size_t)WS_TOTAL);
  }
  if (ws_size < WS_TOTAL) return;
  Params p{};
  for (int i = 0; i < 38; ++i) p.in[i] = (const float*)d_in[i];
  p.out = (float*)d_out;
  p.ws = (char*)d_ws;
    (void)hipMemsetAsync((char*)d_ws + OFF_CNT, 0, 256, stream);
  void* args[] = {&p};
  hipError_t e = hipLaunchCooperativeKernel((void*)fwd_megakernel, dim3(grid_blocks), dim3(NTHR), args, LDS_BYTES, stream);
  if (e != hipSuccess) fprintf(stderr, "cooperative launch failed: %s (grid %d)\n", hipGetErrorString(e), grid_blocks);
}
```

```cpp
#include <hip/hip_runtime.h>
#include <hip/hip_cooperative_groups.h>
#include <hip/hip_fp16.h>
#include <cstdio>
#include <cstdint>
namespace cg = cooperative_groups;

#define DEV __device__ __forceinline__
typedef float f32x16 __attribute__((ext_vector_type(16)));

constexpr int kD = 1024, kB = 4, kT = 8192, kCTX = 256, kROWS = kB * kT;
constexpr int kHYW = 512, kHYC = 1536, kRWW = 512, kRWC = 1792, kINC = 5376;
constexpr int kH = 8, kE = 16, kF = 2048, kCAP = 1024;
constexpr int kSCC = 16, kNSC = kT / (64 * kSCC);
constexpr int kCC = 1280;
constexpr int NTHR = 512;
constexpr size_t LDS_BYTES = 160 * 1024;

constexpr size_t OFF_MOD   = 0;
constexpr size_t OFF_RSTDC = OFF_MOD + 131072;
constexpr size_t OFF_NORM  = OFF_RSTDC + 4096;
constexpr size_t OFF_CNT   = OFF_NORM + 2048;
constexpr size_t OFF_SCTX  = OFF_CNT + 256;
constexpr size_t OFF_BS    = OFF_SCTX + 1048576;
constexpr size_t OFF_AFF   = OFF_BS + 2097152;
constexpr size_t OFF_IDX   = OFF_AFF + 2097152;
constexpr size_t OFF_GATE  = OFF_IDX + 262144;
constexpr size_t OFF_KFU   = OFF_GATE + 262144;
constexpr size_t OFF_SEL   = OFF_KFU + 33554432;
constexpr size_t OFF_WINT  = OFF_SEL + 2097152;
constexpr size_t OFF_HPT   = OFF_WINT + 11010048;
constexpr size_t OFF_RPT   = OFF_HPT + 1048576;
constexpr size_t OFF_WOT   = OFF_RPT + 1048576;
constexpr size_t OFF_W13T  = OFF_WOT + 2097152;
constexpr size_t OFF_W2T   = OFF_W13T + 134217728;
constexpr size_t OFF_A0    = OFF_W2T + 67108864;
constexpr size_t OFF_A1    = OFF_A0 + 67108864;
constexpr size_t A1_BYTES  = 268435456;
constexpr size_t WS_TOTAL  = OFF_A1 + A1_BYTES;
static_assert(WS_TOTAL <= 597000000, "workspace budget");

struct Params {
  const float* in[38];
  float* out;
  char* ws;
};
constexpr int TP_LO = -1, TP_HI = -1;


enum { I_X = 0, I_C, I_CTX, I_CCTX, I_MODW, I_MODB, I_N1PRE, I_N1POST, I_N2PRE, I_N2POST, I_WIN,
       I_HCW, I_HCB, I_HW1, I_HB1, I_HW2, I_HB2, I_HW3, I_HFREQ, I_HBIAS, I_HPROJ,
       I_MU, I_W0, I_WUP, I_A0, I_AUP, I_GUP, I_KK, I_KA, I_RK, I_LNG, I_LNB, I_RWPROJ, I_WOUT, I_ROUTER,
       I_EW1, I_EW3, I_EW2 };

DEV int tidx() { int t = threadIdx.x; asm volatile("" : "+v"(t)); return t; }
DEV float wave_sum(float v) {
  int x;
  x = __builtin_amdgcn_update_dpp(0, __float_as_int(v), 0xB1, 0xF, 0xF, false); v += __int_as_float(x);
  x = __builtin_amdgcn_update_dpp(0, __float_as_int(v), 0x4E, 0xF, 0xF, false); v += __int_as_float(x);
  x = __builtin_amdgcn_update_dpp(0, __float_as_int(v), 0x141, 0xF, 0xF, false); v += __int_as_float(x);
  x = __builtin_amdgcn_update_dpp(0, __float_as_int(v), 0x140, 0xF, 0xF, false); v += __int_as_float(x);
  const float r0 = __int_as_float(__builtin_amdgcn_readlane(__float_as_int(v), 0)), r1 = __int_as_float(__builtin_amdgcn_readlane(__float_as_int(v), 16));
  const float r2 = __int_as_float(__builtin_amdgcn_readlane(__float_as_int(v), 32)), r3 = __int_as_float(__builtin_amdgcn_readlane(__float_as_int(v), 48));
  return (r0 + r1) + (r2 + r3);
}
DEV float sigmoidf_(float x) { return 1.0f / (1.0f + expf(-x)); }
DEV float siluf_(float x) { return x / (1.0f + expf(-x)); }
DEV float softplusf_(float x) { return x > 20.f ? x : log1pf(expf(x)); }
DEV void sincos_cw(float x, float& sn, float& cs) {
  const float kf = rintf(x * 0.6366197723675814f);
  const int k = (int)kf;
  float r = fmaf(kf, -1.5703125f, x);
  r = fmaf(kf, -4.837512969970703125e-4f, r);
  r = fmaf(kf, -7.54978995489188216e-8f, r);
  const float r2 = r * r;
  const float sp = r + r * r2 * (-1.6666654611e-1f + r2 * (8.3321608736e-3f + r2 * (-1.9515295891e-4f)));
  const float cp = 1.0f - 0.5f * r2 + r2 * r2 * (4.166664568298827e-2f + r2 * (-1.388731625493765e-3f + r2 * 2.443315711809948e-5f));
  const float s0 = (k & 1) ? cp : sp, c0 = (k & 1) ? sp : cp;
  sn = (k & 2) ? -s0 : s0;
  cs = ((k + 1) & 2) ? -c0 : c0;
}
DEV float sin_cw(float x) { float a, b; sincos_cw(x, a, b); return a; }
DEV float4 ld4(const float* p) { return *reinterpret_cast<const float4*>(p); }

namespace pg8 {
#define PG8_LAS __attribute__((address_space(3)))
typedef unsigned short bf16_t;
typedef short bf16x8 __attribute__((ext_vector_type(8)));
typedef float f32x4 __attribute__((ext_vector_type(4)));
typedef unsigned u32x4 __attribute__((ext_vector_type(4)));
typedef unsigned u32x2 __attribute__((ext_vector_type(2)));
constexpr int BM = 256, BK = 64, HALF = 128, HTB = HALF * BK * 2, STAGE_BYTES = 8 * HTB, NXCD = 8, WGM = 8;
__host__ __device__ __forceinline__ int lds_byte(int r, int c) { const int st = (r >> 4) * 2 + (c >> 5), rr = r & 15, cc = c & 31, ob = rr * 64 + cc * 2; return st * 1024 + (ob ^ (((ob >> 9) & 1) << 5)); }
__host__ __device__ __forceinline__ void stage_rc(int b, int& R, int& C) { const int st = b / 1024, sb = b % 1024, swz = sb ^ (((sb >> 9) & 1) << 5); R = (st >> 1) * 16 + swz / 64; C = (st & 1) * 32 + (swz % 64) / 2; }
__host__ __device__ __forceinline__ int perm32(int rho) { const int n = rho >> 4, i = rho & 15; return 8 * (i >> 2) + 4 * n + (i & 3); }
typedef __bf16 bf16v2 __attribute__((ext_vector_type(2)));
typedef float f32v2 __attribute__((ext_vector_type(2)));
__device__ __forceinline__ unsigned cvt_pk_bf16(float lo, float hi) { const f32v2 v = {lo, hi}; const bf16v2 r = __builtin_convertvector(v, bf16v2); return __builtin_bit_cast(unsigned, r); }

struct Unit { int pm, pn; const char* a; const char* b; };

struct TileOrder {
  int nM, nN, nwg, G, c;
  __device__ void init(int nM_, int nN_, int G_, int c_) { nM = nM_; nN = nN_; nwg = nM * nN; G = G_; c = c_; }
  __device__ bool tile(int i, int& pm, int& pn) const {
    const long L = (long)i * G + c; if (L >= nwg) return false;
    int wgid = (int)L; { const int q = nwg / NXCD, r = nwg % NXCD, xcd = wgid % NXCD, off = wgid / NXCD; wgid = (xcd < r ? xcd * (q + 1) : r * (q + 1) + (xcd - r) * q) + off; }
    const int nig = WGM * nN, gid = wgid / nig, fm = gid * WGM, gsz = (nM - fm) < WGM ? (nM - fm) : WGM;
    pm = fm + ((wgid % nig) % gsz); pn = (wgid % nig) / gsz; return true;
  }
};

template <class Epi, class Sched, bool GATHER>
__device__ __forceinline__ void gemm_phase(PG8_LAS unsigned char* lds, const int K, const Sched& S, const Epi& E) {
  int tid_ = tidx(); asm volatile("" : "+v"(tid_));
  const int tid = tid_, wid = __builtin_amdgcn_readfirstlane(tid >> 6), lane = tid & 63, wr = wid >> 2, wc = wid & 3, fr = lane & 15, fq = lane >> 4;
  const int nt = K / BK;
  unsigned voffA[2], voffB[2];
#pragma unroll
  for (int i = 0; i < 2; ++i) { int R, C; stage_rc(tid * 16 + i * 8192, R, C); const int Rb = Epi::PERM ? ((R & ~31) + perm32(R & 31)) : R;
    voffA[i] = (unsigned)(R * K + C) * 2u; voffB[i] = (unsigned)(Rb * K + C) * 2u; }
  const size_t kstep = (size_t)(BK * 2);
  const size_t hstep = (size_t)HALF * K * 2;
  const unsigned ldsw = (unsigned)wid * 1024u;
  const int aoff = lds_byte(wr * 64 + fr, fq * 8), boff = lds_byte(wc * 32 + fr, fq * 8);
#define PG8_SA(b, h) (((b) * 2 + (h)) * HTB)
#define PG8_SB(b, h) ((4 + (b) * 2 + (h)) * HTB)
#define PG8_STAGE(bufoff, gbase, voff) do { _Pragma("unroll") for (int _i = 0; _i < 2; ++_i) \
    __builtin_amdgcn_global_load_lds((const unsigned*)((const char*)(gbase) + (voff)[_i]), (PG8_LAS unsigned*)(lds + (bufoff) + ldsw + _i * 8192), 16, 0, 0); } while (0)
#define PG8_STAGE_A(bufoff, gbase, h) do { if constexpr (GATHER) { PG8_STAGE(bufoff, gbase, vAc[h]); } else { PG8_STAGE(bufoff, (gbase) + (h) * hstep, voffA); } } while (0)
#define PG8_GATHER_OFFS(dst, u) do { _Pragma("unroll") for (int _h = 0; _h < 2; ++_h) _Pragma("unroll") for (int _i = 0; _i < 2; ++_i) { int _R, _C; stage_rc(tid * 16 + _i * 8192, _R, _C); \
    dst[_h][_i] = (unsigned)S.row(u, _h * HALF + _R) * (unsigned)(K * 2) + (unsigned)(_C * 2); } } while (0)
#define PG8_LDA(dst, b, h) do { _Pragma("unroll") for (int m = 0; m < 4; ++m) _Pragma("unroll") for (int k = 0; k < 2; ++k) dst[m][k] = *(const PG8_LAS bf16x8*)(lds + PG8_SA(b, h) + aoff + m * 2048 + k * 1024); } while (0)
#define PG8_LDB(dst, b, h) do { _Pragma("unroll") for (int n = 0; n < 2; ++n) _Pragma("unroll") for (int k = 0; k < 2; ++k) dst[n][k] = *(const PG8_LAS bf16x8*)(lds + PG8_SB(b, h) + boff + n * 2048 + k * 1024); } while (0)
#define PG8_MMA(ai, bj, At, Bt) do { __builtin_amdgcn_s_setprio(1); _Pragma("unroll") for (int m = 0; m < 4; ++m) _Pragma("unroll") for (int n = 0; n < 2; ++n) _Pragma("unroll") for (int k = 0; k < 2; ++k) \
    acc[ai][bj][m][n] = __builtin_amdgcn_mfma_f32_16x16x32_bf16(Bt[n][k], At[m][k], acc[ai][bj][m][n], 0, 0, 0); __builtin_amdgcn_s_setprio(0); } while (0)
#define PG8_WAIT_V(n) asm volatile("s_waitcnt vmcnt(" #n ")" ::: "memory")
#define PG8_WAIT_L(n) asm volatile("s_waitcnt lgkmcnt(" #n ")" ::: "memory")
#define PG8_BAR __builtin_amdgcn_s_barrier()
#define PG8_SCHED __builtin_amdgcn_sched_barrier(0)
  Unit cur, nxt; int ui = 0;
  if (!S.next(0, cur)) return;
  unsigned vAc[2][2];
  if constexpr (GATHER) { PG8_GATHER_OFFS(vAc, cur); }
  else { vAc[0][0] = vAc[0][1] = vAc[1][0] = vAc[1][1] = 0u; }
  f32x4 acc[2][2][4][2];
#pragma unroll
  for (int a = 0; a < 2; ++a)
#pragma unroll
    for (int b = 0; b < 2; ++b)
#pragma unroll
      for (int m = 0; m < 4; ++m)
#pragma unroll
        for (int n = 0; n < 2; ++n) acc[a][b][m][n] = (f32x4){0.f, 0.f, 0.f, 0.f};
  bf16x8 At[4][2], B0[2][2], B1[2][2];
  const char* cA = cur.a; const char* cB = cur.b;
  PG8_STAGE(PG8_SB(0, 0), cB, voffB); PG8_STAGE_A(PG8_SA(0, 0), cA, 0); PG8_STAGE(PG8_SB(0, 1), cB + hstep, voffB); PG8_STAGE_A(PG8_SA(0, 1), cA, 1);
  if (wr == 1) PG8_BAR;
  PG8_WAIT_V(4); PG8_BAR;
  PG8_STAGE(PG8_SB(1, 0), cB + kstep, voffB); PG8_STAGE_A(PG8_SA(1, 0), cA + kstep, 0); PG8_STAGE(PG8_SB(1, 1), cB + hstep + kstep, voffB);
  PG8_WAIT_V(6); PG8_BAR;
  for (;;) {
    const bool has_next = S.next(ui + 1, nxt);
    const char* nA = has_next ? nxt.a : cA; const char* nB = has_next ? nxt.b : cB;
    for (int t = 0; t < nt; t += 2) {
      const bool last = (t == nt - 2);
      const char* a1 = cA + (size_t)(t + 1) * kstep;
      const char* a2 = last ? nA : cA + (size_t)(t + 2) * kstep; const char* b2 = last ? nB : cB + (size_t)(t + 2) * kstep;
      const char* a3 = a2 + kstep; const char* b3 = b2 + kstep;
      unsigned vAn[2][2];
      if constexpr (GATHER) { PG8_SCHED; if (last && has_next) { PG8_GATHER_OFFS(vAn, nxt); } PG8_SCHED; }
      PG8_LDB(B0, 0, 0); PG8_SCHED; PG8_LDA(At, 0, 0); PG8_STAGE_A(PG8_SA(1, 1), a1, 1);
      PG8_WAIT_L(8); PG8_BAR; PG8_WAIT_L(0); PG8_MMA(0, 0, At, B0); PG8_BAR; PG8_SCHED;
      if constexpr (GATHER) { if (last && has_next) { vAc[0][0] = vAn[0][0]; vAc[0][1] = vAn[0][1]; vAc[1][0] = vAn[1][0]; vAc[1][1] = vAn[1][1]; } }
      PG8_LDB(B1, 0, 1); PG8_STAGE(PG8_SB(0, 0), b2, voffB);
      PG8_BAR; PG8_WAIT_L(0); PG8_MMA(0, 1, At, B1); PG8_BAR;
      PG8_LDA(At, 0, 1); PG8_STAGE_A(PG8_SA(0, 0), a2, 0);
      PG8_BAR; PG8_WAIT_L(0); PG8_MMA(1, 0, At, B0); PG8_BAR; PG8_SCHED;
      PG8_STAGE(PG8_SB(0, 1), b2 + hstep, voffB);
      PG8_WAIT_V(6); PG8_BAR; PG8_MMA(1, 1, At, B1); PG8_BAR;
      PG8_LDB(B0, 1, 0); PG8_SCHED; PG8_LDA(At, 1, 0); PG8_STAGE_A(PG8_SA(0, 1), a2, 1);
      PG8_WAIT_L(8); PG8_BAR; PG8_WAIT_L(0); PG8_MMA(0, 0, At, B0); PG8_BAR; PG8_SCHED;
      PG8_LDB(B1, 1, 1); PG8_STAGE(PG8_SB(1, 0), b3, voffB);
      PG8_BAR; PG8_WAIT_L(0); PG8_MMA(0, 1, At, B1); PG8_BAR;
      PG8_LDA(At, 1, 1); PG8_STAGE_A(PG8_SA(1, 0), a3, 0);
      PG8_BAR; PG8_WAIT_L(0); PG8_MMA(1, 0, At, B0); PG8_BAR; PG8_SCHED;
      PG8_STAGE(PG8_SB(1, 1), b3 + hstep, voffB);
      PG8_WAIT_V(6); PG8_BAR; PG8_MMA(1, 1, At, B1); PG8_BAR;
    }
    E(acc, cur, wr, wc, fr, fq);
    if (!has_next) break;
#pragma unroll
    for (int a = 0; a < 2; ++a)
#pragma unroll
      for (int b = 0; b < 2; ++b)
#pragma unroll
        for (int m = 0; m < 4; ++m)
#pragma unroll
          for (int n = 0; n < 2; ++n) acc[a][b][m][n] = (f32x4){0.f, 0.f, 0.f, 0.f};
    cur = nxt; cA = nA; cB = nB; ++ui;
  }
  PG8_WAIT_V(0);
  if (wr == 0) PG8_BAR;
  PG8_BAR;
#undef PG8_SA
#undef PG8_SB
#undef PG8_STAGE
#undef PG8_STAGE_A
#undef PG8_GATHER_OFFS
#undef PG8_LDA
#undef PG8_LDB
#undef PG8_MMA
#undef PG8_WAIT_V
#undef PG8_WAIT_L
#undef PG8_BAR
#undef PG8_SCHED
}
}

__device__ void transpose_tile(float* tl, const float* src, int ld, int scol0, unsigned short* dst, int K, int n0, int k0) {
  const int tid = tidx();
  __syncthreads();
#pragma unroll
  for (int ps = 0; ps < 4; ++ps) {
    const int kr = ps * 32 + (tid >> 4), c4 = (tid & 15) * 4;
    const float4 v = ld4(src + (size_t)(k0 + kr) * ld + scol0 + c4);
    tl[kr * 65 + c4] = v.x; tl[kr * 65 + c4 + 1] = v.y; tl[kr * 65 + c4 + 2] = v.z; tl[kr * 65 + c4 + 3] = v.w;
  }
  __syncthreads();
  const int n = tid >> 3, kq = (tid & 7) * 16;
  unsigned w[8];
#pragma unroll
  for (int i = 0; i < 8; ++i) w[i] = pg8::cvt_pk_bf16(tl[(kq + 2 * i) * 65 + n], tl[(kq + 2 * i + 1) * 65 + n]);
  uint4* o = reinterpret_cast<uint4*>(dst + (size_t)(n0 + n) * K + k0 + kq);
  o[0] = make_uint4(w[0], w[1], w[2], w[3]); o[1] = make_uint4(w[4], w[5], w[6], w[7]);
}

typedef unsigned short bf16_t;
DEV float bf2f(bf16_t v) { return __uint_as_float((unsigned)v << 16); }
DEV float bflo(unsigned w) { return __uint_as_float(w << 16); }
DEV float bfhi(unsigned w) { return __uint_as_float(w & 0xffff0000u); }
DEV bf16_t f2bf(float f) { return (bf16_t)(pg8::cvt_pk_bf16(f, 0.f) & 0xffffu); }
DEV float fsigmoid(float x) { return 1.0f / (1.0f + __expf(-x)); }

__device__ void phase_wprep(float* lds, const Params& p, char* ws, int bid, int nb) {
  bf16_t* winT = (bf16_t*)(ws + OFF_WINT); bf16_t* hpT = (bf16_t*)(ws + OFF_HPT); bf16_t* rpT = (bf16_t*)(ws + OFF_RPT);
  bf16_t* woT = (bf16_t*)(ws + OFF_WOT); bf16_t* w13T = (bf16_t*)(ws + OFF_W13T); bf16_t* w2T = (bf16_t*)(ws + OFF_W2T);
  constexpr int N0 = 672, N1 = N0 + 64, N2 = N1 + 64, N3 = N2 + 128, N4 = N3 + 8192, N5 = N4 + 4096;
  for (int item = bid; item < N5; item += nb) {
    if (item < N0) {
      const int nt = item >> 3, kt = item & 7, n0 = nt * 64;
      int scol;
      if (n0 < 3328) scol = n0;
      else { const int r = n0 - 3328, j = r >> 8, q = r & 255; scol = 3328 + (q < 128 ? 0 : 1024) + j * 128 + (q & 127); }
      transpose_tile(lds, p.in[I_WIN], kINC, scol, winT, kD, n0, kt * 128);
    } else if (item < N1) { const int it = item - N0; transpose_tile(lds, p.in[I_HPROJ], kD, (it >> 2) * 64, hpT, 512, (it >> 2) * 64, (it & 3) * 128);
    } else if (item < N2) { const int it = item - N1; transpose_tile(lds, p.in[I_RWPROJ], kD, (it >> 2) * 64, rpT, 512, (it >> 2) * 64, (it & 3) * 128);
    } else if (item < N3) { const int it = item - N2; transpose_tile(lds, p.in[I_WOUT], kD, (it >> 3) * 64, woT, kD, (it >> 3) * 64, (it & 7) * 128);
    } else if (item < N4) {
      const int it = item - N3, e = it >> 9, nt = (it >> 3) & 63, kt = it & 7, n0 = nt * 64, j = n0 >> 8, q = n0 & 255;
      const float* src = (q < 128 ? p.in[I_EW1] : p.in[I_EW3]) + (size_t)e * kD * kF;
      transpose_tile(lds, src, kF, j * 128 + (q & 127), w13T + (size_t)e * 4096 * kD, kD, n0, kt * 128);
    } else {
      const int it = item - N4, e = it >> 8, nt = (it >> 4) & 15, kt = it & 15;
      transpose_tile(lds, p.in[I_EW2] + (size_t)e * kF * kD, kD, nt * 64, w2T + (size_t)e * kD * kF, kF, nt * 64, kt * 128);
    }
  }
}

__device__ void phase_hb(const Params& p, const float* mod, bf16_t* hb, bf16_t* hc, int bid, int nb) {
  const int lane = tidx() & 63, wid = tidx() >> 6;
  const float* g = p.in[I_N1PRE];
  const int rstep = nb * 8, rend = kROWS + kB * kCTX;
  float4 hg[4], hsc[4], hsh[4]; int hm_ = -1;
#pragma unroll
  for (int i = 0; i < 4; ++i) hg[i] = ld4(g + i * 256 + lane * 4);
  int row = bid * 8 + wid;
  float4 nv[4];
  { const float* xr = row >= kROWS ? p.in[I_CTX] + (size_t)(row - kROWS) * kD : p.in[I_X] + (size_t)row * kD;
#pragma unroll
    for (int i = 0; i < 4; ++i) nv[i] = row < rend ? ld4(xr + i * 256 + lane * 4) : make_float4(0.f, 0.f, 0.f, 0.f); }
  for (; row < rend; row += rstep) {
    const bool isctx = row >= kROWS;
    const int mr = isctx ? 4 : row / kT;
    if (mr != hm_) { hm_ = mr;
#pragma unroll
      for (int i = 0; i < 4; ++i) { hsc[i] = ld4(mod + mr * 6144 + 1024 + i * 256 + lane * 4); hsh[i] = ld4(mod + mr * 6144 + i * 256 + lane * 4); } }
    bf16_t* dst = isctx ? hc + (size_t)(row - kROWS) * kD : hb + (size_t)row * kD;
    float4 v[4]; float ss = 0.f;
#pragma unroll
    for (int i = 0; i < 4; ++i) { v[i] = nv[i]; ss += v[i].x * v[i].x + v[i].y * v[i].y + v[i].z * v[i].z + v[i].w * v[i].w; }
    { const int nr = row + rstep < rend ? row + rstep : row;
      const float* xr = nr >= kROWS ? p.in[I_CTX] + (size_t)(nr - kROWS) * kD : p.in[I_X] + (size_t)nr * kD;
#pragma unroll
      for (int i = 0; i < 4; ++i) nv[i] = ld4(xr + i * 256 + lane * 4); }
    ss = wave_sum(ss);
    const float r = rsqrtf(ss * (1.0f / kD) + 1e-6f);
#pragma unroll
    for (int i = 0; i < 4; ++i) {
      const int k = i * 256 + lane * 4;
      const float4 gv = hg[i], sc = hsc[i], sh = hsh[i];
      const float h0 = v[i].x * r * gv.x * (1.f + sc.x) + sh.x, h1 = v[i].y * r * gv.y * (1.f + sc.y) + sh.y;
      const float h2 = v[i].z * r * gv.z * (1.f + sc.z) + sh.z, h3 = v[i].w * r * gv.w * (1.f + sc.w) + sh.w;
      *reinterpret_cast<uint2*>(dst + k) = make_uint2(pg8::cvt_pk_bf16(h0, h1), pg8::cvt_pk_bf16(h2, h3));
    }
  }
}

struct SchedPlain {
  pg8::TileOrder o; const char* A; const char* B; size_t tstep;
  __device__ bool next(int i, pg8::Unit& u) const { if (!o.tile(i, u.pm, u.pn)) return false; u.a = A + (size_t)u.pm * tstep; u.b = B + (size_t)u.pn * tstep; return true; }
  __device__ int row(const pg8::Unit&, int) const { return 0; }
};
struct SchedBranch {
  pg8::TileOrder o; const char* A0; const char* B0; const char* A1; const char* B1;
  __device__ bool next(int i, pg8::Unit& u) const { if (!o.tile(i, u.pm, u.pn)) return false;
    const size_t ts = (size_t)256 * 512 * 2;
    if (u.pn < 4) { u.a = A0 + (size_t)u.pm * ts; u.b = B0 + (size_t)u.pn * ts; } else { u.a = A1 + (size_t)u.pm * ts; u.b = B1 + (size_t)(u.pn - 4) * ts; }
    return true; }
  __device__ int row(const pg8::Unit&, int) const { return 0; }
};
struct SchedExp1 {
  pg8::TileOrder o; const char* H2; const char* W13T; const int* idx; int e0;
  __device__ bool next(int i, pg8::Unit& u) const { if (!o.tile(i, u.pm, u.pn)) return false;
    const int e = e0 + (u.pm >> 4); u.a = H2; u.b = W13T + ((size_t)e * 4096 + (size_t)u.pn * 256) * kD * 2; return true; }
  __device__ int row(const pg8::Unit& u, int r) const { return idx[(unsigned)(u.pm * 256 + r)]; }
};
struct SchedExp2 {
  pg8::TileOrder o; const char* HID; const char* W2T; int e0;
  __device__ bool next(int i, pg8::Unit& u) const { if (!o.tile(i, u.pm, u.pn)) return false;
    const int e = e0 + (u.pm >> 4); u.a = HID + (size_t)u.pm * 256 * kF * 2; u.b = W2T + ((size_t)e * kD + (size_t)u.pn * 256) * kF * 2; return true; }
  __device__ int row(const pg8::Unit&, int) const { return 0; }
};

struct EpiBf16Split {
  static constexpr bool PERM = true;
  bf16_t* o0; int ld0; int nt0; bf16_t* o1; int ld1;
  __device__ __forceinline__ void operator()(const pg8::f32x4 (&acc)[2][2][4][2], const pg8::Unit& u, int wr, int wc, int fr, int fq) const {
    bf16_t* base; int ldc, colt;
    if (u.pn < nt0) { base = o0; ldc = ld0; colt = u.pn * 256; } else { base = o1; ldc = ld1; colt = (u.pn - nt0) * 256; }
    const int row0 = u.pm * 256 + wr * 64 + fr, col0 = colt + wc * 32 + 8 * fq;
#pragma unroll
    for (int ai = 0; ai < 2; ++ai)
#pragma unroll
      for (int m = 0; m < 4; ++m) { bf16_t* rowp = base + (size_t)(row0 + ai * 128 + m * 16) * ldc + col0;
#pragma unroll
        for (int bj = 0; bj < 2; ++bj) { const pg8::f32x4 v0 = acc[ai][bj][m][0], v1 = acc[ai][bj][m][1];
          pg8::u32x4 w; w.x = pg8::cvt_pk_bf16(v0[0], v0[1]); w.y = pg8::cvt_pk_bf16(v0[2], v0[3]); w.z = pg8::cvt_pk_bf16(v1[0], v1[1]); w.w = pg8::cvt_pk_bf16(v1[2], v1[3]);
          *(pg8::u32x4*)(rowp + bj * 128) = w; } }
  }
};
struct EpiF32Store {
  static constexpr bool PERM = false;
  float* C; int ldc;
  __device__ __forceinline__ void operator()(const pg8::f32x4 (&acc)[2][2][4][2], const pg8::Unit& u, int wr, int wc, int fr, int fq) const {
    const int row0 = u.pm * 256 + wr * 64 + fr, col0 = u.pn * 256 + wc * 32 + 4 * fq;
#pragma unroll
    for (int ai = 0; ai < 2; ++ai)
#pragma unroll
      for (int m = 0; m < 4; ++m) { float* rowp = C + (size_t)(row0 + ai * 128 + m * 16) * ldc + col0;
#pragma unroll
        for (int bj = 0; bj < 2; ++bj)
#pragma unroll
          for (int n = 0; n < 2; ++n) *(pg8::f32x4*)(rowp + bj * 128 + n * 16) = acc[ai][bj][m][n]; }
  }
};
struct EpiGatesMerge {
  static constexpr bool PERM = true;
  const bf16_t* yh; const bf16_t* yr; bf16_t* pre;
  __device__ __forceinline__ void operator()(const pg8::f32x4 (&acc)[2][2][4][2], const pg8::Unit& u, int wr, int wc, int fr, int fq) const {
    const int row0 = u.pm * 256 + wr * 64 + fr, col0 = u.pn * 128 + wc * 32 + 8 * fq;
#pragma unroll
    for (int ai = 0; ai < 2; ++ai)
#pragma unroll
      for (int m = 0; m < 4; ++m) { const size_t off = (size_t)(row0 + ai * 128 + m * 16) * kD + col0;
        const pg8::u32x4 a = *(const pg8::u32x4*)(yh + off), b = *(const pg8::u32x4*)(yr + off);
        const pg8::f32x4 g0 = acc[ai][0][m][0], g1 = acc[ai][0][m][1], r0 = acc[ai][1][m][0], r1 = acc[ai][1][m][1];
        float o[8];
        o[0] = fsigmoid(g0[0]) * bflo(a.x) + fsigmoid(r0[0]) * bflo(b.x); o[1] = fsigmoid(g0[1]) * bfhi(a.x) + fsigmoid(r0[1]) * bfhi(b.x);
        o[2] = fsigmoid(g0[2]) * bflo(a.y) + fsigmoid(r0[2]) * bflo(b.y); o[3] = fsigmoid(g0[3]) * bfhi(a.y) + fsigmoid(r0[3]) * bfhi(b.y);
        o[4] = fsigmoid(g1[0]) * bflo(a.z) + fsigmoid(r1[0]) * bflo(b.z); o[5] = fsigmoid(g1[1]) * bfhi(a.z) + fsigmoid(r1[1]) * bfhi(b.z);
        o[6] = fsigmoid(g1[2]) * bflo(a.w) + fsigmoid(r1[2]) * bflo(b.w); o[7] = fsigmoid(g1[3]) * bfhi(a.w) + fsigmoid(r1[3]) * bfhi(b.w);
        pg8::u32x4 w; w.x = pg8::cvt_pk_bf16(o[0], o[1]); w.y = pg8::cvt_pk_bf16(o[2], o[3]); w.z = pg8::cvt_pk_bf16(o[4], o[5]); w.w = pg8::cvt_pk_bf16(o[6], o[7]);
        *(pg8::u32x4*)(pre + off) = w; }
  }
};
struct EpiSwiGLU {
  static constexpr bool PERM = true;
  bf16_t* hid;
  __device__ __forceinline__ void operator()(const pg8::f32x4 (&acc)[2][2][4][2], const pg8::Unit& u, int wr, int wc, int fr, int fq) const {
    const int row0 = u.pm * 256 + wr * 64 + fr, col0 = u.pn * 128 + wc * 32 + 8 * fq;
#pragma unroll
    for (int ai = 0; ai < 2; ++ai)
#pragma unroll
      for (int m = 0; m < 4; ++m) { const size_t off = (size_t)(row0 + ai * 128 + m * 16) * kF + col0;
        float o[8];
#pragma unroll
        for (int n = 0; n < 2; ++n)
#pragma unroll
          for (int j = 0; j < 4; ++j) { const float a = acc[ai][0][m][n][j]; o[n * 4 + j] = a * fsigmoid(a) * acc[ai][1][m][n][j]; }
        pg8::u32x4 w; w.x = pg8::cvt_pk_bf16(o[0], o[1]); w.y = pg8::cvt_pk_bf16(o[2], o[3]); w.z = pg8::cvt_pk_bf16(o[4], o[5]); w.w = pg8::cvt_pk_bf16(o[6], o[7]);
        *(pg8::u32x4*)(hid + off) = w; }
  }
};
struct EpiYE {
  static constexpr bool PERM = true;
  bf16_t* ye; const float* gate; int e0;
  __device__ __forceinline__ void operator()(const pg8::f32x4 (&acc)[2][2][4][2], const pg8::Unit& u, int wr, int wc, int fr, int fq) const {
    const int e = e0 + (u.pm >> 4), s0 = (u.pm & 15) * 256 + wr * 64 + fr, col0 = u.pn * 256 + wc * 32 + 8 * fq;
#pragma unroll
    for (int ai = 0; ai < 2; ++ai)
#pragma unroll
      for (int m = 0; m < 4; ++m) { const int s = s0 + ai * 128 + m * 16, b = s >> 10, c = s & 1023, slot = (b * kE + e) * kCAP + c;
        const float g = gate[slot]; bf16_t* rowp = ye + (size_t)slot * kD + col0;
#pragma unroll
        for (int bj = 0; bj < 2; ++bj) { const pg8::f32x4 v0 = acc[ai][bj][m][0] * g, v1 = acc[ai][bj][m][1] * g;
          pg8::u32x4 w; w.x = pg8::cvt_pk_bf16(v0[0], v0[1]); w.y = pg8::cvt_pk_bf16(v0[2], v0[3]); w.z = pg8::cvt_pk_bf16(v1[0], v1[1]); w.w = pg8::cvt_pk_bf16(v1[2], v1[3]);
          *(pg8::u32x4*)(rowp + bj * 128) = w; } }
  }
};

__device__ void phase_mod(float* lds, const float* c, const float* cctx, const float* modw, const float* modb, float* mod, int bid, int nb) {
  float* sc = lds;
  float* red = lds + 5120;
  const int tid = tidx(), kk = tid >> 5, nl = tid & 31;
  bool loaded = false;
  for (int item = bid; item < 192; item += nb) {
    if (!loaded) {
      for (int i = tid; i < 5120; i += NTHR) { const int v = i >> 10, k = i & 1023; const float cv = v < 4 ? c[v * kD + k] : cctx[k]; sc[i] = siluf_(cv); }
      loaded = true;
    }
    __syncthreads();
    const int n = item * 32 + nl;
    float acc[5] = {0.f, 0.f, 0.f, 0.f, 0.f};
#pragma unroll 16
    for (int k = kk * 64; k < kk * 64 + 64; ++k) {
      const float w = modw[(size_t)k * 6144 + n];
#pragma unroll
      for (int v = 0; v < 5; ++v) acc[v] += sc[v * 1024 + k] * w;
    }
#pragma unroll
    for (int v = 0; v < 5; ++v) red[(kk * 5 + v) * 32 + nl] = acc[v];
    __syncthreads();
    if (tid < 160) {
      const int v = tid >> 5;
      float s = 0.f;
#pragma unroll
      for (int q = 0; q < 16; ++q) s += red[(q * 5 + v) * 32 + nl];
      mod[v * 6144 + n] = s + modb[n];
    }
    __syncthreads();
  }
}

__device__ void phase_filter(float* lds, const Params& p, float* circT, int bid, int nb) {
  float* feat = lds;
  float* h1 = lds + 32 * 33;
  float* h2 = h1 + 32 * 64;
  const float* b1 = p.in[I_HB1]; const float* b2 = p.in[I_HB2];
  const float* w3 = p.in[I_HW3]; const float* fr = p.in[I_HFREQ];
  float* w1 = h2 + 32 * 64;
  float* w2 = w1 + 33 * 64;
  const int tid = tidx();
  for (int item = bid; item < kT / 32; item += nb) {
    const int l0 = item * 32;
    __syncthreads();
    for (int i = tid; i < 33 * 64; i += NTHR) w1[i] = p.in[I_HW1][i];
    for (int i = tid; i < 64 * 64; i += NTHR) w2[i] = p.in[I_HW2][i];
    for (int i = tid; i < 32 * 33; i += NTHR) {
      const int pz = i / 33, f = i % 33, l = l0 + pz;
      float v;
      if (f == 0) v = (float)l / (float)(kT - 1);
      else {
        const int j = (f - 1) & 15;
        const float band = 1e-4f + (float)j * ((15.0f - 1e-4f) / 15.0f);
        const float ang = (6.283185307179586f / (float)kT) * (float)l;
        float sn, cs; sincos_cw(band * ang, sn, cs); v = f <= 16 ? cs : -sn;
      }
      feat[i] = v;
    }
    __syncthreads();
    for (int i = tid; i < 32 * 64; i += NTHR) {
      const int pz = i >> 6, o = i & 63;
      float s = b1[o];
#pragma unroll 3
      for (int f = 0; f < 33; ++f) s += feat[pz * 33 + f] * w1[f * 64 + o];
      h1[i] = sin_cw(fr[o] * s);
    }
    __syncthreads();
    for (int i = tid; i < 32 * 64; i += NTHR) {
      const int pz = i >> 6, o = i & 63;
      float s = b2[o];
#pragma unroll 4
      for (int f = 0; f < 64; ++f) s += h1[pz * 64 + f] * w2[f * 64 + o];
      h2[i] = sin_cw(fr[o] * s);
    }
    __syncthreads();
#pragma unroll 1
    for (int half = 0; half < 2; ++half) {
      const int n = tid + half * 512;
      const int c = tid;
      float wr[64];
#pragma unroll
      for (int o = 0; o < 64; ++o) wr[o] = w3[o * 1024 + n];
      const float dlo = -4.605170185988091f / 1.5f, dhi = -4.605170185988091f / 0.3f;
      const float delta = fabsf(dlo + (float)c * ((dhi - dlo) / 511.0f));
      float asum = 0.f;
#pragma unroll 1
      for (int q = 0; q < 32; ++q) {
        float a = 0.f;
#pragma unroll
        for (int o = 0; o < 64; ++o) a += h2[q * 64 + o] * wr[o];
        const int l = l0 + q;
        const float tt = (float)l / (float)(kT - 1);
        const float v = a * expf(-tt * delta);
        if (half == 0) circT[(size_t)c * 16384 + l] = v;
        else circT[(size_t)c * 16384 + 16384 - l - (l == 0 ? 8192 : 0)] = (l == 0 ? 0.f : v);
      }
      (void)asum;
    }
  }
}

DEV float ldcol(const float* p, size_t i) { return p[i]; }
DEV float ldcol(const bf16_t* p, size_t i) { return bf2f(p[i]); }
namespace rs {
typedef short bf16x8 __attribute__((ext_vector_type(8)));
typedef float f32x4 __attribute__((ext_vector_type(4)));
constexpr int LD = 72, LDR = 40;
#define RS_LAS __attribute__((address_space(3)))
typedef RS_LAS bf16_t* lbf; typedef const RS_LAS bf16_t* clbf; typedef RS_LAS float* lf32;
DEV void lds_barrier() { asm volatile("s_waitcnt lgkmcnt(0)" ::: "memory"); __builtin_amdgcn_s_barrier(); asm volatile("" ::: "memory"); }
template <int K>
DEV f32x4 tmma(f32x4 acc, clbf A, int lda, clbf B, int ldb, int lane) {
  clbf ap = A + (lane & 15) * lda + 8 * (lane >> 4);
  clbf bp = B + (lane & 15) * ldb + 8 * (lane >> 4);
#pragma unroll
  for (int k = 0; k < K; k += 32)
    acc = __builtin_amdgcn_mfma_f32_16x16x32_bf16(*(const RS_LAS bf16x8*)(ap + k), *(const RS_LAS bf16x8*)(bp + k), acc, 0, 0, 0);
  return acc;
}
typedef unsigned u32x2v __attribute__((ext_vector_type(2)));
DEV void st4(lbf p, f32x4 v) { const u32x2v w = {pg8::cvt_pk_bf16(v[0], v[1]), pg8::cvt_pk_bf16(v[2], v[3])}; *(RS_LAS u32x2v*)p = w; }
DEV void st4g(bf16_t* p, f32x4 v) { *reinterpret_cast<uint2*>(p) = make_uint2(pg8::cvt_pk_bf16(v[0], v[1]), pg8::cvt_pk_bf16(v[2], v[3])); }
DEV float ftanh(float x) { const float e = __expf(2.f * x); return 1.f - 2.f / (e + 1.f); }

template <int NC> struct Lay {
  static constexpr int ZTB = NC * LD * 2;
  static constexpr int W = 0, ZT0 = 18432, ZT1 = ZT0 + ZTB, AT = ZT1 + ZTB, BTt = AT + 9216, KTt = BTt + 9216, Vt = KTt + 9216,
                       RT = Vt + 9216, X = (NC == 64 ? RT + 9216 : RT), L = X + 18432, D = L + (NC == 64 ? 36864 : 32768);
  static constexpr int LWt = X, LA = X + 9216, BT = X, KT = X + 9216, UT = X, RHS = (NC == 64 ? X + 9216 : L + 18432);
  static constexpr int CS = L, AG = L + 16384, LAK = L, LOFF = L + 9216, LRB = L + 18432, LRK = L + 27648;
  static constexpr int LDG = D, TDG = D + 4352, WCV = TDG + 5120, SEG = WCV + 256, TF = SEG + 2048, END = TF + 4352;
};
static_assert(Lay<64>::END <= (int)LDS_BYTES && Lay<128>::END <= (int)LDS_BYTES, "scan LDS layout");

template <int NC, bool EMIT>
__device__ void scan_task(float* ldsf, const Params& p, const bf16_t* cols, int ldc, int Tlen, int cR, int cK, int cV, int cLW, int cLA, int muoff,
                          int b, int h, int dir, int step0, int nchunks, const float* Zinit  , float* Zout  , bf16_t* Y, float* BSo) {
  typedef Lay<NC> LY;
  RS_LAS char* lds = (RS_LAS char*)ldsf;
  const int tid = tidx(), lane = tid & 63, w = tid >> 6;
  lbf sWup = (lbf)(lds + LY::W); lbf sAup = sWup + 64 * LD;
  lbf sAT = (lbf)(lds + LY::AT); lbf sBTt = (lbf)(lds + LY::BTt); lbf sKTt = (lbf)(lds + LY::KTt); lbf sVt = (lbf)(lds + LY::Vt);
  lbf sRT = (lbf)(lds + LY::RT);
  lbf sLWt = (lbf)(lds + LY::LWt); lbf sLA = (lbf)(lds + LY::LA); lbf sBT = (lbf)(lds + LY::BT); lbf sKT = (lbf)(lds + LY::KT);
  lbf sUT = (lbf)(lds + LY::UT); lbf sRHS = (lbf)(lds + LY::RHS);
  lf32 sCS = (lf32)(lds + LY::CS); lf32 sAG = (lf32)(lds + LY::AG);
  lbf sLak = (lbf)(lds + LY::LAK); lbf sLoff = (lbf)(lds + LY::LOFF); lbf sLrb = (lbf)(lds + LY::LRB); lbf sLrk = (lbf)(lds + LY::LRK);
  lf32 sLdg = (lf32)(lds + LY::LDG); lbf sTdg = (lbf)(lds + LY::TDG); lf32 sWC = (lf32)(lds + LY::WCV); lf32 sSeg = (lf32)(lds + LY::SEG); lf32 sTf = (lf32)(lds + LY::TF);
  const float* mu = p.in[I_MU];
  const int hj = h * 64 + lane;
  const bf16_t* base = cols + (size_t)b * Tlen * ldc;
  constexpr int NT = NC / 16 * 4 / 8;
  f32x4 Zm[NT];

  __syncthreads();
  for (int i = tid; i < 4096; i += NTHR) { const int ii = i >> 6, j = i & 63;
    sWup[j * LD + ii] = f2bf(p.in[I_WUP][((size_t)dir * 64 + ii) * 512 + h * 64 + j]);
    sAup[j * LD + ii] = f2bf(p.in[I_AUP][((size_t)dir * 64 + ii) * 512 + h * 64 + j]); }
#pragma unroll
  for (int m = 0; m < NT; ++m) {
    const int id = w + 8 * m, tj = id & 3, tn = id >> 2, col = tn * 16 + (lane & 15), j0 = tj * 16 + 4 * (lane >> 4);
#pragma unroll
    for (int q = 0; q < 4; ++q) {
      float v = 0.f;
      if (NC == 128) v = (col < 64 && col == j0 + q) ? 1.f : 0.f;
      else if (Zinit) v = Zinit[col * 64 + j0 + q];
      Zm[m][q] = v;
    }
    st4((lbf)(lds + LY::ZT0) + col * LD + j0, Zm[m]);
  }
  for (int i = tid; i < NC * LD / 2; i += NTHR) ((RS_LAS unsigned*)sUT)[i] = 0u;
  int zcur = 0;
  unsigned long long tprev = 0; const bool tpon = (TP_LO == 100) && EMIT && blockIdx.x == 0 && threadIdx.x == 0;
#define RS_T(k) do { if (TP_LO == 100 && EMIT) { if (tpon) { const unsigned long long tn_ = __builtin_amdgcn_s_memrealtime(); ((unsigned long long*)(p.ws + OFF_NORM + 512))[k] += tn_ - tprev; tprev = tn_; } } } while (0)
#pragma unroll 1
  for (int ci = 0; ci < nchunks; ++ci) {
    const int s0 = step0 + ci * 64;
    lbf sZT = (lbf)(lds + (zcur ? LY::ZT1 : LY::ZT0));
    lbf sZN = (lbf)(lds + (zcur ? LY::ZT0 : LY::ZT1));
    lds_barrier();
    if (TP_LO == 100 && EMIT) { if (tpon) tprev = __builtin_amdgcn_s_memrealtime(); }
    const int stepb = s0 + w * 8 - 1;
    unsigned pf[5][5];
#define RS_PREFETCH(a_lo, a_hi) do { _Pragma("unroll") for (int a = a_lo; a < a_hi; ++a) { if (a == 0 && !EMIT) continue; \
      const bf16_t* rp = base + (a == 0 ? cR + h * 64 : a == 1 ? cK + h * 64 : a == 2 ? cV + h * 64 : a == 3 ? cLW : cLA) + lane; \
      _Pragma("unroll") for (int i = 0; i < 5; ++i) { const int s0_ = stepb + 2 * i, s1_ = s0_ + 1, t0_ = dir ? (Tlen - 1 - s0_) : s0_, t1_ = dir ? (Tlen - 1 - s1_) : s1_; \
        const int c0_ = t0_ < 0 ? 0 : (t0_ >= Tlen ? Tlen - 1 : t0_), c1_ = t1_ < 0 ? 0 : (t1_ >= Tlen ? Tlen - 1 : t1_);     \
        const unsigned l_ = (unsigned)rp[(size_t)c0_ * ldc], h_ = (unsigned)rp[(size_t)c1_ * ldc]; \
        pf[a][i] = ((t0_ == c0_) ? l_ : 0u) | (((t1_ == c1_) ? h_ : 0u) << 16); } } } while (0)
#define RS_ROW(a, i) (((i) & 1) ? __uint_as_float(pf[a][(i) >> 1] & 0xffff0000u) : __uint_as_float(pf[a][(i) >> 1] << 16))
    RS_PREFETCH(3, 5);
    {
      const float m0w = mu[cLW + lane + muoff], m1w = mu[kRWC + cLW + lane + muoff], m0a = mu[cLA + lane + muoff], m1a = mu[kRWC + cLA + lane + muoff];
#pragma unroll
      for (int q = 0; q < 8; ++q) {
        const int tl = w * 8 + q;
        const float wc = RS_ROW(3, q + 1), wp = dir ? RS_ROW(3, q + 2) : RS_ROW(3, q), wn = dir ? RS_ROW(3, q) : RS_ROW(3, q + 2);
        const float ac = RS_ROW(4, q + 1), ap = dir ? RS_ROW(4, q + 2) : RS_ROW(4, q), an = dir ? RS_ROW(4, q) : RS_ROW(4, q + 2);
        const float zw = wc + m0w * (wp - wc) + m1w * (wn - wc);
        const float za = ac + m0a * (ap - ac) + m1a * (an - ac);
        sLWt[tl * LD + lane] = f2bf(ftanh(zw)); sLA[tl * LD + lane] = f2bf(za);
      }
    }
    RS_PREFETCH(0, 3);
    lds_barrier(); RS_T(2);
#pragma unroll 1
    for (int m = 0; m < 2; ++m) {
      const int id = w * 2 + m, tm = id >> 2, tn = id & 3;
      f32x4 aw = {0.f, 0.f, 0.f, 0.f}, aa = {0.f, 0.f, 0.f, 0.f};
      aw = tmma<64>(aw, sLWt + tm * 16 * LD, LD, sWup + tn * 16 * LD, LD, lane);
      aa = tmma<64>(aa, sLA + tm * 16 * LD, LD, sAup + tn * 16 * LD, LD, lane);
      const int j = tn * 16 + (lane & 15);
      const float w0 = p.in[I_W0][dir * 512 + h * 64 + j], a0 = p.in[I_A0][dir * 512 + h * 64 + j];
#pragma unroll
      for (int q = 0; q < 4; ++q) {
        const int t = tm * 16 + 4 * (lane >> 4) + q;
        const float x = -(w0 + aw[q]);
        const float sp = x > 20.f ? x : __logf(1.f + __expf(x));
        sCS[t * 64 + j] = __expf(-sp - 0.5f);
        sAG[t * 64 + j] = fsigmoid(a0 + aa[q]);
      }
    }
    lds_barrier(); RS_T(3);
    {
      const int j = tid & 63, seg = tid >> 6;
      float v[8]; float run = 0.f;
#pragma unroll
      for (int q = 0; q < 8; ++q) { run += sCS[(seg * 8 + q) * 64 + j]; v[q] = run; }
      sSeg[seg * 64 + j] = run;
      lds_barrier();
      float off = 0.f;
#pragma unroll
      for (int s = 0; s < 8; ++s) off += (s < seg) ? sSeg[s * 64 + j] : 0.f;
#pragma unroll
      for (int q = 0; q < 8; ++q) sCS[(seg * 8 + q) * 64 + j] = v[q] + off;
    }
    lds_barrier(); RS_T(4);
    {
      const float kkw = p.in[I_KK][hj], kaw = p.in[I_KA][hj], rkw = p.in[I_RK][hj];
      float m0[3], m1[3];
#pragma unroll
      for (int a = 0; a < 3; ++a) { const int col = (a == 0 ? cR : a == 1 ? cK : cV) + h * 64 + lane; m0[a] = mu[col + muoff]; m1[a] = mu[kRWC + col + muoff]; }
#pragma unroll
      for (int q = 0; q < 8; ++q) {
        const int tl = w * 8 + q, tok = dir ? (Tlen - 1 - (s0 + tl)) : (s0 + tl);
        float rkv[3];
#pragma unroll
        for (int a = 0; a < 3; ++a) { const float xc = RS_ROW(a, q + 1), xp = dir ? RS_ROW(a, q + 2) : RS_ROW(a, q), xn = dir ? RS_ROW(a, q) : RS_ROW(a, q + 2);
          rkv[a] = (a == 0 && !EMIT) ? 0.f : xc + m0[a] * (xp - xc) + m1[a] * (xn - xc); }
        const float ag = sAG[tl * 64 + lane], cs = sCS[tl * 64 + lane], csm = tl > 0 ? sCS[(tl - 1) * 64 + lane] : 0.f;
        const float kkv = rkv[1] * kkw;
        const float ss = wave_sum(kkv * kkv);
        const float kkn = kkv * rsqrtf(fmaxf(ss, 1e-24f));
        const float km = rkv[1] * (1.f + (ag - 1.f) * kaw);
        const float ew = __expf(cs), ewi = __expf(-cs);
        const bf16_t at = f2bf(-kkn * __expf(-csm)), bt = f2bf(kkn * ag * ew), kt = f2bf(km * ew), vt = f2bf(rkv[2]);
        sAT[tl * LD + lane] = at; sBT[tl * LD + lane] = bt; sKT[tl * LD + lane] = kt;
        sBTt[lane * LD + tl] = bt; sKTt[lane * LD + tl] = kt; sVt[lane * LD + tl] = vt;
        if (EMIT) {
          sRT[tl * LD + lane] = f2bf(rkv[0] * ewi);
          const float bsum = wave_sum(rkv[0] * km * rkw);
          if (lane == 0) BSo[((size_t)dir * kROWS + (size_t)b * Tlen + tok) * 8 + h] = bsum;
        }
        if (tl == 63) sWC[lane] = ewi;
        __builtin_amdgcn_sched_barrier(0);
      }
    }
    lds_barrier(); RS_T(5);
    if (w < 4) {
      f32x4 acc = {0.f, 0.f, 0.f, 0.f};
      acc = tmma<64>(acc, sBT + w * 16 * LD, LD, sAT + w * 16 * LD, LD, lane);
      const int c = lane & 15, kq = lane >> 4, r4 = 4 * kq;
      lf32 Pm = sLdg + w * 272; lf32 Tm = sTf + w * 272;
#pragma unroll
      for (int q = 0; q < 4; ++q) { const float lv = (r4 + q < c) ? acc[q] : 0.f;
        Pm[c * 17 + r4 + q] = lv; Tm[c * 17 + r4 + q] = lv + ((r4 + q) == c ? 1.f : 0.f); }
#pragma unroll 1
      for (int lev = 0; lev < 3; ++lev) {
        f32x4 a2 = {0.f, 0.f, 0.f, 0.f};
#pragma unroll
        for (int s4 = 0; s4 < 4; ++s4) a2 = __builtin_amdgcn_mfma_f32_16x16x4f32(Pm[c * 17 + 4 * s4 + kq], Pm[(4 * s4 + kq) * 17 + c], a2, 0, 0, 0);
#pragma unroll
        for (int q = 0; q < 4; ++q) Pm[(r4 + q) * 17 + c] = a2[q];
        f32x4 a3 = {0.f, 0.f, 0.f, 0.f};
#pragma unroll
        for (int s4 = 0; s4 < 4; ++s4) a3 = __builtin_amdgcn_mfma_f32_16x16x4f32(Tm[c * 17 + 4 * s4 + kq], Pm[(4 * s4 + kq) * 17 + c], a3, 0, 0, 0);
#pragma unroll
        for (int q = 0; q < 4; ++q) Tm[(r4 + q) * 17 + c] += a3[q];
      }
#pragma unroll
      for (int q = 0; q < 4; ++q) { sTdg[(w * 16 + r4 + q) * LDR + c] = f2bf(Tm[(r4 + q) * 17 + c]); sTdg[(w * 16 + r4 + q) * LDR + 16 + c] = (bf16_t)0; }
    }
    {
      constexpr int NP = EMIT ? 4 : 2;
#pragma unroll 1
      for (int pr = 0; pr < NP; ++pr) {
        clbf Lsrc = (pr < 2) ? sAT : sRT;
        clbf Rsrc = (pr & 1) ? sKT : sBT;
        lbf dst = pr == 0 ? sLoff : pr == 1 ? sLak : pr == 2 ? sLrb : sLrk;
#pragma unroll 1
        for (int m = 0; m < 2; ++m) {
          const int id = w + 8 * m, tt = id >> 2, tu = id & 3;
          f32x4 acc = {0.f, 0.f, 0.f, 0.f};
          if (tu < tt || (pr != 0 && tu == tt)) acc = tmma<64>(acc, Rsrc + tu * 16 * LD, LD, Lsrc + tt * 16 * LD, LD, lane);
          const int t = tt * 16 + (lane & 15), u0 = tu * 16 + 4 * (lane >> 4);
#pragma unroll
          for (int q = 0; q < 4; ++q) { const bool keep = (pr < 2) ? (u0 + q < t) : (u0 + q <= t); acc[q] = keep ? acc[q] : 0.f; }
          st4(dst + t * LD + u0, acc);
        }
      }
    }
    lds_barrier(); RS_T(6);
    for (int i = tid; i < NC * 8; i += NTHR) ((RS_LAS unsigned*)sRHS)[(i >> 3) * (LDR / 2) + 8 + (i & 7)] = 0u;
    RS_T(7);
#pragma unroll 1
    for (int bk = 0; bk < 4; ++bk) {
      if (w < NC / 16) {
        const int tn = w;
        f32x4 acc = {0.f, 0.f, 0.f, 0.f};
        acc = tmma<64>(acc, sAT + bk * 16 * LD, LD, sZT + tn * 16 * LD, LD, lane);
        if (NC == 64 || tn >= 4) acc = tmma<64>(acc, sLak + bk * 16 * LD, LD, sVt + (NC == 64 ? tn : tn - 4) * 16 * LD, LD, lane);
        if (bk > 0) acc = tmma<64>(acc, sLoff + bk * 16 * LD, LD, sUT + tn * 16 * LD, LD, lane);
        st4(sRHS + (tn * 16 + (lane & 15)) * LDR + 4 * (lane >> 4), acc);
      }
      lds_barrier();
      if (w < NC / 16) {
        const int tn = w;
        f32x4 acc = {0.f, 0.f, 0.f, 0.f};
        acc = tmma<32>(acc, sTdg + bk * 16 * LDR, LDR, sRHS + tn * 16 * LDR, LDR, lane);
        st4(sUT + (tn * 16 + (lane & 15)) * LD + bk * 16 + 4 * (lane >> 4), acc);
      }
      lds_barrier();
    }
    RS_T(8);
    if (EMIT) {
#pragma unroll 1
      for (int m = 0; m < 2; ++m) {
        const int id = w + 8 * m, ti = id & 3, tt = id >> 2;
        f32x4 acc = {0.f, 0.f, 0.f, 0.f};
        acc = tmma<64>(acc, sZT + ti * 16 * LD, LD, sRT + tt * 16 * LD, LD, lane);
        acc = tmma<64>(acc, sUT + ti * 16 * LD, LD, sLrb + tt * 16 * LD, LD, lane);
        acc = tmma<64>(acc, sVt + ti * 16 * LD, LD, sLrk + tt * 16 * LD, LD, lane);
        const int tl = tt * 16 + (lane & 15), tok = dir ? (Tlen - 1 - (s0 + tl)) : (s0 + tl);
        st4g(Y + (size_t)dir * kROWS * 512 + ((size_t)b * Tlen + tok) * 512 + h * 64 + ti * 16 + 4 * (lane >> 4), acc);
      }
    }
#pragma unroll
    for (int m = 0; m < NT; ++m) {
      const int id = w + 8 * m, tj = id & 3, tn = id >> 2;
      f32x4 acc = {0.f, 0.f, 0.f, 0.f};
      acc = tmma<64>(acc, sBTt + tj * 16 * LD, LD, sUT + tn * 16 * LD, LD, lane);
      if (NC == 64 || tn >= 4) acc = tmma<64>(acc, sKTt + tj * 16 * LD, LD, sVt + (NC == 64 ? tn : tn - 4) * 16 * LD, LD, lane);
      const int j0 = tj * 16 + 4 * (lane >> 4), col = tn * 16 + (lane & 15);
#pragma unroll
      for (int q = 0; q < 4; ++q) Zm[m][q] = sWC[j0 + q] * (Zm[m][q] + acc[q]);
      st4(sZN + col * LD + j0, Zm[m]);
    }
    zcur ^= 1;
    RS_T(9);
  }
#pragma unroll
  for (int m = 0; m < NT; ++m) {
    const int id = w + 8 * m, tj = id & 3, tn = id >> 2, j0 = tj * 16 + 4 * (lane >> 4), col = tn * 16 + (lane & 15);
    if (Zout) *reinterpret_cast<f32x4*>(Zout + (size_t)col * 64 + j0) = Zm[m];
  }
  __syncthreads();
}
}

__device__ void scan_passB(float* lds, int chain, const float* sinit, const float* PQ, float* S0) {
  float* sS = lds;
  float* sP = lds + 64 * 65;
  const int tid = tidx(), i = tid >> 3, jq = (tid & 7) * 8;
  __syncthreads();
  for (int e = tid; e < 4096; e += NTHR) sS[(e >> 6) * 65 + (e & 63)] = sinit[e];
  for (int sc = 0; sc < kNSC; ++sc) {
    const size_t task = (size_t)chain * kNSC + sc;
    __syncthreads();
    for (int e = tid; e < 4096; e += NTHR) S0[task * 4096 + e] = sS[(e >> 6) * 65 + (e & 63)];
    if (sc == kNSC - 1) break;
    for (int e = tid; e < 2048; e += NTHR) reinterpret_cast<float4*>(sP)[e] = reinterpret_cast<const float4*>(PQ + task * 8192)[e];
    __syncthreads();
    float acc[8];
#pragma unroll
    for (int q = 0; q < 8; ++q) acc[q] = sP[(64 + i) * 64 + jq + q];
#pragma unroll 8
    for (int jp = 0; jp < 64; ++jp) {
      const float s = sS[i * 65 + jp];
      const float4 z0 = *reinterpret_cast<const float4*>(&sP[jp * 64 + jq]), z1 = *reinterpret_cast<const float4*>(&sP[jp * 64 + jq + 4]);
      acc[0] += s * z0.x; acc[1] += s * z0.y; acc[2] += s * z0.z; acc[3] += s * z0.w;
      acc[4] += s * z1.x; acc[5] += s * z1.y; acc[6] += s * z1.z; acc[7] += s * z1.w;
    }
    __syncthreads();
#pragma unroll
    for (int q = 0; q < 8; ++q) sS[i * 65 + jq + q] = acc[q];
  }
  __syncthreads();
}

typedef float cf_ __attribute__((ext_vector_type(2)));
typedef float2 cf;
#define FFT_LAS __attribute__((address_space(3)))
typedef FFT_LAS cf_* lcf;
DEV cf ldc_(const FFT_LAS cf_* q) { const cf_ v = *q; return make_float2(v.x, v.y); }
DEV void stc_(FFT_LAS cf_* q, cf v) { const cf_ w = {v.x, v.y}; *q = w; }
DEV cf cmul(cf a, cf b) { return make_float2(a.x * b.x - a.y * b.y, a.x * b.y + a.y * b.x); }
DEV cf cadd(cf a, cf b) { return make_float2(a.x + b.x, a.y + b.y); }
DEV cf csub(cf a, cf b) { return make_float2(a.x - b.x, a.y - b.y); }
DEV int PADI(int i) { return i + (i >> 4); }
constexpr int FFT_N = 16384, FFT_PAD = FFT_N + FFT_N / 16;
DEV void dft4(cf& x0, cf& x1, cf& x2, cf& x3) {
  const cf a0 = cadd(x0, x2), a1 = csub(x0, x2), a2 = cadd(x1, x3), d = csub(x1, x3);
  const cf a3 = make_float2(d.y, -d.x);
  x0 = cadd(a0, a2); x1 = cadd(a1, a3); x2 = csub(a0, a2); x3 = csub(a1, a3);
}
DEV void dft16(cf (&v)[16]) {
#pragma unroll
  for (int a = 0; a < 4; ++a) dft4(v[a], v[a + 4], v[a + 8], v[a + 12]);
  const cf w1 = make_float2(0.9238795325112867f, -0.3826834323650898f), w2 = make_float2(0.7071067811865476f, -0.7071067811865476f);
  const cf w3 = make_float2(0.3826834323650898f, -0.9238795325112867f), w6 = make_float2(-0.7071067811865476f, -0.7071067811865476f);
  const cf w9 = make_float2(-0.9238795325112867f, 0.3826834323650898f);
  v[1 + 4] = cmul(v[1 + 4], w1); v[1 + 8] = cmul(v[1 + 8], w2); v[1 + 12] = cmul(v[1 + 12], w3);
  v[2 + 4] = cmul(v[2 + 4], w2); v[2 + 8] = make_float2(v[2 + 8].y, -v[2 + 8].x); v[2 + 12] = cmul(v[2 + 12], w6);
  v[3 + 4] = cmul(v[3 + 4], w3); v[3 + 8] = cmul(v[3 + 8], w6); v[3 + 12] = cmul(v[3 + 12], w9);
#pragma unroll
  for (int c = 0; c < 4; ++c) dft4(v[4 * c], v[4 * c + 1], v[4 * c + 2], v[4 * c + 3]);
}
template <int PASS>
DEV void fft_pass16(lcf buf, int tid) {
  constexpr int lg = 4 * PASS, Ns = 1 << lg;
  cf v0[16], v1[16];
  const lcf rd = buf + PADI(tid);
#pragma unroll
  for (int r = 0; r < 16; ++r) { v0[r] = ldc_(rd + 1088 * r); v1[r] = ldc_(rd + 1088 * r + 544); }
  __syncthreads();
#pragma unroll
  for (int h = 0; h < 2; ++h) {
    cf (&v)[16] = h ? v1 : v0;
    int tl = tid; asm volatile("" : "+v"(tl) :: "memory");
    const int j = tl + 512 * h, k = j & (Ns - 1);
    if (PASS > 0) {
      float sn, cs; sincos_cw(-6.283185307179586f * (float)k / (float)(Ns * 16), sn, cs);
      const cf w = make_float2(cs, sn); cf pw = w;
#pragma unroll
      for (int r = 1; r < 16; ++r) { v[r] = cmul(v[r], pw); if (r < 15) pw = cmul(pw, w); }
    }
    dft16(v);
    const int j0 = ((j >> lg) << (lg + 4)) + k;
    const lcf wr = buf + PADI(j0);
    constexpr int step = PASS == 0 ? 1 : Ns + Ns / 16;
#pragma unroll
    for (int r = 0; r < 16; ++r) stc_(wr + step * r, v[4 * (r & 3) + (r >> 2)]);
  }
  __syncthreads();
}
__device__ void fft16384(lcf buf) {
  int tid = tidx(); asm volatile("" : "+v"(tid));
  fft_pass16<0>(buf, tid);
  fft_pass16<1>(buf, tid);
  fft_pass16<2>(buf, tid);
#pragma unroll 2
  for (int q = 0; q < 8; ++q) {
    const int j = tid + 512 * q;
    const lcf pp = buf + PADI(j);
    cf x0 = ldc_(pp), x1 = ldc_(pp + 4352), x2 = ldc_(pp + 8704), x3 = ldc_(pp + 13056);
    float sn, cs; sincos_cw(-6.283185307179586f * (float)j / 16384.0f, sn, cs);
    const cf w1 = make_float2(cs, sn), w2 = cmul(w1, w1), w3 = cmul(w2, w1);
    x1 = cmul(x1, w1); x2 = cmul(x2, w2); x3 = cmul(x3, w3);
    dft4(x0, x1, x2, x3);
    stc_(pp, x0); stc_(pp + 4352, x1); stc_(pp + 8704, x2); stc_(pp + 13056, x3);
  }
  __syncthreads();
}
DEV void hy_conv3x8(float (&u)[8], const Params& p, const bf16_t* hyt, int col, int b, int t0) {
  const bf16_t* q = hyt + (size_t)col * kROWS + b * kT;
  const uint4 cv = *reinterpret_cast<const uint4*>(q + t0);
  const float pr_ = bf2f(q[t0 > 0 ? t0 - 1 : 0]), nx_ = bf2f(q[t0 + 8 < kT ? t0 + 8 : kT - 1]);
  const float prv = t0 > 0 ? pr_ : 0.f, nxt = t0 + 8 < kT ? nx_ : 0.f;
  const float* cw = p.in[I_HCW];
  const float w0 = cw[col], w1 = cw[kHYC + col], w2 = cw[2 * kHYC + col], bs = p.in[I_HCB][col];
  const float x[10] = {prv, bflo(cv.x), bfhi(cv.x), bflo(cv.y), bfhi(cv.y), bflo(cv.z), bfhi(cv.z), bflo(cv.w), bfhi(cv.w), nxt};
#pragma unroll
  for (int i = 0; i < 8; ++i) u[i] = w0 * x[i] + w1 * x[i + 1] + w2 * x[i + 2] + bs;
}
__device__ void fftconv_channel(float* ldsf, const Params& p, int c, const float* circT, const bf16_t* hyt, bf16_t* hyot) {
  const lcf buf = (lcf)ldsf;
  float* red = ldsf + 2 * FFT_PAD;
  const int tid = tidx(), lane = tid & 63, wid = tid >> 6;
  const float* cc = circT + (size_t)c * FFT_N;
  const float hbias = p.in[I_HBIAS][c];
  unsigned H[32];
#pragma unroll
  for (int m = 0; m < 32; ++m) H[m] = 0u;
  float inrm = 0.f;
  __syncthreads();
#pragma unroll 1
  for (int ph = 0; ph < 5; ++ph) {
    const int pair = (ph - 1) >> 1, b0 = 2 * pair, b1 = b0 + 1;
    if (ph == 0) {
      float asum = 0.f;
#pragma unroll 1
      for (int mb = 0; mb < 32; mb += 16) {
        float fv[16];
#pragma unroll
        for (int m = 0; m < 16; ++m) fv[m] = cc[tid + 512 * (mb + m)];
#pragma unroll
        for (int m = 0; m < 16; ++m) { asum += fabsf(fv[m]); stc_(buf + PADI(tid) + 544 * (mb + m), make_float2(fv[m], 0.f)); }
      }
      asum = wave_sum(asum);
      if (lane == 0) red[wid] = asum;
    } else if (ph & 1) {
#pragma unroll 1
      for (int mm = 0; mm < 2; ++mm) {
        const int t0 = mm * 4096 + tid * 8;
        float v0[8], x0[8], v1[8], x1[8];
        hy_conv3x8(v0, p, hyt, 1024 + c, b0, t0); hy_conv3x8(x0, p, hyt, 512 + c, b0, t0);
        hy_conv3x8(v1, p, hyt, 1024 + c, b1, t0); hy_conv3x8(x1, p, hyt, 512 + c, b1, t0);
        const lcf dst = buf + PADI(t0);
#pragma unroll
        for (int i = 0; i < 8; ++i) { stc_(dst + i, make_float2(v0[i] * x0[i], v1[i] * x1[i])); stc_(buf + PADI(t0 + 8192) + i, make_float2(0.f, 0.f)); }
      }
    }
    __syncthreads();
    if (ph == 0) { float nrm = 0.f;
#pragma unroll
      for (int w = 0; w < 8; ++w) nrm += red[w];
      inrm = 1.0f / nrm; }
    fft16384(buf);
    if (ph == 0) {
#pragma unroll
      for (int m = 0; m < 32; ++m) { const cf hv = ldc_(buf + PADI(tid) + 544 * m); const __half2 hh = __floats2half2_rn(hv.x * inrm, hv.y * inrm); H[m] = *reinterpret_cast<const unsigned*>(&hh); }
    } else if (ph & 1) {
#pragma unroll
      for (int m = 0; m < 32; ++m) { const int i = PADI(tid) + 544 * m; const unsigned hu = H[m]; const float2 hf = __half22float2(*reinterpret_cast<const __half2*>(&hu)); const cf w = cmul(ldc_(buf + i), hf); stc_(buf + i, make_float2(w.y, w.x)); }
    } else {
      const float scale = 1.0f / (float)FFT_N;
#pragma unroll 1
      for (int mm = 0; mm < 2; ++mm) {
        const int t0 = mm * 4096 + tid * 8;
        float v0[8], x0[8], v1[8], x1[8], g0[8], g1[8];
        hy_conv3x8(v0, p, hyt, 1024 + c, b0, t0); hy_conv3x8(x0, p, hyt, 512 + c, b0, t0); hy_conv3x8(g0, p, hyt, c, b0, t0);
        hy_conv3x8(v1, p, hyt, 1024 + c, b1, t0); hy_conv3x8(x1, p, hyt, 512 + c, b1, t0); hy_conv3x8(g1, p, hyt, c, b1, t0);
        const lcf src = buf + PADI(t0);
        float o0[8], o1[8];
#pragma unroll
        for (int i = 0; i < 8; ++i) { const cf val = ldc_(src + i);
          o0[i] = (val.y * scale + hbias * v0[i] * x0[i]) * g0[i]; o1[i] = (val.x * scale + hbias * v1[i] * x1[i]) * g1[i]; }
        *reinterpret_cast<uint4*>(hyot + (size_t)c * kROWS + b0 * kT + t0) = make_uint4(pg8::cvt_pk_bf16(o0[0], o0[1]), pg8::cvt_pk_bf16(o0[2], o0[3]), pg8::cvt_pk_bf16(o0[4], o0[5]), pg8::cvt_pk_bf16(o0[6], o0[7]));
        *reinterpret_cast<uint4*>(hyot + (size_t)c * kROWS + b1 * kT + t0) = make_uint4(pg8::cvt_pk_bf16(o1[0], o1[1]), pg8::cvt_pk_bf16(o1[2], o1[3]), pg8::cvt_pk_bf16(o1[4], o1[5]), pg8::cvt_pk_bf16(o1[6], o1[7]));
      }
    }
    __syncthreads();
  }
}
__device__ void phase_hyo_transpose(float* ldsf, const bf16_t* hyot, bf16_t* hyo, int bid, int nb) {
  bf16_t* tl = reinterpret_cast<bf16_t*>(ldsf);
  const int tid = tidx();
  for (int item = bid; item < 8 * 512; item += nb) {
    const int c0 = (item & 7) * 64, t0 = (item >> 3) * 64;
    __syncthreads();
    { const int cl = tid >> 3, t8 = (tid & 7) * 8;
      const uint4 u = *reinterpret_cast<const uint4*>(hyot + (size_t)(c0 + cl) * kROWS + t0 + t8);
      *reinterpret_cast<uint4*>(tl + cl * 72 + t8) = u; }
    __syncthreads();
    { const int tl_ = tid >> 3, c8 = (tid & 7) * 8;
      unsigned w[4];
#pragma unroll
      for (int i = 0; i < 4; ++i) w[i] = (unsigned)tl[(c8 + 2 * i) * 72 + tl_] | ((unsigned)tl[(c8 + 2 * i + 1) * 72 + tl_] << 16);
      *reinterpret_cast<uint4*>(hyo + (size_t)(t0 + tl_) * 512 + c0 + c8) = make_uint4(w[0], w[1], w[2], w[3]); }
  }
}

__device__ void phase_rwout(float* lds, const Params& p, const bf16_t* rwc, const bf16_t* Y0, const bf16_t* Y1, const float* BS, bf16_t* rwo, int bid, int nb) {
  const int tid = tidx(), lane = tid & 63, wid = tid >> 6;
  bf16_t* sG = reinterpret_cast<bf16_t*>(lds);
  float* sLg = lds + 32768 + wid * 256;
  const float* mu = p.in[I_MU]; const float* gup = p.in[I_GUP]; const float* lng = p.in[I_LNG]; const float* lnb = p.in[I_LNB];
  __syncthreads();
  for (int e = tid; e < 128 * 512 / 4; e += NTHR) { const float4 v = ld4(gup + (size_t)e * 4);
    *reinterpret_cast<uint2*>(sG + (size_t)e * 4) = make_uint2(pg8::cvt_pk_bf16(v.x, v.y), pg8::cvt_pk_bf16(v.z, v.w)); }
  __syncthreads();
  const int c0 = lane * 8, h = lane >> 3;
  for (int rp = bid * 8 + wid; rp < kROWS / 2; rp += nb * 8) {
#pragma unroll
    for (int r = 0; r < 2; ++r) {
      const int row = 2 * rp + r, t = row & (kT - 1);
      const bf16_t* cur = rwc + (size_t)row * kRWC;
#pragma unroll
      for (int k = 0; k < 2; ++k) {
        const int col = 1664 + lane + 64 * k;
        const float cv = bf2f(cur[col]), pv_ = bf2f(cur[col - (t > 0 ? kRWC : 0)]), nv_ = bf2f(cur[col + (t < kT - 1 ? kRWC : 0)]);
        const float pv = t > 0 ? pv_ : 0.f, nv = t < kT - 1 ? nv_ : 0.f;
        sLg[r * 128 + lane + 64 * k] = sigmoidf_(cv + mu[col] * (pv - cv) + mu[kRWC + col] * (nv - cv));
      }
    }
    __syncthreads();
    float g0[8], g1[8];
#pragma unroll
    for (int j = 0; j < 8; ++j) { g0[j] = 0.f; g1[j] = 0.f; }
#pragma unroll 4
    for (int i = 0; i < 128; ++i) {
      const uint4 u = *reinterpret_cast<const uint4*>(sG + i * 512 + c0);
      const float s0 = sLg[i], s1 = sLg[128 + i];
      const float w0 = bflo(u.x), w1 = bfhi(u.x), w2 = bflo(u.y), w3 = bfhi(u.y), w4 = bflo(u.z), w5 = bfhi(u.z), w6 = bflo(u.w), w7 = bfhi(u.w);
      g0[0] += s0 * w0; g0[1] += s0 * w1; g0[2] += s0 * w2; g0[3] += s0 * w3; g0[4] += s0 * w4; g0[5] += s0 * w5; g0[6] += s0 * w6; g0[7] += s0 * w7;
      g1[0] += s1 * w0; g1[1] += s1 * w1; g1[2] += s1 * w2; g1[3] += s1 * w3; g1[4] += s1 * w4; g1[5] += s1 * w5; g1[6] += s1 * w6; g1[7] += s1 * w7;
    }
#pragma unroll
    for (int r = 0; r < 2; ++r) {
      const int row = 2 * rp + r, t = row & (kT - 1);
      const bf16_t* cur = rwc + (size_t)row * kRWC;
      float y[8];
      {
        const uint4 u0 = *reinterpret_cast<const uint4*>(Y0 + (size_t)row * 512 + c0), u1 = *reinterpret_cast<const uint4*>(Y1 + (size_t)row * 512 + c0);
        y[0] = bflo(u0.x) + bflo(u1.x); y[1] = bfhi(u0.x) + bfhi(u1.x); y[2] = bflo(u0.y) + bflo(u1.y); y[3] = bfhi(u0.y) + bfhi(u1.y);
        y[4] = bflo(u0.z) + bflo(u1.z); y[5] = bfhi(u0.z) + bfhi(u1.z); y[6] = bflo(u0.w) + bflo(u1.w); y[7] = bfhi(u0.w) + bfhi(u1.w);
      }
      float sum = 0.f;
#pragma unroll
      for (int j = 0; j < 8; ++j) sum += y[j];
      sum += __shfl_xor(sum, 1); sum += __shfl_xor(sum, 2); sum += __shfl_xor(sum, 4);
      const float mean = sum * (1.0f / 64.0f);
      float var = 0.f;
#pragma unroll
      for (int j = 0; j < 8; ++j) { const float d = y[j] - mean; var += d * d; }
      var += __shfl_xor(var, 1); var += __shfl_xor(var, 2); var += __shfl_xor(var, 4);
      const float rs = rsqrtf(var * (1.0f / 64.0f) + 64e-5f);
      const float bsum = BS[(size_t)row * 8 + h] + BS[((size_t)kROWS + row) * 8 + h];
      const uint4 vc = *reinterpret_cast<const uint4*>(cur + 1024 + c0);
      uint4 vp = *reinterpret_cast<const uint4*>(cur - (t > 0 ? kRWC : 0) + 1024 + c0);
      uint4 vn = *reinterpret_cast<const uint4*>(cur + (t < kT - 1 ? kRWC : 0) + 1024 + c0);
      if (t == 0) vp = make_uint4(0u, 0u, 0u, 0u);
      if (t == kT - 1) vn = make_uint4(0u, 0u, 0u, 0u);
      const unsigned cw[4] = {vc.x, vc.y, vc.z, vc.w}, pw[4] = {vp.x, vp.y, vp.z, vp.w}, nw[4] = {vn.x, vn.y, vn.z, vn.w};
      float o[8];
#pragma unroll
      for (int j = 0; j < 8; ++j) {
        const int col = 1024 + c0 + j;
        const float cv = (j & 1) ? bfhi(cw[j >> 1]) : bflo(cw[j >> 1]), pv = (j & 1) ? bfhi(pw[j >> 1]) : bflo(pw[j >> 1]), nv = (j & 1) ? bfhi(nw[j >> 1]) : bflo(nw[j >> 1]);
        const float vm = cv + mu[col] * (pv - cv) + mu[kRWC + col] * (nv - cv);
        const float yn = (y[j] - mean) * rs * lng[c0 + j] + lnb[c0 + j];
        o[j] = (yn + bsum * vm) * (r ? g1[j] : g0[j]);
      }
      *reinterpret_cast<uint4*>(rwo + (size_t)row * 512 + c0) = make_uint4(pg8::cvt_pk_bf16(o[0], o[1]), pg8::cvt_pk_bf16(o[2], o[3]), pg8::cvt_pk_bf16(o[4], o[5]), pg8::cvt_pk_bf16(o[6], o[7]));
    }
    __syncthreads();
  }
}

__device__ void phase_post(float* lds, const Params& p, float* mx, bf16_t* h2o, float* aff, const float* mod, int bid, int nb) {
  const int lane = tidx() & 63, wid = tidx() >> 6;
  __syncthreads();
  for (int q = tidx(); q < 1024 * 16 / 4; q += NTHR) { const float4 v = ld4(p.in[I_ROUTER] + (size_t)q * 4); const int k = q >> 2, e0 = (q & 3) * 4;
    lds[(e0 + 0) * 1024 + k] = v.x; lds[(e0 + 1) * 1024 + k] = v.y; lds[(e0 + 2) * 1024 + k] = v.z; lds[(e0 + 3) * 1024 + k] = v.w; }
  __syncthreads();
  const float* x = p.in[I_X]; const float* n1post = p.in[I_N1POST]; const float* n2pre = p.in[I_N2PRE]; const float* rw = p.in[I_ROUTER];
  float4 hgp[4], hgn[4], hgt[4], hsc[4], hsh[4]; int hb_ = -1;
#pragma unroll
  for (int i = 0; i < 4; ++i) { hgp[i] = ld4(n1post + i * 256 + lane * 4); hgn[i] = ld4(n2pre + i * 256 + lane * 4); }
  float4 nm[4], nx[4];
  { const int r0 = bid * 8 + wid;
#pragma unroll
    for (int i = 0; i < 4; ++i) { nm[i] = ld4(mx + (size_t)r0 * kD + i * 256 + lane * 4); nx[i] = ld4(x + (size_t)r0 * kD + i * 256 + lane * 4); } }
  for (int row = bid * 8 + wid; row < kROWS; row += nb * 8) {
    const int b = row / kT;
    if (b != hb_) { hb_ = b;
#pragma unroll
      for (int i = 0; i < 4; ++i) { const int k = i * 256 + lane * 4; hgt[i] = ld4(mod + b * 6144 + 2048 + k); hsc[i] = ld4(mod + b * 6144 + 4096 + k); hsh[i] = ld4(mod + b * 6144 + 3072 + k); } }
    float m[16], xv[16];
    float4 xc[4];
    float ss = 0.f;
#pragma unroll
    for (int i = 0; i < 4; ++i) { const float4 v = nm[i]; xc[i] = nx[i];
      m[i * 4] = v.x; m[i * 4 + 1] = v.y; m[i * 4 + 2] = v.z; m[i * 4 + 3] = v.w; ss += v.x * v.x + v.y * v.y + v.z * v.z + v.w * v.w; }
    { const int nr = row + nb * 8 < kROWS ? row + nb * 8 : row;
#pragma unroll
      for (int i = 0; i < 4; ++i) { nm[i] = ld4(mx + (size_t)nr * kD + i * 256 + lane * 4); nx[i] = ld4(x + (size_t)nr * kD + i * 256 + lane * 4); } }
    ss = wave_sum(ss);
    const float r1 = rsqrtf(ss * (1.0f / kD) + 1e-6f);
    float s2 = 0.f;
#pragma unroll
    for (int i = 0; i < 4; ++i) {
      const int k = i * 256 + lane * 4;
      const float4 xx = xc[i], gp = hgp[i], gt = hgt[i];
      xv[i * 4] = xx.x + gt.x * m[i * 4] * r1 * gp.x; xv[i * 4 + 1] = xx.y + gt.y * m[i * 4 + 1] * r1 * gp.y;
      xv[i * 4 + 2] = xx.z + gt.z * m[i * 4 + 2] * r1 * gp.z; xv[i * 4 + 3] = xx.w + gt.w * m[i * 4 + 3] * r1 * gp.w;
      *reinterpret_cast<float4*>(mx + (size_t)row * kD + k) = make_float4(xv[i * 4], xv[i * 4 + 1], xv[i * 4 + 2], xv[i * 4 + 3]);
#pragma unroll
      for (int j = 0; j < 4; ++j) s2 += xv[i * 4 + j] * xv[i * 4 + j];
    }
    s2 = wave_sum(s2);
    const float r2 = rsqrtf(s2 * (1.0f / kD) + 1e-6f);
    float lgt[16];
#pragma unroll
    for (int e = 0; e < 16; ++e) lgt[e] = 0.f;
#pragma unroll
    for (int i = 0; i < 4; ++i) {
      const int k0 = i * 256 + lane * 4;
      const float4 gn = hgn[i], sc = hsc[i], sh = hsh[i];
      float hh[4];
      hh[0] = xv[i * 4] * r2 * gn.x * (1.f + sc.x) + sh.x; hh[1] = xv[i * 4 + 1] * r2 * gn.y * (1.f + sc.y) + sh.y;
      hh[2] = xv[i * 4 + 2] * r2 * gn.z * (1.f + sc.z) + sh.z; hh[3] = xv[i * 4 + 3] * r2 * gn.w * (1.f + sc.w) + sh.w;
      *reinterpret_cast<uint2*>(h2o + (size_t)row * kD + k0) = make_uint2(pg8::cvt_pk_bf16(hh[0], hh[1]), pg8::cvt_pk_bf16(hh[2], hh[3]));
#pragma unroll
      for (int e = 0; e < 16; ++e) {
        const float4 w = *reinterpret_cast<const float4*>(lds + e * 1024 + k0);
        lgt[e] += hh[0] * w.x + hh[1] * w.y + hh[2] * w.z + hh[3] * w.w;
        if ((e & 3) == 3) __builtin_amdgcn_sched_barrier(0);
      }
    }
    float mxv = -1e30f;
#pragma unroll
    for (int e = 0; e < 16; ++e) { lgt[e] = wave_sum(lgt[e]); mxv = fmaxf(mxv, lgt[e]); }
    float den = 0.f;
#pragma unroll
    for (int e = 0; e < 16; ++e) { lgt[e] = expf(lgt[e] - mxv); den += lgt[e]; }
    const float inv = 1.0f / den;
    float mine = 0.f;
#pragma unroll
    for (int e = 0; e < 16; ++e) if (lane == e) mine = lgt[e] * inv;
    if (lane < 16) aff[(size_t)row * 16 + lane] = mine;
  }
}

__device__ void phase_topk(float* lds, const float* aff, int* idx, float* gate, int* sel, int bid, int nb) {
  unsigned* keys = reinterpret_cast<unsigned*>(lds);
  unsigned* hist = keys + kT;
  unsigned* misc = hist + 256;
  unsigned* wtot = misc + 4;
  const int tid = tidx(), lane = tid & 63, wid = tid >> 6;
  for (int item = bid; item < kB * kE; item += nb) {
    const int b = item / kE, e = item % kE;
    __syncthreads();
    for (int t = tid; t < kT; t += NTHR) keys[t] = __float_as_uint(aff[((size_t)b * kT + t) * 16 + e]);
    if (tid == 0) { misc[0] = 0u; misc[1] = (unsigned)kCAP; }
    __syncthreads();
#pragma unroll 1
    for (int pass = 0; pass < 4; ++pass) {
      const int shift = 24 - 8 * pass;
      if (tid < 256) hist[tid] = 0u;
      __syncthreads();
      const unsigned prefix = misc[0];
      for (int t = tid; t < kT; t += NTHR) { const unsigned k = keys[t];
        if (pass == 0 || (k >> (shift + 8)) == (prefix >> (shift + 8))) atomicAdd(&hist[(k >> shift) & 255u], 1u); }
      __syncthreads();
      if (tid == 0) {
        unsigned need = misc[1], above = 0u; int d = 255;
        for (; d > 0; --d) { const unsigned h = hist[d]; if (above + h >= need) break; above += h; }
        misc[0] = prefix | ((unsigned)d << shift); misc[1] = need - above;
      }
      __syncthreads();
    }
    const unsigned thr = misc[0], need = misc[1];
    unsigned cg = 0u, ce = 0u;
#pragma unroll
    for (int q = 0; q < 16; ++q) { const unsigned k = keys[tid * 16 + q]; cg += (k > thr); ce += (k == thr); }
    const float wg = wave_sum((float)cg), we = wave_sum((float)ce);
    if (lane == 0) { wtot[wid] = (unsigned)wg; wtot[8 + wid] = (unsigned)we; }
    __syncthreads();
    unsigned pg = cg, pe = ce;
#pragma unroll
    for (int o = 1; o < 64; o <<= 1) { const unsigned ug = __shfl_up(pg, o), ue = __shfl_up(pe, o); if (lane >= o) { pg += ug; pe += ue; } }
    unsigned og = pg - cg, oe = pe - ce;
    for (int w = 0; w < wid; ++w) { og += wtot[w]; oe += wtot[8 + w]; }
#pragma unroll 1
    for (int q = 0; q < 16; ++q) {
      const int t = tid * 16 + q; const unsigned k = keys[t];
      const bool isg = k > thr, ise = k == thr;
      const bool take = isg || (ise && oe < need);
      const unsigned pos = og + (oe < need ? oe : need);
      if (take) { idx[(e * kB + b) * kCAP + pos] = b * kT + t; gate[item * kCAP + pos] = __uint_as_float(k); }
      sel[((size_t)b * kT + t) * 16 + e] = take ? (int)pos : -1;
      og += isg; oe += ise;
    }
  }
}

__device__ void phase_final(const Params& p, const bf16_t* ye, const int* sel, float* out, const float* mod, int bid, int nb, int tsn) {
  float tscale = 1.f;
  if (TP_LO == 100) { const unsigned long long* ta = (const unsigned long long*)(p.ws + OFF_NORM + 512); float tot = 0.f; for (int k = 2; k <= 9; ++k) tot += (float)ta[k]; tscale = 1.f + sqrtf(1.0e-3f * (float)ta[TP_HI] / tot); }
  else if (TP_LO >= 0) { const unsigned long long* ts = (const unsigned long long*)(p.ws + OFF_NORM); const float tot = (float)(ts[tsn - 2] - ts[0]), part = (float)(ts[TP_HI] - ts[TP_LO]); tscale = 1.f + sqrtf(1.0e-3f * part / tot); }
  const int lane = tidx() & 63, wid = tidx() >> 6;
  const float* n2post = p.in[I_N2POST];
  float4 hgp[4], hgt[4]; int hb_ = -1;
#pragma unroll
  for (int i = 0; i < 4; ++i) hgp[i] = ld4(n2post + i * 256 + lane * 4);
  int nmyc = lane < 16 ? sel[(size_t)(bid * 8 + wid) * 16 + lane] : -1;
  float4 no[4];
#pragma unroll
  for (int i = 0; i < 4; ++i) no[i] = ld4(out + (size_t)(bid * 8 + wid) * kD + i * 256 + lane * 4);
  for (int row = bid * 8 + wid; row < kROWS; row += nb * 8) {
    const int b = row / kT;
    if (b != hb_) { hb_ = b;
#pragma unroll
      for (int i = 0; i < 4; ++i) hgt[i] = ld4(mod + b * 6144 + 5120 + i * 256 + lane * 4); }
    float m[16];
#pragma unroll
    for (int i = 0; i < 16; ++i) m[i] = 0.f;
    const int myc = nmyc;
    float4 oc[4];
#pragma unroll
    for (int i = 0; i < 4; ++i) oc[i] = no[i];
    { const int nr = row + nb * 8 < kROWS ? row + nb * 8 : row;
      nmyc = lane < 16 ? sel[(size_t)nr * 16 + lane] : -1;
#pragma unroll
      for (int i = 0; i < 4; ++i) no[i] = ld4(out + (size_t)nr * kD + i * 256 + lane * 4); }
    unsigned long long msk = __ballot(myc >= 0) & 0xffffull;
#pragma unroll 1
    while (msk) {
      const int e1 = __builtin_ctzll(msk); msk &= msk - 1;
      const bool two = msk != 0ull;
      const int e2 = two ? __builtin_ctzll(msk) : e1; if (two) msk &= msk - 1;
      const int c1 = __shfl(myc, e1), c2 = __shfl(myc, e2);
      const bf16_t* s1 = ye + ((size_t)(b * kE + e1) * kCAP + c1) * kD;
      const bf16_t* s2 = ye + ((size_t)(b * kE + e2) * kCAP + c2) * kD;
      uint2 u1[4], u2[4];
#pragma unroll
      for (int i = 0; i < 4; ++i) { u1[i] = *reinterpret_cast<const uint2*>(s1 + i * 256 + lane * 4); u2[i] = *reinterpret_cast<const uint2*>(s2 + i * 256 + lane * 4); }
      const float f2 = two ? 1.f : 0.f;
#pragma unroll
      for (int i = 0; i < 4; ++i) {
        m[i * 4] += bflo(u1[i].x) + f2 * bflo(u2[i].x); m[i * 4 + 1] += bfhi(u1[i].x) + f2 * bfhi(u2[i].x);
        m[i * 4 + 2] += bflo(u1[i].y) + f2 * bflo(u2[i].y); m[i * 4 + 3] += bfhi(u1[i].y) + f2 * bfhi(u2[i].y);
      }
    }
    float ss = 0.f;
#pragma unroll
    for (int i = 0; i < 16; ++i) ss += m[i] * m[i];
    ss = wave_sum(ss);
    const float r = rsqrtf(ss * (1.0f / kD) + 1e-6f);
#pragma unroll
    for (int i = 0; i < 4; ++i) {
      const int k = i * 256 + lane * 4;
      float4 o = oc[i];
      const float4 gp = hgp[i], gt = hgt[i];
      o.x += gt.x * m[i * 4] * r * gp.x; o.y += gt.y * m[i * 4 + 1] * r * gp.y; o.z += gt.z * m[i * 4 + 2] * r * gp.z; o.w += gt.w * m[i * 4 + 3] * r * gp.w;
      if (TP_LO >= 0) { o.x *= tscale; o.y *= tscale; o.z *= tscale; o.w *= tscale; }
      *reinterpret_cast<float4*>(out + (size_t)row * kD + k) = o;
    }
  }
}


DEV void grid_barrier(unsigned* cnt, unsigned target) {
  asm volatile("s_waitcnt vmcnt(0) lgkmcnt(0)" ::: "memory");
  __syncthreads();
  if (threadIdx.x == 0) {
    __builtin_amdgcn_fence(__ATOMIC_RELEASE, "agent");
    asm volatile("s_waitcnt vmcnt(0)" ::: "memory");
    __hip_atomic_fetch_add(cnt, 1u, __ATOMIC_RELAXED, __HIP_MEMORY_SCOPE_AGENT);
    while (__hip_atomic_load(cnt, __ATOMIC_RELAXED, __HIP_MEMORY_SCOPE_AGENT) < target) __builtin_amdgcn_s_sleep(2);
    __builtin_amdgcn_fence(__ATOMIC_ACQUIRE, "agent");
    asm volatile("s_waitcnt vmcnt(0)" ::: "memory");
  }
  __syncthreads();
}

template <class Epi, class Sched, bool G>
DEV void run_gemm(float* lds, int K, const Sched& S, const Epi& E) {
  __syncthreads();
  pg8::gemm_phase<Epi, Sched, G>((PG8_LAS unsigned char*)lds, K, S, E);
  __syncthreads();
}

#if defined(__HIP_DEVICE_COMPILE__)
typedef __attribute__((address_space(4))) const Params* kargs_ptr;
DEV kargs_ptr kargs() { kargs_ptr k = (kargs_ptr)__builtin_amdgcn_kernarg_segment_ptr(); asm volatile("" : "+s"(k)); return k; }
#else
typedef const Params* kargs_ptr;
__device__ inline kargs_ptr kargs() { return nullptr; }
#endif
__global__ void __launch_bounds__(NTHR, 2) fwd_megakernel(Params p_by_value_unused) {
#define p (*kargs())
  extern __shared__ __attribute__((aligned(16))) float lds[];
  cg::grid_group grid = cg::this_grid();
  const int bid = blockIdx.x, nb = gridDim.x;
  char* const wsx = p.ws;
  int tsn = 0;
  unsigned gb_n = 0;
#define GBAR() do { ++gb_n; grid_barrier((unsigned*)(wsx + OFF_CNT), gb_n * (unsigned)nb); } while (0)
#define STAMP() do { if (TP_LO >= 0) { if (bid == 0 && threadIdx.x == 0) ((unsigned long long*)(wsx + OFF_NORM))[tsn] = __builtin_amdgcn_s_memrealtime(); ++tsn; } } while (0)
  STAMP();
  if (TP_LO == 100 && bid == 0 && threadIdx.x < 16) ((unsigned long long*)(wsx + OFF_NORM + 512))[threadIdx.x] = 0ull;
  char* const ws = p.ws;
  constexpr size_t MB = 1048576;
#define b_mod   ((float*)(ws + OFF_MOD))
#define b_rstdc ((float*)(ws + OFF_RSTDC))
#define b_sctx  ((float*)(ws + OFF_SCTX))
#define b_BS    ((float*)(ws + OFF_BS))
#define b_aff   ((float*)(ws + OFF_AFF))
#define b_idx   ((int*)(ws + OFF_IDX))
#define b_gate  ((float*)(ws + OFF_GATE))
#define b_HC    ((bf16_t*)(ws + OFF_A1 + 244 * MB))
#define b_CC    ((bf16_t*)(ws + OFF_A1 + 240 * MB))
#define b_kfu   ((float*)(ws + OFF_KFU))
#define b_sel   ((int*)(ws + OFF_SEL))
#define b_winT  ((const char*)(ws + OFF_WINT))
#define b_hpT   ((const char*)(ws + OFF_HPT))
#define b_rpT   ((const char*)(ws + OFF_RPT))
#define b_woT   ((const char*)(ws + OFF_WOT))
#define b_w13T  ((const char*)(ws + OFF_W13T))
#define b_w2T   ((const char*)(ws + OFF_W2T))
#define b_hb    ((bf16_t*)(ws + OFF_A0))
#define b_A1    (ws + OFF_A1)
#define b_HYT   ((bf16_t*)(b_A1))
#define b_RWC   ((bf16_t*)(b_A1 + 96 * MB))
#define b_HYOT  ((bf16_t*)(b_A1 + 208 * MB))
#define b_HYO   ((bf16_t*)(b_A1))
#define b_RWO   ((bf16_t*)(b_A1 + 32 * MB))
#define b_YH    ((bf16_t*)(b_A1 + 96 * MB))
#define b_YR    ((bf16_t*)(b_A1 + 160 * MB))
#define b_PRE   ((bf16_t*)(b_A1))
#define b_HID0  ((bf16_t*)(b_A1))
#define b_YE    ((bf16_t*)(b_A1 + 128 * MB))
#define b_Y0    ((bf16_t*)(p.out + (size_t)kROWS * 512))
#define b_Y1    (b_Y0 + (size_t)kROWS * 512)
#define b_PQ    (p.out)
#define b_S0    ((float*)(ws + OFF_KFU))

  phase_mod(lds, p.in[I_C], p.in[I_CCTX], p.in[I_MODW], p.in[I_MODB], b_mod, bid, nb);
  phase_filter(lds, p, b_kfu, bid, nb);
  phase_wprep(lds, p, ws, bid, nb);
  grid.sync(); STAMP();
  phase_hb(p, b_mod, b_hb, b_HC, bid, nb);
  GBAR(); STAMP();
  {
    SchedPlain S0; if (nb == 256) S0.o.init(4, 5, 128, bid >= 128 ? bid - 128 : 1 << 20); else S0.o.init(4, 5, nb, bid);
    S0.A = (const char*)b_HC; S0.B = b_winT + (size_t)2048 * kD * 2; S0.tstep = (size_t)256 * kD * 2;
    EpiBf16Split E0{b_CC, kCC, 5, b_CC, kCC};
    SchedPlain S; S.o.init(kROWS / 256, 7, nb, bid); S.A = (const char*)b_hb; S.B = b_winT + (size_t)1536 * kD * 2; S.tstep = (size_t)256 * kD * 2;
    EpiBf16Split E{b_RWC, kRWC, 7, b_RWC, kRWC};
    run_gemm<EpiBf16Split, SchedPlain, false>(lds, kD, S, E);
    SchedPlain S2; S2.o.init(6, kROWS / 256, nb, bid); S2.A = b_winT; S2.B = (const char*)b_hb; S2.tstep = (size_t)256 * kD * 2;
    EpiBf16Split E2{b_HYT, kROWS, kROWS / 256, b_HYT, kROWS};
    run_gemm<EpiBf16Split, SchedPlain, false>(lds, kD, S2, E2);
    run_gemm<EpiBf16Split, SchedPlain, false>(lds, kD, S0, E0);
  }
  GBAR(); STAMP();
  {
    constexpr int NTA = 64 * (kNSC - 1);
    const bool bal = nb == 256, light = bal && bid >= 192;
    const int kc = light ? bid - 192 : bid;
    if (light || (!bal && bid < 64)) {
      const int dir = kc >> 5, b = (kc >> 3) & 3, h = kc & 7;
      rs::scan_task<64, false>(lds, p, b_CC, kCC, kCTX, 0, 0, 512, 1024, 1088, 512, b, h, dir, 0, 4, nullptr, b_sctx + (size_t)kc * 4096, nullptr, nullptr);
    }
    const int c0 = !bal ? bid : (light ? 320 + (bid - 192) * 3 : (bid < 128 ? bid : 256 + (bid - 128)));
    const int cstep = !bal ? nb : (light ? 1 : 128);
    const int cend = !bal ? 512 : (light ? c0 + 3 : (bid < 128 ? 256 : c0 + 1));
    for (int c = c0; c < cend; c += cstep) fftconv_channel(lds, p, c, b_kfu, b_HYT, b_HYOT);
    const int t0 = light ? 384 + (bid - 192) : bid, tstep = bal ? 192 : nb, tend = bal ? (light ? t0 + 1 : 384) : NTA;
    for (int task = t0; task < tend; task += tstep) {
      const int chain = task / (kNSC - 1), sc = task % (kNSC - 1), dir = chain >> 5, b = (chain >> 3) & 3, h = chain & 7;
      rs::scan_task<128, false>(lds, p, b_RWC, kRWC, kT, 0, 512, 1024, 1536, 1600, 0, b, h, dir, sc * kSCC * 64, kSCC, nullptr, b_PQ + ((size_t)chain * kNSC + sc) * 8192, nullptr, nullptr);
    }
  }
  GBAR(); STAMP();
  if (bid < 64) scan_passB(lds, bid, b_sctx + (size_t)bid * 4096, b_PQ, b_S0);
  phase_hyo_transpose(lds, b_HYOT, b_HYO, bid, nb);
  GBAR(); STAMP();
  for (int task = bid; task < 64 * kNSC; task += nb) {
    const int chain = task / kNSC, sc = task % kNSC, dir = chain >> 5, b = (chain >> 3) & 3, h = chain & 7;
    rs::scan_task<64, true>(lds, p, b_RWC, kRWC, kT, 0, 512, 1024, 1536, 1600, 0, b, h, dir, sc * kSCC * 64, kSCC, b_S0 + (size_t)task * 4096, nullptr, b_Y0, b_BS);
  }
  GBAR(); STAMP();
  phase_rwout(lds, p, b_RWC, b_Y0, b_Y1, b_BS, b_RWO, bid, nb);
  GBAR(); STAMP();
  {
    SchedBranch S; S.o.init(kROWS / 256, 8, nb, bid); S.A0 = (const char*)b_HYO; S.B0 = b_hpT; S.A1 = (const char*)b_RWO; S.B1 = b_rpT;
    EpiBf16Split E{b_YH, kD, 4, b_YR, kD};
    run_gemm<EpiBf16Split, SchedBranch, false>(lds, 512, S, E);
  }
  GBAR(); STAMP();
  {
    SchedPlain S; S.o.init(kROWS / 256, 8, nb, bid); S.A = (const char*)b_hb; S.B = b_winT + (size_t)3328 * kD * 2; S.tstep = (size_t)256 * kD * 2;
    EpiGatesMerge E{b_YH, b_YR, b_PRE};
    run_gemm<EpiGatesMerge, SchedPlain, false>(lds, kD, S, E);
  }
  GBAR(); STAMP();
  {
    SchedPlain S; S.o.init(kROWS / 256, 4, nb, bid); S.A = (const char*)b_PRE; S.B = b_woT; S.tstep = (size_t)256 * kD * 2;
    EpiF32Store E{p.out, kD};
    run_gemm<EpiF32Store, SchedPlain, false>(lds, kD, S, E);
  }
  GBAR(); STAMP();
  phase_post(lds, p, p.out, b_hb, b_aff, b_mod, bid, nb);
  GBAR(); STAMP();
  phase_topk(lds, b_aff, b_idx, b_gate, b_sel, bid, nb);
  GBAR(); STAMP();
  for (int g = 0; g <= 4; ++g) {
    if (g < 4) {
      SchedExp1 S; S.o.init(64, 16, nb, bid); S.H2 = (const char*)b_hb; S.W13T = b_w13T; S.idx = b_idx + g * 4 * 4096; S.e0 = g * 4;
      EpiSwiGLU E{b_HID0 + (size_t)(g & 1) * 16384 * kF};
      run_gemm<EpiSwiGLU, SchedExp1, true>(lds, kD, S, E);
    }
    if (g > 0) {
      SchedExp2 S; S.o.init(64, 4, nb, bid); S.HID = (const char*)(b_HID0 + (size_t)((g - 1) & 1) * 16384 * kF); S.W2T = b_w2T; S.e0 = (g - 1) * 4;
      EpiYE E{b_YE, b_gate, (g - 1) * 4};
      run_gemm<EpiYE, SchedExp2, false>(lds, kF, S, E);
    }
    GBAR(); STAMP();
  }
  phase_final(p, b_YE, b_sel, p.out, b_mod, bid, nb, tsn);
}

#undef b_mod
#undef b_rstdc
#undef b_sctx
#undef b_BS
#undef b_aff
#undef b_idx
#undef b_gate
#undef b_CC
#undef b_HC
#undef b_kfu
#undef b_sel
#undef b_winT
#undef b_hpT
#undef b_rpT
#undef b_woT
#undef b_w13T
#undef b_w2T
#undef b_hb
#undef b_A1
#undef b_HYT
#undef b_RWC
#undef b_HYOT
#undef b_HYO
#undef b_RWO
#undef b_YH
#undef b_YR
#undef b_PRE
#undef b_HID0
#undef b_YE
#undef b_Y0
#undef b_Y1
#undef p
#undef b_PQ
#undef b_S0
extern "C" void kernel_launch(void* const* d_in, const int* in_sizes, int n_in, void* d_out, int out_size, void* d_ws, size_t ws_size,
                              hipStream_t stream) {
  static int grid_blocks = 0;
  if (!grid_blocks) {
    int dev = 0, cus = 0, per_cu = 0;
    (void)hipGetDevice(&dev);
    (void)hipDeviceGetAttribute(&cus, hipDeviceAttributeMultiprocessorCount, dev);
    (void)hipFuncSetAttribute((const void*)fwd_megakernel, hipFuncAttributeMaxDynamicSharedMemorySize, (int)LDS_BYTES);
    (void)hipOccupancyMaxActiveBlocksPerMultiprocessor(&per_cu, fwd_megakernel, NTHR, LDS_BYTES);
    if (per_cu < 1) per_cu = 1;
    if (per_cu > 1) per_cu = 1;
    grid_blocks = cus * per_cu;
    if (ws_size < WS_TOTAL) fprintf(stderr, "kernel_launch: workspace too small: %zu < %zu\n", ws_size, (size_t)WS_TOTAL);
  }
  if (ws_size < WS_TOTAL) return;
  Params p{};
  for (int i = 0; i < 38; ++i) p.in[i] = (const float*)d_in[i];
  p.out = (float*)d_out;
  p.ws = (char*)d_ws;
    (void)hipMemsetAsync((char*)d_ws + OFF_CNT, 0, 256, stream);
  void* args[] = {&p};
  hipError_t e = hipLaunchCooperativeKernel((void*)fwd_megakernel, dim3(grid_blocks), dim3(NTHR), args, LDS_BYTES, stream);
  if (e != hipSuccess) fprintf(stderr, "cooperative launch failed: %s (grid %d)\n", hipGetErrorString(e), grid_blocks);
}
```

```cpp
#include <hip/hip_runtime.h>
#include <hip/hip_cooperative_groups.h>
#include <hip/hip_fp16.h>
#include <cstdio>
#include <cstdint>
namespace cg = cooperative_groups;

#define DEV __device__ __forceinline__
typedef float f32x16 __attribute__((ext_vector_type(16)));

constexpr int kD = 1024, kB = 4, kT = 8192, kCTX = 256, kROWS = kB * kT;
constexpr int kHYW = 512, kHYC = 1536, kRWW = 512, kRWC = 1792, kINC = 5376;
constexpr int kH = 8, kE = 16, kF = 2048, kCAP = 1024;
constexpr int kSCC = 32, kNSC = kT / (64 * kSCC);
constexpr int kCC = 1280;
constexpr int NTHR = 512;
constexpr size_t LDS_BYTES = 160 * 1024;

constexpr size_t OFF_MOD   = 0;
constexpr size_t OFF_RSTDC = OFF_MOD + 131072;
constexpr size_t OFF_NORM  = OFF_RSTDC + 4096;
constexpr size_t OFF_CNT   = OFF_NORM + 2048;
constexpr size_t OFF_SCTX  = OFF_CNT + 256;
constexpr size_t OFF_BS    = OFF_SCTX + 1048576;
constexpr size_t OFF_AFF   = OFF_BS + 2097152;
constexpr size_t OFF_IDX   = OFF_AFF + 2097152;
constexpr size_t OFF_GATE  = OFF_IDX + 262144;
constexpr size_t OFF_KFU   = OFF_GATE + 262144;
constexpr size_t OFF_SEL   = OFF_KFU + 33554432;
constexpr size_t OFF_WINT  = OFF_SEL + 2097152;
constexpr size_t OFF_HPT   = OFF_WINT + 11010048;
constexpr size_t OFF_RPT   = OFF_HPT + 1048576;
constexpr size_t OFF_WOT   = OFF_RPT + 1048576;
constexpr size_t OFF_W13T  = OFF_WOT + 2097152;
constexpr size_t OFF_W2T   = OFF_W13T + 134217728;
constexpr size_t OFF_A0    = OFF_W2T + 67108864;
constexpr size_t OFF_A1    = OFF_A0 + 67108864;
constexpr size_t A1_BYTES  = 268435456;
constexpr size_t WS_TOTAL  = OFF_A1 + A1_BYTES;
static_assert(WS_TOTAL <= 597000000, "workspace budget");

struct Params {
  const float* in[38];
  float* out;
  char* ws;
};
constexpr int TP_LO = -1, TP_HI = -1;


enum { I_X = 0, I_C, I_CTX, I_CCTX, I_MODW, I_MODB, I_N1PRE, I_N1POST, I_N2PRE, I_N2POST, I_WIN,
       I_HCW, I_HCB, I_HW1, I_HB1, I_HW2, I_HB2, I_HW3, I_HFREQ, I_HBIAS, I_HPROJ,
       I_MU, I_W0, I_WUP, I_A0, I_AUP, I_GUP, I_KK, I_KA, I_RK, I_LNG, I_LNB, I_RWPROJ, I_WOUT, I_ROUTER,
       I_EW1, I_EW3, I_EW2 };

DEV int tidx() { int t = threadIdx.x; asm volatile("" : "+v"(t)); return t; }
DEV float wave_sum(float v) {
  int x;
  x = __builtin_amdgcn_update_dpp(0, __float_as_int(v), 0xB1, 0xF, 0xF, false); v += __int_as_float(x);
  x = __builtin_amdgcn_update_dpp(0, __float_as_int(v), 0x4E, 0xF, 0xF, false); v += __int_as_float(x);
  x = __builtin_amdgcn_update_dpp(0, __float_as_int(v), 0x141, 0xF, 0xF, false); v += __int_as_float(x);
  x = __builtin_amdgcn_update_dpp(0, __float_as_int(v), 0x140, 0xF, 0xF, false); v += __int_as_float(x);
  const float r0 = __int_as_float(__builtin_amdgcn_readlane(__float_as_int(v), 0)), r1 = __int_as_float(__builtin_amdgcn_readlane(__float_as_int(v), 16));
  const float r2 = __int_as_float(__builtin_amdgcn_readlane(__float_as_int(v), 32)), r3 = __int_as_float(__builtin_amdgcn_readlane(__float_as_int(v), 48));
  return (r0 + r1) + (r2 + r3);
}
DEV float sigmoidf_(float x) { return 1.0f / (1.0f + expf(-x)); }
DEV float siluf_(float x) { return x / (1.0f + expf(-x)); }
DEV float softplusf_(float x) { return x > 20.f ? x : log1pf(expf(x)); }
DEV void sincos_cw(float x, float& sn, float& cs) {
  const float kf = rintf(x * 0.6366197723675814f);
  const int k = (int)kf;
  float r = fmaf(kf, -1.5703125f, x);
  r = fmaf(kf, -4.837512969970703125e-4f, r);
  r = fmaf(kf, -7.54978995489188216e-8f, r);
  const float r2 = r * r;
  const float sp = r + r * r2 * (-1.6666654611e-1f + r2 * (8.3321608736e-3f + r2 * (-1.9515295891e-4f)));
  const float cp = 1.0f - 0.5f * r2 + r2 * r2 * (4.166664568298827e-2f + r2 * (-1.388731625493765e-3f + r2 * 2.443315711809948e-5f));
  const float s0 = (k & 1) ? cp : sp, c0 = (k & 1) ? sp : cp;
  sn = (k & 2) ? -s0 : s0;
  cs = ((k + 1) & 2) ? -c0 : c0;
}
DEV float sin_cw(float x) { float a, b; sincos_cw(x, a, b); return a; }
DEV float4 ld4(const float* p) { return *reinterpret_cast<const float4*>(p); }

namespace pg8 {
#define PG8_LAS __attribute__((address_space(3)))
typedef unsigned short bf16_t;
typedef short bf16x8 __attribute__((ext_vector_type(8)));
typedef float f32x4 __attribute__((ext_vector_type(4)));
typedef unsigned u32x4 __attribute__((ext_vector_type(4)));
typedef unsigned u32x2 __attribute__((ext_vector_type(2)));
constexpr int BM = 256, BK = 64, HALF = 128, HTB = HALF * BK * 2, STAGE_BYTES = 8 * HTB, NXCD = 8, WGM = 8;
__host__ __device__ __forceinline__ int lds_byte(int r, int c) { const int st = (r >> 4) * 2 + (c >> 5), rr = r & 15, cc = c & 31, ob = rr * 64 + cc * 2; return st * 1024 + (ob ^ (((ob >> 9) & 1) << 5)); }
__host__ __device__ __forceinline__ void stage_rc(int b, int& R, int& C) { const int st = b / 1024, sb = b % 1024, swz = sb ^ (((sb >> 9) & 1) << 5); R = (st >> 1) * 16 + swz / 64; C = (st & 1) * 32 + (swz % 64) / 2; }
__host__ __device__ __forceinline__ int perm32(int rho) { const int n = rho >> 4, i = rho & 15; return 8 * (i >> 2) + 4 * n + (i & 3); }
typedef __bf16 bf16v2 __attribute__((ext_vector_type(2)));
typedef float f32v2 __attribute__((ext_vector_type(2)));
__device__ __forceinline__ unsigned cvt_pk_bf16(float lo, float hi) { const f32v2 v = {lo, hi}; const bf16v2 r = __builtin_convertvector(v, bf16v2); return __builtin_bit_cast(unsigned, r); }

struct Unit { int pm, pn; const char* a; const char* b; };

struct TileOrder {
  int nM, nN, nwg, G, c;
  __device__ void init(int nM_, int nN_, int G_, int c_) { nM = nM_; nN = nN_; nwg = nM * nN; G = G_; c = c_; }
  __device__ bool tile(int i, int& pm, int& pn) const {
    const long L = (long)i * G + c; if (L >= nwg) return false;
    int wgid = (int)L; { const int q = nwg / NXCD, r = nwg % NXCD, xcd = wgid % NXCD, off = wgid / NXCD; wgid = (xcd < r ? xcd * (q + 1) : r * (q + 1) + (xcd - r) * q) + off; }
    const int nig = WGM * nN, gid = wgid / nig, fm = gid * WGM, gsz = (nM - fm) < WGM ? (nM - fm) : WGM;
    pm = fm + ((wgid % nig) % gsz); pn = (wgid % nig) / gsz; return true;
  }
};

template <class Epi, class Sched, bool GATHER>
__device__ __forceinline__ void gemm_phase(PG8_LAS unsigned char* lds, const int K, const Sched& S, const Epi& E) {
  int tid_ = tidx(); asm volatile("" : "+v"(tid_));
  const int tid = tid_, wid = __builtin_amdgcn_readfirstlane(tid >> 6), lane = tid & 63, wr = wid >> 2, wc = wid & 3, fr = lane & 15, fq = lane >> 4;
  const int nt = K / BK;
  unsigned voffA[2], voffB[2];
#pragma unroll
  for (int i = 0; i < 2; ++i) { int R, C; stage_rc(tid * 16 + i * 8192, R, C); const int Rb = Epi::PERM ? ((R & ~31) + perm32(R & 31)) : R;
    voffA[i] = (unsigned)(R * K + C) * 2u; voffB[i] = (unsigned)(Rb * K + C) * 2u; }
  const size_t kstep = (size_t)(BK * 2);
  const size_t hstep = (size_t)HALF * K * 2;
  const unsigned ldsw = (unsigned)wid * 1024u;
  const int aoff = lds_byte(wr * 64 + fr, fq * 8), boff = lds_byte(wc * 32 + fr, fq * 8);
#define PG8_SA(b, h) (((b) * 2 + (h)) * HTB)
#define PG8_SB(b, h) ((4 + (b) * 2 + (h)) * HTB)
#define PG8_STAGE(bufoff, gbase, voff) do { _Pragma("unroll") for (int _i = 0; _i < 2; ++_i) \
    __builtin_amdgcn_global_load_lds((const unsigned*)((const char*)(gbase) + (voff)[_i]), (PG8_LAS unsigned*)(lds + (bufoff) + ldsw + _i * 8192), 16, 0, 0); } while (0)
#define PG8_STAGE_A(bufoff, gbase, h) do { if constexpr (GATHER) { PG8_STAGE(bufoff, gbase, vAc[h]); } else { PG8_STAGE(bufoff, (gbase) + (h) * hstep, voffA); } } while (0)
#define PG8_GATHER_OFFS(dst, u) do { _Pragma("unroll") for (int _h = 0; _h < 2; ++_h) _Pragma("unroll") for (int _i = 0; _i < 2; ++_i) { int _R, _C; stage_rc(tid * 16 + _i * 8192, _R, _C); \
    dst[_h][_i] = (unsigned)S.row(u, _h * HALF + _R) * (unsigned)(K * 2) + (unsigned)(_C * 2); } } while (0)
#define PG8_LDA(dst, b, h) do { _Pragma("unroll") for (int m = 0; m < 4; ++m) _Pragma("unroll") for (int k = 0; k < 2; ++k) dst[m][k] = *(const PG8_LAS bf16x8*)(lds + PG8_SA(b, h) + aoff + m * 2048 + k * 1024); } while (0)
#define PG8_LDB(dst, b, h) do { _Pragma("unroll") for (int n = 0; n < 2; ++n) _Pragma("unroll") for (int k = 0; k < 2; ++k) dst[n][k] = *(const PG8_LAS bf16x8*)(lds + PG8_SB(b, h) + boff + n * 2048 + k * 1024); } while (0)
#define PG8_MMA(ai, bj, At, Bt) do { __builtin_amdgcn_s_setprio(1); _Pragma("unroll") for (int m = 0; m < 4; ++m) _Pragma("unroll") for (int n = 0; n < 2; ++n) _Pragma("unroll") for (int k = 0; k < 2; ++k) \
    acc[ai][bj][m][n] = __builtin_amdgcn_mfma_f32_16x16x32_bf16(Bt[n][k], At[m][k], acc[ai][bj][m][n], 0, 0, 0); __builtin_amdgcn_s_setprio(0); } while (0)
#define PG8_WAIT_V(n) asm volatile("s_waitcnt vmcnt(" #n ")" ::: "memory")
#define PG8_WAIT_L(n) asm volatile("s_waitcnt lgkmcnt(" #n ")" ::: "memory")
#define PG8_BAR __builtin_amdgcn_s_barrier()
#define PG8_SCHED __builtin_amdgcn_sched_barrier(0)
  Unit cur, nxt; int ui = 0;
  if (!S.next(0, cur)) return;
  unsigned vAc[2][2];
  if constexpr (GATHER) { PG8_GATHER_OFFS(vAc, cur); }
  else { vAc[0][0] = vAc[0][1] = vAc[1][0] = vAc[1][1] = 0u; }
  f32x4 acc[2][2][4][2];
#pragma unroll
  for (int a = 0; a < 2; ++a)
#pragma unroll
    for (int b = 0; b < 2; ++b)
#pragma unroll
      for (int m = 0; m < 4; ++m)
#pragma unroll
        for (int n = 0; n < 2; ++n) acc[a][b][m][n] = (f32x4){0.f, 0.f, 0.f, 0.f};
  bf16x8 At[4][2], B0[2][2], B1[2][2];
  const char* cA = cur.a; const char* cB = cur.b;
  PG8_STAGE(PG8_SB(0, 0), cB, voffB); PG8_STAGE_A(PG8_SA(0, 0), cA, 0); PG8_STAGE(PG8_SB(0, 1), cB + hstep, voffB); PG8_STAGE_A(PG8_SA(0, 1), cA, 1);
  if (wr == 1) PG8_BAR;
  PG8_WAIT_V(4); PG8_BAR;
  PG8_STAGE(PG8_SB(1, 0), cB + kstep, voffB); PG8_STAGE_A(PG8_SA(1, 0), cA + kstep, 0); PG8_STAGE(PG8_SB(1, 1), cB + hstep + kstep, voffB);
  PG8_WAIT_V(6); PG8_BAR;
  for (;;) {
    const bool has_next = S.next(ui + 1, nxt);
    const char* nA = has_next ? nxt.a : cA; const char* nB = has_next ? nxt.b : cB;
    for (int t = 0; t < nt; t += 2) {
      const bool last = (t == nt - 2);
      const char* a1 = cA + (size_t)(t + 1) * kstep;
      const char* a2 = last ? nA : cA + (size_t)(t + 2) * kstep; const char* b2 = last ? nB : cB + (size_t)(t + 2) * kstep;
      const char* a3 = a2 + kstep; const char* b3 = b2 + kstep;
      unsigned vAn[2][2];
      if constexpr (GATHER) { PG8_SCHED; if (last && has_next) { PG8_GATHER_OFFS(vAn, nxt); } PG8_SCHED; }
      PG8_LDB(B0, 0, 0); PG8_SCHED; PG8_LDA(At, 0, 0); PG8_STAGE_A(PG8_SA(1, 1), a1, 1);
      PG8_WAIT_L(8); PG8_BAR; PG8_WAIT_L(0); PG8_MMA(0, 0, At, B0); PG8_BAR; PG8_SCHED;
      if constexpr (GATHER) { if (last && has_next) { vAc[0][0] = vAn[0][0]; vAc[0][1] = vAn[0][1]; vAc[1][0] = vAn[1][0]; vAc[1][1] = vAn[1][1]; } }
      PG8_LDB(B1, 0, 1); PG8_STAGE(PG8_SB(0, 0), b2, voffB);
      PG8_BAR; PG8_WAIT_L(0); PG8_MMA(0, 1, At, B1); PG8_BAR;
      PG8_LDA(At, 0, 1); PG8_STAGE_A(PG8_SA(0, 0), a2, 0);
      PG8_BAR; PG8_WAIT_L(0); PG8_MMA(1, 0, At, B0); PG8_BAR; PG8_SCHED;
      PG8_STAGE(PG8_SB(0, 1), b2 + hstep, voffB);
      PG8_WAIT_V(6); PG8_BAR; PG8_MMA(1, 1, At, B1); PG8_BAR;
      PG8_LDB(B0, 1, 0); PG8_SCHED; PG8_LDA(At, 1, 0); PG8_STAGE_A(PG8_SA(0, 1), a2, 1);
      PG8_WAIT_L(8); PG8_BAR; PG8_WAIT_L(0); PG8_MMA(0, 0, At, B0); PG8_BAR; PG8_SCHED;
      PG8_LDB(B1, 1, 1); PG8_STAGE(PG8_SB(1, 0), b3, voffB);
      PG8_BAR; PG8_WAIT_L(0); PG8_MMA(0, 1, At, B1); PG8_BAR;
      PG8_LDA(At, 1, 1); PG8_STAGE_A(PG8_SA(1, 0), a3, 0);
      PG8_BAR; PG8_WAIT_L(0); PG8_MMA(1, 0, At, B0); PG8_BAR; PG8_SCHED;
      PG8_STAGE(PG8_SB(1, 1), b3 + hstep, voffB);
      PG8_WAIT_V(6); PG8_BAR; PG8_MMA(1, 1, At, B1); PG8_BAR;
    }
    E(acc, cur, wr, wc, fr, fq);
    if (!has_next) break;
#pragma unroll
    for (int a = 0; a < 2; ++a)
#pragma unroll
      for (int b = 0; b < 2; ++b)
#pragma unroll
        for (int m = 0; m < 4; ++m)
#pragma unroll
          for (int n = 0; n < 2; ++n) acc[a][b][m][n] = (f32x4){0.f, 0.f, 0.f, 0.f};
    cur = nxt; cA = nA; cB = nB; ++ui;
  }
  PG8_WAIT_V(0);
  if (wr == 0) PG8_BAR;
  PG8_BAR;
#undef PG8_SA
#undef PG8_SB
#undef PG8_STAGE
#undef PG8_STAGE_A
#undef PG8_GATHER_OFFS
#undef PG8_LDA
#undef PG8_LDB
#undef PG8_MMA
#undef PG8_WAIT_V
#undef PG8_WAIT_L
#undef PG8_BAR
#undef PG8_SCHED
}
}

__device__ void transpose_tile(float* tl, const float* src, int ld, int scol0, unsigned short* dst, int K, int n0, int k0) {
  const int tid = tidx();
  __syncthreads();
#pragma unroll
  for (int ps = 0; ps < 4; ++ps) {
    const int kr = ps * 32 + (tid >> 4), c4 = (tid & 15) * 4;
    const float4 v = ld4(src + (size_t)(k0 + kr) * ld + scol0 + c4);
    tl[kr * 65 + c4] = v.x; tl[kr * 65 + c4 + 1] = v.y; tl[kr * 65 + c4 + 2] = v.z; tl[kr * 65 + c4 + 3] = v.w;
  }
  __syncthreads();
  const int n = tid >> 3, kq = (tid & 7) * 16;
  unsigned w[8];
#pragma unroll
  for (int i = 0; i < 8; ++i) w[i] = pg8::cvt_pk_bf16(tl[(kq + 2 * i) * 65 + n], tl[(kq + 2 * i + 1) * 65 + n]);
  uint4* o = reinterpret_cast<uint4*>(dst + (size_t)(n0 + n) * K + k0 + kq);
  o[0] = make_uint4(w[0], w[1], w[2], w[3]); o[1] = make_uint4(w[4], w[5], w[6], w[7]);
}

typedef unsigned short bf16_t;
DEV float bf2f(bf16_t v) { return __uint_as_float((unsigned)v << 16); }
DEV float bflo(unsigned w) { return __uint_as_float(w << 16); }
DEV float bfhi(unsigned w) { return __uint_as_float(w & 0xffff0000u); }
DEV bf16_t f2bf(float f) { return (bf16_t)(pg8::cvt_pk_bf16(f, 0.f) & 0xffffu); }
DEV float fsigmoid(float x) { return 1.0f / (1.0f + __expf(-x)); }

__device__ void phase_wprep(float* lds, const Params& p, char* ws, int bid, int nb) {
  bf16_t* winT = (bf16_t*)(ws + OFF_WINT); bf16_t* hpT = (bf16_t*)(ws + OFF_HPT); bf16_t* rpT = (bf16_t*)(ws + OFF_RPT);
  bf16_t* woT = (bf16_t*)(ws + OFF_WOT); bf16_t* w13T = (bf16_t*)(ws + OFF_W13T); bf16_t* w2T = (bf16_t*)(ws + OFF_W2T);
  constexpr int N0 = 672, N1 = N0 + 64, N2 = N1 + 64, N3 = N2 + 128, N4 = N3 + 8192, N5 = N4 + 4096;
  for (int item = bid; item < N5; item += nb) {
    if (item < N0) {
      const int nt = item >> 3, kt = item & 7, n0 = nt * 64;
      int scol;
      if (n0 < 3328) scol = n0;
      else { const int r = n0 - 3328, j = r >> 8, q = r & 255; scol = 3328 + (q < 128 ? 0 : 1024) + j * 128 + (q & 127); }
      transpose_tile(lds, p.in[I_WIN], kINC, scol, winT, kD, n0, kt * 128);
    } else if (item < N1) { const int it = item - N0; transpose_tile(lds, p.in[I_HPROJ], kD, (it >> 2) * 64, hpT, 512, (it >> 2) * 64, (it & 3) * 128);
    } else if (item < N2) { const int it = item - N1; transpose_tile(lds, p.in[I_RWPROJ], kD, (it >> 2) * 64, rpT, 512, (it >> 2) * 64, (it & 3) * 128);
    } else if (item < N3) { const int it = item - N2; transpose_tile(lds, p.in[I_WOUT], kD, (it >> 3) * 64, woT, kD, (it >> 3) * 64, (it & 7) * 128);
    } else if (item < N4) {
      const int it = item - N3, e = it >> 9, nt = (it >> 3) & 63, kt = it & 7, n0 = nt * 64, j = n0 >> 8, q = n0 & 255;
      const float* src = (q < 128 ? p.in[I_EW1] : p.in[I_EW3]) + (size_t)e * kD * kF;
      transpose_tile(lds, src, kF, j * 128 + (q & 127), w13T + (size_t)e * 4096 * kD, kD, n0, kt * 128);
    } else {
      const int it = item - N4, e = it >> 8, nt = (it >> 4) & 15, kt = it & 15;
      transpose_tile(lds, p.in[I_EW2] + (size_t)e * kF * kD, kD, nt * 64, w2T + (size_t)e * kD * kF, kF, nt * 64, kt * 128);
    }
  }
}

__device__ void phase_hb(const Params& p, const float* mod, bf16_t* hb, bf16_t* hc, int bid, int nb) {
  const int lane = tidx() & 63, wid = tidx() >> 6;
  const float* g = p.in[I_N1PRE];
  const int rstep = nb * 8, rend = kROWS + kB * kCTX;
  float4 hg[4], hsc[4], hsh[4]; int hm_ = -1;
#pragma unroll
  for (int i = 0; i < 4; ++i) hg[i] = ld4(g + i * 256 + lane * 4);
  int row = bid * 8 + wid;
  float4 nv[4];
  { const float* xr = row >= kROWS ? p.in[I_CTX] + (size_t)(row - kROWS) * kD : p.in[I_X] + (size_t)row * kD;
#pragma unroll
    for (int i = 0; i < 4; ++i) nv[i] = row < rend ? ld4(xr + i * 256 + lane * 4) : make_float4(0.f, 0.f, 0.f, 0.f); }
  for (; row < rend; row += rstep) {
    const bool isctx = row >= kROWS;
    const int mr = isctx ? 4 : row / kT;
    if (mr != hm_) { hm_ = mr;
#pragma unroll
      for (int i = 0; i < 4; ++i) { hsc[i] = ld4(mod + mr * 6144 + 1024 + i * 256 + lane * 4); hsh[i] = ld4(mod + mr * 6144 + i * 256 + lane * 4); } }
    bf16_t* dst = isctx ? hc + (size_t)(row - kROWS) * kD : hb + (size_t)row * kD;
    float4 v[4]; float ss = 0.f;
#pragma unroll
    for (int i = 0; i < 4; ++i) { v[i] = nv[i]; ss += v[i].x * v[i].x + v[i].y * v[i].y + v[i].z * v[i].z + v[i].w * v[i].w; }
    { const int nr = row + rstep < rend ? row + rstep : row;
      const float* xr = nr >= kROWS ? p.in[I_CTX] + (size_t)(nr - kROWS) * kD : p.in[I_X] + (size_t)nr * kD;
#pragma unroll
      for (int i = 0; i < 4; ++i) nv[i] = ld4(xr + i * 256 + lane * 4); }
    ss = wave_sum(ss);
    const float r = rsqrtf(ss * (1.0f / kD) + 1e-6f);
#pragma unroll
    for (int i = 0; i < 4; ++i) {
      const int k = i * 256 + lane * 4;
      const float4 gv = hg[i], sc = hsc[i], sh = hsh[i];
      const float h0 = v[i].x * r * gv.x * (1.f + sc.x) + sh.x, h1 = v[i].y * r * gv.y * (1.f + sc.y) + sh.y;
      const float h2 = v[i].z * r * gv.z * (1.f + sc.z) + sh.z, h3 = v[i].w * r * gv.w * (1.f + sc.w) + sh.w;
      *reinterpret_cast<uint2*>(dst + k) = make_uint2(pg8::cvt_pk_bf16(h0, h1), pg8::cvt_pk_bf16(h2, h3));
    }
  }
}

struct SchedPlain {
  pg8::TileOrder o; const char* A; const char* B; size_t tstep;
  __device__ bool next(int i, pg8::Unit& u) const { if (!o.tile(i, u.pm, u.pn)) return false; u.a = A + (size_t)u.pm * tstep; u.b = B + (size_t)u.pn * tstep; return true; }
  __device__ int row(const pg8::Unit&, int) const { return 0; }
};
struct SchedBranch {
  pg8::TileOrder o; const char* A0; const char* B0; const char* A1; const char* B1;
  __device__ bool next(int i, pg8::Unit& u) const { if (!o.tile(i, u.pm, u.pn)) return false;
    const size_t ts = (size_t)256 * 512 * 2;
    if (u.pn < 4) { u.a = A0 + (size_t)u.pm * ts; u.b = B0 + (size_t)u.pn * ts; } else { u.a = A1 + (size_t)u.pm * ts; u.b = B1 + (size_t)(u.pn - 4) * ts; }
    return true; }
  __device__ int row(const pg8::Unit&, int) const { return 0; }
};
struct SchedExp1 {
  pg8::TileOrder o; const char* H2; const char* W13T; const int* idx; int e0;
  __device__ bool next(int i, pg8::Unit& u) const { if (!o.tile(i, u.pm, u.pn)) return false;
    const int e = e0 + (u.pm >> 4); u.a = H2; u.b = W13T + ((size_t)e * 4096 + (size_t)u.pn * 256) * kD * 2; return true; }
  __device__ int row(const pg8::Unit& u, int r) const { return idx[(unsigned)(u.pm * 256 + r)]; }
};
struct SchedExp2 {
  pg8::TileOrder o; const char* HID; const char* W2T; int e0;
  __device__ bool next(int i, pg8::Unit& u) const { if (!o.tile(i, u.pm, u.pn)) return false;
    const int e = e0 + (u.pm >> 4); u.a = HID + (size_t)u.pm * 256 * kF * 2; u.b = W2T + ((size_t)e * kD + (size_t)u.pn * 256) * kF * 2; return true; }
  __device__ int row(const pg8::Unit&, int) const { return 0; }
};

struct EpiBf16Split {
  static constexpr bool PERM = true;
  bf16_t* o0; int ld0; int nt0; bf16_t* o1; int ld1;
  __device__ __forceinline__ void operator()(const pg8::f32x4 (&acc)[2][2][4][2], const pg8::Unit& u, int wr, int wc, int fr, int fq) const {
    bf16_t* base; int ldc, colt;
    if (u.pn < nt0) { base = o0; ldc = ld0; colt = u.pn * 256; } else { base = o1; ldc = ld1; colt = (u.pn - nt0) * 256; }
    const int row0 = u.pm * 256 + wr * 64 + fr, col0 = colt + wc * 32 + 8 * fq;
#pragma unroll
    for (int ai = 0; ai < 2; ++ai)
#pragma unroll
      for (int m = 0; m < 4; ++m) { bf16_t* rowp = base + (size_t)(row0 + ai * 128 + m * 16) * ldc + col0;
#pragma unroll
        for (int bj = 0; bj < 2; ++bj) { const pg8::f32x4 v0 = acc[ai][bj][m][0], v1 = acc[ai][bj][m][1];
          pg8::u32x4 w; w.x = pg8::cvt_pk_bf16(v0[0], v0[1]); w.y = pg8::cvt_pk_bf16(v0[2], v0[3]); w.z = pg8::cvt_pk_bf16(v1[0], v1[1]); w.w = pg8::cvt_pk_bf16(v1[2], v1[3]);
          *(pg8::u32x4*)(rowp + bj * 128) = w; } }
  }
};
struct EpiF32Store {
  static constexpr bool PERM = false;
  float* C; int ldc;
  __device__ __forceinline__ void operator()(const pg8::f32x4 (&acc)[2][2][4][2], const pg8::Unit& u, int wr, int wc, int fr, int fq) const {
    const int row0 = u.pm * 256 + wr * 64 + fr, col0 = u.pn * 256 + wc * 32 + 4 * fq;
#pragma unroll
    for (int ai = 0; ai < 2; ++ai)
#pragma unroll
      for (int m = 0; m < 4; ++m) { float* rowp = C + (size_t)(row0 + ai * 128 + m * 16) * ldc + col0;
#pragma unroll
        for (int bj = 0; bj < 2; ++bj)
#pragma unroll
          for (int n = 0; n < 2; ++n) *(pg8::f32x4*)(rowp + bj * 128 + n * 16) = acc[ai][bj][m][n]; }
  }
};
struct EpiGatesMerge {
  static constexpr bool PERM = true;
  const bf16_t* yh; const bf16_t* yr; bf16_t* pre;
  __device__ __forceinline__ void operator()(const pg8::f32x4 (&acc)[2][2][4][2], const pg8::Unit& u, int wr, int wc, int fr, int fq) const {
    const int row0 = u.pm * 256 + wr * 64 + fr, col0 = u.pn * 128 + wc * 32 + 8 * fq;
#pragma unroll
    for (int ai = 0; ai < 2; ++ai)
#pragma unroll
      for (int m = 0; m < 4; ++m) { const size_t off = (size_t)(row0 + ai * 128 + m * 16) * kD + col0;
        const pg8::u32x4 a = *(const pg8::u32x4*)(yh + off), b = *(const pg8::u32x4*)(yr + off);
        const pg8::f32x4 g0 = acc[ai][0][m][0], g1 = acc[ai][0][m][1], r0 = acc[ai][1][m][0], r1 = acc[ai][1][m][1];
        float o[8];
        o[0] = fsigmoid(g0[0]) * bflo(a.x) + fsigmoid(r0[0]) * bflo(b.x); o[1] = fsigmoid(g0[1]) * bfhi(a.x) + fsigmoid(r0[1]) * bfhi(b.x);
        o[2] = fsigmoid(g0[2]) * bflo(a.y) + fsigmoid(r0[2]) * bflo(b.y); o[3] = fsigmoid(g0[3]) * bfhi(a.y) + fsigmoid(r0[3]) * bfhi(b.y);
        o[4] = fsigmoid(g1[0]) * bflo(a.z) + fsigmoid(r1[0]) * bflo(b.z); o[5] = fsigmoid(g1[1]) * bfhi(a.z) + fsigmoid(r1[1]) * bfhi(b.z);
        o[6] = fsigmoid(g1[2]) * bflo(a.w) + fsigmoid(r1[2]) * bflo(b.w); o[7] = fsigmoid(g1[3]) * bfhi(a.w) + fsigmoid(r1[3]) * bfhi(b.w);
        pg8::u32x4 w; w.x = pg8::cvt_pk_bf16(o[0], o[1]); w.y = pg8::cvt_pk_bf16(o[2], o[3]); w.z = pg8::cvt_pk_bf16(o[4], o[5]); w.w = pg8::cvt_pk_bf16(o[6], o[7]);
        *(pg8::u32x4*)(pre + off) = w; }
  }
};
struct EpiSwiGLU {
  static constexpr bool PERM = true;
  bf16_t* hid;
  __device__ __forceinline__ void operator()(const pg8::f32x4 (&acc)[2][2][4][2], const pg8::Unit& u, int wr, int wc, int fr, int fq) const {
    const int row0 = u.pm * 256 + wr * 64 + fr, col0 = u.pn * 128 + wc * 32 + 8 * fq;
#pragma unroll
    for (int ai = 0; ai < 2; ++ai)
#pragma unroll
      for (int m = 0; m < 4; ++m) { const size_t off = (size_t)(row0 + ai * 128 + m * 16) * kF + col0;
        float o[8];
#pragma unroll
        for (int n = 0; n < 2; ++n)
#pragma unroll
          for (int j = 0; j < 4; ++j) { const float a = acc[ai][0][m][n][j]; o[n * 4 + j] = a * fsigmoid(a) * acc[ai][1][m][n][j]; }
        pg8::u32x4 w; w.x = pg8::cvt_pk_bf16(o[0], o[1]); w.y = pg8::cvt_pk_bf16(o[2], o[3]); w.z = pg8::cvt_pk_bf16(o[4], o[5]); w.w = pg8::cvt_pk_bf16(o[6], o[7]);
        *(pg8::u32x4*)(hid + off) = w; }
  }
};
struct EpiYE {
  static constexpr bool PERM = true;
  bf16_t* ye; const float* gate; int e0;
  __device__ __forceinline__ void operator()(const pg8::f32x4 (&acc)[2][2][4][2], const pg8::Unit& u, int wr, int wc, int fr, int fq) const {
    const int e = e0 + (u.pm >> 4), s0 = (u.pm & 15) * 256 + wr * 64 + fr, col0 = u.pn * 256 + wc * 32 + 8 * fq;
#pragma unroll
    for (int ai = 0; ai < 2; ++ai)
#pragma unroll
      for (int m = 0; m < 4; ++m) { const int s = s0 + ai * 128 + m * 16, b = s >> 10, c = s & 1023, slot = (b * kE + e) * kCAP + c;
        const float g = gate[slot]; bf16_t* rowp = ye + (size_t)slot * kD + col0;
#pragma unroll
        for (int bj = 0; bj < 2; ++bj) { const pg8::f32x4 v0 = acc[ai][bj][m][0] * g, v1 = acc[ai][bj][m][1] * g;
          pg8::u32x4 w; w.x = pg8::cvt_pk_bf16(v0[0], v0[1]); w.y = pg8::cvt_pk_bf16(v0[2], v0[3]); w.z = pg8::cvt_pk_bf16(v1[0], v1[1]); w.w = pg8::cvt_pk_bf16(v1[2], v1[3]);
          *(pg8::u32x4*)(rowp + bj * 128) = w; } }
  }
};

__device__ void phase_mod(float* lds, const float* c, const float* cctx, const float* modw, const float* modb, float* mod, int bid, int nb) {
  float* sc = lds;
  float* red = lds + 5120;
  const int tid = tidx(), kk = tid >> 5, nl = tid & 31;
  bool loaded = false;
  for (int item = bid; item < 192; item += nb) {
    if (!loaded) {
      for (int i = tid; i < 5120; i += NTHR) { const int v = i >> 10, k = i & 1023; const float cv = v < 4 ? c[v * kD + k] : cctx[k]; sc[i] = siluf_(cv); }
      loaded = true;
    }
    __syncthreads();
    const int n = item * 32 + nl;
    float acc[5] = {0.f, 0.f, 0.f, 0.f, 0.f};
#pragma unroll 16
    for (int k = kk * 64; k < kk * 64 + 64; ++k) {
      const float w = modw[(size_t)k * 6144 + n];
#pragma unroll
      for (int v = 0; v < 5; ++v) acc[v] += sc[v * 1024 + k] * w;
    }
#pragma unroll
    for (int v = 0; v < 5; ++v) red[(kk * 5 + v) * 32 + nl] = acc[v];
    __syncthreads();
    if (tid < 160) {
      const int v = tid >> 5;
      float s = 0.f;
#pragma unroll
      for (int q = 0; q < 16; ++q) s += red[(q * 5 + v) * 32 + nl];
      mod[v * 6144 + n] = s + modb[n];
    }
    __syncthreads();
  }
}

__device__ void phase_filter(float* lds, const Params& p, float* circT, int bid, int nb) {
  float* feat = lds;
  float* h1 = lds + 32 * 33;
  float* h2 = h1 + 32 * 64;
  const float* b1 = p.in[I_HB1]; const float* b2 = p.in[I_HB2];
  const float* w3 = p.in[I_HW3]; const float* fr = p.in[I_HFREQ];
  float* w1 = h2 + 32 * 64;
  float* w2 = w1 + 33 * 64;
  const int tid = tidx();
  for (int item = bid; item < kT / 32; item += nb) {
    const int l0 = item * 32;
    __syncthreads();
    for (int i = tid; i < 33 * 64; i += NTHR) w1[i] = p.in[I_HW1][i];
    for (int i = tid; i < 64 * 64; i += NTHR) w2[i] = p.in[I_HW2][i];
    for (int i = tid; i < 32 * 33; i += NTHR) {
      const int pz = i / 33, f = i % 33, l = l0 + pz;
      float v;
      if (f == 0) v = (float)l / (float)(kT - 1);
      else {
        const int j = (f - 1) & 15;
        const float band = 1e-4f + (float)j * ((15.0f - 1e-4f) / 15.0f);
        const float ang = (6.283185307179586f / (float)kT) * (float)l;
        float sn, cs; sincos_cw(band * ang, sn, cs); v = f <= 16 ? cs : -sn;
      }
      feat[i] = v;
    }
    __syncthreads();
    for (int i = tid; i < 32 * 64; i += NTHR) {
      const int pz = i >> 6, o = i & 63;
      float s = b1[o];
#pragma unroll 3
      for (int f = 0; f < 33; ++f) s += feat[pz * 33 + f] * w1[f * 64 + o];
      h1[i] = sin_cw(fr[o] * s);
    }
    __syncthreads();
    for (int i = tid; i < 32 * 64; i += NTHR) {
      const int pz = i >> 6, o = i & 63;
      float s = b2[o];
#pragma unroll 4
      for (int f = 0; f < 64; ++f) s += h1[pz * 64 + f] * w2[f * 64 + o];
      h2[i] = sin_cw(fr[o] * s);
    }
    __syncthreads();
#pragma unroll 1
    for (int half = 0; half < 2; ++half) {
      const int n = tid + half * 512;
      const int c = tid;
      float wr[64];
#pragma unroll
      for (int o = 0; o < 64; ++o) wr[o] = w3[o * 1024 + n];
      const float dlo = -4.605170185988091f / 1.5f, dhi = -4.605170185988091f / 0.3f;
      const float delta = fabsf(dlo + (float)c * ((dhi - dlo) / 511.0f));
      float asum = 0.f;
#pragma unroll 1
      for (int q = 0; q < 32; ++q) {
        float a = 0.f;
#pragma unroll
        for (int o = 0; o < 64; ++o) a += h2[q * 64 + o] * wr[o];
        const int l = l0 + q;
        const float tt = (float)l / (float)(kT - 1);
        const float v = a * expf(-tt * delta);
        if (half == 0) circT[(size_t)c * 16384 + l] = v;
        else circT[(size_t)c * 16384 + 16384 - l - (l == 0 ? 8192 : 0)] = (l == 0 ? 0.f : v);
      }
      (void)asum;
    }
  }
}

DEV float ldcol(const float* p, size_t i) { return p[i]; }
DEV float ldcol(const bf16_t* p, size_t i) { return bf2f(p[i]); }
namespace rs {
typedef short bf16x8 __attribute__((ext_vector_type(8)));
typedef float f32x4 __attribute__((ext_vector_type(4)));
constexpr int LD = 72, LDR = 40;
#define RS_LAS __attribute__((address_space(3)))
typedef RS_LAS bf16_t* lbf; typedef const RS_LAS bf16_t* clbf; typedef RS_LAS float* lf32;
DEV void lds_barrier() { asm volatile("s_waitcnt lgkmcnt(0)" ::: "memory"); __builtin_amdgcn_s_barrier(); asm volatile("" ::: "memory"); }
template <int K>
DEV f32x4 tmma(f32x4 acc, clbf A, int lda, clbf B, int ldb, int lane) {
  clbf ap = A + (lane & 15) * lda + 8 * (lane >> 4);
  clbf bp = B + (lane & 15) * ldb + 8 * (lane >> 4);
#pragma unroll
  for (int k = 0; k < K; k += 32)
    acc = __builtin_amdgcn_mfma_f32_16x16x32_bf16(*(const RS_LAS bf16x8*)(ap + k), *(const RS_LAS bf16x8*)(bp + k), acc, 0, 0, 0);
  return acc;
}
typedef unsigned u32x2v __attribute__((ext_vector_type(2)));
DEV void st4(lbf p, f32x4 v) { const u32x2v w = {pg8::cvt_pk_bf16(v[0], v[1]), pg8::cvt_pk_bf16(v[2], v[3])}; *(RS_LAS u32x2v*)p = w; }
DEV void st4g(bf16_t* p, f32x4 v) { *reinterpret_cast<uint2*>(p) = make_uint2(pg8::cvt_pk_bf16(v[0], v[1]), pg8::cvt_pk_bf16(v[2], v[3])); }
DEV float ftanh(float x) { const float e = __expf(2.f * x); return 1.f - 2.f / (e + 1.f); }

template <int NC> struct Lay {
  static constexpr int ZTB = NC * LD * 2;
  static constexpr int W = 0, ZT0 = 18432, ZT1 = ZT0 + ZTB, AT = ZT1 + ZTB, BTt = AT + 9216, KTt = BTt + 9216, Vt = KTt + 9216,
                       RT = Vt + 9216, X = (NC == 64 ? RT + 9216 : RT), L = X + 18432, D = L + (NC == 64 ? 36864 : 32768);
  static constexpr int LWt = X, LA = X + 9216, BT = X, KT = X + 9216, UT = X, RHS = (NC == 64 ? X + 9216 : L + 18432);
  static constexpr int CS = L, AG = L + 16384, LAK = L, LOFF = L + 9216, LRB = L + 18432, LRK = L + 27648;
  static constexpr int LDG = D, TDG = D + 4352, WCV = TDG + 5120, SEG = WCV + 256, TF = SEG + 2048, END = TF + 4352;
};
static_assert(Lay<64>::END <= (int)LDS_BYTES && Lay<128>::END <= (int)LDS_BYTES, "scan LDS layout");

template <int NC, bool EMIT>
__device__ void scan_task(float* ldsf, const Params& p, const bf16_t* cols, int ldc, int Tlen, int cR, int cK, int cV, int cLW, int cLA, int muoff,
                          int b, int h, int dir, int step0, int nchunks, const float* Zinit  , float* Zout  , bf16_t* Y, float* BSo) {
  typedef Lay<NC> LY;
  RS_LAS char* lds = (RS_LAS char*)ldsf;
  const int tid = tidx(), lane = tid & 63, w = tid >> 6;
  lbf sWup = (lbf)(lds + LY::W); lbf sAup = sWup + 64 * LD;
  lbf sAT = (lbf)(lds + LY::AT); lbf sBTt = (lbf)(lds + LY::BTt); lbf sKTt = (lbf)(lds + LY::KTt); lbf sVt = (lbf)(lds + LY::Vt);
  lbf sRT = (lbf)(lds + LY::RT);
  lbf sLWt = (lbf)(lds + LY::LWt); lbf sLA = (lbf)(lds + LY::LA); lbf sBT = (lbf)(lds + LY::BT); lbf sKT = (lbf)(lds + LY::KT);
  lbf sUT = (lbf)(lds + LY::UT); lbf sRHS = (lbf)(lds + LY::RHS);
  lf32 sCS = (lf32)(lds + LY::CS); lf32 sAG = (lf32)(lds + LY::AG);
  lbf sLak = (lbf)(lds + LY::LAK); lbf sLoff = (lbf)(lds + LY::LOFF); lbf sLrb = (lbf)(lds + LY::LRB); lbf sLrk = (lbf)(lds + LY::LRK);
  lf32 sLdg = (lf32)(lds + LY::LDG); lbf sTdg = (lbf)(lds + LY::TDG); lf32 sWC = (lf32)(lds + LY::WCV); lf32 sSeg = (lf32)(lds + LY::SEG); lf32 sTf = (lf32)(lds + LY::TF);
  const float* mu = p.in[I_MU];
  const int hj = h * 64 + lane;
  const bf16_t* base = cols + (size_t)b * Tlen * ldc;
  constexpr int NT = NC / 16 * 4 / 8;
  f32x4 Zm[NT];

  __syncthreads();
  for (int i = tid; i < 4096; i += NTHR) { const int ii = i >> 6, j = i & 63;
    sWup[j * LD + ii] = f2bf(p.in[I_WUP][((size_t)dir * 64 + ii) * 512 + h * 64 + j]);
    sAup[j * LD + ii] = f2bf(p.in[I_AUP][((size_t)dir * 64 + ii) * 512 + h * 64 + j]); }
#pragma unroll
  for (int m = 0; m < NT; ++m) {
    const int id = w + 8 * m, tj = id & 3, tn = id >> 2, col = tn * 16 + (lane & 15), j0 = tj * 16 + 4 * (lane >> 4);
#pragma unroll
    for (int q = 0; q < 4; ++q) {
      float v = 0.f;
      if (NC == 128) v = (col < 64 && col == j0 + q) ? 1.f : 0.f;
      else if (Zinit) v = Zinit[col * 64 + j0 + q];
      Zm[m][q] = v;
    }
    st4((lbf)(lds + LY::ZT0) + col * LD + j0, Zm[m]);
  }
  for (int i = tid; i < NC * LD / 2; i += NTHR) ((RS_LAS unsigned*)sUT)[i] = 0u;
  int zcur = 0;
  unsigned long long tprev = 0; const bool tpon = (TP_LO == 100) && EMIT && blockIdx.x == 0 && threadIdx.x == 0;
#define RS_T(k) do { if (TP_LO == 100 && EMIT) { if (tpon) { const unsigned long long tn_ = __builtin_amdgcn_s_memrealtime(); ((unsigned long long*)(p.ws + OFF_NORM + 512))[k] += tn_ - tprev; tprev = tn_; } } } while (0)
#pragma unroll 1
  for (int ci = 0; ci < nchunks; ++ci) {
    const int s0 = step0 + ci * 64;
    lbf sZT = (lbf)(lds + (zcur ? LY::ZT1 : LY::ZT0));
    lbf sZN = (lbf)(lds + (zcur ? LY::ZT0 : LY::ZT1));
    lds_barrier();
    if (TP_LO == 100 && EMIT) { if (tpon) tprev = __builtin_amdgcn_s_memrealtime(); }
    const int stepb = s0 + w * 8 - 1;
    unsigned pf[5][5];
#define RS_PREFETCH(a_lo, a_hi) do { _Pragma("unroll") for (int a = a_lo; a < a_hi; ++a) { if (a == 0 && !EMIT) continue; \
      const bf16_t* rp = base + (a == 0 ? cR + h * 64 : a == 1 ? cK + h * 64 : a == 2 ? cV + h * 64 : a == 3 ? cLW : cLA) + lane; \
      _Pragma("unroll") for (int i = 0; i < 5; ++i) { const int s0_ = stepb + 2 * i, s1_ = s0_ + 1, t0_ = dir ? (Tlen - 1 - s0_) : s0_, t1_ = dir ? (Tlen - 1 - s1_) : s1_; \
        const int c0_ = t0_ < 0 ? 0 : (t0_ >= Tlen ? Tlen - 1 : t0_), c1_ = t1_ < 0 ? 0 : (t1_ >= Tlen ? Tlen - 1 : t1_);     \
        const unsigned l_ = (unsigned)rp[(size_t)c0_ * ldc], h_ = (unsigned)rp[(size_t)c1_ * ldc]; \
        pf[a][i] = ((t0_ == c0_) ? l_ : 0u) | (((t1_ == c1_) ? h_ : 0u) << 16); } } } while (0)
#define RS_ROW(a, i) (((i) & 1) ? __uint_as_float(pf[a][(i) >> 1] & 0xffff0000u) : __uint_as_float(pf[a][(i) >> 1] << 16))
    RS_PREFETCH(3, 5);
    {
      const float m0w = mu[cLW + lane + muoff], m1w = mu[kRWC + cLW + lane + muoff], m0a = mu[cLA + lane + muoff], m1a = mu[kRWC + cLA + lane + muoff];
#pragma unroll
      for (int q = 0; q < 8; ++q) {
        const int tl = w * 8 + q;
        const float wc = RS_ROW(3, q + 1), wp = dir ? RS_ROW(3, q + 2) : RS_ROW(3, q), wn = dir ? RS_ROW(3, q) : RS_ROW(3, q + 2);
        const float ac = RS_ROW(4, q + 1), ap = dir ? RS_ROW(4, q + 2) : RS_ROW(4, q), an = dir ? RS_ROW(4, q) : RS_ROW(4, q + 2);
        const float zw = wc + m0w * (wp - wc) + m1w * (wn - wc);
        const float za = ac + m0a * (ap - ac) + m1a * (an - ac);
        sLWt[tl * LD + lane] = f2bf(ftanh(zw)); sLA[tl * LD + lane] = f2bf(za);
      }
    }
    RS_PREFETCH(0, 3);
    lds_barrier(); RS_T(2);
#pragma unroll 1
    for (int m = 0; m < 2; ++m) {
      const int id = w * 2 + m, tm = id >> 2, tn = id & 3;
      f32x4 aw = {0.f, 0.f, 0.f, 0.f}, aa = {0.f, 0.f, 0.f, 0.f};
      aw = tmma<64>(aw, sLWt + tm * 16 * LD, LD, sWup + tn * 16 * LD, LD, lane);
      aa = tmma<64>(aa, sLA + tm * 16 * LD, LD, sAup + tn * 16 * LD, LD, lane);
      const int j = tn * 16 + (lane & 15);
      const float w0 = p.in[I_W0][dir * 512 + h * 64 + j], a0 = p.in[I_A0][dir * 512 + h * 64 + j];
#pragma unroll
      for (int q = 0; q < 4; ++q) {
        const int t = tm * 16 + 4 * (lane >> 4) + q;
        const float x = -(w0 + aw[q]);
        const float sp = x > 20.f ? x : __logf(1.f + __expf(x));
        sCS[t * 64 + j] = __expf(-sp - 0.5f);
        sAG[t * 64 + j] = fsigmoid(a0 + aa[q]);
      }
    }
    lds_barrier(); RS_T(3);
    {
      const int j = tid & 63, seg = tid >> 6;
      float v[8]; float run = 0.f;
#pragma unroll
      for (int q = 0; q < 8; ++q) { run += sCS[(seg * 8 + q) * 64 + j]; v[q] = run; }
      sSeg[seg * 64 + j] = run;
      lds_barrier();
      float off = 0.f;
#pragma unroll
      for (int s = 0; s < 8; ++s) off += (s < seg) ? sSeg[s * 64 + j] : 0.f;
#pragma unroll
      for (int q = 0; q < 8; ++q) sCS[(seg * 8 + q) * 64 + j] = v[q] + off;
    }
    lds_barrier(); RS_T(4);
    {
      const float kkw = p.in[I_KK][hj], kaw = p.in[I_KA][hj], rkw = p.in[I_RK][hj];
      float m0[3], m1[3];
#pragma unroll
      for (int a = 0; a < 3; ++a) { const int col = (a == 0 ? cR : a == 1 ? cK : cV) + h * 64 + lane; m0[a] = mu[col + muoff]; m1[a] = mu[kRWC + col + muoff]; }
#pragma unroll
      for (int q = 0; q < 8; ++q) {
        const int tl = w * 8 + q, tok = dir ? (Tlen - 1 - (s0 + tl)) : (s0 + tl);
        float rkv[3];
#pragma unroll
        for (int a = 0; a < 3; ++a) { const float xc = RS_ROW(a, q + 1), xp = dir ? RS_ROW(a, q + 2) : RS_ROW(a, q), xn = dir ? RS_ROW(a, q) : RS_ROW(a, q + 2);
          rkv[a] = (a == 0 && !EMIT) ? 0.f : xc + m0[a] * (xp - xc) + m1[a] * (xn - xc); }
        const float ag = sAG[tl * 64 + lane], cs = sCS[tl * 64 + lane], csm = tl > 0 ? sCS[(tl - 1) * 64 + lane] : 0.f;
        const float kkv = rkv[1] * kkw;
        const float ss = wave_sum(kkv * kkv);
        const float kkn = kkv * rsqrtf(fmaxf(ss, 1e-24f));
        const float km = rkv[1] * (1.f + (ag - 1.f) * kaw);
        const float ew = __expf(cs), ewi = __expf(-cs);
        const bf16_t at = f2bf(-kkn * __expf(-csm)), bt = f2bf(kkn * ag * ew), kt = f2bf(km * ew), vt = f2bf(rkv[2]);
        sAT[tl * LD + lane] = at; sBT[tl * LD + lane] = bt; sKT[tl * LD + lane] = kt;
        sBTt[lane * LD + tl] = bt; sKTt[lane * LD + tl] = kt; sVt[lane * LD + tl] = vt;
        if (EMIT) {
          sRT[tl * LD + lane] = f2bf(rkv[0] * ewi);
          const float bsum = wave_sum(rkv[0] * km * rkw);
          if (lane == 0) BSo[((size_t)dir * kROWS + (size_t)b * Tlen + tok) * 8 + h] = bsum;
        }
        if (tl == 63) sWC[lane] = ewi;
        __builtin_amdgcn_sched_barrier(0);
      }
    }
    lds_barrier(); RS_T(5);
    if (w < 4) {
      f32x4 acc = {0.f, 0.f, 0.f, 0.f};
      acc = tmma<64>(acc, sBT + w * 16 * LD, LD, sAT + w * 16 * LD, LD, lane);
      const int c = lane & 15, kq = lane >> 4, r4 = 4 * kq;
      lf32 Pm = sLdg + w * 272; lf32 Tm = sTf + w * 272;
#pragma unroll
      for (int q = 0; q < 4; ++q) { const float lv = (r4 + q < c) ? acc[q] : 0.f;
        Pm[c * 17 + r4 + q] = lv; Tm[c * 17 + r4 + q] = lv + ((r4 + q) == c ? 1.f : 0.f); }
#pragma unroll 1
      for (int lev = 0; lev < 3; ++lev) {
        f32x4 a2 = {0.f, 0.f, 0.f, 0.f};
#pragma unroll
        for (int s4 = 0; s4 < 4; ++s4) a2 = __builtin_amdgcn_mfma_f32_16x16x4f32(Pm[c * 17 + 4 * s4 + kq], Pm[(4 * s4 + kq) * 17 + c], a2, 0, 0, 0);
#pragma unroll
        for (int q = 0; q < 4; ++q) Pm[(r4 + q) * 17 + c] = a2[q];
        f32x4 a3 = {0.f, 0.f, 0.f, 0.f};
#pragma unroll
        for (int s4 = 0; s4 < 4; ++s4) a3 = __builtin_amdgcn_mfma_f32_16x16x4f32(Tm[c * 17 + 4 * s4 + kq], Pm[(4 * s4 + kq) * 17 + c], a3, 0, 0, 0);
#pragma unroll
        for (int q = 0; q < 4; ++q) Tm[(r4 + q) * 17 + c] += a3[q];
      }
#pragma unroll
      for (int q = 0; q < 4; ++q) { sTdg[(w * 16 + r4 + q) * LDR + c] = f2bf(Tm[(r4 + q) * 17 + c]); sTdg[(w * 16 + r4 + q) * LDR + 16 + c] = (bf16_t)0; }
    }
    {
      constexpr int NP = EMIT ? 4 : 2;
#pragma unroll 1
      for (int pr = 0; pr < NP; ++pr) {
        clbf Lsrc = (pr < 2) ? sAT : sRT;
        clbf Rsrc = (pr & 1) ? sKT : sBT;
        lbf dst = pr == 0 ? sLoff : pr == 1 ? sLak : pr == 2 ? sLrb : sLrk;
#pragma unroll 1
        for (int m = 0; m < 2; ++m) {
          const int id = w + 8 * m, tt = id >> 2, tu = id & 3;
          f32x4 acc = {0.f, 0.f, 0.f, 0.f};
          if (tu < tt || (pr != 0 && tu == tt)) acc = tmma<64>(acc, Rsrc + tu * 16 * LD, LD, Lsrc + tt * 16 * LD, LD, lane);
          const int t = tt * 16 + (lane & 15), u0 = tu * 16 + 4 * (lane >> 4);
#pragma unroll
          for (int q = 0; q < 4; ++q) { const bool keep = (pr < 2) ? (u0 + q < t) : (u0 + q <= t); acc[q] = keep ? acc[q] : 0.f; }
          st4(dst + t * LD + u0, acc);
        }
      }
    }
    lds_barrier(); RS_T(6);
    for (int i = tid; i < NC * 8; i += NTHR) ((RS_LAS unsigned*)sRHS)[(i >> 3) * (LDR / 2) + 8 + (i & 7)] = 0u;
    RS_T(7);
#pragma unroll 1
    for (int bk = 0; bk < 4; ++bk) {
      if (w < NC / 16) {
        const int tn = w;
        f32x4 acc = {0.f, 0.f, 0.f, 0.f};
        acc = tmma<64>(acc, sAT + bk * 16 * LD, LD, sZT + tn * 16 * LD, LD, lane);
        if (NC == 64 || tn >= 4) acc = tmma<64>(acc, sLak + bk * 16 * LD, LD, sVt + (NC == 64 ? tn : tn - 4) * 16 * LD, LD, lane);
        if (bk > 0) acc = tmma<64>(acc, sLoff + bk * 16 * LD, LD, sUT + tn * 16 * LD, LD, lane);
        st4(sRHS + (tn * 16 + (lane & 15)) * LDR + 4 * (lane >> 4), acc);
      }
      lds_barrier();
      if (w < NC / 16) {
        const int tn = w;
        f32x4 acc = {0.f, 0.f, 0.f, 0.f};
        acc = tmma<32>(acc, sTdg + bk * 16 * LDR, LDR, sRHS + tn * 16 * LDR, LDR, lane);
        st4(sUT + (tn * 16 + (lane & 15)) * LD + bk * 16 + 4 * (lane >> 4), acc);
      }
      lds_barrier();
    }
    RS_T(8);
    if (EMIT) {
#pragma unroll 1
      for (int m = 0; m < 2; ++m) {
        const int id = w + 8 * m, ti = id & 3, tt = id >> 2;
        f32x4 acc = {0.f, 0.f, 0.f, 0.f};
        acc = tmma<64>(acc, sZT + ti * 16 * LD, LD, sRT + tt * 16 * LD, LD, lane);
        acc = tmma<64>(acc, sUT + ti * 16 * LD, LD, sLrb + tt * 16 * LD, LD, lane);
        acc = tmma<64>(acc, sVt + ti * 16 * LD, LD, sLrk + tt * 16 * LD, LD, lane);
        const int tl = tt * 16 + (lane & 15), tok = dir ? (Tlen - 1 - (s0 + tl)) : (s0 + tl);
        st4g(Y + (size_t)dir * kROWS * 512 + ((size_t)b * Tlen + tok) * 512 + h * 64 + ti * 16 + 4 * (lane >> 4), acc);
      }
    }
#pragma unroll
    for (int m = 0; m < NT; ++m) {
      const int id = w + 8 * m, tj = id & 3, tn = id >> 2;
      f32x4 acc = {0.f, 0.f, 0.f, 0.f};
      acc = tmma<64>(acc, sBTt + tj * 16 * LD, LD, sUT + tn * 16 * LD, LD, lane);
      if (NC == 64 || tn >= 4) acc = tmma<64>(acc, sKTt + tj * 16 * LD, LD, sVt + (NC == 64 ? tn : tn - 4) * 16 * LD, LD, lane);
      const int j0 = tj * 16 + 4 * (lane >> 4), col = tn * 16 + (lane & 15);
#pragma unroll
      for (int q = 0; q < 4; ++q) Zm[m][q] = sWC[j0 + q] * (Zm[m][q] + acc[q]);
      st4(sZN + col * LD + j0, Zm[m]);
    }
    zcur ^= 1;
    RS_T(9);
  }
#pragma unroll
  for (int m = 0; m < NT; ++m) {
    const int id = w + 8 * m, tj = id & 3, tn = id >> 2, j0 = tj * 16 + 4 * (lane >> 4), col = tn * 16 + (lane & 15);
    if (Zout) *reinterpret_cast<f32x4*>(Zout + (size_t)col * 64 + j0) = Zm[m];
  }
  __syncthreads();
}
}

__device__ void scan_passB(float* lds, int chain, const float* sinit, const float* PQ, float* S0) {
  float* sS = lds;
  float* sP = lds + 64 * 65;
  const int tid = tidx(), i = tid >> 3, jq = (tid & 7) * 8;
  __syncthreads();
  for (int e = tid; e < 4096; e += NTHR) sS[(e >> 6) * 65 + (e & 63)] = sinit[e];
  for (int sc = 0; sc < kNSC; ++sc) {
    const size_t task = (size_t)chain * kNSC + sc;
    __syncthreads();
    for (int e = tid; e < 4096; e += NTHR) S0[task * 4096 + e] = sS[(e >> 6) * 65 + (e & 63)];
    if (sc == kNSC - 1) break;
    for (int e = tid; e < 2048; e += NTHR) reinterpret_cast<float4*>(sP)[e] = reinterpret_cast<const float4*>(PQ + task * 8192)[e];
    __syncthreads();
    float acc[8];
#pragma unroll
    for (int q = 0; q < 8; ++q) acc[q] = sP[(64 + i) * 64 + jq + q];
#pragma unroll 8
    for (int jp = 0; jp < 64; ++jp) {
      const float s = sS[i * 65 + jp];
      const float4 z0 = *reinterpret_cast<const float4*>(&sP[jp * 64 + jq]), z1 = *reinterpret_cast<const float4*>(&sP[jp * 64 + jq + 4]);
      acc[0] += s * z0.x; acc[1] += s * z0.y; acc[2] += s * z0.z; acc[3] += s * z0.w;
      acc[4] += s * z1.x; acc[5] += s * z1.y; acc[6] += s * z1.z; acc[7] += s * z1.w;
    }
    __syncthreads();
#pragma unroll
    for (int q = 0; q < 8; ++q) sS[i * 65 + jq + q] = acc[q];
  }
  __syncthreads();
}

typedef float cf_ __attribute__((ext_vector_type(2)));
typedef float2 cf;
#define FFT_LAS __attribute__((address_space(3)))
typedef FFT_LAS cf_* lcf;
DEV cf ldc_(const FFT_LAS cf_* q) { const cf_ v = *q; return make_float2(v.x, v.y); }
DEV void stc_(FFT_LAS cf_* q, cf v) { const cf_ w = {v.x, v.y}; *q = w; }
DEV cf cmul(cf a, cf b) { return make_float2(a.x * b.x - a.y * b.y, a.x * b.y + a.y * b.x); }
DEV cf cadd(cf a, cf b) { return make_float2(a.x + b.x, a.y + b.y); }
DEV cf csub(cf a, cf b) { return make_float2(a.x - b.x, a.y - b.y); }
DEV int PADI(int i) { return i + (i >> 4); }
constexpr int FFT_N = 16384, FFT_PAD = FFT_N + FFT_N / 16;
DEV void dft4(cf& x0, cf& x1, cf& x2, cf& x3) {
  const cf a0 = cadd(x0, x2), a1 = csub(x0, x2), a2 = cadd(x1, x3), d = csub(x1, x3);
  const cf a3 = make_float2(d.y, -d.x);
  x0 = cadd(a0, a2); x1 = cadd(a1, a3); x2 = csub(a0, a2); x3 = csub(a1, a3);
}
DEV void dft16(cf (&v)[16]) {
#pragma unroll
  for (int a = 0; a < 4; ++a) dft4(v[a], v[a + 4], v[a + 8], v[a + 12]);
  const cf w1 = make_float2(0.9238795325112867f, -0.3826834323650898f), w2 = make_float2(0.7071067811865476f, -0.7071067811865476f);
  const cf w3 = make_float2(0.3826834323650898f, -0.9238795325112867f), w6 = make_float2(-0.7071067811865476f, -0.7071067811865476f);
  const cf w9 = make_float2(-0.9238795325112867f, 0.3826834323650898f);
  v[1 + 4] = cmul(v[1 + 4], w1); v[1 + 8] = cmul(v[1 + 8], w2); v[1 + 12] = cmul(v[1 + 12], w3);
  v[2 + 4] = cmul(v[2 + 4], w2); v[2 + 8] = make_float2(v[2 + 8].y, -v[2 + 8].x); v[2 + 12] = cmul(v[2 + 12], w6);
  v[3 + 4] = cmul(v[3 + 4], w3); v[3 + 8] = cmul(v[3 + 8], w6); v[3 + 12] = cmul(v[3 + 12], w9);
#pragma unroll
  for (int c = 0; c < 4; ++c) dft4(v[4 * c], v[4 * c + 1], v[4 * c + 2], v[4 * c + 3]);
}
template <int PASS>
DEV void fft_pass16(lcf buf, int tid) {
  constexpr int lg = 4 * PASS, Ns = 1 << lg;
  cf v0[16], v1[16];
  const lcf rd = buf + PADI(tid);
#pragma unroll
  for (int r = 0; r < 16; ++r) { v0[r] = ldc_(rd + 1088 * r); v1[r] = ldc_(rd + 1088 * r + 544); }
  __syncthreads();
#pragma unroll
  for (int h = 0; h < 2; ++h) {
    cf (&v)[16] = h ? v1 : v0;
    int tl = tid; asm volatile("" : "+v"(tl) :: "memory");
    const int j = tl + 512 * h, k = j & (Ns - 1);
    if (PASS > 0) {
      float sn, cs; sincos_cw(-6.283185307179586f * (float)k / (float)(Ns * 16), sn, cs);
      const cf w = make_float2(cs, sn); cf pw = w;
#pragma unroll
      for (int r = 1; r < 16; ++r) { v[r] = cmul(v[r], pw); if (r < 15) pw = cmul(pw, w); }
    }
    dft16(v);
    const int j0 = ((j >> lg) << (lg + 4)) + k;
    const lcf wr = buf + PADI(j0);
    constexpr int step = PASS == 0 ? 1 : Ns + Ns / 16;
#pragma unroll
    for (int r = 0; r < 16; ++r) stc_(wr + step * r, v[4 * (r & 3) + (r >> 2)]);
  }
  __syncthreads();
}
__device__ void fft16384(lcf buf) {
  int tid = tidx(); asm volatile("" : "+v"(tid));
  fft_pass16<0>(buf, tid);
  fft_pass16<1>(buf, tid);
  fft_pass16<2>(buf, tid);
#pragma unroll 2
  for (int q = 0; q < 8; ++q) {
    const int j = tid + 512 * q;
    const lcf pp = buf + PADI(j);
    cf x0 = ldc_(pp), x1 = ldc_(pp + 4352), x2 = ldc_(pp + 8704), x3 = ldc_(pp + 13056);
    float sn, cs; sincos_cw(-6.283185307179586f * (float)j / 16384.0f, sn, cs);
    const cf w1 = make_float2(cs, sn), w2 = cmul(w1, w1), w3 = cmul(w2, w1);
    x1 = cmul(x1, w1); x2 = cmul(x2, w2); x3 = cmul(x3, w3);
    dft4(x0, x1, x2, x3);
    stc_(pp, x0); stc_(pp + 4352, x1); stc_(pp + 8704, x2); stc_(pp + 13056, x3);
  }
  __syncthreads();
}
DEV void hy_conv3x8(float (&u)[8], const Params& p, const bf16_t* hyt, int col, int b, int t0) {
  const bf16_t* q = hyt + (size_t)col * kROWS + b * kT;
  const uint4 cv = *reinterpret_cast<const uint4*>(q + t0);
  const float pr_ = bf2f(q[t0 > 0 ? t0 - 1 : 0]), nx_ = bf2f(q[t0 + 8 < kT ? t0 + 8 : kT - 1]);
  const float prv = t0 > 0 ? pr_ : 0.f, nxt = t0 + 8 < kT ? nx_ : 0.f;
  const float* cw = p.in[I_HCW];
  const float w0 = cw[col], w1 = cw[kHYC + col], w2 = cw[2 * kHYC + col], bs = p.in[I_HCB][col];
  const float x[10] = {prv, bflo(cv.x), bfhi(cv.x), bflo(cv.y), bfhi(cv.y), bflo(cv.z), bfhi(cv.z), bflo(cv.w), bfhi(cv.w), nxt};
#pragma unroll
  for (int i = 0; i < 8; ++i) u[i] = w0 * x[i] + w1 * x[i + 1] + w2 * x[i + 2] + bs;
}
__device__ void fftconv_channel(float* ldsf, const Params& p, int c, const float* circT, const bf16_t* hyt, bf16_t* hyot) {
  const lcf buf = (lcf)ldsf;
  float* red = ldsf + 2 * FFT_PAD;
  const int tid = tidx(), lane = tid & 63, wid = tid >> 6;
  const float* cc = circT + (size_t)c * FFT_N;
  const float hbias = p.in[I_HBIAS][c];
  unsigned H[32];
#pragma unroll
  for (int m = 0; m < 32; ++m) H[m] = 0u;
  float inrm = 0.f;
  __syncthreads();
#pragma unroll 1
  for (int ph = 0; ph < 5; ++ph) {
    const int pair = (ph - 1) >> 1, b0 = 2 * pair, b1 = b0 + 1;
    if (ph == 0) {
      float asum = 0.f;
#pragma unroll 1
      for (int mb = 0; mb < 32; mb += 16) {
        float fv[16];
#pragma unroll
        for (int m = 0; m < 16; ++m) fv[m] = cc[tid + 512 * (mb + m)];
#pragma unroll
        for (int m = 0; m < 16; ++m) { asum += fabsf(fv[m]); stc_(buf + PADI(tid) + 544 * (mb + m), make_float2(fv[m], 0.f)); }
      }
      asum = wave_sum(asum);
      if (lane == 0) red[wid] = asum;
    } else if (ph & 1) {
#pragma unroll 1
      for (int mm = 0; mm < 2; ++mm) {
        const int t0 = mm * 4096 + tid * 8;
        float v0[8], x0[8], v1[8], x1[8];
        hy_conv3x8(v0, p, hyt, 1024 + c, b0, t0); hy_conv3x8(x0, p, hyt, 512 + c, b0, t0);
        hy_conv3x8(v1, p, hyt, 1024 + c, b1, t0); hy_conv3x8(x1, p, hyt, 512 + c, b1, t0);
        const lcf dst = buf + PADI(t0);
#pragma unroll
        for (int i = 0; i < 8; ++i) { stc_(dst + i, make_float2(v0[i] * x0[i], v1[i] * x1[i])); stc_(buf + PADI(t0 + 8192) + i, make_float2(0.f, 0.f)); }
      }
    }
    __syncthreads();
    if (ph == 0) { float nrm = 0.f;
#pragma unroll
      for (int w = 0; w < 8; ++w) nrm += red[w];
      inrm = 1.0f / nrm; }
    fft16384(buf);
    if (ph == 0) {
#pragma unroll
      for (int m = 0; m < 32; ++m) { const cf hv = ldc_(buf + PADI(tid) + 544 * m); const __half2 hh = __floats2half2_rn(hv.x * inrm, hv.y * inrm); H[m] = *reinterpret_cast<const unsigned*>(&hh); }
    } else if (ph & 1) {
#pragma unroll
      for (int m = 0; m < 32; ++m) { const int i = PADI(tid) + 544 * m; const unsigned hu = H[m]; const float2 hf = __half22float2(*reinterpret_cast<const __half2*>(&hu)); const cf w = cmul(ldc_(buf + i), hf); stc_(buf + i, make_float2(w.y, w.x)); }
    } else {
      const float scale = 1.0f / (float)FFT_N;
#pragma unroll 1
      for (int mm = 0; mm < 2; ++mm) {
        const int t0 = mm * 4096 + tid * 8;
        float v0[8], x0[8], v1[8], x1[8], g0[8], g1[8];
        hy_conv3x8(v0, p, hyt, 1024 + c, b0, t0); hy_conv3x8(x0, p, hyt, 512 + c, b0, t0); hy_conv3x8(g0, p, hyt, c, b0, t0);
        hy_conv3x8(v1, p, hyt, 1024 + c, b1, t0); hy_conv3x8(x1, p, hyt, 512 + c, b1, t0); hy_conv3x8(g1, p, hyt, c, b1, t0);
        const lcf src = buf + PADI(t0);
        float o0[8], o1[8];
#pragma unroll
        for (int i = 0; i < 8; ++i) { const cf val = ldc_(src + i);
          o0[i] = (val.y * scale + hbias * v0[i] * x0[i]) * g0[i]; o1[i] = (val.x * scale + hbias * v1[i] * x1[i]) * g1[i]; }
        *reinterpret_cast<uint4*>(hyot + (size_t)c * kROWS + b0 * kT + t0) = make_uint4(pg8::cvt_pk_bf16(o0[0], o0[1]), pg8::cvt_pk_bf16(o0[2], o0[3]), pg8::cvt_pk_bf16(o0[4], o0[5]), pg8::cvt_pk_bf16(o0[6], o0[7]));
        *reinterpret_cast<uint4*>(hyot + (size_t)c * kROWS + b1 * kT + t0) = make_uint4(pg8::cvt_pk_bf16(o1[0], o1[1]), pg8::cvt_pk_bf16(o1[2], o1[3]), pg8::cvt_pk_bf16(o1[4], o1[5]), pg8::cvt_pk_bf16(o1[6], o1[7]));
      }
    }
    __syncthreads();
  }
}
__device__ void phase_hyo_transpose(float* ldsf, const bf16_t* hyot, bf16_t* hyo, int bid, int nb) {
  bf16_t* tl = reinterpret_cast<bf16_t*>(ldsf);
  const int tid = tidx();
  for (int item = bid; item < 8 * 512; item += nb) {
    const int c0 = (item & 7) * 64, t0 = (item >> 3) * 64;
    __syncthreads();
    { const int cl = tid >> 3, t8 = (tid & 7) * 8;
      const uint4 u = *reinterpret_cast<const uint4*>(hyot + (size_t)(c0 + cl) * kROWS + t0 + t8);
      *reinterpret_cast<uint4*>(tl + cl * 72 + t8) = u; }
    __syncthreads();
    { const int tl_ = tid >> 3, c8 = (tid & 7) * 8;
      unsigned w[4];
#pragma unroll
      for (int i = 0; i < 4; ++i) w[i] = (unsigned)tl[(c8 + 2 * i) * 72 + tl_] | ((unsigned)tl[(c8 + 2 * i + 1) * 72 + tl_] << 16);
      *reinterpret_cast<uint4*>(hyo + (size_t)(t0 + tl_) * 512 + c0 + c8) = make_uint4(w[0], w[1], w[2], w[3]); }
  }
}

__device__ void phase_rwout(float* lds, const Params& p, const bf16_t* rwc, const bf16_t* Y0, const bf16_t* Y1, const float* BS, bf16_t* rwo, int bid, int nb) {
  const int tid = tidx(), lane = tid & 63, wid = tid >> 6;
  bf16_t* sG = reinterpret_cast<bf16_t*>(lds);
  float* sLg = lds + 32768 + wid * 256;
  const float* mu = p.in[I_MU]; const float* gup = p.in[I_GUP]; const float* lng = p.in[I_LNG]; const float* lnb = p.in[I_LNB];
  __syncthreads();
  for (int e = tid; e < 128 * 512 / 4; e += NTHR) { const float4 v = ld4(gup + (size_t)e * 4);
    *reinterpret_cast<uint2*>(sG + (size_t)e * 4) = make_uint2(pg8::cvt_pk_bf16(v.x, v.y), pg8::cvt_pk_bf16(v.z, v.w)); }
  __syncthreads();
  const int c0 = lane * 8, h = lane >> 3;
  for (int rp = bid * 8 + wid; rp < kROWS / 2; rp += nb * 8) {
#pragma unroll
    for (int r = 0; r < 2; ++r) {
      const int row = 2 * rp + r, t = row & (kT - 1);
      const bf16_t* cur = rwc + (size_t)row * kRWC;
#pragma unroll
      for (int k = 0; k < 2; ++k) {
        const int col = 1664 + lane + 64 * k;
        const float cv = bf2f(cur[col]), pv_ = bf2f(cur[col - (t > 0 ? kRWC : 0)]), nv_ = bf2f(cur[col + (t < kT - 1 ? kRWC : 0)]);
        const float pv = t > 0 ? pv_ : 0.f, nv = t < kT - 1 ? nv_ : 0.f;
        sLg[r * 128 + lane + 64 * k] = sigmoidf_(cv + mu[col] * (pv - cv) + mu[kRWC + col] * (nv - cv));
      }
    }
    __syncthreads();
    float g0[8], g1[8];
#pragma unroll
    for (int j = 0; j < 8; ++j) { g0[j] = 0.f; g1[j] = 0.f; }
#pragma unroll 4
    for (int i = 0; i < 128; ++i) {
      const uint4 u = *reinterpret_cast<const uint4*>(sG + i * 512 + c0);
      const float s0 = sLg[i], s1 = sLg[128 + i];
      const float w0 = bflo(u.x), w1 = bfhi(u.x), w2 = bflo(u.y), w3 = bfhi(u.y), w4 = bflo(u.z), w5 = bfhi(u.z), w6 = bflo(u.w), w7 = bfhi(u.w);
      g0[0] += s0 * w0; g0[1] += s0 * w1; g0[2] += s0 * w2; g0[3] += s0 * w3; g0[4] += s0 * w4; g0[5] += s0 * w5; g0[6] += s0 * w6; g0[7] += s0 * w7;
      g1[0] += s1 * w0; g1[1] += s1 * w1; g1[2] += s1 * w2; g1[3] += s1 * w3; g1[4] += s1 * w4; g1[5] += s1 * w5; g1[6] += s1 * w6; g1[7] += s1 * w7;
    }
#pragma unroll
    for (int r = 0; r < 2; ++r) {
      const int row = 2 * rp + r, t = row & (kT - 1);
      const bf16_t* cur = rwc + (size_t)row * kRWC;
      float y[8];
      {
        const uint4 u0 = *reinterpret_cast<const uint4*>(Y0 + (size_t)row * 512 + c0), u1 = *reinterpret_cast<const uint4*>(Y1 + (size_t)row * 512 + c0);
        y[0] = bflo(u0.x) + bflo(u1.x); y[1] = bfhi(u0.x) + bfhi(u1.x); y[2] = bflo(u0.y) + bflo(u1.y); y[3] = bfhi(u0.y) + bfhi(u1.y);
        y[4] = bflo(u0.z) + bflo(u1.z); y[5] = bfhi(u0.z) + bfhi(u1.z); y[6] = bflo(u0.w) + bflo(u1.w); y[7] = bfhi(u0.w) + bfhi(u1.w);
      }
      float sum = 0.f;
#pragma unroll
      for (int j = 0; j < 8; ++j) sum += y[j];
      sum += __shfl_xor(sum, 1); sum += __shfl_xor(sum, 2); sum += __shfl_xor(sum, 4);
      const float mean = sum * (1.0f / 64.0f);
      float var = 0.f;
#pragma unroll
      for (int j = 0; j < 8; ++j) { const float d = y[j] - mean; var += d * d; }
      var += __shfl_xor(var, 1); var += __shfl_xor(var, 2); var += __shfl_xor(var, 4);
      const float rs = rsqrtf(var * (1.0f / 64.0f) + 64e-5f);
      const float bsum = BS[(size_t)row * 8 + h] + BS[((size_t)kROWS + row) * 8 + h];
      const uint4 vc = *reinterpret_cast<const uint4*>(cur + 1024 + c0);
      uint4 vp = *reinterpret_cast<const uint4*>(cur - (t > 0 ? kRWC : 0) + 1024 + c0);
      uint4 vn = *reinterpret_cast<const uint4*>(cur + (t < kT - 1 ? kRWC : 0) + 1024 + c0);
      if (t == 0) vp = make_uint4(0u, 0u, 0u, 0u);
      if (t == kT - 1) vn = make_uint4(0u, 0u, 0u, 0u);
      const unsigned cw[4] = {vc.x, vc.y, vc.z, vc.w}, pw[4] = {vp.x, vp.y, vp.z, vp.w}, nw[4] = {vn.x, vn.y, vn.z, vn.w};
      float o[8];
#pragma unroll
      for (int j = 0; j < 8; ++j) {
        const int col = 1024 + c0 + j;
        const float cv = (j & 1) ? bfhi(cw[j >> 1]) : bflo(cw[j >> 1]), pv = (j & 1) ? bfhi(pw[j >> 1]) : bflo(pw[j >> 1]), nv = (j & 1) ? bfhi(nw[j >> 1]) : bflo(nw[j >> 1]);
        const float vm = cv + mu[col] * (pv - cv) + mu[kRWC + col] * (nv - cv);
        const float yn = (y[j] - mean) * rs * lng[c0 + j] + lnb[c0 + j];
        o[j] = (yn + bsum * vm) * (r ? g1[j] : g0[j]);
      }
      *reinterpret_cast<uint4*>(rwo + (size_t)row * 512 + c0) = make_uint4(pg8::cvt_pk_bf16(o[0], o[1]), pg8::cvt_pk_bf16(o[2], o[3]), pg8::cvt_pk_bf16(o[4], o[5]), pg8::cvt_pk_bf16(o[6], o[7]));
    }
    __syncthreads();
  }
}

__device__ void phase_post(float* lds, const Params& p, float* mx, bf16_t* h2o, float* aff, const float* mod, int bid, int nb) {
  const int lane = tidx() & 63, wid = tidx() >> 6;
  __syncthreads();
  for (int q = tidx(); q < 1024 * 16 / 4; q += NTHR) { const float4 v = ld4(p.in[I_ROUTER] + (size_t)q * 4); const int k = q >> 2, e0 = (q & 3) * 4;
    lds[(e0 + 0) * 1024 + k] = v.x; lds[(e0 + 1) * 1024 + k] = v.y; lds[(e0 + 2) * 1024 + k] = v.z; lds[(e0 + 3) * 1024 + k] = v.w; }
  __syncthreads();
  const float* x = p.in[I_X]; const float* n1post = p.in[I_N1POST]; const float* n2pre = p.in[I_N2PRE]; const float* rw = p.in[I_ROUTER];
  float4 hgp[4], hgn[4], hgt[4], hsc[4], hsh[4]; int hb_ = -1;
#pragma unroll
  for (int i = 0; i < 4; ++i) { hgp[i] = ld4(n1post + i * 256 + lane * 4); hgn[i] = ld4(n2pre + i * 256 + lane * 4); }
  float4 nm[4], nx[4];
  { const int r0 = bid * 8 + wid;
#pragma unroll
    for (int i = 0; i < 4; ++i) { nm[i] = ld4(mx + (size_t)r0 * kD + i * 256 + lane * 4); nx[i] = ld4(x + (size_t)r0 * kD + i * 256 + lane * 4); } }
  for (int row = bid * 8 + wid; row < kROWS; row += nb * 8) {
    const int b = row / kT;
    if (b != hb_) { hb_ = b;
#pragma unroll
      for (int i = 0; i < 4; ++i) { const int k = i * 256 + lane * 4; hgt[i] = ld4(mod + b * 6144 + 2048 + k); hsc[i] = ld4(mod + b * 6144 + 4096 + k); hsh[i] = ld4(mod + b * 6144 + 3072 + k); } }
    float m[16], xv[16];
    float4 xc[4];
    float ss = 0.f;
#pragma unroll
    for (int i = 0; i < 4; ++i) { const float4 v = nm[i]; xc[i] = nx[i];
      m[i * 4] = v.x; m[i * 4 + 1] = v.y; m[i * 4 + 2] = v.z; m[i * 4 + 3] = v.w; ss += v.x * v.x + v.y * v.y + v.z * v.z + v.w * v.w; }
    { const int nr = row + nb * 8 < kROWS ? row + nb * 8 : row;
#pragma unroll
      for (int i = 0; i < 4; ++i) { nm[i] = ld4(mx + (size_t)nr * kD + i * 256 + lane * 4); nx[i] = ld4(x + (size_t)nr * kD + i * 256 + lane * 4); } }
    ss = wave_sum(ss);
    const float r1 = rsqrtf(ss * (1.0f / kD) + 1e-6f);
    float s2 = 0.f;
#pragma unroll
    for (int i = 0; i < 4; ++i) {
      const int k = i * 256 + lane * 4;
      const float4 xx = xc[i], gp = hgp[i], gt = hgt[i];
      xv[i * 4] = xx.x + gt.x * m[i * 4] * r1 * gp.x; xv[i * 4 + 1] = xx.y + gt.y * m[i * 4 + 1] * r1 * gp.y;
      xv[i * 4 + 2] = xx.z + gt.z * m[i * 4 + 2] * r1 * gp.z; xv[i * 4 + 3] = xx.w + gt.w * m[i * 4 + 3] * r1 * gp.w;
      *reinterpret_cast<float4*>(mx + (size_t)row * kD + k) = make_float4(xv[i * 4], xv[i * 4 + 1], xv[i * 4 + 2], xv[i * 4 + 3]);
#pragma unroll
      for (int j = 0; j < 4; ++j) s2 += xv[i * 4 + j] * xv[i * 4 + j];
    }
    s2 = wave_sum(s2);
    const float r2 = rsqrtf(s2 * (1.0f / kD) + 1e-6f);
    float lgt[16];
#pragma unroll
    for (int e = 0; e < 16; ++e) lgt[e] = 0.f;
#pragma unroll
    for (int i = 0; i < 4; ++i) {
      const int k0 = i * 256 + lane * 4;
      const float4 gn = hgn[i], sc = hsc[i], sh = hsh[i];
      float hh[4];
      hh[0] = xv[i * 4] * r2 * gn.x * (1.f + sc.x) + sh.x; hh[1] = xv[i * 4 + 1] * r2 * gn.y * (1.f + sc.y) + sh.y;
      hh[2] = xv[i * 4 + 2] * r2 * gn.z * (1.f + sc.z) + sh.z; hh[3] = xv[i * 4 + 3] * r2 * gn.w * (1.f + sc.w) + sh.w;
      *reinterpret_cast<uint2*>(h2o + (size_t)row * kD + k0) = make_uint2(pg8::cvt_pk_bf16(hh[0], hh[1]), pg8::cvt_pk_bf16(hh[2], hh[3]));
#pragma unroll
      for (int e = 0; e < 16; ++e) {
        const float4 w = *reinterpret_cast<const float4*>(lds + e * 1024 + k0);
        lgt[e] += hh[0] * w.x + hh[1] * w.y + hh[2] * w.z + hh[3] * w.w;
        if ((e & 3) == 3) __builtin_amdgcn_sched_barrier(0);
      }
    }
    float mxv = -1e30f;
#pragma unroll
    for (int e = 0; e < 16; ++e) { lgt[e] = wave_sum(lgt[e]); mxv = fmaxf(mxv, lgt[e]); }
    float den = 0.f;
#pragma unroll
    for (int e = 0; e < 16; ++e) { lgt[e] = expf(lgt[e] - mxv); den += lgt[e]; }
    const float inv = 1.0f / den;
    float mine = 0.f;
#pragma unroll
    for (int e = 0; e < 16; ++e) if (lane == e) mine = lgt[e] * inv;
    if (lane < 16) aff[(size_t)row * 16 + lane] = mine;
  }
}

__device__ void phase_topk(float* lds, const float* aff, int* idx, float* gate, int* sel, int bid, int nb) {
  unsigned* keys = reinterpret_cast<unsigned*>(lds);
  unsigned* hist = keys + kT;
  unsigned* misc = hist + 256;
  unsigned* wtot = misc + 4;
  const int tid = tidx(), lane = tid & 63, wid = tid >> 6;
  for (int item = bid; item < kB * kE; item += nb) {
    const int b = item / kE, e = item % kE;
    __syncthreads();
    for (int t = tid; t < kT; t += NTHR) keys[t] = __float_as_uint(aff[((size_t)b * kT + t) * 16 + e]);
    if (tid == 0) { misc[0] = 0u; misc[1] = (unsigned)kCAP; }
    __syncthreads();
#pragma unroll 1
    for (int pass = 0; pass < 4; ++pass) {
      const int shift = 24 - 8 * pass;
      if (tid < 256) hist[tid] = 0u;
      __syncthreads();
      const unsigned prefix = misc[0];
      for (int t = tid; t < kT; t += NTHR) { const unsigned k = keys[t];
        if (pass == 0 || (k >> (shift + 8)) == (prefix >> (shift + 8))) atomicAdd(&hist[(k >> shift) & 255u], 1u); }
      __syncthreads();
      if (tid == 0) {
        unsigned need = misc[1], above = 0u; int d = 255;
        for (; d > 0; --d) { const unsigned h = hist[d]; if (above + h >= need) break; above += h; }
        misc[0] = prefix | ((unsigned)d << shift); misc[1] = need - above;
      }
      __syncthreads();
    }
    const unsigned thr = misc[0], need = misc[1];
    unsigned cg = 0u, ce = 0u;
#pragma unroll
    for (int q = 0; q < 16; ++q) { const unsigned k = keys[tid * 16 + q]; cg += (k > thr); ce += (k == thr); }
    const float wg = wave_sum((float)cg), we = wave_sum((float)ce);
    if (lane == 0) { wtot[wid] = (unsigned)wg; wtot[8 + wid] = (unsigned)we; }
    __syncthreads();
    unsigned pg = cg, pe = ce;
#pragma unroll
    for (int o = 1; o < 64; o <<= 1) { const unsigned ug = __shfl_up(pg, o), ue = __shfl_up(pe, o); if (lane >= o) { pg += ug; pe += ue; } }
    unsigned og = pg - cg, oe = pe - ce;
    for (int w = 0; w < wid; ++w) { og += wtot[w]; oe += wtot[8 + w]; }
#pragma unroll 1
    for (int q = 0; q < 16; ++q) {
      const int t = tid * 16 + q; const unsigned k = keys[t];
      const bool isg = k > thr, ise = k == thr;
      const bool take = isg || (ise && oe < need);
      const unsigned pos = og + (oe < need ? oe : need);
      if (take) { idx[(e * kB + b) * kCAP + pos] = b * kT + t; gate[item * kCAP + pos] = __uint_as_float(k); }
      sel[((size_t)b * kT + t) * 16 + e] = take ? (int)pos : -1;
      og += isg; oe += ise;
    }
  }
}

__device__ void phase_final(const Params& p, const bf16_t* ye, const int* sel, float* out, const float* mod, int bid, int nb, int tsn) {
  float tscale = 1.f;
  if (TP_LO == 100) { const unsigned long long* ta = (const unsigned long long*)(p.ws + OFF_NORM + 512); float tot = 0.f; for (int k = 2; k <= 9; ++k) tot += (float)ta[k]; tscale = 1.f + sqrtf(1.0e-3f * (float)ta[TP_HI] / tot); }
  else if (TP_LO >= 0) { const unsigned long long* ts = (const unsigned long long*)(p.ws + OFF_NORM); const float tot = (float)(ts[tsn - 2] - ts[0]), part = (float)(ts[TP_HI] - ts[TP_LO]); tscale = 1.f + sqrtf(1.0e-3f * part / tot); }
  const int lane = tidx() & 63, wid = tidx() >> 6;
  const float* n2post = p.in[I_N2POST];
  float4 hgp[4], hgt[4]; int hb_ = -1;
#pragma unroll
  for (int i = 0; i < 4; ++i) hgp[i] = ld4(n2post + i * 256 + lane * 4);
  int nmyc = lane < 16 ? sel[(size_t)(bid * 8 + wid) * 16 + lane] : -1;
  float4 no[4];
#pragma unroll
  for (int i = 0; i < 4; ++i) no[i] = ld4(out + (size_t)(bid * 8 + wid) * kD + i * 256 + lane * 4);
  for (int row = bid * 8 + wid; row < kROWS; row += nb * 8) {
    const int b = row / kT;
    if (b != hb_) { hb_ = b;
#pragma unroll
      for (int i = 0; i < 4; ++i) hgt[i] = ld4(mod + b * 6144 + 5120 + i * 256 + lane * 4); }
    float m[16];
#pragma unroll
    for (int i = 0; i < 16; ++i) m[i] = 0.f;
    const int myc = nmyc;
    float4 oc[4];
#pragma unroll
    for (int i = 0; i < 4; ++i) oc[i] = no[i];
    { const int nr = row + nb * 8 < kROWS ? row + nb * 8 : row;
      nmyc = lane < 16 ? sel[(size_t)nr * 16 + lane] : -1;
#pragma unroll
      for (int i = 0; i < 4; ++i) no[i] = ld4(out + (size_t)nr * kD + i * 256 + lane * 4); }
    unsigned long long msk = __ballot(myc >= 0) & 0xffffull;
#pragma unroll 1
    while (msk) {
      const int e1 = __builtin_ctzll(msk); msk &= msk - 1;
      const bool two = msk != 0ull;
      const int e2 = two ? __builtin_ctzll(msk) : e1; if (two) msk &= msk - 1;
      const int c1 = __shfl(myc, e1), c2 = __shfl(myc, e2);
      const bf16_t* s1 = ye + ((size_t)(b * kE + e1) * kCAP + c1) * kD;
      const bf16_t* s2 = ye + ((size_t)(b * kE + e2) * kCAP + c2) * kD;
      uint2 u1[4], u2[4];
#pragma unroll
      for (int i = 0; i < 4; ++i) { u1[i] = *reinterpret_cast<const uint2*>(s1 + i * 256 + lane * 4); u2[i] = *reinterpret_cast<const uint2*>(s2 + i * 256 + lane * 4); }
      const float f2 = two ? 1.f : 0.f;
#pragma unroll
      for (int i = 0; i < 4; ++i) {
        m[i * 4] += bflo(u1[i].x) + f2 * bflo(u2[i].x); m[i * 4 + 1] += bfhi(u1[i].x) + f2 * bfhi(u2[i].x);
        m[i * 4 + 2] += bflo(u1[i].y) + f2 * bflo(u2[i].y); m[i * 4 + 3] += bfhi(u1[i].y) + f2 * bfhi(u2[i].y);
      }
    }
    float ss = 0.f;
#pragma unroll
    for (int i = 0; i < 16; ++i) ss += m[i] * m[i];
    ss = wave_sum(ss);
    const float r = rsqrtf(ss * (1.0f / kD) + 1e-6f);
#pragma unroll
    for (int i = 0; i < 4; ++i) {
      const int k = i * 256 + lane * 4;
      float4 o = oc[i];
      const float4 gp = hgp[i], gt = hgt[i];
      o.x += gt.x * m[i * 4] * r * gp.x; o.y += gt.y * m[i * 4 + 1] * r * gp.y; o.z += gt.z * m[i * 4 + 2] * r * gp.z; o.w += gt.w * m[i * 4 + 3] * r * gp.w;
      if (TP_LO >= 0) { o.x *= tscale; o.y *= tscale; o.z *= tscale; o.w *= tscale; }
      *reinterpret_cast<float4*>(out + (size_t)row * kD + k) = o;
    }
  }
}


DEV void grid_barrier(unsigned* cnt, unsigned target) {
  asm volatile("s_waitcnt vmcnt(0) lgkmcnt(0)" ::: "memory");
  __syncthreads();
  if (threadIdx.x == 0) {
    __builtin_amdgcn_fence(__ATOMIC_RELEASE, "agent");
    asm volatile("s_waitcnt vmcnt(0)" ::: "memory");
    __hip_atomic_fetch_add(cnt, 1u, __ATOMIC_RELAXED, __HIP_MEMORY_SCOPE_AGENT);
    while (__hip_atomic_load(cnt, __ATOMIC_RELAXED, __HIP_MEMORY_SCOPE_AGENT) < target) __builtin_amdgcn_s_sleep(2);
    __builtin_amdgcn_fence(__ATOMIC_ACQUIRE, "agent");
    asm volatile("s_waitcnt vmcnt(0)" ::: "memory");
  }
  __syncthreads();
}

template <class Epi, class Sched, bool G>
DEV void run_gemm(float* lds, int K, const Sched& S, const Epi& E) {
  __syncthreads();
  pg8::gemm_phase<Epi, Sched, G>((PG8_LAS unsigned char*)lds, K, S, E);
  __syncthreads();
}

#if defined(__HIP_DEVICE_COMPILE__)
typedef __attribute__((address_space(4))) const Params* kargs_ptr;
DEV kargs_ptr kargs() { kargs_ptr k = (kargs_ptr)__builtin_amdgcn_kernarg_segment_ptr(); asm volatile("" : "+s"(k)); return k; }
#else
typedef const Params* kargs_ptr;
__device__ inline kargs_ptr kargs() { return nullptr; }
#endif
__global__ void __launch_bounds__(NTHR, 2) fwd_megakernel(Params p_by_value_unused) {
#define p (*kargs())
  extern __shared__ __attribute__((aligned(16))) float lds[];
  cg::grid_group grid = cg::this_grid();
  const int bid = blockIdx.x, nb = gridDim.x;
  char* const wsx = p.ws;
  int tsn = 0;
  unsigned gb_n = 0;
#define GBAR() do { ++gb_n; grid_barrier((unsigned*)(wsx + OFF_CNT), gb_n * (unsigned)nb); } while (0)
#define STAMP() do { if (TP_LO >= 0) { if (bid == 0 && threadIdx.x == 0) ((unsigned long long*)(wsx + OFF_NORM))[tsn] = __builtin_amdgcn_s_memrealtime(); ++tsn; } } while (0)
  STAMP();
  if (TP_LO == 100 && bid == 0 && threadIdx.x < 16) ((unsigned long long*)(wsx + OFF_NORM + 512))[threadIdx.x] = 0ull;
  char* const ws = p.ws;
  constexpr size_t MB = 1048576;
#define b_mod   ((float*)(ws + OFF_MOD))
#define b_rstdc ((float*)(ws + OFF_RSTDC))
#define b_sctx  ((float*)(ws + OFF_SCTX))
#define b_BS    ((float*)(ws + OFF_BS))
#define b_aff   ((float*)(ws + OFF_AFF))
#define b_idx   ((int*)(ws + OFF_IDX))
#define b_gate  ((float*)(ws + OFF_GATE))
#define b_HC    ((bf16_t*)(ws + OFF_A1 + 244 * MB))
#define b_CC    ((bf16_t*)(ws + OFF_A1 + 240 * MB))
#define b_kfu   ((float*)(ws + OFF_KFU))
#define b_sel   ((int*)(ws + OFF_SEL))
#define b_winT  ((const char*)(ws + OFF_WINT))
#define b_hpT   ((const char*)(ws + OFF_HPT))
#define b_rpT   ((const char*)(ws + OFF_RPT))
#define b_woT   ((const char*)(ws + OFF_WOT))
#define b_w13T  ((const char*)(ws + OFF_W13T))
#define b_w2T   ((const char*)(ws + OFF_W2T))
#define b_hb    ((bf16_t*)(ws + OFF_A0))
#define b_A1    (ws + OFF_A1)
#define b_HYT   ((bf16_t*)(b_A1))
#define b_RWC   ((bf16_t*)(b_A1 + 96 * MB))
#define b_HYOT  ((bf16_t*)(b_A1 + 208 * MB))
#define b_HYO   ((bf16_t*)(b_A1))
#define b_RWO   ((bf16_t*)(b_A1 + 32 * MB))
#define b_YH    ((bf16_t*)(b_A1 + 96 * MB))
#define b_YR    ((bf16_t*)(b_A1 + 160 * MB))
#define b_PRE   ((bf16_t*)(b_A1))
#define b_HID0  ((bf16_t*)(b_A1))
#define b_YE    ((bf16_t*)(b_A1 + 128 * MB))
#define b_Y0    ((bf16_t*)(p.out + (size_t)kROWS * 512))
#define b_Y1    (b_Y0 + (size_t)kROWS * 512)
#define b_PQ    (p.out)
#define b_S0    ((float*)(ws + OFF_KFU))

  phase_mod(lds, p.in[I_C], p.in[I_CCTX], p.in[I_MODW], p.in[I_MODB], b_mod, bid, nb);
  phase_filter(lds, p, b_kfu, bid, nb);
  phase_wprep(lds, p, ws, bid, nb);
  grid.sync(); STAMP();
  phase_hb(p, b_mod, b_hb, b_HC, bid, nb);
  GBAR(); STAMP();
  {
    SchedPlain S0; if (nb == 256) S0.o.init(4, 5, 128, bid >= 128 ? bid - 128 : 1 << 20); else S0.o.init(4, 5, nb, bid);
    S0.A = (const char*)b_HC; S0.B = b_winT + (size_t)2048 * kD * 2; S0.tstep = (size_t)256 * kD * 2;
    EpiBf16Split E0{b_CC, kCC, 5, b_CC, kCC};
    SchedPlain S; S.o.init(kROWS / 256, 7, nb, bid); S.A = (const char*)b_hb; S.B = b_winT + (size_t)1536 * kD * 2; S.tstep = (size_t)256 * kD * 2;
    EpiBf16Split E{b_RWC, kRWC, 7, b_RWC, kRWC};
    run_gemm<EpiBf16Split, SchedPlain, false>(lds, kD, S, E);
    SchedPlain S2; S2.o.init(6, kROWS / 256, nb, bid); S2.A = b_winT; S2.B = (const char*)b_hb; S2.tstep = (size_t)256 * kD * 2;
    EpiBf16Split E2{b_HYT, kROWS, kROWS / 256, b_HYT, kROWS};
    run_gemm<EpiBf16Split, SchedPlain, false>(lds, kD, S2, E2);
    run_gemm<EpiBf16Split, SchedPlain, false>(lds, kD, S0, E0);
  }
  GBAR(); STAMP();
  {
    constexpr int NTA = 64 * (kNSC - 1);
    const bool bal = nb == 256, light = bal && bid >= 192;
    const int kc = light ? bid - 192 : bid;
    if (light || (!bal && bid < 64)) {
      const int dir = kc >> 5, b = (kc >> 3) & 3, h = kc & 7;
      rs::scan_task<64, false>(lds, p, b_CC, kCC, kCTX, 0, 0, 512, 1024, 1088, 512, b, h, dir, 0, 4, nullptr, b_sctx + (size_t)kc * 4096, nullptr, nullptr);
    }
    const int c0 = !bal ? bid : (light ? 192 + (bid - 192) * 5 : bid), cstep = !bal ? nb : 1, cend = !bal ? 512 : (light ? c0 + 5 : c0 + 1);
    for (int c = c0; c < cend; c += cstep) fftconv_channel(lds, p, c, b_kfu, b_HYT, b_HYOT);
    const int t0 = bid, tstep = bal ? NTA : nb, tend = (bal && light) ? 0 : NTA;
    for (int task = t0; task < tend; task += tstep) {
      const int chain = task / (kNSC - 1), sc = task % (kNSC - 1), dir = chain >> 5, b = (chain >> 3) & 3, h = chain & 7;
      rs::scan_task<128, false>(lds, p, b_RWC, kRWC, kT, 0, 512, 1024, 1536, 1600, 0, b, h, dir, sc * kSCC * 64, kSCC, nullptr, b_PQ + ((size_t)chain * kNSC + sc) * 8192, nullptr, nullptr);
    }
  }
  GBAR(); STAMP();
  if (bid < 64) scan_passB(lds, bid, b_sctx + (size_t)bid * 4096, b_PQ, b_S0);
  phase_hyo_transpose(lds, b_HYOT, b_HYO, bid, nb);
  GBAR(); STAMP();
  for (int task = bid; task < 64 * kNSC; task += nb) {
    const int chain = task / kNSC, sc = task % kNSC, dir = chain >> 5, b = (chain >> 3) & 3, h = chain & 7;
    rs::scan_task<64, true>(lds, p, b_RWC, kRWC, kT, 0, 512, 1024, 1536, 1600, 0, b, h, dir, sc * kSCC * 64, kSCC, b_S0 + (size_t)task * 4096, nullptr, b_Y0, b_BS);
  }
  GBAR(); STAMP();
  phase_rwout(lds, p, b_RWC, b_Y0, b_Y1, b_BS, b_RWO, bid, nb);
  GBAR(); STAMP();
  {
    SchedBranch S; S.o.init(kROWS / 256, 8, nb, bid); S.A0 = (const char*)b_HYO; S.B0 = b_hpT; S.A1 = (const char*)b_RWO; S.B1 = b_rpT;
    EpiBf16Split E{b_YH, kD, 4, b_YR, kD};
    run_gemm<EpiBf16Split, SchedBranch, false>(lds, 512, S, E);
  }
  GBAR(); STAMP();
  {
    SchedPlain S; S.o.init(kROWS / 256, 8, nb, bid); S.A = (const char*)b_hb; S.B = b_winT + (size_t)3328 * kD * 2; S.tstep = (size_t)256 * kD * 2;
    EpiGatesMerge E{b_YH, b_YR, b_PRE};
    run_gemm<EpiGatesMerge, SchedPlain, false>(lds, kD, S, E);
  }
  GBAR(); STAMP();
  {
    SchedPlain S; S.o.init(kROWS / 256, 4, nb, bid); S.A = (const char*)b_PRE; S.B = b_woT; S.tstep = (size_t)256 * kD * 2;
    EpiF32Store E{p.out, kD};
    run_gemm<EpiF32Store, SchedPlain, false>(lds, kD, S, E);
  }
  GBAR(); STAMP();
  phase_post(lds, p, p.out, b_hb, b_aff, b_mod, bid, nb);
  GBAR(); STAMP();
  phase_topk(lds, b_aff, b_idx, b_gate, b_sel, bid, nb);
  GBAR(); STAMP();
  for (int g = 0; g <= 4; ++g) {
    if (g < 4) {
      SchedExp1 S; S.o.init(64, 16, nb, bid); S.H2 = (const char*)b_hb; S.W13T = b_w13T; S.idx = b_idx + g * 4 * 4096; S.e0 = g * 4;
      EpiSwiGLU E{b_HID0 + (size_t)(g & 1) * 16384 * kF};
      run_gemm<EpiSwiGLU, SchedExp1, true>(lds, kD, S, E);
    }
    if (g > 0) {
      SchedExp2 S; S.o.init(64, 4, nb, bid); S.HID = (const char*)(b_HID0 + (size_t)((g - 1) & 1) * 16384 * kF); S.W2T = b_w2T; S.e0 = (g - 1) * 4;
      EpiYE E{b_YE, b_gate, (g - 1) * 4};
      run_gemm<EpiYE, SchedExp2, false>(lds, kF, S, E);
    }
    GBAR(); STAMP();
  }
  phase_final(p, b_YE, b_sel, p.out, b_mod, bid, nb, tsn);
}

#undef b_mod
#undef b_rstdc
#undef b_sctx
#undef b_BS
#undef b_aff
#undef b_idx
#undef b_gate
#undef b_CC
#undef b_HC
#undef b_kfu
#undef b_sel
#undef b_winT
#undef b_hpT
#undef b_rpT
#undef b_woT
#undef b_w13T
#undef b_w2T
#undef b_hb
#undef b_A1
#undef b_HYT
#undef b_RWC
#undef b_HYOT
#undef b_HYO
#undef b_RWO
#undef b_YH
#undef b_YR
#undef b_PRE
#undef b_HID0
#undef b_YE
#undef b_Y0
#undef b_Y1
#undef p
#undef b_PQ
#undef b_S0
extern "C" void kernel_launch(void* const* d_in, const int* in_sizes, int n_in, void* d_out, int out_size, void* d_ws, size_t ws_size,
                              hipStream_t stream) {
  static int grid_blocks = 0;
  if (!grid_blocks) {
    int dev = 0, cus = 0, per_cu = 0;
    (void)hipGetDevice(&dev);
    (void)hipDeviceGetAttribute(&cus, hipDeviceAttributeMultiprocessorCount, dev);
    (void)hipFuncSetAttribute((const void*)fwd_megakernel, hipFuncAttributeMaxDynamicSharedMemorySize, (int)LDS_BYTES);
    (void)hipOccupancyMaxActiveBlocksPerMultiprocessor(&per_cu, fwd_megakernel, NTHR, LDS_BYTES);
    if (per_cu < 1) per_cu = 1;
    if (per_cu > 1) per_cu = 1;
    grid_blocks = cus * per_cu;
    if (ws_size < WS_TOTAL) fprintf(stderr, "kernel_launch: workspace too small: %zu < %zu\n", ws_size, (size_t)WS_TOTAL);
  }
  if (ws_size < WS_TOTAL) return;
  Params p{};
  for (int i = 0; i < 38; ++i) p.in[i] = (const float*)d_in[i];
  p.out = (float*)d_out;
  p.ws = (char*)d_ws;
    (void)hipMemsetAsync((char*)d_ws + OFF_CNT, 0, 256, stream);
  void* args[] = {&p};
  hipError_t e = hipLaunchCooperativeKernel((void*)fwd_megakernel, dim3(grid_blocks), dim3(NTHR), args, LDS_BYTES, stream);
  if (e != hipSuccess) fprintf(stderr, "cooperative launch failed: %s (grid %d)\n", hipGetErrorString(e), grid_blocks);
}
```
